# Optimizing an MI355X kernel written in HIP

```python
import jax, jax.numpy as jnp
from jax import lax
import numpy as np

D_MODEL = 1024
BATCH = 32
SEQ = 2048
DEPTH = 4

HEAD_DIM = 64
DIL_PATTERNS = ((128, 1), (512, 4), (2048, 16))
DIL_HEADS = 4
N_DIL_SUB = DIL_HEADS * len(DIL_PATTERNS)
DIL_QKV = N_DIL_SUB * HEAD_DIM
DIL_OUT = DIL_HEADS * HEAD_DIM
DIL_BLOCK = 64
WIN_HALF = 128
WIN_BLOCK = 128
WIN_Q = D_MODEL
WIN_Q_HEADS = WIN_Q // HEAD_DIM
WIN_KV_HEADS = 4
WIN_KV = WIN_KV_HEADS * HEAD_DIM
N_BRANCH = 2
SPLITS = (DIL_QKV, 2 * DIL_QKV, 3 * DIL_QKV,
          3 * DIL_QKV + WIN_Q, 3 * DIL_QKV + WIN_Q + WIN_KV, 3 * DIL_QKV + WIN_Q + 2 * WIN_KV)
IN_COLS = 3 * DIL_QKV + WIN_Q + 2 * WIN_KV + N_BRANCH * D_MODEL
N_EXPERTS = 16
CAPACITY_FACTOR = 2
D_EXPERT = 1024
RMS_EPS = 1e-6
NEG_INF = -1e30

kernel_name = "hybrid_dilated_window_ec_moe_encoder"


def rmsnorm(x, g):
    xf = x.astype(jnp.float32)
    y = xf * lax.rsqrt(jnp.mean(xf * xf, axis=-1, keepdims=True) + RMS_EPS)
    return (y * g.astype(jnp.float32)).astype(x.dtype)


def alibi_slopes(n):
    return 2.0 ** (-8.0 * jnp.arange(1, n + 1, dtype=jnp.float32) / n)


def banded_attention(q, k, v, half, blk, slopes, pos_scale, sink=None):
    N, L, H, dh = q.shape
    Hk = k.shape[2]
    G = H // Hk
    nb = -(-L // blk)
    Lp = nb * blk
    pad = Lp - L
    qb = jnp.pad(q, ((0, 0), (0, pad), (0, 0), (0, 0))).reshape(N, nb, blk, Hk, G, dh)

    def key_blocks(t):
        tp = jnp.pad(t, ((0, 0), (blk, pad + blk), (0, 0), (0, 0)))
        return jnp.concatenate([
            tp[:, :Lp].reshape(N, nb, blk, Hk, dh),
            tp[:, blk:blk + Lp].reshape(N, nb, blk, Hk, dh),
            tp[:, 2 * blk:].reshape(N, nb, blk, Hk, dh)], axis=2)

    kb = key_blocks(k)
    vb = key_blocks(v)
    a = jnp.arange(blk)[:, None]
    b = jnp.arange(3 * blk)[None, :]
    rel = b - blk - a
    kpos = (jnp.arange(nb)[:, None, None] - 1) * blk + b[None]
    mask = (jnp.abs(rel) <= half)[None] & (kpos >= 0) & (kpos < L)
    bias = -slopes.astype(jnp.float32).reshape(Hk, G)[:, :, None, None] * \
        (pos_scale * jnp.abs(rel)).astype(jnp.float32)[None, None]
    s = jnp.einsum('nibkgd,nijkd->nikgbj', qb, kb).astype(jnp.float32) * (dh ** -0.5) + bias
    s = jnp.where(mask[None, :, None, None], s, NEG_INF)
    m = jnp.max(s, axis=-1)
    if sink is not None:
        sk = sink.astype(jnp.float32).reshape(Hk, G)[:, :, None]
        m = jnp.maximum(m, sk)
    p = jnp.exp(s - m[..., None])
    denom = jnp.sum(p, axis=-1)
    if sink is not None:
        denom = denom + jnp.exp(sk - m)
    p = p / denom[..., None]
    o = jnp.einsum('nikgbj,nijkd->nibkgd', p.astype(v.dtype), vb)
    o = o.reshape(N, Lp, H, dh)[:, :L]
    lse = jnp.moveaxis(m + jnp.log(denom), -1, 2).reshape(N, Lp, H)[:, :L]
    return o, lse


def dilated_mixture(q, k, v):
    B, S = q.shape[:2]
    slopes = alibi_slopes(N_DIL_SUB)
    outs, lses = [], []
    for g, (w, r) in enumerate(DIL_PATTERNS):
        sl = slice(g * DIL_HEADS, (g + 1) * DIL_HEADS)

        def strided(t):
            return t[:, :, sl].reshape(B, S // r, r, DIL_HEADS, HEAD_DIM).transpose(0, 2, 1, 3, 4) \
                .reshape(B * r, S // r, DIL_HEADS, HEAD_DIM)

        o, lse = banded_attention(strided(q), strided(k), strided(v), w // (2 * r), DIL_BLOCK,
                                  slopes[sl], r)
        outs.append(o.reshape(B, r, S // r, DIL_HEADS, HEAD_DIM).transpose(0, 2, 1, 3, 4)
                    .reshape(B, S, DIL_HEADS, HEAD_DIM))
        lses.append(lse.reshape(B, r, S // r, DIL_HEADS).transpose(0, 2, 1, 3).reshape(B, S, DIL_HEADS))
    wts = jax.nn.softmax(jnp.stack(lses, axis=0), axis=0)
    return jnp.sum(wts[..., None].astype(q.dtype) * jnp.stack(outs, axis=0), axis=0)


def hybrid_mixer(h, w_in, w_branch_a, w_branch_b, b_gate, sink_logit, w_out):
    B, S, D = h.shape
    proj = jnp.einsum('bsd,dc->bsc', h, w_in)
    qa, ka, va, qw, kw, vw, gates = jnp.split(proj, SPLITS, axis=-1)
    oa = dilated_mixture(qa.reshape(B, S, N_DIL_SUB, HEAD_DIM),
                         ka.reshape(B, S, N_DIL_SUB, HEAD_DIM),
                         va.reshape(B, S, N_DIL_SUB, HEAD_DIM))
    ya = jnp.einsum('bsc,cd->bsd', oa.reshape(B, S, DIL_OUT), w_branch_a)
    ob, _ = banded_attention(qw.reshape(B, S, WIN_Q_HEADS, HEAD_DIM),
                             kw.reshape(B, S, WIN_KV_HEADS, HEAD_DIM),
                             vw.reshape(B, S, WIN_KV_HEADS, HEAD_DIM),
                             WIN_HALF, WIN_BLOCK, alibi_slopes(WIN_Q_HEADS), 1, sink_logit)
    yb = jnp.einsum('bsc,cd->bsd', ob.reshape(B, S, WIN_Q), w_branch_b)
    g = jax.nn.sigmoid((gates + b_gate).astype(jnp.float32)).astype(h.dtype).reshape(B, S, N_BRANCH, D)
    merged = g[:, :, 0] * ya + g[:, :, 1] * yb
    return jnp.einsum('bsd,de->bse', merged, w_out)


def expert_choice_ffn(h, w_router, w_gate, w_up, w_down):
    B, S, D = h.shape
    cap = CAPACITY_FACTOR * S // N_EXPERTS
    aff = jax.nn.softmax(jnp.einsum('bsd,de->bse', h, w_router).astype(jnp.float32), axis=-1)
    gate, idx = lax.top_k(jnp.swapaxes(aff, 1, 2), cap)
    bidx = jnp.arange(B)[:, None, None]
    xe = h[bidx, idx]
    a = jnp.einsum('becd,edf->becf', xe, w_gate)
    u = jnp.einsum('becd,edf->becf', xe, w_up)
    ye = jnp.einsum('becf,efd->becd', jax.nn.silu(a) * u, w_down)
    return jnp.zeros_like(h).at[bidx, idx].add(gate[..., None].astype(h.dtype) * ye)


def setup_inputs(seed: int = 0) -> dict:
    key = jax.random.key(seed)
    ks = jax.random.split(key, 14)
    f = jnp.float32
    return {
        "x": jax.random.normal(ks[0], (BATCH, SEQ, D_MODEL), f),
        "norm_mix": 1.0 + 0.02 * jax.random.normal(ks[1], (DEPTH, D_MODEL), f),
        "w_in": jax.random.normal(ks[2], (DEPTH, D_MODEL, IN_COLS), f) * D_MODEL ** -0.5,
        "w_branch_a": jax.random.normal(ks[3], (DEPTH, DIL_OUT, D_MODEL), f) * DIL_OUT ** -0.5,
        "w_branch_b": jax.random.normal(ks[4], (DEPTH, WIN_Q, D_MODEL), f) * WIN_Q ** -0.5,
        "b_gate": 0.1 * jax.random.normal(ks[5], (DEPTH, N_BRANCH * D_MODEL), f),
        "sink_logit": 0.5 * jax.random.normal(ks[6], (DEPTH, WIN_Q_HEADS), f),
        "w_out": jax.random.normal(ks[7], (DEPTH, D_MODEL, D_MODEL), f) * D_MODEL ** -0.5,
        "norm_ffn": 1.0 + 0.02 * jax.random.normal(ks[8], (DEPTH, D_MODEL), f),
        "w_router": jax.random.normal(ks[9], (DEPTH, D_MODEL, N_EXPERTS), f) * D_MODEL ** -0.5,
        "w_expert_gate": jax.random.normal(ks[10], (DEPTH, N_EXPERTS, D_MODEL, D_EXPERT), f) * D_MODEL ** -0.5,
        "w_expert_up": jax.random.normal(ks[11], (DEPTH, N_EXPERTS, D_MODEL, D_EXPERT), f) * D_MODEL ** -0.5,
        "w_expert_down": jax.random.normal(ks[12], (DEPTH, N_EXPERTS, D_EXPERT, D_MODEL), f) * D_EXPERT ** -0.5,
        "norm_final": 1.0 + 0.02 * jax.random.normal(ks[13], (D_MODEL,), f),
    }


def reference(x, norm_mix, w_in, w_branch_a, w_branch_b, b_gate, sink_logit, w_out,
              norm_ffn, w_router, w_expert_gate, w_expert_up, w_expert_down, norm_final):
    h = x
    for l in range(DEPTH):
        h = h + hybrid_mixer(rmsnorm(h, norm_mix[l]), w_in[l], w_branch_a[l], w_branch_b[l],
                             b_gate[l], sink_logit[l], w_out[l])
        h = h + expert_choice_ffn(rmsnorm(h, norm_ffn[l]), w_router[l], w_expert_gate[l],
                                  w_expert_up[l], w_expert_down[l])
    return rmsnorm(h, norm_final)
```

```cpp
#include <hip/hip_runtime.h>
#include <cstdio>
#include <cstdint>
typedef __bf16 nbf16x2 __attribute__((ext_vector_type(2)));
typedef __bf16 nbf16x4 __attribute__((ext_vector_type(4)));
typedef __bf16 nbf16x8 __attribute__((ext_vector_type(8)));
typedef float f32x2_t __attribute__((ext_vector_type(2)));
typedef float f32x8_t __attribute__((ext_vector_type(8)));
__device__ __forceinline__ unsigned pk2bf(float lo, float hi) { f32x2_t v = {lo, hi}; return __builtin_bit_cast(unsigned, __builtin_convertvector(v, nbf16x2)); }
__device__ __forceinline__ float bflo(unsigned w) { return __builtin_bit_cast(float, w << 16); }
__device__ __forceinline__ float bfhi(unsigned w) { return __builtin_bit_cast(float, w & 0xffff0000u); }
namespace pg8 {
#define PG8_LAS __attribute__((address_space(3)))
typedef unsigned short bf16_t;
typedef short bf16x8 __attribute__((ext_vector_type(8)));
typedef float f32x4 __attribute__((ext_vector_type(4)));
typedef unsigned u32x4 __attribute__((ext_vector_type(4)));
constexpr int BM = 256, BK = 64, HALF = 128, HTB = HALF * BK * 2  , STAGE_BYTES = 8 * HTB, NXCD = 8;
#ifndef PG8_WGM
#define PG8_WGM 8
#endif
#ifndef PG8_WGM_G
#define PG8_WGM_G 8
#endif
constexpr int WGM = PG8_WGM, WGM_G = PG8_WGM_G;

__host__ __device__ __forceinline__ int lds_byte(int r, int c) { const int st = (r >> 4) * 2 + (c >> 5), rr = r & 15, cc = c & 31, ob = rr * 64 + cc * 2; return st * 1024 + (ob ^ (((ob >> 9) & 1) << 5)); }
__host__ __device__ __forceinline__ void stage_rc(int b, int& R, int& C) { const int st = b / 1024, sb = b % 1024, swz = sb ^ (((sb >> 9) & 1) << 5); R = (st >> 1) * 16 + swz / 64; C = (st & 1) * 32 + (swz % 64) / 2; }
__host__ __device__ __forceinline__ int perm32(int rho) { const int n = rho >> 4, i = rho & 15; return 8 * (i >> 2) + 4 * n + (i & 3); }

struct Unit { int pm, pn; };
struct Gemm { const bf16_t* A; const bf16_t* Bt; int M, N, K; };

struct StaticOrder {
    int nM, nN, nwg, G, c;
    __host__ __device__ void init(int M, int N, int G_, int c_) { nM = M / BM; nN = N / BM; nwg = nM * nN; G = G_; c = c_; }
    __host__ __device__ bool next(int i, Unit& u) const {
        const long L = (long)i * G + c; if (L >= nwg) return false;
        int wgid = (int)L; { const int q = nwg / NXCD, r = nwg % NXCD, xcd = wgid % NXCD, off = wgid / NXCD; wgid = (xcd < r ? xcd * (q + 1) : r * (q + 1) + (xcd - r) * q) + off; }
        const int nig = WGM * nN, gid = wgid / nig, fm = gid * WGM, gsz = (nM - fm) < WGM ? (nM - fm) : WGM;
        u.pm = fm + ((wgid % nig) % gsz); u.pn = (wgid % nig) / gsz; return true;
    }
    __device__ __forceinline__ void a_ready(const Unit&) const {}
    __device__ __forceinline__ void done(const Unit&) const {}
};

struct GroupedOrder {
    int nMg, nNg, upg, ntot, G, c;
    __host__ __device__ void init(int ngrp, int nMg_, int nNg_, int G_, int c_) { nMg = nMg_; nNg = nNg_; upg = nMg * nNg; ntot = ngrp * upg; G = G_; c = c_; }
    __host__ __device__ bool next(int i, Unit& u) const {
        const long L = (long)i * G + c; if (L >= ntot) return false;
        const int e = (int)(L / upg); int wgid = (int)(L % upg);
        { const int q = upg / NXCD, r = upg % NXCD, xcd = wgid % NXCD, off = wgid / NXCD; wgid = (xcd < r ? xcd * (q + 1) : r * (q + 1) + (xcd - r) * q) + off; }
        const int nig = WGM_G * nNg, gid = wgid / nig, fm = gid * WGM_G, gsz = (nMg - fm) < WGM_G ? (nMg - fm) : WGM_G;
        u.pm = e * nMg + fm + ((wgid % nig) % gsz); u.pn = e * nNg + (wgid % nig) / gsz; return true;
    }
    __device__ __forceinline__ void a_ready(const Unit&) const {}
    __device__ __forceinline__ void done(const Unit&) const {}
};

#ifndef EPI_NT
#define EPI_NT 0
#endif
#if EPI_NT
#define EPI_ST(ptr, val) __builtin_nontemporal_store((val), (ptr))
#else
#define EPI_ST(ptr, val) (*(ptr) = (val))
#endif
#ifndef EPI_NT_B
#define EPI_NT_B 0
#endif
#if EPI_NT_B
#define EPI_ST_B(ptr, val) __builtin_nontemporal_store((val), (ptr))
#else
#define EPI_ST_B(ptr, val) (*(ptr) = (val))
#endif
__device__ __forceinline__ u32x4 pack8(const f32x4 a, const f32x4 b) { u32x4 w; w.x = pk2bf(a[0], a[1]); w.y = pk2bf(a[2], a[3]); w.z = pk2bf(b[0], b[1]); w.w = pk2bf(b[2], b[3]); return w; }
__device__ __forceinline__ void unpack8(const u32x4 w, f32x4& a, f32x4& b) { a = (f32x4){bflo(w.x), bfhi(w.x), bflo(w.y), bfhi(w.y)}; b = (f32x4){bflo(w.z), bfhi(w.z), bflo(w.w), bfhi(w.w)}; }
__device__ __forceinline__ float sigmoidf_fast(float x) { return __builtin_amdgcn_rcpf(1.0f + __builtin_amdgcn_exp2f(-1.4426950408889634f * x)); }

__device__ __forceinline__ size_t gate_blk(int pm, int pn, int wave, int ai, int m, int bj, int lane) { return ((size_t)(((pm * 4 + pn) * 8 + wave) * 16 + (ai * 8 + m * 2 + bj)) * 64 + lane) * 8; }
__device__ __forceinline__ u32x4 xchg_pair(const u32x4 v) { u32x4 r;
#pragma unroll
    for (int w = 0; w < 4; ++w) r[w] = (unsigned)__builtin_amdgcn_mov_dpp((int)v[w], 0xB1, 0xF, 0xF, true);
    return r; }
__device__ __forceinline__ void wide_pair(const u32x4 p0, const u32x4 p1, bool odd, u32x4& a, u32x4& b) {
    const u32x4 recv = xchg_pair(odd ? p0 : p1); a = odd ? recv : p0; b = odd ? p1 : recv; }
struct EpiInProj {
    static constexpr bool PERM = true, AFTER_DRAIN = false, WIDE = false;
    bf16_t *qa, *ka, *va, *qw, *kw, *vw, *gr, *g1; const float* bgate; float qscale;
    __device__ __forceinline__ void operator()(const f32x4 (&acc)[2][2][4][2], const Unit& u, int wr, int wc, int fr, int fq) const {
        const int pn = u.pn; const int row0 = u.pm * BM + wr * 64 + fr;
        if (pn >= 15) {
            const int cc0 = (pn - 15) * HALF + wc * 32 + 8 * fq;
            f32x4 b0[2], b1[2];
#pragma unroll
            for (int n = 0; n < 2; ++n) { b0[n] = *(const f32x4*)(bgate + cc0 + 4 * n); b1[n] = *(const f32x4*)(bgate + 1024 + cc0 + 4 * n); }
#pragma unroll
            for (int ai = 0; ai < 2; ++ai)
#pragma unroll
                for (int m = 0; m < 4; ++m) { const size_t off = gate_blk(u.pm, (pn - 15) >> 1, wr * 4 + wc, ai, m, (pn - 15) & 1, fq * 16 + fr); f32x4 rr[2], gg[2];
#pragma unroll
                    for (int n = 0; n < 2; ++n)
#pragma unroll
                        for (int j = 0; j < 4; ++j) { float a0 = acc[ai][0][m][n][j] + b0[n][j], a1 = acc[ai][1][m][n][j] + b1[n][j];
                            a0 = fminf(fmaxf(a0, -30.f), 30.f); a1 = fminf(fmaxf(a1, -30.f), 30.f);
                            const float e0 = __builtin_amdgcn_exp2f(-1.4426950408889634f * a0), e1 = __builtin_amdgcn_exp2f(-1.4426950408889634f * a1);
                            gg[n][j] = __builtin_amdgcn_rcpf(1.0f + e1); rr[n][j] = (1.0f + e1) * __builtin_amdgcn_rcpf(1.0f + e0); }
                    EPI_ST_B((u32x4*)(gr + off), pack8(rr[0], rr[1])); EPI_ST_B((u32x4*)(g1 + off), pack8(gg[0], gg[1])); }
            return;
        }
        bf16_t* base; int ldc, ct; float sc = 1.0f;
        if (pn < 3) { base = qa; ldc = 768; ct = pn; sc = qscale; }
        else if (pn < 6) { base = ka; ldc = 768; ct = pn - 3; }
        else if (pn < 9) { base = va; ldc = 768; ct = pn - 6; }
        else if (pn < 13) { base = qw; ldc = 1024; ct = pn - 9; sc = qscale; }
        else if (pn == 13) { base = kw; ldc = 256; ct = 0; }
        else { base = vw; ldc = 256; ct = 0; }
        const int col0 = ct * BM + wc * 32 + 8 * fq;
#pragma unroll
        for (int ai = 0; ai < 2; ++ai)
#pragma unroll
            for (int m = 0; m < 4; ++m) { bf16_t* rowp = base + (size_t)(row0 + ai * HALF + m * 16) * ldc + col0;
#pragma unroll
                for (int bj = 0; bj < 2; ++bj) EPI_ST_B((u32x4*)(rowp + bj * HALF), pack8(acc[ai][bj][m][0] * sc, acc[ai][bj][m][1] * sc)); }
    }
};
struct EpiMergeDual {
    static constexpr bool PERM = true, AFTER_DRAIN = false, WIDE = true;
    bf16_t* merged; const bf16_t* gr; const bf16_t* g1;
    __device__ __forceinline__ size_t gblk(const Unit& u, int wr, int wc, int ai, int m, int bj, int fr, int fq) const { return gate_blk(u.pm, u.pn, wr * 4 + 2 * (wc & 1) + bj, ai, m, wc >> 1, fq * 16 + fr); }
    __device__ __forceinline__ void mid(f32x4 (&acc)[2][2][4][2], const Unit& u, int wr, int wc, int fr, int fq) const {
        u32x4 w[2][4][2];
#pragma unroll
        for (int ai = 0; ai < 2; ++ai)
#pragma unroll
            for (int m = 0; m < 4; ++m) {
#pragma unroll
                for (int bj = 0; bj < 2; ++bj) w[ai][m][bj] = *(const u32x4*)(gr + gblk(u, wr, wc, ai, m, bj, fr, fq)); }
        asm volatile("" ::: "memory");
#pragma unroll
        for (int ai = 0; ai < 2; ++ai)
#pragma unroll
            for (int m = 0; m < 4; ++m) {
#pragma unroll
                for (int bj = 0; bj < 2; ++bj) { f32x4 r0, r1; unpack8(w[ai][m][bj], r0, r1); acc[ai][bj][m][0] *= r0; acc[ai][bj][m][1] *= r1; } }
    }
    __device__ __forceinline__ void operator()(const f32x4 (&acc)[2][2][4][2], const Unit& u, int wr, int wc, int fr, int fq) const {
        const bool odd = (fr & 1) != 0;
        const int rowe = u.pm * BM + wr * 64 + (fr & ~1), col = u.pn * BM + wc * 64 + 8 * fq + (odd ? 32 : 0);
        u32x4 w[2][4][2];
#pragma unroll
        for (int ai = 0; ai < 2; ++ai)
#pragma unroll
            for (int m = 0; m < 4; ++m) {
#pragma unroll
                for (int bj = 0; bj < 2; ++bj) w[ai][m][bj] = *(const u32x4*)(g1 + gblk(u, wr, wc, ai, m, bj, fr, fq)); }
        asm volatile("" ::: "memory");
#pragma unroll
        for (int ai = 0; ai < 2; ++ai)
#pragma unroll
            for (int m = 0; m < 4; ++m) { f32x4 a0, a1, c0, c1; unpack8(w[ai][m][0], a0, a1); unpack8(w[ai][m][1], c0, c1);
                u32x4 a, b; wide_pair(pack8(acc[ai][0][m][0] * a0, acc[ai][0][m][1] * a1), pack8(acc[ai][1][m][0] * c0, acc[ai][1][m][1] * c1), odd, a, b);
                bf16_t* p = merged + (size_t)(rowe + ai * HALF + m * 16) * 1024 + col;
                EPI_ST((u32x4*)p, a); EPI_ST((u32x4*)(p + 1024), b); }
    }
};
struct EpiResid {
    static constexpr bool PERM = true, AFTER_DRAIN = false, WIDE = true;
    const bf16_t* base; bf16_t* out;
    __device__ __forceinline__ void operator()(const f32x4 (&acc)[2][2][4][2], const Unit& u, int wr, int wc, int fr, int fq) const {
        const bool odd = (fr & 1) != 0;
        const int rowe = u.pm * BM + wr * 64 + (fr & ~1), col = u.pn * BM + wc * 64 + 8 * fq + (odd ? 32 : 0);
        u32x4 la[2][4], lb[2][4];
#pragma unroll
        for (int ai = 0; ai < 2; ++ai)
#pragma unroll
            for (int m = 0; m < 4; ++m) { const bf16_t* p = base + (size_t)(rowe + ai * HALF + m * 16) * 1024 + col; la[ai][m] = *(const u32x4*)p; lb[ai][m] = *(const u32x4*)(p + 1024); }
        asm volatile("" ::: "memory");
#pragma unroll
        for (int ai = 0; ai < 2; ++ai)
#pragma unroll
            for (int m = 0; m < 4; ++m) {
                const u32x4 recv = xchg_pair(odd ? la[ai][m] : lb[ai][m]); const u32x4 r0 = odd ? recv : la[ai][m], r1 = odd ? lb[ai][m] : recv;
                f32x4 b0, b1, c0, c1; unpack8(r0, b0, b1); unpack8(r1, c0, c1);
                u32x4 a, b; wide_pair(pack8(b0 + acc[ai][0][m][0], b1 + acc[ai][0][m][1]), pack8(c0 + acc[ai][1][m][0], c1 + acc[ai][1][m][1]), odd, a, b);
                bf16_t* p = out + (size_t)(rowe + ai * HALF + m * 16) * 1024 + col;
                EPI_ST((u32x4*)p, a); EPI_ST((u32x4*)(p + 1024), b); }
    }
};
struct EpiSwiGLU {
    static constexpr bool PERM = true, AFTER_DRAIN = false, WIDE = false;
    bf16_t* act;
    __device__ __forceinline__ void operator()(const f32x4 (&acc)[2][2][4][2], const Unit& u, int wr, int wc, int fr, int fq) const {
        const int row0 = u.pm * BM + wr * 64 + fr, col0 = (u.pn & 7) * HALF + wc * 32 + 8 * fq;
#pragma unroll
        for (int ai = 0; ai < 2; ++ai)
#pragma unroll
            for (int m = 0; m < 4; ++m) { f32x4 o[2];
#pragma unroll
                for (int n = 0; n < 2; ++n)
#pragma unroll
                    for (int j = 0; j < 4; ++j) { const float a = acc[ai][0][m][n][j], up = acc[ai][1][m][n][j]; o[n][j] = a * sigmoidf_fast(a) * up; }
                EPI_ST((u32x4*)(act + (size_t)(row0 + ai * HALF + m * 16) * 1024 + col0), pack8(o[0], o[1])); }
    }
};
struct EpiDown {
    static constexpr bool PERM = true, AFTER_DRAIN = false, WIDE = true;
    bf16_t* y; const PG8_LAS float* glds; mutable int ui;
    __device__ __forceinline__ void operator()(const f32x4 (&acc)[2][2][4][2], const Unit& u, int wr, int wc, int fr, int fq) const {
        const bool odd = (fr & 1) != 0;
        const int rowe = u.pm * BM + wr * 64 + (fr & ~1), col = (u.pn & 3) * BM + wc * 64 + 8 * fq + (odd ? 32 : 0);
#pragma unroll
        for (int ai = 0; ai < 2; ++ai)
#pragma unroll
            for (int m = 0; m < 4; ++m) { const float gv = glds[ui * 256 + wr * 64 + fr + ai * HALF + m * 16];
                u32x4 a, b; wide_pair(pack8(acc[ai][0][m][0] * gv, acc[ai][0][m][1] * gv), pack8(acc[ai][1][m][0] * gv, acc[ai][1][m][1] * gv), odd, a, b);
                bf16_t* p = y + (size_t)(rowe + ai * HALF + m * 16) * 1024 + col;
                EPI_ST((u32x4*)p, a); EPI_ST((u32x4*)(p + 1024), b); }
        ++ui;
    }
};

template <class Epi, class Sched, bool ALIGN_EPI = false, bool SP2 = false, bool GATHER = false>
__device__ __forceinline__ void gemm_phase(int tid_, PG8_LAS unsigned char* lds, const Gemm g, const Sched& S, const Epi& E, const PG8_LAS int* arow = nullptr) {
    static_assert(!GATHER || SP2, "GATHER is written for the SP2 loop");
    asm volatile("" : "+v"(tid_));
    const int tid = tid_, wid = __builtin_amdgcn_readfirstlane(tid >> 6), lane = tid & 63, wr = wid >> 2, wc = wid & 3, fr = lane & 15, fq = lane >> 4;
    const int K = g.K, nt = K / BK;
    unsigned voffA[2], voffB[2];
#pragma unroll
    for (int i = 0; i < 2; ++i) { int R, C; stage_rc(tid * 16 + i * 8192, R, C); const int Rb = Epi::WIDE ? ((R >> 5) * 64 + perm32(R & 31)) : (Epi::PERM ? ((R & ~31) + perm32(R & 31)) : R);
        voffA[i] = (unsigned)(R * K + C) * 2u; voffB[i] = (unsigned)(Rb * K + C) * 2u; }
    unsigned vA0[2] = {voffA[0], voffA[1]}, vA1[2] = {voffA[0], voffA[1]}, nA0[2] = {voffA[0], voffA[1]}, nA1[2] = {voffA[0], voffA[1]};
    int gR[2], gC[2];
#pragma unroll
    for (int i = 0; i < 2; ++i) { stage_rc(tid * 16 + i * 8192, gR[i], gC[i]); }
#define PG8_GOFF(dst0, dst1, u_) do { _Pragma("unroll") for (int _i = 0; _i < 2; ++_i) { \
        dst0[_i] = ((unsigned)arow[(u_) * 256 + gR[_i]] * (unsigned)K + (unsigned)gC[_i]) * 2u; dst1[_i] = ((unsigned)arow[(u_) * 256 + HALF + gR[_i]] * (unsigned)K + (unsigned)gC[_i]) * 2u; } } while (0)
    const size_t kstep = (size_t)(BK * 2);
    const size_t hstep = (size_t)HALF * K * 2;
    const size_t tstep = 2 * hstep;
    const size_t bhs = Epi::WIDE ? (size_t)32 * K * 2 : hstep;
    const size_t ahs = GATHER ? (size_t)0 : hstep, atstep = GATHER ? (size_t)0 : tstep;
    const unsigned ldsw = (unsigned)wid * 1024u;
    const int aoff = lds_byte(wr * 64 + fr, fq * 8), boff = lds_byte(wc * 32 + fr, fq * 8);
#define PG8_SA(b, h) (((b) * 2 + (h)) * HTB)
#define PG8_SB(b, h) ((4 + (b) * 2 + (h)) * HTB)
#define PG8_STAGE(bufoff, gbase, voff) do { _Pragma("unroll") for (int _i = 0; _i < 2; ++_i) \
        __builtin_amdgcn_global_load_lds((const unsigned*)((const char*)(gbase) + (voff)[_i]), (PG8_LAS unsigned*)(lds + (bufoff) + ldsw + _i * 8192), 16, 0, 0); } while (0)
#define PG8_LDA(dst, b, h) do { _Pragma("unroll") for (int m = 0; m < 4; ++m) _Pragma("unroll") for (int k = 0; k < 2; ++k) dst[m][k] = *(const PG8_LAS bf16x8*)(lds + PG8_SA(b, h) + aoff + m * 2048 + k * 1024); } while (0)
#define PG8_LDB(dst, b, h) do { _Pragma("unroll") for (int n = 0; n < 2; ++n) _Pragma("unroll") for (int k = 0; k < 2; ++k) dst[n][k] = *(const PG8_LAS bf16x8*)(lds + PG8_SB(b, h) + boff + n * 2048 + k * 1024); } while (0)
#define PG8_MMA(ai, bj, At, Bt) do { __builtin_amdgcn_s_setprio(1); _Pragma("unroll") for (int m = 0; m < 4; ++m) _Pragma("unroll") for (int n = 0; n < 2; ++n) _Pragma("unroll") for (int k = 0; k < 2; ++k) \
        acc[ai][bj][m][n] = __builtin_amdgcn_mfma_f32_16x16x32_bf16(Bt[n][k], At[m][k], acc[ai][bj][m][n], 0, 0, 0); __builtin_amdgcn_s_setprio(0); } while (0)
#define PG8_WAIT_V(n) asm volatile("s_waitcnt vmcnt(" #n ")" ::: "memory")
#define PG8_WAIT_L(n) asm volatile("s_waitcnt lgkmcnt(" #n ")" ::: "memory")
#define PG8_BAR __builtin_amdgcn_s_barrier()
#define PG8_SCHED __builtin_amdgcn_sched_barrier(0)
    Unit cur, nxt; int ui = 0;
    if (!S.next(0, cur)) return;
    f32x4 acc[2][2][4][2];
#pragma unroll
    for (int a = 0; a < 2; ++a)
#pragma unroll
        for (int b = 0; b < 2; ++b)
#pragma unroll
            for (int m = 0; m < 4; ++m)
#pragma unroll
                for (int n = 0; n < 2; ++n) acc[a][b][m][n] = (f32x4){0.f, 0.f, 0.f, 0.f};
    bf16x8 At[4][2], B0[2][2], B1[2][2];
    const char* cA = (const char*)g.A + (size_t)cur.pm * atstep; const char* cB = (const char*)g.Bt + (size_t)cur.pn * tstep;
    if constexpr (GATHER) { PG8_GOFF(vA0, vA1, 0); }
    S.a_ready(cur);
    if constexpr (SP2) {
        PG8_STAGE(PG8_SB(0, 0), cB, voffB); PG8_STAGE(PG8_SB(0, 1), cB + bhs, voffB); PG8_STAGE(PG8_SA(0, 0), cA, vA0); PG8_STAGE(PG8_SA(0, 1), cA + ahs, vA1);
        if (wr == 1) PG8_BAR;
        PG8_WAIT_V(2); PG8_BAR;
        PG8_STAGE(PG8_SB(1, 0), cB + kstep, voffB); PG8_STAGE(PG8_SA(1, 0), cA + kstep, vA0); PG8_STAGE(PG8_SB(1, 1), cB + bhs + kstep, voffB);
        PG8_WAIT_V(6); PG8_BAR;
    } else {
        PG8_STAGE(PG8_SB(0, 0), cB, voffB); PG8_STAGE(PG8_SA(0, 0), cA, voffA); PG8_STAGE(PG8_SB(0, 1), cB + bhs, voffB); PG8_STAGE(PG8_SA(0, 1), cA + hstep, voffA);
        if (wr == 1) PG8_BAR;
        PG8_WAIT_V(4); PG8_BAR;
        PG8_STAGE(PG8_SB(1, 0), cB + kstep, voffB); PG8_STAGE(PG8_SA(1, 0), cA + kstep, voffA); PG8_STAGE(PG8_SB(1, 1), cB + bhs + kstep, voffB);
        PG8_WAIT_V(6); PG8_BAR;
    }
    for (;;) {
        const bool has_next = S.next(ui + 1, nxt);
        const char* nA = has_next ? (const char*)g.A + (size_t)nxt.pm * atstep : cA; const char* nB = has_next ? (const char*)g.Bt + (size_t)nxt.pn * tstep : cB;
#pragma unroll 1
        for (int t = 0; t < nt; t += 2) {
            const bool last = (t == nt - 2);
            const char* a1 = cA + (size_t)(t + 1) * kstep;
            const char* a2 = last ? nA : cA + (size_t)(t + 2) * kstep; const char* b2 = last ? nB : cB + (size_t)(t + 2) * kstep;
            const char* a3 = a2 + kstep; const char* b3 = b2 + kstep;
            if (last && has_next) S.a_ready(nxt);
            unsigned s0[2] = {vA0[0], vA0[1]}, s1[2] = {vA1[0], vA1[1]};
            if constexpr (GATHER) { if (last && has_next) { PG8_GOFF(nA0, nA1, ui + 1); s0[0] = nA0[0]; s0[1] = nA0[1]; s1[0] = nA1[0]; s1[1] = nA1[1]; } }
            if constexpr (SP2) {
            PG8_LDB(B0, 0, 0); PG8_LDB(B1, 0, 1); PG8_SCHED; PG8_LDA(At, 0, 0); PG8_STAGE(PG8_SA(1, 1), a1 + ahs, vA1);
            PG8_WAIT_V(8); PG8_WAIT_L(0); PG8_BAR; PG8_MMA(0, 0, At, B0); PG8_MMA(0, 1, At, B1); PG8_BAR; PG8_SCHED;
            PG8_LDA(At, 0, 1); PG8_STAGE(PG8_SB(0, 0), b2, voffB); PG8_STAGE(PG8_SB(0, 1), b2 + bhs, voffB); PG8_STAGE(PG8_SA(0, 0), a2, s0);
            PG8_WAIT_V(8); PG8_WAIT_L(0); PG8_BAR; PG8_MMA(1, 0, At, B0); PG8_MMA(1, 1, At, B1); PG8_BAR; PG8_SCHED;
            PG8_LDB(B0, 1, 0); PG8_LDB(B1, 1, 1); PG8_SCHED; PG8_LDA(At, 1, 0); PG8_STAGE(PG8_SA(0, 1), a2 + ahs, s1);
            PG8_WAIT_V(8); PG8_WAIT_L(0); PG8_BAR; PG8_MMA(0, 0, At, B0); PG8_MMA(0, 1, At, B1); PG8_BAR; PG8_SCHED;
            PG8_LDA(At, 1, 1); PG8_STAGE(PG8_SB(1, 0), b3, voffB); PG8_STAGE(PG8_SB(1, 1), b3 + bhs, voffB); PG8_STAGE(PG8_SA(1, 0), a3, s0);
            PG8_WAIT_V(8); PG8_WAIT_L(0); PG8_BAR; PG8_MMA(1, 0, At, B0); PG8_MMA(1, 1, At, B1); PG8_BAR; PG8_SCHED;
            } else {
            PG8_LDB(B0, 0, 0); PG8_SCHED; PG8_LDA(At, 0, 0); PG8_STAGE(PG8_SA(1, 1), a1 + hstep, voffA);
            PG8_WAIT_L(8); PG8_BAR; PG8_WAIT_L(0); PG8_MMA(0, 0, At, B0); PG8_BAR; PG8_SCHED;
            PG8_LDB(B1, 0, 1); PG8_STAGE(PG8_SB(0, 0), b2, voffB);
            PG8_BAR; PG8_WAIT_L(0); PG8_MMA(0, 1, At, B1); PG8_BAR;
            PG8_LDA(At, 0, 1); PG8_STAGE(PG8_SA(0, 0), a2, voffA);
            PG8_BAR; PG8_WAIT_L(0); PG8_MMA(1, 0, At, B0); PG8_BAR; PG8_SCHED;
            PG8_STAGE(PG8_SB(0, 1), b2 + bhs, voffB);
            PG8_WAIT_V(6); PG8_BAR; PG8_MMA(1, 1, At, B1); PG8_BAR;
            PG8_LDB(B0, 1, 0); PG8_SCHED; PG8_LDA(At, 1, 0); PG8_STAGE(PG8_SA(0, 1), a2 + hstep, voffA);
            PG8_WAIT_L(8); PG8_BAR; PG8_WAIT_L(0); PG8_MMA(0, 0, At, B0); PG8_BAR; PG8_SCHED;
            PG8_LDB(B1, 1, 1); PG8_STAGE(PG8_SB(1, 0), b3, voffB);
            PG8_BAR; PG8_WAIT_L(0); PG8_MMA(0, 1, At, B1); PG8_BAR;
            PG8_LDA(At, 1, 1); PG8_STAGE(PG8_SA(1, 0), a3, voffA);
            PG8_BAR; PG8_WAIT_L(0); PG8_MMA(1, 0, At, B0); PG8_BAR; PG8_SCHED;
            PG8_STAGE(PG8_SB(1, 1), b3 + bhs, voffB);
            PG8_WAIT_V(6); PG8_BAR; PG8_MMA(1, 1, At, B1); PG8_BAR;
            }
        }
        if constexpr (ALIGN_EPI) { if (wr == 0) PG8_BAR; }
        if constexpr (!Epi::AFTER_DRAIN) { E(acc, cur, wr, wc, fr, fq); S.done(cur); }
        if (!has_next) break;
#pragma unroll
        for (int a = 0; a < 2; ++a)
#pragma unroll
            for (int b = 0; b < 2; ++b)
#pragma unroll
                for (int m = 0; m < 4; ++m)
#pragma unroll
                    for (int n = 0; n < 2; ++n) acc[a][b][m][n] = (f32x4){0.f, 0.f, 0.f, 0.f};
        cur = nxt; cA = nA; cB = nB; ++ui;
        if constexpr (GATHER) { vA0[0] = nA0[0]; vA0[1] = nA0[1]; vA1[0] = nA1[0]; vA1[1] = nA1[1]; }
        if constexpr (ALIGN_EPI) { if (wr == 1) PG8_BAR; }
    }
    PG8_WAIT_V(0);
    if constexpr (!ALIGN_EPI) { if (wr == 0) PG8_BAR; }
    PG8_BAR;
    if constexpr (Epi::AFTER_DRAIN) { E.fused(acc, cur, wr, wc, fr, fq, lds, wid, lane); S.done(cur); }
#undef PG8_SA
#undef PG8_SB
#undef PG8_STAGE
#undef PG8_LDA
#undef PG8_LDB
#undef PG8_MMA
#undef PG8_WAIT_V
#undef PG8_WAIT_L
#undef PG8_BAR
#undef PG8_SCHED
#undef PG8_GOFF
}

template <class Epi, class Sched>
__device__ __forceinline__ void gemm_phase_dual(int tid_, PG8_LAS unsigned char* lds, const Gemm g0, const Gemm g1, const Sched& S, const Epi& E) {
    asm volatile("" : "+v"(tid_));
    const int tid = tid_, wid = __builtin_amdgcn_readfirstlane(tid >> 6), lane = tid & 63, wr = wid >> 2, wc = wid & 3, fr = lane & 15, fq = lane >> 4;
    unsigned vA_0[2], vB_0[2], vA_1[2], vB_1[2];
#pragma unroll
    for (int i = 0; i < 2; ++i) { int R, C; stage_rc(tid * 16 + i * 8192, R, C); const int Rb = Epi::WIDE ? ((R >> 5) * 64 + perm32(R & 31)) : (Epi::PERM ? ((R & ~31) + perm32(R & 31)) : R);
        vA_0[i] = (unsigned)(R * g0.K + C) * 2u; vB_0[i] = (unsigned)(Rb * g0.K + C) * 2u; vA_1[i] = (unsigned)(R * g1.K + C) * 2u; vB_1[i] = (unsigned)(Rb * g1.K + C) * 2u; }
    const size_t kstep = (size_t)(BK * 2);
    const size_t hs_0 = (size_t)HALF * g0.K * 2, hs_1 = (size_t)HALF * g1.K * 2;
#define PG8_BH(x) (Epi::WIDE ? (x) / 4 : (x))
    const int nt_0 = g0.K / BK, nt_1 = g1.K / BK;
    const unsigned ldsw = (unsigned)wid * 1024u;
    const int aoff = lds_byte(wr * 64 + fr, fq * 8), boff = lds_byte(wc * 32 + fr, fq * 8);
#define PG8_SA(b, h) (((b) * 2 + (h)) * HTB)
#define PG8_SB(b, h) ((4 + (b) * 2 + (h)) * HTB)
#define PG8_STAGE(bufoff, gbase, voff) do { _Pragma("unroll") for (int _i = 0; _i < 2; ++_i) \
        __builtin_amdgcn_global_load_lds((const unsigned*)((const char*)(gbase) + (voff)[_i]), (PG8_LAS unsigned*)(lds + (bufoff) + ldsw + _i * 8192), 16, 0, 0); } while (0)
#define PG8_LDA(dst, b, h) do { _Pragma("unroll") for (int m = 0; m < 4; ++m) _Pragma("unroll") for (int k = 0; k < 2; ++k) dst[m][k] = *(const PG8_LAS bf16x8*)(lds + PG8_SA(b, h) + aoff + m * 2048 + k * 1024); } while (0)
#define PG8_LDB(dst, b, h) do { _Pragma("unroll") for (int n = 0; n < 2; ++n) _Pragma("unroll") for (int k = 0; k < 2; ++k) dst[n][k] = *(const PG8_LAS bf16x8*)(lds + PG8_SB(b, h) + boff + n * 2048 + k * 1024); } while (0)
#define PG8_MMA(ai, bj, At, Bt) do { __builtin_amdgcn_s_setprio(1); _Pragma("unroll") for (int m = 0; m < 4; ++m) _Pragma("unroll") for (int n = 0; n < 2; ++n) _Pragma("unroll") for (int k = 0; k < 2; ++k) \
        acc[ai][bj][m][n] = __builtin_amdgcn_mfma_f32_16x16x32_bf16(Bt[n][k], At[m][k], acc[ai][bj][m][n], 0, 0, 0); __builtin_amdgcn_s_setprio(0); } while (0)
#define PG8_WAIT_V(n) asm volatile("s_waitcnt vmcnt(" #n ")" ::: "memory")
#define PG8_WAIT_L(n) asm volatile("s_waitcnt lgkmcnt(" #n ")" ::: "memory")
#define PG8_BAR __builtin_amdgcn_s_barrier()
#define PG8_SCHED __builtin_amdgcn_sched_barrier(0)
    Unit cur, nxt; int ui = 0, s = 0;
    if (!S.next(0, cur)) return;
    f32x4 acc[2][2][4][2];
#pragma unroll
    for (int a = 0; a < 2; ++a)
#pragma unroll
        for (int b = 0; b < 2; ++b)
#pragma unroll
            for (int m = 0; m < 4; ++m)
#pragma unroll
                for (int n = 0; n < 2; ++n) acc[a][b][m][n] = (f32x4){0.f, 0.f, 0.f, 0.f};
    bf16x8 At[4][2], B0[2][2], B1[2][2];
    const char* cA = (const char*)g0.A + (size_t)cur.pm * 2 * hs_0; const char* cB = (const char*)g0.Bt + (size_t)cur.pn * 2 * hs_0;
    size_t hsC = hs_0; unsigned vAc[2] = {vA_0[0], vA_0[1]}, vBc[2] = {vB_0[0], vB_0[1]};
    PG8_STAGE(PG8_SB(0, 0), cB, vBc); PG8_STAGE(PG8_SB(0, 1), cB + PG8_BH(hsC), vBc); PG8_STAGE(PG8_SA(0, 0), cA, vAc); PG8_STAGE(PG8_SA(0, 1), cA + hsC, vAc);
    if (wr == 1) PG8_BAR;
    PG8_WAIT_V(2); PG8_BAR;
    PG8_STAGE(PG8_SB(1, 0), cB + kstep, vBc); PG8_STAGE(PG8_SA(1, 0), cA + kstep, vAc); PG8_STAGE(PG8_SB(1, 1), cB + PG8_BH(hsC) + kstep, vBc);
    PG8_WAIT_V(6); PG8_BAR;
    for (;;) {
        bool has_next = true; if (s == 1) has_next = S.next(ui + 1, nxt);
        const int npm = (s == 0) ? cur.pm : nxt.pm, npn = (s == 0) ? cur.pn : nxt.pn;
        const size_t hsN = has_next ? (s == 0 ? hs_1 : hs_0) : hsC;
        const char* nA = has_next ? (s == 0 ? (const char*)g1.A : (const char*)g0.A) + (size_t)npm * 2 * hsN : cA;
        const char* nB = has_next ? (s == 0 ? (const char*)g1.Bt : (const char*)g0.Bt) + (size_t)npn * 2 * hsN : cB;
        unsigned vAn[2], vBn[2];
#pragma unroll
        for (int i = 0; i < 2; ++i) { vAn[i] = has_next ? (s == 0 ? vA_1[i] : vA_0[i]) : vAc[i]; vBn[i] = has_next ? (s == 0 ? vB_1[i] : vB_0[i]) : vBc[i]; }
        const int nt = (s == 0) ? nt_0 : nt_1;
#pragma unroll 1
        for (int t = 0; t < nt; t += 2) {
            const bool last = (t == nt - 2);
            const char* a1 = cA + (size_t)(t + 1) * kstep;
            const char* a2 = last ? nA : cA + (size_t)(t + 2) * kstep; const char* b2 = last ? nB : cB + (size_t)(t + 2) * kstep;
            const char* a3 = a2 + kstep; const char* b3 = b2 + kstep;
            const size_t hs2 = last ? hsN : hsC;
            unsigned vA2[2], vB2[2];
#pragma unroll
            for (int i = 0; i < 2; ++i) { vA2[i] = last ? vAn[i] : vAc[i]; vB2[i] = last ? vBn[i] : vBc[i]; }
            PG8_LDB(B0, 0, 0); PG8_LDB(B1, 0, 1); PG8_SCHED; PG8_LDA(At, 0, 0); PG8_STAGE(PG8_SA(1, 1), a1 + hsC, vAc);
            PG8_WAIT_V(8); PG8_WAIT_L(0); PG8_BAR; PG8_MMA(0, 0, At, B0); PG8_MMA(0, 1, At, B1); PG8_BAR; PG8_SCHED;
            PG8_LDA(At, 0, 1); PG8_STAGE(PG8_SB(0, 0), b2, vB2); PG8_STAGE(PG8_SB(0, 1), b2 + PG8_BH(hs2), vB2); PG8_STAGE(PG8_SA(0, 0), a2, vA2);
            PG8_WAIT_V(8); PG8_WAIT_L(0); PG8_BAR; PG8_MMA(1, 0, At, B0); PG8_MMA(1, 1, At, B1); PG8_BAR; PG8_SCHED;
            PG8_LDB(B0, 1, 0); PG8_LDB(B1, 1, 1); PG8_SCHED; PG8_LDA(At, 1, 0); PG8_STAGE(PG8_SA(0, 1), a2 + hs2, vA2);
            PG8_WAIT_V(8); PG8_WAIT_L(0); PG8_BAR; PG8_MMA(0, 0, At, B0); PG8_MMA(0, 1, At, B1); PG8_BAR; PG8_SCHED;
            PG8_LDA(At, 1, 1); PG8_STAGE(PG8_SB(1, 0), b3, vB2); PG8_STAGE(PG8_SB(1, 1), b3 + PG8_BH(hs2), vB2); PG8_STAGE(PG8_SA(1, 0), a3, vA2);
            PG8_WAIT_V(8); PG8_WAIT_L(0); PG8_BAR; PG8_MMA(1, 0, At, B0); PG8_MMA(1, 1, At, B1); PG8_BAR; PG8_SCHED;
        }
        if (wr == 0) PG8_BAR;
        if (s == 0) E.mid(acc, cur, wr, wc, fr, fq); else E(acc, cur, wr, wc, fr, fq);
        if (!has_next) break;
        if (s == 1) {
#pragma unroll
            for (int a = 0; a < 2; ++a)
#pragma unroll
                for (int b = 0; b < 2; ++b)
#pragma unroll
                    for (int m = 0; m < 4; ++m)
#pragma unroll
                        for (int n = 0; n < 2; ++n) acc[a][b][m][n] = (f32x4){0.f, 0.f, 0.f, 0.f};
            cur = nxt; ++ui; }
        s ^= 1; cA = nA; cB = nB; hsC = hsN;
#pragma unroll
        for (int i = 0; i < 2; ++i) { vAc[i] = vAn[i]; vBc[i] = vBn[i]; }
        if (wr == 1) PG8_BAR;
    }
    PG8_WAIT_V(0);
    PG8_BAR;
#undef PG8_SA
#undef PG8_SB
#undef PG8_STAGE
#undef PG8_LDA
#undef PG8_LDB
#undef PG8_MMA
#undef PG8_WAIT_V
#undef PG8_WAIT_L
#undef PG8_BAR
#undef PG8_SCHED
#undef PG8_BH
}
}

constexpr int NWAVES = 8;
constexpr int NB = 32, SEQ = 2048, DM = 1024, MTOK = NB * SEQ, DEPTH = 4;
constexpr int INC = 5888, NE = 16, CAP = 256, DEX = 1024, MEXP = NE * NB * CAP;
constexpr float RMS_EPS = 1e-6f, LOG2E = 1.4426950408889634f;
constexpr float QSCALE = 0.125f * LOG2E;

constexpr size_t MiB = 1u << 20;
constexpr size_t WS_CTL = 0, CTL_ZERO_BYTES = 32768;
constexpr size_t WS_WIN = 1 * MiB;
constexpr size_t WS_WA = WS_WIN + (size_t)INC * DM * 2;
constexpr size_t WS_WB = WS_WA + (size_t)DM * 256 * 2;
constexpr size_t WS_WO = WS_WB + (size_t)DM * DM * 2;
constexpr size_t WS_WGU = WS_WO + (size_t)DM * DM * 2;
constexpr size_t WS_WD = WS_WGU + (size_t)NE * 2048 * DM * 2;
constexpr size_t WS_HN = WS_WD + (size_t)NE * DM * DEX * 2;
constexpr size_t WS_BIG = WS_HN + (size_t)MTOK * DM * 2;
constexpr size_t B_QA = 0, B_KA = 96 * MiB, B_VA = 192 * MiB, B_QW = 288 * MiB, B_KW = 416 * MiB, B_VW = 448 * MiB, B_G = 480 * MiB, B_OA = 736 * MiB, B_END = 768 * MiB;
constexpr size_t B_MERGED = 0;
constexpr size_t B_XE = 0, B_ACT = 256 * MiB, B_Y = 512 * MiB;
constexpr size_t WS_AFF = WS_BIG + B_END;
constexpr size_t WS_SEL = WS_AFF + (size_t)MTOK * NE * 4;
constexpr size_t WS_GATE = WS_SEL + (size_t)MTOK * NE * 4;
constexpr size_t WS_LSE = WS_GATE + (size_t)MEXP * 4;
constexpr size_t WS_IDX = WS_LSE + (size_t)3 * MTOK * 4 * 4;
constexpr size_t WS_HB = WS_IDX + (size_t)MEXP * 4;
constexpr size_t WS_END = WS_HB + (size_t)MTOK * DM * 2;
static_assert(WS_WIN % 256 == 0 && WS_WA % 256 == 0 && WS_WGU % 256 == 0 && WS_HN % 256 == 0 && WS_BIG % 256 == 0 && WS_AFF % 256 == 0, "alignment");
constexpr int CW_BAR = 4096;
constexpr int AROW_OFF = 131072;
constexpr int MISC_OFF = 147456, LDS_BYTES = 151552;

#define GAS __attribute__((address_space(1)))
#define LAS __attribute__((address_space(3)))
typedef unsigned short bf16;
typedef unsigned v4u __attribute__((ext_vector_type(4)));
typedef unsigned v2u __attribute__((ext_vector_type(2)));
typedef float f32x4 __attribute__((ext_vector_type(4)));
typedef float f32x16 __attribute__((ext_vector_type(16)));
typedef short bf16x8 __attribute__((ext_vector_type(8)));
#define LDS_WAIT() asm volatile("s_waitcnt lgkmcnt(0)" ::: "memory")
#define VM_WAIT() asm volatile("s_waitcnt vmcnt(0)" ::: "memory")

#define XB_TMO      128
#define XB_XCNT(j)  (256  + 64 * (j))
#define XB_XSUB(j)  (1280 + 64 * (j))
#define XB_XGEN(j)  (2304 + 64 * (j))
#define XB_TOP      3328
#define XB_TOPGEN   3392
#define XCD_BAR_WORDS 3456
#define XB_SPIN_CAP (1u << 18)

__device__ __forceinline__ unsigned xb_ld(unsigned* p)              { return __hip_atomic_load(p, __ATOMIC_RELAXED, __HIP_MEMORY_SCOPE_AGENT); }
__device__ __forceinline__ unsigned xb_add(unsigned* p, unsigned v) { return __hip_atomic_fetch_add(p, v, __ATOMIC_RELAXED, __HIP_MEMORY_SCOPE_AGENT); }
__device__ __forceinline__ unsigned xb_xcc_id() { return (unsigned)__builtin_amdgcn_s_getreg((3 << 11) | 20) & 0xFu; }
#define XB_SPIN(cond, bar) do { unsigned _sp = 0; while (cond) { __builtin_amdgcn_s_sleep(1); \
    if ((++_sp & 255u) == 0u) { if (xb_ld(&(bar)[XB_TMO])) break; if (_sp > XB_SPIN_CAP) { atomicAdd(&(bar)[XB_TMO], 1u); break; } } } } while (0)

__device__ __forceinline__ int xb_lane() { unsigned z = 0u; asm volatile("" : "+v"(z)); return (int)__builtin_amdgcn_mbcnt_hi(~0u, __builtin_amdgcn_mbcnt_lo(~0u, z)); }
struct XcdBarrier {
    int w;
    unsigned* bar; unsigned x;
    volatile LAS unsigned* st;
};

__device__ __forceinline__ XcdBarrier xcd_barrier_post(unsigned* bar, volatile LAS unsigned* st, int wave) {
    XcdBarrier b; b.w = wave; b.bar = bar; b.x = xb_xcc_id(); b.st = st;
    if (wave == 0 && xb_lane() == 0) (void)xb_add(&bar[XB_XCNT(b.x)], 1u);
    return b;
}
__device__ __forceinline__ void xcd_barrier_complete(unsigned* bar, unsigned x, unsigned& nloc, unsigned& nx) {
    const unsigned G = gridDim.x * gridDim.y * gridDim.z;
    unsigned sum, cnt, mine, sp = 0u;
    for (;;) {
        sum = 0u; cnt = 0u; mine = 0u;
#pragma unroll
        for (unsigned j = 0; j < 16; ++j) { const unsigned c = xb_ld(&bar[XB_XCNT(j)]); sum += c; cnt += (c > 0u) ? 1u : 0u; mine = (j == x) ? c : mine; }
        if (sum == G) break;
        __builtin_amdgcn_s_sleep(1);
        if ((++sp & 255u) == 0u) { if (xb_ld(&bar[XB_TMO])) break; if (sp > XB_SPIN_CAP) { atomicAdd(&bar[XB_TMO], 1u); break; } }
    }
    nloc = mine > 0u ? mine : 1u; nx = cnt > 0u ? cnt : 1u;
}

__device__ __forceinline__ void xcd_barrier(const XcdBarrier& b) {
    asm volatile("s_waitcnt vmcnt(0)" ::: "memory");
    __syncthreads();
    if (b.w == 0 && xb_lane() == 0) {
        unsigned* bar = b.bar;
        __builtin_amdgcn_s_waitcnt(0);
        unsigned nloc = b.st[0], nx = b.st[1];
        if (nloc == 0u) { xcd_barrier_complete(bar, b.x, nloc, nx); b.st[0] = nloc; b.st[1] = nx; }
        const unsigned old = xb_add(&bar[XB_XSUB(b.x)], 1u);
        const unsigned gen = old / nloc;
        if (old + 1u == (gen + 1u) * nloc) {
            __builtin_amdgcn_fence(__ATOMIC_RELEASE, "agent");
            asm volatile("s_waitcnt vmcnt(0)" ::: "memory");
            const unsigned og = xb_add(&bar[XB_TOP], 1u);
            const unsigned tg = og / nx;
            if (og + 1u == (tg + 1u) * nx) xb_add(&bar[XB_TOPGEN], 1u);
            else XB_SPIN(xb_ld(&bar[XB_TOPGEN]) == tg, bar);
            __builtin_amdgcn_fence(__ATOMIC_ACQUIRE, "agent");
            xb_add(&bar[XB_XGEN(b.x)], 1u);
            asm volatile("s_waitcnt vmcnt(0)" ::: "memory");
        } else {
            XB_SPIN(xb_ld(&bar[XB_XGEN(b.x)]) == gen, bar);
            __builtin_amdgcn_fence(__ATOMIC_ACQUIRE, "agent");
            asm volatile("s_waitcnt vmcnt(0)" ::: "memory");
        }
    }
    __syncthreads();
}

struct Frame {
    LAS unsigned char* lds;
    int tid, lane, wave, gw;
};
constexpr int PTAB_OFF = MISC_OFF + 256;
__device__ __forceinline__ unsigned long long ptab_get(LAS unsigned char* lds, int i) {
    LAS unsigned char* base = lds + PTAB_OFF; asm volatile("" : "+v"(base));
    const unsigned long long v = ((const volatile LAS unsigned long long*)base)[i];
    const unsigned lo = __builtin_amdgcn_readfirstlane((unsigned)v), hi = __builtin_amdgcn_readfirstlane((unsigned)(v >> 32));
    return ((unsigned long long)hi << 32) | lo;
}
#define P_IN(i) ((const float*)(const GAS float*)ptab_get(F.lds, (i)))
#define P_OUT ((float*)(GAS float*)ptab_get(F.lds, 14))
#define P_WS ((unsigned char*)(GAS unsigned char*)ptab_get(F.lds, 15))
__device__ __forceinline__ Frame make_frame(LAS unsigned char* lds, int wave_s) { Frame F; F.lds = lds; int bx = blockIdx.x; asm volatile("" : "+s"(bx));
    int ln = xb_lane(); asm volatile("" : "+v"(ln));
    F.lane = ln; F.wave = wave_s; F.tid = wave_s * 64 + ln; F.gw = bx * NWAVES + F.wave; return F; }
__device__ __forceinline__ float shx(float v, int o, int lane) { return __builtin_bit_cast(float, __builtin_amdgcn_ds_bpermute((lane ^ o) << 2, __builtin_bit_cast(int, v))); }
__device__ __forceinline__ unsigned shrel(unsigned v, int d, int lane) { return (unsigned)__builtin_amdgcn_ds_bpermute(((lane + d) & 63) << 2, (int)v); }
__device__ __forceinline__ float wave_sum(float v, int lane) {
#pragma unroll
    for (int o = 1; o < 64; o <<= 1) v += shx(v, o, lane);
    return v;
}
__device__ __forceinline__ void transpose_item(const float* W, int K, int N, bf16* dst, LAS float* scr, int k0, int n0, int lane) {
    float tv[32];
#pragma unroll
    for (int i = 0; i < 32; ++i) { const int kk = 2 * i + (lane >> 5); tv[i] = W[(size_t)(k0 + kk) * N + n0 + (lane & 31)]; }
#pragma unroll
    for (int i = 0; i < 32; ++i) { const int kk = 2 * i + (lane >> 5); scr[kk * 33 + (lane & 31)] = tv[i]; }
    LDS_WAIT(); asm volatile("" ::: "memory");
    const int c = lane & 7;
#pragma unroll
    for (int j = 0; j < 4; ++j) { const int n = (lane >> 3) + 8 * j; const LAS float* s = scr + (8 * c) * 33 + n;
        v4u o; o.x = pk2bf(s[0 * 33], s[1 * 33]); o.y = pk2bf(s[2 * 33], s[3 * 33]); o.z = pk2bf(s[4 * 33], s[5 * 33]); o.w = pk2bf(s[6 * 33], s[7 * 33]);
        *(GAS v4u*)(dst + (size_t)n * K + k0 + 8 * c) = o; }
    LDS_WAIT(); asm volatile("" ::: "memory");
}
__device__ __forceinline__ void convert_weights(Frame& F, int l) {
    LAS float* scr = (LAS float*)(F.lds + F.wave * 8448);
    const int NGW = 256 * NWAVES;
    unsigned char* ws = P_WS;
    bf16* WinT = (bf16*)(ws + WS_WIN); bf16* WaT = (bf16*)(ws + WS_WA); bf16* WbT = (bf16*)(ws + WS_WB); bf16* WoT = (bf16*)(ws + WS_WO);
    bf16* WguT = (bf16*)(ws + WS_WGU); bf16* WdT = (bf16*)(ws + WS_WD);
    const float* w_in = P_IN(2) + (size_t)l * DM * INC; const float* w_a = P_IN(3) + (size_t)l * 256 * DM; const float* w_b = P_IN(4) + (size_t)l * DM * DM;
    const float* w_o = P_IN(7) + (size_t)l * DM * DM;
    const float* w_g = P_IN(10) + (size_t)l * NE * DM * DEX; const float* w_u = P_IN(11) + (size_t)l * NE * DM * DEX; const float* w_d = P_IN(12) + (size_t)l * NE * DEX * DM;
    constexpr int I_IN = 16 * (INC / 32), I_A = 4 * 32, I_B = 16 * 32, I_O = 16 * 32, I_E = NE * 16 * 32;
    constexpr int NITEMS = I_IN + I_A + I_B + I_O + 3 * I_E;
    for (int it = F.gw; it < NITEMS; it += NGW) {
        int r = it;
        if (r < I_IN) { const int nb = r % (INC / 32), kb = r / (INC / 32), n0 = 32 * nb; int drow = n0;
            if (n0 >= 3840) { const int gc = n0 - 3840, br = gc >> 10, cc = gc & 1023; drow = 3840 + (cc >> 7) * 256 + br * 128 + (cc & 127); }
            transpose_item(w_in, DM, INC, WinT + (size_t)drow * DM, scr, 64 * kb, n0, F.lane); continue; } r -= I_IN;
        if (r < I_A) { const int nb = r % 32, kb = r / 32; transpose_item(w_a, 256, DM, WaT + (size_t)(32 * nb) * 256, scr, 64 * kb, 32 * nb, F.lane); continue; } r -= I_A;
        if (r < I_B) { const int nb = r % 32, kb = r / 32; transpose_item(w_b, DM, DM, WbT + (size_t)(32 * nb) * DM, scr, 64 * kb, 32 * nb, F.lane); continue; } r -= I_B;
        if (r < I_O) { const int nb = r % 32, kb = r / 32; transpose_item(w_o, DM, DM, WoT + (size_t)(32 * nb) * DM, scr, 64 * kb, 32 * nb, F.lane); continue; } r -= I_O;
        if (r < 2 * I_E) { const int up = r >= I_E; if (up) r -= I_E; const int e = r / 512, loc = r % 512, nb = loc % 32, kb = loc / 32, f0 = 32 * nb;
            const float* W = (up ? w_u : w_g) + (size_t)e * DM * DEX;
            transpose_item(W, DM, DEX, WguT + ((size_t)e * 2048 + (f0 >> 7) * 256 + (up ? 128 : 0) + (f0 & 127)) * DM, scr, 64 * kb, f0, F.lane); continue; } r -= 2 * I_E;
        { const int e = r / 512, loc = r % 512, nb = loc % 32, kb = loc / 32;
            transpose_item(w_d + (size_t)e * DEX * DM, DEX, DM, WdT + ((size_t)e * 1024 + 32 * nb) * DEX, scr, 64 * kb, 32 * nb, F.lane); }
    }
}
__device__ __forceinline__ void unpk8(const v4u w, float (&v)[8]) { v[0] = bflo(w.x); v[1] = bfhi(w.x); v[2] = bflo(w.y); v[3] = bfhi(w.y); v[4] = bflo(w.z); v[5] = bfhi(w.z); v[6] = bflo(w.w); v[7] = bfhi(w.w); }
__device__ __forceinline__ v4u pk8(const float (&v)[8]) { v4u w; w.x = pk2bf(v[0], v[1]); w.y = pk2bf(v[2], v[3]); w.z = pk2bf(v[4], v[5]); w.w = pk2bf(v[6], v[7]); return w; }
template <bool XIN, bool COMBINE, bool FINAL>
__device__ __forceinline__ void norm_rows(Frame& F, const float* xin, bf16* hb, const float* gain, bf16* hn, float* out) {
    const int NGW = 256 * NWAVES;
    unsigned char* ws = P_WS;
    const int* sel = (const int*)(ws + WS_SEL); const bf16* Y = (const bf16*)(ws + WS_BIG + B_Y);
    float gv[2][8];
#pragma unroll
    for (int j = 0; j < 2; ++j) { const f32x4 a = *(const f32x4*)(gain + (64 * j + F.lane) * 8), b = *(const f32x4*)(gain + (64 * j + F.lane) * 8 + 4);
        gv[j][0] = a.x; gv[j][1] = a.y; gv[j][2] = a.z; gv[j][3] = a.w; gv[j][4] = b.x; gv[j][5] = b.y; gv[j][6] = b.z; gv[j][7] = b.w; }
    constexpr int NR = 4;
    for (int m0 = F.gw; m0 < MTOK; m0 += NR * NGW) {
        float v[NR][2][8]; int sv[NR];
#pragma unroll
        for (int rr = 0; rr < NR; ++rr) { const int m = m0 + rr * NGW;
            if (COMBINE) sv[rr] = sel[(size_t)m * NE + (F.lane & 15)];
            if (XIN) {
#pragma unroll
                for (int j = 0; j < 2; ++j) { const f32x4 a = *(const f32x4*)(xin + (size_t)m * DM + (64 * j + F.lane) * 8), b = *(const f32x4*)(xin + (size_t)m * DM + (64 * j + F.lane) * 8 + 4);
                    v[rr][j][0] = a.x; v[rr][j][1] = a.y; v[rr][j][2] = a.z; v[rr][j][3] = a.w; v[rr][j][4] = b.x; v[rr][j][5] = b.y; v[rr][j][6] = b.z; v[rr][j][7] = b.w; }
            } else {
#pragma unroll
                for (int j = 0; j < 2; ++j) unpk8(*(const v4u*)(hb + (size_t)m * DM + (64 * j + F.lane) * 8), v[rr][j]);
            } }
        if (COMBINE) {
            unsigned msk[NR];
#pragma unroll
            for (int rr = 0; rr < NR; ++rr) msk[rr] = (unsigned)(__builtin_amdgcn_ballot_w64(sv[rr] >= 0) & 0xffffull);
            unsigned any = 0u;
#pragma unroll
            for (int rr = 0; rr < NR; ++rr) any |= msk[rr];
            while (any != 0u) {
                v4u yv[NR][2]; float wgt[NR];
#pragma unroll
                for (int rr = 0; rr < NR; ++rr) { const int m = m0 + rr * NGW, b = m >> 11; const bool has = msk[rr] != 0u;
                    const int e = has ? __builtin_ctz(msk[rr]) : 0; const int r = has ? __builtin_amdgcn_readlane(sv[rr], e) : 0;
                    const bf16* yr = Y + ((size_t)(e * NB + b) * CAP + r) * DM; wgt[rr] = has ? 1.0f : 0.0f; msk[rr] &= msk[rr] - 1u;
#pragma unroll
                    for (int j = 0; j < 2; ++j) yv[rr][j] = *(const v4u*)(yr + (64 * j + F.lane) * 8); }
                any = 0u;
#pragma unroll
                for (int rr = 0; rr < NR; ++rr) { any |= msk[rr];
#pragma unroll
                    for (int j = 0; j < 2; ++j) { float y[8]; unpk8(yv[rr][j], y);
#pragma unroll
                        for (int i = 0; i < 8; ++i) v[rr][j][i] += wgt[rr] * y[i]; } }
            }
        }
#pragma unroll
        for (int rr = 0; rr < NR; ++rr) { const int m = m0 + rr * NGW;
            if ((XIN || COMBINE) && !FINAL) {
#pragma unroll
                for (int j = 0; j < 2; ++j) *(v4u*)(hb + (size_t)m * DM + (64 * j + F.lane) * 8) = pk8(v[rr][j]);
            }
            float ss = 0.f;
#pragma unroll
            for (int j = 0; j < 2; ++j)
#pragma unroll
                for (int i = 0; i < 8; ++i) ss += v[rr][j][i] * v[rr][j][i];
            const float rs = 1.0f / sqrtf(wave_sum(ss, F.lane) * (1.0f / DM) + RMS_EPS);
#pragma unroll
            for (int j = 0; j < 2; ++j) { float o[8];
#pragma unroll
                for (int i = 0; i < 8; ++i) o[i] = v[rr][j][i] * rs * gv[j][i];
                if (FINAL) { float* op = out + (size_t)m * DM + (64 * j + F.lane) * 8; *(f32x4*)op = (f32x4){o[0], o[1], o[2], o[3]}; *(f32x4*)(op + 4) = (f32x4){o[4], o[5], o[6], o[7]}; }
                else *(v4u*)(hn + (size_t)m * DM + (64 * j + F.lane) * 8) = pk8(o); } }
    }
}
constexpr int RT_PITCH = 2048 + 16;
__device__ __forceinline__ void norm_router(Frame& F, const bf16* hb, const float* gain, const float* wr, bf16* hn, float* aff) {
    LAS unsigned char* whi = F.lds; LAS unsigned char* wlo = F.lds + 16 * RT_PITCH; LAS float* gl = (LAS float*)(F.lds + 32 * RT_PITCH);
    { const float g0 = gain[F.tid], g1 = gain[F.tid + NWAVES * 64]; gl[F.tid] = g0; gl[F.tid + NWAVES * 64] = g1; }
    __syncthreads();
    { f32x4 wv[8];
#pragma unroll
      for (int j = 0; j < 8; ++j) wv[j] = *(const f32x4*)(wr + 4 * (F.tid + j * NWAVES * 64));
      asm volatile("" ::: "memory");
#pragma unroll
      for (int j = 0; j < 8; ++j) { const int i0 = 4 * (F.tid + j * NWAVES * 64), k = i0 >> 4, e0 = i0 & 15; const float g = gl[k];
#pragma unroll
          for (int t = 0; t < 4; ++t) { const float w = wv[j][t] * g; const unsigned hi = pk2bf(w, 0.f) & 0xffffu; const float rem = w - bflo(hi);
              *(LAS unsigned short*)(whi + (e0 + t) * RT_PITCH + k * 2) = (unsigned short)hi; *(LAS unsigned short*)(wlo + (e0 + t) * RT_PITCH + k * 2) = (unsigned short)(pk2bf(rem, 0.f) & 0xffffu); } } }
    __syncthreads();
    const int NGW = 256 * NWAVES, r16 = F.lane & 15, q = F.lane >> 4;
    for (int grp = F.gw; grp < MTOK / 16; grp += NGW) {
        const size_t row = (size_t)grp * 16 + r16;
        v4u xs[32];
#pragma unroll
        for (int s = 0; s < 16; ++s) { const v4u* p = (const v4u*)(hb + row * DM + 64 * s + 16 * q); xs[2 * s] = p[0]; xs[2 * s + 1] = p[1]; }
        f32x4 acc = {0.f, 0.f, 0.f, 0.f}; float ss = 0.f;
#pragma unroll
        for (int s = 0; s < 16; ++s) {
#pragma unroll
            for (int h2 = 0; h2 < 2; ++h2) { const bf16x8 a = __builtin_bit_cast(bf16x8, xs[2 * s + h2]);
                const bf16x8 bh = *(const LAS bf16x8*)(whi + r16 * RT_PITCH + (64 * s + 16 * q + 8 * h2) * 2), bl = *(const LAS bf16x8*)(wlo + r16 * RT_PITCH + (64 * s + 16 * q + 8 * h2) * 2);
                acc = __builtin_amdgcn_mfma_f32_16x16x32_bf16(a, bh, acc, 0, 0, 0); acc = __builtin_amdgcn_mfma_f32_16x16x32_bf16(a, bl, acc, 0, 0, 0);
                float x[8]; unpk8(xs[2 * s + h2], x);
#pragma unroll
                for (int i = 0; i < 8; ++i) ss += x[i] * x[i]; }
            asm volatile("" ::: "memory"); }
        ss += shx(ss, 16, F.lane); ss += shx(ss, 32, F.lane);
        const float rs = 1.0f / sqrtf(ss * (1.0f / DM) + RMS_EPS);
        float lg[4];
#pragma unroll
        for (int r = 0; r < 4; ++r) { const float rr = __builtin_bit_cast(float, __builtin_amdgcn_ds_bpermute((4 * q + r) << 2, __builtin_bit_cast(int, rs))); lg[r] = acc[r] * rr; }
#pragma unroll
        for (int r = 0; r < 4; ++r) { float mx = lg[r];
#pragma unroll
            for (int o = 1; o < 16; o <<= 1) mx = fmaxf(mx, shx(mx, o, F.lane));
            const float ex = __expf(lg[r] - mx); float sm = ex;
#pragma unroll
            for (int o = 1; o < 16; o <<= 1) sm += shx(sm, o, F.lane);
            aff[((size_t)grp * 16 + 4 * q + r) * NE + r16] = ex / sm; }
#pragma unroll
        for (int s = 0; s < 16; ++s) {
#pragma unroll
            for (int h2 = 0; h2 < 2; ++h2) { v4u t = xs[2 * s + h2]; asm volatile("" : "+v"(t));
                float x[8]; unpk8(t, x); const int k0 = 64 * s + 16 * q + 8 * h2;
                const f32x4 ga = *(const LAS f32x4*)(gl + k0), gb = *(const LAS f32x4*)(gl + k0 + 4);
                x[0] *= rs * ga.x; x[1] *= rs * ga.y; x[2] *= rs * ga.z; x[3] *= rs * ga.w; x[4] *= rs * gb.x; x[5] *= rs * gb.y; x[6] *= rs * gb.z; x[7] *= rs * gb.w;
                *(v4u*)(hn + row * DM + k0) = pk8(x); }
            asm volatile("" ::: "memory"); }
    }
}
__device__ __forceinline__ void topk_gather(Frame& F, const float* aff, int* sel, float* gatev, int* idxg) {
    LAS unsigned* hist = (LAS unsigned*)F.lds;
    volatile LAS unsigned* st = (volatile LAS unsigned*)(F.lds + 1024);
    for (int u = blockIdx.x; u < NB * NE; u += 256) {
        const int b = u >> 4, e = u & 15;
        unsigned bits[4];
#pragma unroll
        for (int q = 0; q < 4; ++q) bits[q] = __float_as_uint(aff[((size_t)b * SEQ + 4 * F.tid + q) * NE + e]);
        unsigned prefix = 0u, kk = CAP;
#pragma unroll 1
        for (int pass = 0; pass < 4; ++pass) {
            const int shift = 24 - 8 * pass;
            if (F.tid < 256) hist[F.tid] = 0u;
            __syncthreads();
#pragma unroll
            for (int q = 0; q < 4; ++q) { const bool in = (pass == 0) || ((bits[q] >> (shift + 8)) == prefix); if (in) atomicAdd((unsigned*)&hist[(bits[q] >> shift) & 255u], 1u); }
            __syncthreads();
            if (F.wave == 0) {
                const unsigned c0 = hist[4 * F.lane], c1 = hist[4 * F.lane + 1], c2 = hist[4 * F.lane + 2], c3 = hist[4 * F.lane + 3];
                unsigned incl = c0 + c1 + c2 + c3;
#pragma unroll
                for (int o = 1; o < 64; o <<= 1) { const unsigned v = shrel(incl, o, F.lane); if (F.lane + o < 64) incl += v; }
                unsigned cum = incl - (c0 + c1 + c2 + c3);
                int found = -1; unsigned above = 0u;
                if (cum < kk && cum + c3 >= kk) { found = 3; above = cum; } cum += c3;
                if (cum < kk && cum + c2 >= kk) { found = 2; above = cum; } cum += c2;
                if (cum < kk && cum + c1 >= kk) { found = 1; above = cum; } cum += c1;
                if (cum < kk && cum + c0 >= kk) { found = 0; above = cum; }
                if (found >= 0) { st[0] = (prefix << 8) | (unsigned)(4 * F.lane + found); st[1] = kk - above; }
            }
            __syncthreads();
            prefix = st[0]; kk = st[1];
        }
        const unsigned T = prefix;
        unsigned ngt = 0u, neq = 0u;
#pragma unroll
        for (int q = 0; q < 4; ++q) { ngt += bits[q] > T ? 1u : 0u; neq += bits[q] == T ? 1u : 0u; }
        unsigned pk = ngt | (neq << 16), inc = pk;
#pragma unroll
        for (int o = 1; o < 64; o <<= 1) { const unsigned v = shrel(inc, -o, F.lane); if (F.lane >= o) inc += v; }
        if (F.lane == 63) st[8 + F.wave] = inc;
        __syncthreads();
        unsigned base = 0u;
#pragma unroll
        for (int w = 0; w < NWAVES; ++w) base += (w < F.wave) ? st[8 + w] : 0u;
        const unsigned excl = base + inc - pk;
        unsigned pgt = excl & 0xffffu, peq = excl >> 16;
#pragma unroll
        for (int q = 0; q < 4; ++q) { const int i = 4 * F.tid + q; const bool g = bits[q] > T, eq = bits[q] == T; const bool keep = g || (eq && peq < kk);
            const unsigned slot = pgt + (peq < kk ? peq : kk);
            if (keep) { idxg[(size_t)(e * NB + b) * CAP + slot] = b * SEQ + i; gatev[(size_t)(e * NB + b) * CAP + slot] = __uint_as_float(bits[q]); }
            sel[((size_t)b * SEQ + i) * NE + e] = keep ? (int)slot : -1;
            pgt += g ? 1u : 0u; peq += eq ? 1u : 0u; }
        __syncthreads();
    }
}


constexpr int ATT_KPITCH = 144, ATT_VT_OFF = 512 * ATT_KPITCH, ATT_VPITCH = 1040, ATT_SINK_OFF = MISC_OFF + 1024;
static_assert(ATT_VT_OFF + 64 * ATT_VPITCH <= MISC_OFF, "attention LDS");
#ifndef ATT_JT_UNROLL
#define ATT_JT_UNROLL 1
#endif
struct ChunkP { const bf16* K; const bf16* V; int ldkv, tok0, cstep, r, L, nseg, qs, i0; };
template <int W>
__device__ __forceinline__ void attn_issue(const ChunkP& p, int tid, v4u (&kreg)[8], v4u (&vreg)[2][4]) {
    asm volatile("" : "+v"(tid));
    const int KS = p.qs + 2 * W, nrows = p.nseg * KS, Lm1 = p.L - 1;
    constexpr int NKP = 8;
#pragma unroll
    for (int it = 0; it < NKP; ++it) { const int pc = tid + it * NWAVES * 64, row0 = pc >> 3, ch = pc & 7, row = row0 < nrows ? row0 : nrows - 1, s = row >= KS ? 1 : 0, rho = row - s * KS;
        int j = p.i0 - W + rho; j = j < 0 ? 0 : j; j = j > Lm1 ? Lm1 : j;
        kreg[it] = *(const v4u*)(p.K + (size_t)(p.tok0 + s * p.cstep + p.r * j) * p.ldkv + ch * 8); }
#pragma unroll
    for (int it = 0; it < 2; ++it) { const int t = tid + it * NWAVES * 64, r4 = t >> 3, ch = t & 7, rowa = 4 * r4, row0 = rowa < nrows ? rowa : nrows - 4, s = row0 >= KS ? 1 : 0, rho = row0 - s * KS, j0 = p.i0 - W + rho;
#pragma unroll
        for (int q = 0; q < 4; ++q) { int j = j0 + q; j = j < 0 ? 0 : j; j = j > Lm1 ? Lm1 : j;
            vreg[it][q] = *(const v4u*)(p.V + (size_t)(p.tok0 + s * p.cstep + p.r * j) * p.ldkv + ch * 8); } }
}
__device__ __forceinline__ void attn_loadq(const Frame& F, const ChunkP& p, const bf16* Q, int ldq, bf16x8 (&qf)[4]) {
    int lane_ = F.lane; asm volatile("" : "+v"(lane_));
    const int wq = F.wave * 32, sidx = (wq >= p.qs) ? 1 : 0, qo = wq - sidx * p.qs, ql = lane_ & 31, hh = lane_ >> 5, qi = p.i0 + qo + ql;
    const bf16* q0 = Q + (size_t)(p.tok0 + sidx * p.cstep + p.r * qi) * ldq;
#pragma unroll
    for (int ks = 0; ks < 4; ++ks) qf[ks] = *(const bf16x8*)(q0 + 16 * ks + 8 * hh);
}
template <int W>
__device__ __forceinline__ void attn_commit(Frame& F, const ChunkP& p, const v4u (&kreg)[8], const v4u (&vreg)[2][4]) {
    int tid = F.tid; asm volatile("" : "+v"(tid));
    const int KS = p.qs + 2 * W, nrows = p.nseg * KS;
    LAS unsigned char* ldsK = F.lds; LAS unsigned char* ldsV = F.lds + ATT_VT_OFF;
    constexpr int NKP = 8;
#pragma unroll
    for (int it = 0; it < NKP; ++it) { const int pc = tid + it * NWAVES * 64, row = pc >> 3, ch = pc & 7;
        if (pc < nrows * 8) *(LAS v4u*)(ldsK + row * ATT_KPITCH + ch * 16) = kreg[it]; }
#pragma unroll
    for (int it = 0; it < 2; ++it) { const int t = tid + it * NWAVES * 64, r4 = t >> 3, ch = t & 7, row0 = 4 * r4;
        if (t < nrows * 2) {
            const int kap = row0 & 31, slot = (kap >> 4) * 16 + ((kap >> 2) & 1) * 8 + ((kap >> 3) & 1) * 4, pos = (row0 & ~31) + slot;
#pragma unroll
            for (int w = 0; w < 4; ++w) {
                v2u lo, hi;
                lo.x = (vreg[it][0][w] & 0xffffu) | (vreg[it][1][w] << 16); lo.y = (vreg[it][2][w] & 0xffffu) | (vreg[it][3][w] << 16);
                hi.x = (vreg[it][0][w] >> 16) | (vreg[it][1][w] & 0xffff0000u); hi.y = (vreg[it][2][w] >> 16) | (vreg[it][3][w] & 0xffff0000u);
                *(LAS v2u*)(ldsV + (ch * 8 + 2 * w) * ATT_VPITCH + pos * 2) = lo;
                *(LAS v2u*)(ldsV + (ch * 8 + 2 * w + 1) * ATT_VPITCH + pos * 2) = hi;
            } } }
}
#ifndef ATT_THR
#define ATT_THR 8.0f
#endif
template <int W, int NH, bool SINK, bool WRITE_LSE>
__device__ __forceinline__ void attn_compute(Frame& F, const ChunkP& p, bf16* Q, int ldq, long odelta, float* lse, float slope1, const float* sinkp, int hbase, bf16x8 (&qf)[4]) {
    constexpr int NJT = 2 * W / 32 + 1, JC = W / 32;
    const int KS = p.qs + 2 * W, L = p.L, i0 = p.i0;
    LAS unsigned char* ldsK = F.lds; LAS unsigned char* ldsV = F.lds + ATT_VT_OFF;
    const int wq = F.wave * 32, sidx = (wq >= p.qs) ? 1 : 0, qo = wq - sidx * p.qs, segbase = sidx * KS;
    int lane_ = F.lane; asm volatile("" : "+v"(lane_));
    const int ql = lane_ & 31, hh = lane_ >> 5;
    const int qi = i0 + qo + ql;
    const size_t qtok = (size_t)(p.tok0 + sidx * p.cstep + p.r * qi);
    const float flo = (float)((-qi > -W) ? -qi : -W), fhi = (float)((L - 1 - qi < W) ? (L - 1 - qi) : W);
#pragma unroll 1
    for (int g = 0; g < NH; ++g) {
        bf16* qptr = Q + qtok * ldq + g * 64;
        f32x16 O0, O1;
        float m, l;
#ifdef PRB_REP
        constexpr int nrep = (NH == PRB_NH) ? PRB_REP : 1;
#pragma unroll 1
        for (int rep = 0; rep < nrep; ++rep) {
        asm volatile("" ::: "memory");
#endif
#pragma unroll
        for (int i = 0; i < 16; ++i) { O0[i] = 0.f; O1[i] = 0.f; }
        const float sl = (NH == 1) ? slope1 : __builtin_amdgcn_exp2f(-0.5f * (float)(hbase + g + 1)) * LOG2E;
        const float sk2 = SINK ? *(const LAS float*)(F.lds + ATT_SINK_OFF + 4 * (hbase + g)) : 0.f;
        {
            const int jbase = i0 + qo - W + 32 * JC, krow = segbase + qo + 32 * JC;
            const bool need_mask = (jbase < 0) || (jbase + 31 >= L);
            f32x16 S;
#pragma unroll
            for (int i = 0; i < 16; ++i) S[i] = 0.f;
#pragma unroll
            for (int ks = 0; ks < 4; ++ks) { const bf16x8 kf = *(const LAS bf16x8*)(ldsK + (krow + ql) * ATT_KPITCH + (16 * ks + 8 * hh) * 2); S = __builtin_amdgcn_mfma_f32_32x32x16_bf16(kf, qf[ks], S, 0, 0, 0); }
            const float fd0 = (float)(jbase + 4 * hh - qi);
#pragma unroll
            for (int i = 0; i < 16; ++i) { const float fd = fd0 + (float)((i & 3) + 8 * (i >> 2)); S[i] = S[i] - sl * fabsf(fd); }
            if (need_mask) {
#pragma unroll
                for (int i = 0; i < 16; ++i) { const float fd = fd0 + (float)((i & 3) + 8 * (i >> 2)); S[i] = (fd >= flo && fd <= fhi) ? S[i] : -INFINITY; } }
            float mloc = S[0];
#pragma unroll
            for (int i = 1; i < 16; ++i) mloc = fmaxf(mloc, S[i]);
            m = fmaxf(mloc, shx(mloc, 32, lane_));
            float ps = 0.f;
#pragma unroll
            for (int i = 0; i < 16; ++i) { const float pv = __builtin_amdgcn_exp2f(S[i] - m); S[i] = pv; ps += pv; }
            l = ps;
#pragma unroll
            for (int s2 = 0; s2 < 2; ++s2) {
                f32x8_t pp;
#pragma unroll
                for (int i = 0; i < 8; ++i) pp[i] = S[8 * s2 + i];
                const bf16x8 pf = __builtin_bit_cast(bf16x8, __builtin_convertvector(pp, nbf16x8));
                const bf16x8 v0 = *(const LAS bf16x8*)(ldsV + ql * ATT_VPITCH + (krow + 16 * s2 + 8 * hh) * 2);
                const bf16x8 v1 = *(const LAS bf16x8*)(ldsV + (ql + 32) * ATT_VPITCH + (krow + 16 * s2 + 8 * hh) * 2);
                O0 = __builtin_amdgcn_mfma_f32_32x32x16_bf16(v0, pf, O0, 0, 0, 0);
                O1 = __builtin_amdgcn_mfma_f32_32x32x16_bf16(v1, pf, O1, 0, 0, 0);
            }
        }
#pragma unroll 1
        for (int jt = 0; jt < NJT; ++jt) {
            if (jt == JC) continue;
            const int jbase = i0 + qo - W + 32 * jt;
            if (jbase + 31 < 0 || jbase >= L) continue;
            const bool need_mask = (jt == 0) || (jt == NJT - 1) || (jbase < 0) || (jbase + 31 >= L);
            const int krow = segbase + qo + 32 * jt;
            const float fd0 = (float)(jbase + 4 * hh - qi);
            bf16x8 kf[4];
#pragma unroll
            for (int ks = 0; ks < 4; ++ks) kf[ks] = *(const LAS bf16x8*)(ldsK + (krow + ql) * ATT_KPITCH + (16 * ks + 8 * hh) * 2);
            const bf16x8 vf00 = *(const LAS bf16x8*)(ldsV + ql * ATT_VPITCH + (krow + 8 * hh) * 2), vf10 = *(const LAS bf16x8*)(ldsV + (ql + 32) * ATT_VPITCH + (krow + 8 * hh) * 2);
            f32x16 S;
            if (jt < JC) { const float k1 = sl * fd0 - m;
#pragma unroll
                for (int i = 0; i < 16; ++i) S[i] = fmaf(sl, (float)((i & 3) + 8 * (i >> 2)), k1); }
            else { const float k1 = -sl * fd0 - m;
#pragma unroll
                for (int i = 0; i < 16; ++i) S[i] = fmaf(-sl, (float)((i & 3) + 8 * (i >> 2)), k1); }
            if (need_mask) {
#pragma unroll
                for (int i = 0; i < 16; ++i) { const float fd = fd0 + (float)((i & 3) + 8 * (i >> 2)); S[i] = (fd >= flo && fd <= fhi) ? S[i] : -INFINITY; } }
#pragma unroll
            for (int ks = 0; ks < 4; ++ks) S = __builtin_amdgcn_mfma_f32_32x32x16_bf16(kf[ks], qf[ks], S, 0, 0, 0);
            const bf16x8 vf01 = *(const LAS bf16x8*)(ldsV + ql * ATT_VPITCH + (krow + 16 + 8 * hh) * 2), vf11 = *(const LAS bf16x8*)(ldsV + (ql + 32) * ATT_VPITCH + (krow + 16 + 8 * hh) * 2);
            float tmax = S[0];
#pragma unroll
            for (int i = 1; i < 16; ++i) tmax = fmaxf(tmax, S[i]);
            if (__builtin_amdgcn_ballot_w64(tmax > ATT_THR) != 0ull) {
                float d = fmaxf(tmax, 0.f); d = fmaxf(d, shx(d, 32, lane_));
                const float sc = __builtin_amdgcn_exp2f(-d);
#pragma unroll
                for (int i = 0; i < 16; ++i) { S[i] -= d; O0[i] *= sc; O1[i] *= sc; }
                l *= sc; m += d;
            }
            float ps = 0.f;
#pragma unroll
            for (int i = 0; i < 16; ++i) { const float pv = __builtin_amdgcn_exp2f(S[i]); S[i] = pv; ps += pv; }
            l += ps;
            { f32x8_t pp;
#pragma unroll
              for (int i = 0; i < 8; ++i) pp[i] = S[i];
              const bf16x8 pf = __builtin_bit_cast(bf16x8, __builtin_convertvector(pp, nbf16x8));
              O0 = __builtin_amdgcn_mfma_f32_32x32x16_bf16(vf00, pf, O0, 0, 0, 0); O1 = __builtin_amdgcn_mfma_f32_32x32x16_bf16(vf10, pf, O1, 0, 0, 0); }
            { f32x8_t pp;
#pragma unroll
              for (int i = 0; i < 8; ++i) pp[i] = S[8 + i];
              const bf16x8 pf = __builtin_bit_cast(bf16x8, __builtin_convertvector(pp, nbf16x8));
              O0 = __builtin_amdgcn_mfma_f32_32x32x16_bf16(vf01, pf, O0, 0, 0, 0); O1 = __builtin_amdgcn_mfma_f32_32x32x16_bf16(vf11, pf, O1, 0, 0, 0); }
        }
#ifdef PRB_REP
        }
        const float sk2 = SINK ? *(const LAS float*)(F.lds + ATT_SINK_OFF + 4 * (hbase + g)) : 0.f;
#endif
        float lt = l + shx(l, 32, lane_);
        float osc = 1.0f;
        if (SINK) { const float mf = fmaxf(m, sk2); osc = __builtin_amdgcn_exp2f(m - mf); lt = lt * osc + __builtin_amdgcn_exp2f(sk2 - mf); }
        if (WRITE_LSE) { if (hh == 0) lse[qtok * 4] = m + __builtin_amdgcn_logf(lt); }
        const float inv = osc / lt;
        if (NH > 1 && g + 1 < NH) {
#pragma unroll
            for (int ks = 0; ks < 4; ++ks) qf[ks] = *(const bf16x8*)(qptr + 64 + 16 * ks + 8 * hh); }
        v2u WW[8];
#pragma unroll
        for (int g4 = 0; g4 < 4; ++g4) {
            WW[g4].x = pk2bf(O0[4 * g4] * inv, O0[4 * g4 + 1] * inv); WW[g4].y = pk2bf(O0[4 * g4 + 2] * inv, O0[4 * g4 + 3] * inv);
            WW[4 + g4].x = pk2bf(O1[4 * g4] * inv, O1[4 * g4 + 1] * inv); WW[4 + g4].y = pk2bf(O1[4 * g4 + 2] * inv, O1[4 * g4 + 3] * inv); }
#pragma unroll
        for (int s4 = 0; s4 < 4; ++s4) {
            v2u a = WW[2 * s4], b = WW[2 * s4 + 1];
            { const auto r = __builtin_amdgcn_permlane32_swap(a.x, b.x, false, false); a.x = r[0]; b.x = r[1]; }
            { const auto r = __builtin_amdgcn_permlane32_swap(a.y, b.y, false, false); a.y = r[0]; b.y = r[1]; }
            *(v4u*)(qptr + odelta + 16 * s4 + 8 * hh) = (v4u){a.x, a.y, b.x, b.y};
#ifdef PRB_ST2
            asm volatile("" ::: "memory");
            *(v4u*)(qptr + odelta + 16 * s4 + 8 * hh) = (v4u){a.x, a.y, b.x, b.y};
            asm volatile("" ::: "memory");
#endif
        }
    }
}
__device__ __forceinline__ ChunkP dil_chunk(const bf16* KA, const bf16* VA, int b, int hs, int sc) {
    const int grp = sc >> 3, ix = sc & 7, col = grp * 256 + hs * 64; ChunkP p; p.K = KA + col; p.V = VA + col; p.ldkv = 768;
    if (grp == 0) { p.tok0 = b * SEQ; p.cstep = 0; p.r = 1; p.L = 2048; p.nseg = 1; p.qs = 256; p.i0 = 256 * ix; }
    else if (grp == 1) { p.tok0 = b * SEQ + (ix >> 1); p.cstep = 0; p.r = 4; p.L = 512; p.nseg = 1; p.qs = 256; p.i0 = 256 * (ix & 1); }
    else { p.tok0 = b * SEQ + 2 * ix; p.cstep = 1; p.r = 16; p.L = 128; p.nseg = 2; p.qs = 128; p.i0 = 0; }
    return p;
}
__device__ __forceinline__ ChunkP win_chunk(const bf16* KW, const bf16* VW, int wc) {
    const int b = wc >> 5, kvh = (wc >> 3) & 3, ch = wc & 7; ChunkP p; p.K = KW + kvh * 64; p.V = VW + kvh * 64; p.ldkv = 256;
    p.tok0 = b * SEQ; p.cstep = 0; p.r = 1; p.L = SEQ; p.nseg = 1; p.qs = 256; p.i0 = 256 * ch; return p;
}
__device__ __forceinline__ void attention_phase(Frame& F, int l, long odA, long odW, int which = 3) {
    unsigned char* ws = P_WS;
    bf16* big = (bf16*)(ws + WS_BIG);
    bf16* QA = big + B_QA / 2; bf16* KA = big + B_KA / 2; bf16* VA = big + B_VA / 2; bf16* QW = big + B_QW / 2; bf16* KW = big + B_KW / 2; bf16* VW = big + B_VW / 2; bf16* OA = big + B_OA / 2;
    float* LSE = (float*)(ws + WS_LSE);
    const int c = blockIdx.x;
    int w_lo, w_hi;
    v4u kreg[8], vreg[2][4];
    bf16x8 qf[4];
#ifndef ATT_N1
#define ATT_N1 0
#endif
    static_assert(ATT_N1 == 0, "the dilated workgroups take no window chunks");
    if (c < 128) { w_lo = ATT_N1 * c; w_hi = w_lo + ATT_N1; } else { w_lo = 128 * ATT_N1 + (c - 128) * (8 - ATT_N1); w_hi = w_lo + (8 - ATT_N1); }
    if (c < 128) { if (which & 1) {
        const int b = c >> 2, hs = c & 3;
        { const ChunkP p0 = dil_chunk(KA, VA, b, hs, 0); attn_issue<64>(p0, F.tid, kreg, vreg); attn_loadq(F, p0, QA + hs * 64, 768, qf); attn_commit<64>(F, p0, kreg, vreg); }
        __syncthreads();
#pragma unroll 1
        for (int sc = 0; sc < 24; ++sc) {
            const ChunkP p = dil_chunk(KA, VA, b, hs, sc); const int grp = sc >> 3;
            const int scn = sc + 1 < 24 ? sc + 1 : sc;
            const ChunkP pn = dil_chunk(KA, VA, b, hs, scn);
            bf16x8 qn[4];
            attn_issue<64>(pn, F.tid, kreg, vreg); attn_loadq(F, pn, QA + (scn >> 3) * 256 + hs * 64, 768, qn);
            const float slope1 = __builtin_amdgcn_exp2f(-8.0f * (float)(grp * 4 + hs + 1) / 12.0f) * (float)p.r * LOG2E;
            attn_compute<64, 1, false, true>(F, p, QA + grp * 256 + hs * 64, 768, odA, LSE + (size_t)grp * MTOK * 4 + hs, slope1, nullptr, 0, qf);
            __syncthreads();
            if (sc + 1 < 24) attn_commit<64>(F, pn, kreg, vreg);
            __syncthreads();
#pragma unroll
            for (int ks = 0; ks < 4; ++ks) qf[ks] = qn[ks];
        }
        VM_WAIT(); __syncthreads(); __builtin_amdgcn_fence(__ATOMIC_ACQUIRE, "agent"); VM_WAIT();
        constexpr int CB = 8;
#pragma unroll 1
        for (int t0 = F.tid; t0 < SEQ * 8; t0 += NWAVES * 64 * CB) {
            float lv[CB][3]; v4u av[CB][3];
#pragma unroll
            for (int k = 0; k < CB; ++k) { const int t = t0 + k * NWAVES * 64, tok = t >> 3, ch = t & 7; const size_t row = (size_t)b * SEQ + tok;
                lv[k][0] = LSE[row * 4 + hs]; lv[k][1] = LSE[(size_t)MTOK * 4 + row * 4 + hs]; lv[k][2] = LSE[(size_t)2 * MTOK * 4 + row * 4 + hs];
                const bf16* og = QA + odA + row * 768 + hs * 64 + ch * 8; av[k][0] = *(const v4u*)(og); av[k][1] = *(const v4u*)(og + 256); av[k][2] = *(const v4u*)(og + 512); }
            asm volatile("" ::: "memory");
#pragma unroll
            for (int k = 0; k < CB; ++k) { const int t = t0 + k * NWAVES * 64, tok = t >> 3, ch = t & 7; const size_t row = (size_t)b * SEQ + tok;
                const float mx = fmaxf(lv[k][0], fmaxf(lv[k][1], lv[k][2]));
                float w0 = __builtin_amdgcn_exp2f(lv[k][0] - mx), w1 = __builtin_amdgcn_exp2f(lv[k][1] - mx), w2 = __builtin_amdgcn_exp2f(lv[k][2] - mx);
                const float inv = 1.0f / (w0 + w1 + w2); w0 *= inv; w1 *= inv; w2 *= inv;
                v4u o;
#pragma unroll
                for (int w = 0; w < 4; ++w) o[w] = pk2bf(w0 * bflo(av[k][0][w]) + w1 * bflo(av[k][1][w]) + w2 * bflo(av[k][2][w]), w0 * bfhi(av[k][0][w]) + w1 * bfhi(av[k][1][w]) + w2 * bfhi(av[k][2][w]));
                *(v4u*)(OA + row * 256 + hs * 64 + ch * 8) = o; }
        }
    } } else if (which & 2) {
        if (F.tid < 16) *(LAS float*)(F.lds + ATT_SINK_OFF + 4 * F.tid) = P_IN(6)[l * 16 + F.tid] * LOG2E;
        const ChunkP p0 = win_chunk(KW, VW, w_lo); attn_issue<128>(p0, F.tid, kreg, vreg); attn_loadq(F, p0, QW + ((w_lo >> 3) & 3) * 256, 1024, qf); attn_commit<128>(F, p0, kreg, vreg);
        __syncthreads();
    }
#pragma unroll 1
    for (int wc = w_lo; wc < ((which & 2) ? w_hi : w_lo); ++wc) {
        const ChunkP p = win_chunk(KW, VW, wc); const int kvh = (wc >> 3) & 3;
        const int wn = wc + 1 < w_hi ? wc + 1 : wc;
        const ChunkP pn = win_chunk(KW, VW, wn);
        bf16x8 qn[4];
        attn_issue<128>(pn, F.tid, kreg, vreg); attn_loadq(F, pn, QW + ((wn >> 3) & 3) * 256, 1024, qn);
        attn_compute<128, 4, true, false>(F, p, QW + kvh * 256, 1024, odW, nullptr, 0.f, nullptr, kvh * 4, qf);
        __syncthreads();
        if (wc + 1 < w_hi) attn_commit<128>(F, pn, kreg, vreg);
        __syncthreads();
#pragma unroll
        for (int ks = 0; ks < 4; ++ks) qf[ks] = qn[ks];
    }
}
#ifndef PH_A
#define PH_A 1
#endif
#ifndef PH_B
#define PH_B 1
#endif
#ifndef PH_C
#define PH_C 1
#endif
#ifndef PH_D
#define PH_D 1
#endif
#ifndef PH_E
#define PH_E 1
#endif
#ifndef PH_F
#define PH_F 1
#endif
#ifndef PH_G
#define PH_G 1
#endif
#ifndef PH_H
#define PH_H 1
#endif
#ifndef PH_I
#define PH_I 1
#endif
#ifndef PH_J
#define PH_J 1
#endif
#ifndef PH_Z
#define PH_Z 1
#endif

struct Args { const float* in[14]; float* out; unsigned char* ws; };
__global__ void __launch_bounds__(NWAVES * 64, 2) mk_fwd(Args args) {
    extern __shared__ __attribute__((aligned(16))) unsigned char lds_raw[];
    LAS unsigned char* const lds = (LAS unsigned char*)lds_raw;
    int wave_s = __builtin_amdgcn_readfirstlane((int)(threadIdx.x >> 6)); asm volatile("" : "+s"(wave_s));
    {
        const int t0 = wave_s * 64 + xb_lane();
        volatile LAS unsigned* MISC = (volatile LAS unsigned*)(lds + MISC_OFF);
        if (t0 < 32) MISC[t0] = 0u;
        if (t0 == 0) { volatile LAS unsigned long long* pt = (volatile LAS unsigned long long*)(lds + PTAB_OFF);
            pt[0] = (unsigned long long)args.in[0]; pt[1] = (unsigned long long)args.in[1]; pt[2] = (unsigned long long)args.in[2]; pt[3] = (unsigned long long)args.in[3];
            pt[4] = (unsigned long long)args.in[4]; pt[5] = (unsigned long long)args.in[5]; pt[6] = (unsigned long long)args.in[6]; pt[7] = (unsigned long long)args.in[7];
            pt[8] = (unsigned long long)args.in[8]; pt[9] = (unsigned long long)args.in[9]; pt[10] = (unsigned long long)args.in[10]; pt[11] = (unsigned long long)args.in[11];
            pt[12] = (unsigned long long)args.in[12]; pt[13] = (unsigned long long)args.in[13]; pt[14] = (unsigned long long)args.out; pt[15] = (unsigned long long)args.ws; }
        __syncthreads();
    }
    XcdBarrier bar = xcd_barrier_post((unsigned*)(args.ws + WS_CTL) + CW_BAR, (volatile LAS unsigned*)(lds + MISC_OFF) + 8, wave_s);
    const int G = 256;

#pragma unroll 1
    for (int l = 0; l < DEPTH; ++l) {
        int c = blockIdx.x; asm volatile("" : "+s"(c));
#if PH_A
        { Frame F = make_frame(lds, wave_s); convert_weights(F, l);
          unsigned char* ws = P_WS;
          if (l == 0) norm_rows<true, false, false>(F, P_IN(0), (bf16*)(ws + WS_HB), P_IN(1) + l * DM, (bf16*)(ws + WS_HN), nullptr);
          else norm_rows<false, true, false>(F, nullptr, (bf16*)(ws + WS_HB), P_IN(1) + l * DM, (bf16*)(ws + WS_HN), nullptr);
          }
#endif
        xcd_barrier(bar);
#if PH_B
        { Frame F = make_frame(lds, wave_s); unsigned char* ws = P_WS; bf16* big = (bf16*)(ws + WS_BIG);
          pg8::Gemm g{(const bf16*)(ws + WS_HN), (const bf16*)(ws + WS_WIN), MTOK, INC, DM}; pg8::StaticOrder S; S.init(MTOK, INC, G, c);
          pg8::EpiInProj E{big + B_QA / 2, big + B_KA / 2, big + B_VA / 2, big + B_QW / 2, big + B_KW / 2, big + B_VW / 2, big + B_G / 2, big + B_G / 2 + (size_t)MTOK * DM, P_IN(5) + l * 2048, QSCALE};
          pg8::gemm_phase<pg8::EpiInProj, pg8::StaticOrder, true, true>(F.tid, lds, g, S, E); }
#endif
        xcd_barrier(bar);
#ifdef DUP_C
        { Frame F = make_frame(lds, wave_s); attention_phase(F, l, ((long)WS_HN - (long)(WS_BIG + B_QA)) / 2, ((long)WS_HN - (long)(WS_BIG + B_QW)) / 2, DUP_C); }
        xcd_barrier(bar);
#endif
#if PH_C
        { Frame F = make_frame(lds, wave_s); attention_phase(F, l, 0, 0); }
#endif
        xcd_barrier(bar);
#if PH_E
        { Frame F = make_frame(lds, wave_s); unsigned char* ws = P_WS; bf16* big = (bf16*)(ws + WS_BIG);
          pg8::Gemm g0{big + B_OA / 2, (const bf16*)(ws + WS_WA), MTOK, DM, 256}; pg8::Gemm g1{big + B_QW / 2, (const bf16*)(ws + WS_WB), MTOK, DM, DM}; pg8::StaticOrder S; S.init(MTOK, DM, G, c);
          pg8::EpiMergeDual E{big + B_MERGED / 2, big + B_G / 2, big + B_G / 2 + (size_t)MTOK * DM};
          pg8::gemm_phase_dual<pg8::EpiMergeDual, pg8::StaticOrder>(F.tid, lds, g0, g1, S, E); }
#endif
        xcd_barrier(bar);
#if PH_F
        { Frame F = make_frame(lds, wave_s); unsigned char* ws = P_WS; bf16* big = (bf16*)(ws + WS_BIG); bf16* hb = (bf16*)(ws + WS_HB);
          pg8::Gemm g{big + B_MERGED / 2, (const bf16*)(ws + WS_WO), MTOK, DM, DM}; pg8::StaticOrder S; S.init(MTOK, DM, G, c);
          pg8::EpiResid E{hb, hb};
          pg8::gemm_phase<pg8::EpiResid, pg8::StaticOrder, true, true>(F.tid, lds, g, S, E); }
#endif
        xcd_barrier(bar);
#if PH_G
        { Frame F = make_frame(lds, wave_s); unsigned char* ws = P_WS;
          norm_router(F, (const bf16*)(ws + WS_HB), P_IN(8) + l * DM, P_IN(9) + (size_t)l * DM * NE, (bf16*)(ws + WS_HN), (float*)(ws + WS_AFF)); }
#endif
        xcd_barrier(bar);
#if PH_H
        { Frame F = make_frame(lds, wave_s); unsigned char* ws = P_WS;
          topk_gather(F, (const float*)(ws + WS_AFF), (int*)(ws + WS_SEL), (float*)(ws + WS_GATE), (int*)(ws + WS_IDX)); }
#endif
        xcd_barrier(bar);
#if PH_I
        { Frame F = make_frame(lds, wave_s); unsigned char* ws = P_WS; bf16* big = (bf16*)(ws + WS_BIG);
          pg8::Gemm g{(const bf16*)(ws + WS_HN), (const bf16*)(ws + WS_WGU), MEXP, NE * 2048, DM}; pg8::GroupedOrder S; S.init(NE, NB, 8, G, c);
          pg8::EpiSwiGLU E{big + B_ACT / 2};
          { const int* idxg = (const int*)(ws + WS_IDX); LAS int* arow = (LAS int*)(lds + AROW_OFF);
            int rv[NE]; const int r = F.tid & 255;
#pragma unroll
            for (int i = 0; i < NE; ++i) { pg8::Unit u; u.pm = 0; u.pn = 0; S.next(i, u); rv[i] = u.pm; }
            asm volatile("" ::: "memory");
#pragma unroll
            for (int i = 0; i < NE; ++i) rv[i] = idxg[(size_t)rv[i] * 256 + r];
#pragma unroll
            for (int i = 0; i < NE; ++i) if (F.tid < 256) arow[i * 256 + r] = rv[i];
            __syncthreads(); }
          pg8::gemm_phase<pg8::EpiSwiGLU, pg8::GroupedOrder, true, true, true>(F.tid, lds, g, S, E, (const LAS int*)(lds + AROW_OFF)); }
#endif
        xcd_barrier(bar);
#if PH_J
        { Frame F = make_frame(lds, wave_s); unsigned char* ws = P_WS; bf16* big = (bf16*)(ws + WS_BIG);
          pg8::Gemm g{big + B_ACT / 2, (const bf16*)(ws + WS_WD), MEXP, NE * 1024, DEX}; pg8::GroupedOrder S; S.init(NE, NB, 4, G, c);
          pg8::EpiDown E{big + B_Y / 2, (const LAS float*)(lds + AROW_OFF), 0};
          { const float* gatev = (const float*)(ws + WS_GATE); LAS float* gl = (LAS float*)(lds + AROW_OFF);
            float gv[8]; int pmv[8]; const int r = F.tid & 255;
#pragma unroll
            for (int i = 0; i < 8; ++i) { pg8::Unit u; u.pm = 0; u.pn = 0; S.next(i, u); pmv[i] = u.pm; }
            asm volatile("" ::: "memory");
#pragma unroll
            for (int i = 0; i < 8; ++i) gv[i] = gatev[(size_t)pmv[i] * 256 + r];
#pragma unroll
            for (int i = 0; i < 8; ++i) if (F.tid < 256) gl[i * 256 + r] = gv[i];
            __syncthreads(); }
          pg8::gemm_phase<pg8::EpiDown, pg8::GroupedOrder, true, true>(F.tid, lds, g, S, E); }
#endif
        xcd_barrier(bar);
    }
#if PH_Z
    { Frame F = make_frame(lds, wave_s); unsigned char* ws = P_WS; norm_rows<false, true, true>(F, nullptr, (bf16*)(ws + WS_HB), P_IN(13), nullptr, P_OUT); }
#endif
}

extern "C" void kernel_launch(void* const* d_in, const int* in_sizes, int n_in, void* d_out, int out_size, void* d_ws, size_t ws_size, hipStream_t stream) {
    static int grid = 0;
    if (grid == 0) {
        if (n_in != 14 || out_size != MTOK * DM || ws_size < WS_END) { fprintf(stderr, "kernel_launch: unexpected shapes (n_in %d, out %d, ws %zu < %zu); nothing launched\n", n_in, out_size, ws_size, (size_t)WS_END); grid = -1; return; }
        int dev = 0, cus = 0, per_cu = 0;
        if (hipGetDevice(&dev) != hipSuccess || hipDeviceGetAttribute(&cus, hipDeviceAttributeMultiprocessorCount, dev) != hipSuccess) { grid = -1; return; }
        if (hipFuncSetAttribute((const void*)mk_fwd, hipFuncAttributeMaxDynamicSharedMemorySize, LDS_BYTES) != hipSuccess) { fprintf(stderr, "kernel_launch: hipFuncSetAttribute failed\n"); grid = -1; return; }
        if (hipOccupancyMaxActiveBlocksPerMultiprocessor(&per_cu, (const void*)mk_fwd, NWAVES * 64, LDS_BYTES) != hipSuccess || per_cu < 1) fprintf(stderr, "kernel_launch: occupancy query reports %d\n", per_cu);
        (void)hipGetLastError();
        grid = 256;
        if (cus != 256) fprintf(stderr, "kernel_launch: device has %d CUs, built for 256\n", cus);
    }
    if (grid < 0) return;
    (void)in_sizes;
    hipMemsetAsync((char*)d_ws + WS_CTL, 0, CTL_ZERO_BYTES, stream);
    Args a{};
    for (int i = 0; i < 14; ++i) a.in[i] = (const float*)d_in[i];
    a.out = (float*)d_out; a.ws = (unsigned char*)d_ws;
    hipLaunchKernelGGL(mk_fwd, dim3(grid), dim3(NWAVES * 64), LDS_BYTES, stream, a);
}
```

```cpp
#include <hip/hip_runtime.h>
#include <cstdio>
#include <cstdint>
typedef __bf16 nbf16x2 __attribute__((ext_vector_type(2)));
typedef __bf16 nbf16x4 __attribute__((ext_vector_type(4)));
typedef __bf16 nbf16x8 __attribute__((ext_vector_type(8)));
typedef float f32x2_t __attribute__((ext_vector_type(2)));
typedef float f32x8_t __attribute__((ext_vector_type(8)));
__device__ __forceinline__ unsigned pk2bf(float lo, float hi) { f32x2_t v = {lo, hi}; return __builtin_bit_cast(unsigned, __builtin_convertvector(v, nbf16x2)); }
__device__ __forceinline__ float bflo(unsigned w) { return __builtin_bit_cast(float, w << 16); }
__device__ __forceinline__ float bfhi(unsigned w) { return __builtin_bit_cast(float, w & 0xffff0000u); }
namespace pg8 {
#define PG8_LAS __attribute__((address_space(3)))
typedef unsigned short bf16_t;
typedef short bf16x8 __attribute__((ext_vector_type(8)));
typedef float f32x4 __attribute__((ext_vector_type(4)));
typedef unsigned u32x4 __attribute__((ext_vector_type(4)));
constexpr int BM = 256, BK = 64, HALF = 128, HTB = HALF * BK * 2  , STAGE_BYTES = 8 * HTB, NXCD = 8;
#ifndef PG8_WGM
#define PG8_WGM 8
#endif
#ifndef PG8_WGM_G
#define PG8_WGM_G 8
#endif
constexpr int WGM = PG8_WGM, WGM_G = PG8_WGM_G;

__host__ __device__ __forceinline__ int lds_byte(int r, int c) { const int st = (r >> 4) * 2 + (c >> 5), rr = r & 15, cc = c & 31, ob = rr * 64 + cc * 2; return st * 1024 + (ob ^ (((ob >> 9) & 1) << 5)); }
__host__ __device__ __forceinline__ void stage_rc(int b, int& R, int& C) { const int st = b / 1024, sb = b % 1024, swz = sb ^ (((sb >> 9) & 1) << 5); R = (st >> 1) * 16 + swz / 64; C = (st & 1) * 32 + (swz % 64) / 2; }
__host__ __device__ __forceinline__ int perm32(int rho) { const int n = rho >> 4, i = rho & 15; return 8 * (i >> 2) + 4 * n + (i & 3); }

struct Unit { int pm, pn; };
struct Gemm { const bf16_t* A; const bf16_t* Bt; int M, N, K; };

struct StaticOrder {
    int nM, nN, nwg, G, c;
    __host__ __device__ void init(int M, int N, int G_, int c_) { nM = M / BM; nN = N / BM; nwg = nM * nN; G = G_; c = c_; }
    __host__ __device__ bool next(int i, Unit& u) const {
        const long L = (long)i * G + c; if (L >= nwg) return false;
        int wgid = (int)L; { const int q = nwg / NXCD, r = nwg % NXCD, xcd = wgid % NXCD, off = wgid / NXCD; wgid = (xcd < r ? xcd * (q + 1) : r * (q + 1) + (xcd - r) * q) + off; }
        const int nig = WGM * nN, gid = wgid / nig, fm = gid * WGM, gsz = (nM - fm) < WGM ? (nM - fm) : WGM;
        u.pm = fm + ((wgid % nig) % gsz); u.pn = (wgid % nig) / gsz; return true;
    }
    __device__ __forceinline__ void a_ready(const Unit&) const {}
    __device__ __forceinline__ void done(const Unit&) const {}
};

struct GroupedOrder {
    int nMg, nNg, upg, ntot, G, c;
    __host__ __device__ void init(int ngrp, int nMg_, int nNg_, int G_, int c_) { nMg = nMg_; nNg = nNg_; upg = nMg * nNg; ntot = ngrp * upg; G = G_; c = c_; }
    __host__ __device__ bool next(int i, Unit& u) const {
        const long L = (long)i * G + c; if (L >= ntot) return false;
        const int e = (int)(L / upg); int wgid = (int)(L % upg);
        { const int q = upg / NXCD, r = upg % NXCD, xcd = wgid % NXCD, off = wgid / NXCD; wgid = (xcd < r ? xcd * (q + 1) : r * (q + 1) + (xcd - r) * q) + off; }
        const int nig = WGM_G * nNg, gid = wgid / nig, fm = gid * WGM_G, gsz = (nMg - fm) < WGM_G ? (nMg - fm) : WGM_G;
        u.pm = e * nMg + fm + ((wgid % nig) % gsz); u.pn = e * nNg + (wgid % nig) / gsz; return true;
    }
    __device__ __forceinline__ void a_ready(const Unit&) const {}
    __device__ __forceinline__ void done(const Unit&) const {}
};

#ifndef EPI_NT
#define EPI_NT 0
#endif
#if EPI_NT
#define EPI_ST(ptr, val) __builtin_nontemporal_store((val), (ptr))
#else
#define EPI_ST(ptr, val) (*(ptr) = (val))
#endif
#ifndef EPI_NT_B
#define EPI_NT_B 0
#endif
#if EPI_NT_B
#define EPI_ST_B(ptr, val) __builtin_nontemporal_store((val), (ptr))
#else
#define EPI_ST_B(ptr, val) (*(ptr) = (val))
#endif
__device__ __forceinline__ u32x4 pack8(const f32x4 a, const f32x4 b) { u32x4 w; w.x = pk2bf(a[0], a[1]); w.y = pk2bf(a[2], a[3]); w.z = pk2bf(b[0], b[1]); w.w = pk2bf(b[2], b[3]); return w; }
__device__ __forceinline__ void unpack8(const u32x4 w, f32x4& a, f32x4& b) { a = (f32x4){bflo(w.x), bfhi(w.x), bflo(w.y), bfhi(w.y)}; b = (f32x4){bflo(w.z), bfhi(w.z), bflo(w.w), bfhi(w.w)}; }
__device__ __forceinline__ float sigmoidf_fast(float x) { return __builtin_amdgcn_rcpf(1.0f + __builtin_amdgcn_exp2f(-1.4426950408889634f * x)); }

__device__ __forceinline__ size_t gate_blk(int pm, int pn, int wave, int ai, int m, int bj, int lane) { return ((size_t)(((pm * 4 + pn) * 8 + wave) * 16 + (ai * 8 + m * 2 + bj)) * 64 + lane) * 8; }
__device__ __forceinline__ u32x4 xchg_pair(const u32x4 v) { u32x4 r;
#pragma unroll
    for (int w = 0; w < 4; ++w) r[w] = (unsigned)__builtin_amdgcn_mov_dpp((int)v[w], 0xB1, 0xF, 0xF, true);
    return r; }
__device__ __forceinline__ void wide_pair(const u32x4 p0, const u32x4 p1, bool odd, u32x4& a, u32x4& b) {
    const u32x4 recv = xchg_pair(odd ? p0 : p1); a = odd ? recv : p0; b = odd ? p1 : recv; }
struct EpiInProj {
    static constexpr bool PERM = true, AFTER_DRAIN = false, WIDE = true;
    bf16_t *qa, *ka, *va, *qw, *kw, *vw, *gr, *g1; const float* bgate; float qscale;
    __device__ __forceinline__ void operator()(const f32x4 (&acc)[2][2][4][2], const Unit& u, int wr, int wc, int fr, int fq) const {
        const int pn = u.pn; const int row0 = u.pm * BM + wr * 64 + fr;
        if (pn >= 15) {
            const int cc0 = (pn - 15) * HALF + wc * 32 + 8 * fq;
            f32x4 b0[2], b1[2];
#pragma unroll
            for (int n = 0; n < 2; ++n) { b0[n] = *(const f32x4*)(bgate + cc0 + 4 * n); b1[n] = *(const f32x4*)(bgate + 1024 + cc0 + 4 * n); }
#pragma unroll
            for (int ai = 0; ai < 2; ++ai)
#pragma unroll
                for (int m = 0; m < 4; ++m) { const size_t off = gate_blk(u.pm, (pn - 15) >> 1, wr * 4 + wc, ai, m, (pn - 15) & 1, fq * 16 + fr); f32x4 rr[2], gg[2];
#pragma unroll
                    for (int n = 0; n < 2; ++n)
#pragma unroll
                        for (int j = 0; j < 4; ++j) { float a0 = acc[ai][0][m][n][j] + b0[n][j], a1 = acc[ai][1][m][n][j] + b1[n][j];
                            a0 = fminf(fmaxf(a0, -30.f), 30.f); a1 = fminf(fmaxf(a1, -30.f), 30.f);
                            const float e0 = __builtin_amdgcn_exp2f(-1.4426950408889634f * a0), e1 = __builtin_amdgcn_exp2f(-1.4426950408889634f * a1);
                            gg[n][j] = __builtin_amdgcn_rcpf(1.0f + e1); rr[n][j] = (1.0f + e1) * __builtin_amdgcn_rcpf(1.0f + e0); }
                    EPI_ST_B((u32x4*)(gr + off), pack8(rr[0], rr[1])); EPI_ST_B((u32x4*)(g1 + off), pack8(gg[0], gg[1])); }
            return;
        }
        bf16_t* base; int ldc, ct; float sc = 1.0f;
        if (pn < 3) { base = qa; ldc = 768; ct = pn; sc = qscale; }
        else if (pn < 6) { base = ka; ldc = 768; ct = pn - 3; }
        else if (pn < 9) { base = va; ldc = 768; ct = pn - 6; }
        else if (pn < 13) { base = qw; ldc = 1024; ct = pn - 9; sc = qscale; }
        else if (pn == 13) { base = kw; ldc = 256; ct = 0; }
        else { base = vw; ldc = 256; ct = 0; }
        const bool odd = (fr & 1) != 0;
        const int col0 = ct * BM + wc * 64 + 8 * fq + (odd ? 32 : 0);
#pragma unroll
        for (int ai = 0; ai < 2; ++ai)
#pragma unroll
            for (int m = 0; m < 4; ++m) { bf16_t* rowp = base + (size_t)(row0 - (odd ? 1 : 0) + ai * HALF + m * 16) * ldc + col0;
                u32x4 a, b; wide_pair(pack8(acc[ai][0][m][0] * sc, acc[ai][0][m][1] * sc), pack8(acc[ai][1][m][0] * sc, acc[ai][1][m][1] * sc), odd, a, b);
                EPI_ST_B((u32x4*)rowp, a); EPI_ST_B((u32x4*)(rowp + ldc), b); }
    }
};
struct EpiMergeDual {
    static constexpr bool PERM = true, AFTER_DRAIN = false, WIDE = true;
    bf16_t* merged; const bf16_t* gr; const bf16_t* g1;
    __device__ __forceinline__ size_t gblk(const Unit& u, int wr, int wc, int ai, int m, int bj, int fr, int fq) const { return gate_blk(u.pm, u.pn, wr * 4 + 2 * (wc & 1) + bj, ai, m, wc >> 1, fq * 16 + fr); }
    __device__ __forceinline__ void mid(f32x4 (&acc)[2][2][4][2], const Unit& u, int wr, int wc, int fr, int fq) const {
        u32x4 w[2][4][2];
#pragma unroll
        for (int ai = 0; ai < 2; ++ai)
#pragma unroll
            for (int m = 0; m < 4; ++m) {
#pragma unroll
                for (int bj = 0; bj < 2; ++bj) w[ai][m][bj] = *(const u32x4*)(gr + gblk(u, wr, wc, ai, m, bj, fr, fq)); }
        asm volatile("" ::: "memory");
#pragma unroll
        for (int ai = 0; ai < 2; ++ai)
#pragma unroll
            for (int m = 0; m < 4; ++m) {
#pragma unroll
                for (int bj = 0; bj < 2; ++bj) { f32x4 r0, r1; unpack8(w[ai][m][bj], r0, r1); acc[ai][bj][m][0] *= r0; acc[ai][bj][m][1] *= r1; } }
    }
    __device__ __forceinline__ void operator()(const f32x4 (&acc)[2][2][4][2], const Unit& u, int wr, int wc, int fr, int fq) const {
        const bool odd = (fr & 1) != 0;
        const int rowe = u.pm * BM + wr * 64 + (fr & ~1), col = u.pn * BM + wc * 64 + 8 * fq + (odd ? 32 : 0);
        u32x4 w[2][4][2];
#pragma unroll
        for (int ai = 0; ai < 2; ++ai)
#pragma unroll
            for (int m = 0; m < 4; ++m) {
#pragma unroll
                for (int bj = 0; bj < 2; ++bj) w[ai][m][bj] = *(const u32x4*)(g1 + gblk(u, wr, wc, ai, m, bj, fr, fq)); }
        asm volatile("" ::: "memory");
#pragma unroll
        for (int ai = 0; ai < 2; ++ai)
#pragma unroll
            for (int m = 0; m < 4; ++m) { f32x4 a0, a1, c0, c1; unpack8(w[ai][m][0], a0, a1); unpack8(w[ai][m][1], c0, c1);
                u32x4 a, b; wide_pair(pack8(acc[ai][0][m][0] * a0, acc[ai][0][m][1] * a1), pack8(acc[ai][1][m][0] * c0, acc[ai][1][m][1] * c1), odd, a, b);
                bf16_t* p = merged + (size_t)(rowe + ai * HALF + m * 16) * 1024 + col;
                EPI_ST((u32x4*)p, a); EPI_ST((u32x4*)(p + 1024), b); }
    }
};
struct EpiResid {
    static constexpr bool PERM = true, AFTER_DRAIN = false, WIDE = true;
    const bf16_t* base; bf16_t* out;
    __device__ __forceinline__ void operator()(const f32x4 (&acc)[2][2][4][2], const Unit& u, int wr, int wc, int fr, int fq) const {
        const bool odd = (fr & 1) != 0;
        const int rowe = u.pm * BM + wr * 64 + (fr & ~1), col = u.pn * BM + wc * 64 + 8 * fq + (odd ? 32 : 0);
        u32x4 la[2][4], lb[2][4];
#pragma unroll
        for (int ai = 0; ai < 2; ++ai)
#pragma unroll
            for (int m = 0; m < 4; ++m) { const bf16_t* p = base + (size_t)(rowe + ai * HALF + m * 16) * 1024 + col; la[ai][m] = *(const u32x4*)p; lb[ai][m] = *(const u32x4*)(p + 1024); }
        asm volatile("" ::: "memory");
#pragma unroll
        for (int ai = 0; ai < 2; ++ai)
#pragma unroll
            for (int m = 0; m < 4; ++m) {
                const u32x4 recv = xchg_pair(odd ? la[ai][m] : lb[ai][m]); const u32x4 r0 = odd ? recv : la[ai][m], r1 = odd ? lb[ai][m] : recv;
                f32x4 b0, b1, c0, c1; unpack8(r0, b0, b1); unpack8(r1, c0, c1);
                u32x4 a, b; wide_pair(pack8(b0 + acc[ai][0][m][0], b1 + acc[ai][0][m][1]), pack8(c0 + acc[ai][1][m][0], c1 + acc[ai][1][m][1]), odd, a, b);
                bf16_t* p = out + (size_t)(rowe + ai * HALF + m * 16) * 1024 + col;
                EPI_ST((u32x4*)p, a); EPI_ST((u32x4*)(p + 1024), b); }
    }
};
struct EpiSwiGLU {
    static constexpr bool PERM = true, AFTER_DRAIN = false, WIDE = false;
    bf16_t* act;
    __device__ __forceinline__ void operator()(const f32x4 (&acc)[2][2][4][2], const Unit& u, int wr, int wc, int fr, int fq) const {
        const int row0 = u.pm * BM + wr * 64 + fr, col0 = (u.pn & 7) * HALF + wc * 32 + 8 * fq;
#pragma unroll
        for (int ai = 0; ai < 2; ++ai)
#pragma unroll
            for (int m = 0; m < 4; ++m) { f32x4 o[2];
#pragma unroll
                for (int n = 0; n < 2; ++n)
#pragma unroll
                    for (int j = 0; j < 4; ++j) { const float a = acc[ai][0][m][n][j], up = acc[ai][1][m][n][j]; o[n][j] = a * sigmoidf_fast(a) * up; }
                EPI_ST((u32x4*)(act + (size_t)(row0 + ai * HALF + m * 16) * 1024 + col0), pack8(o[0], o[1])); }
    }
};
struct EpiDown {
    static constexpr bool PERM = true, AFTER_DRAIN = false, WIDE = true;
    bf16_t* y; const PG8_LAS float* glds; mutable int ui;
    __device__ __forceinline__ void operator()(const f32x4 (&acc)[2][2][4][2], const Unit& u, int wr, int wc, int fr, int fq) const {
        const bool odd = (fr & 1) != 0;
        const int rowe = u.pm * BM + wr * 64 + (fr & ~1), col = (u.pn & 3) * BM + wc * 64 + 8 * fq + (odd ? 32 : 0);
#pragma unroll
        for (int ai = 0; ai < 2; ++ai)
#pragma unroll
            for (int m = 0; m < 4; ++m) { const float gv = glds[ui * 256 + wr * 64 + fr + ai * HALF + m * 16];
                u32x4 a, b; wide_pair(pack8(acc[ai][0][m][0] * gv, acc[ai][0][m][1] * gv), pack8(acc[ai][1][m][0] * gv, acc[ai][1][m][1] * gv), odd, a, b);
                bf16_t* p = y + (size_t)(rowe + ai * HALF + m * 16) * 1024 + col;
                EPI_ST((u32x4*)p, a); EPI_ST((u32x4*)(p + 1024), b); }
        ++ui;
    }
};

template <class Epi, class Sched, bool ALIGN_EPI = false, bool SP2 = false, bool GATHER = false>
__device__ __forceinline__ void gemm_phase(int tid_, PG8_LAS unsigned char* lds, const Gemm g, const Sched& S, const Epi& E, const PG8_LAS int* arow = nullptr) {
    static_assert(!GATHER || SP2, "GATHER is written for the SP2 loop");
    asm volatile("" : "+v"(tid_));
    const int tid = tid_, wid = __builtin_amdgcn_readfirstlane(tid >> 6), lane = tid & 63, wr = wid >> 2, wc = wid & 3, fr = lane & 15, fq = lane >> 4;
    const int K = g.K, nt = K / BK;
    unsigned voffA[2], voffB[2];
#pragma unroll
    for (int i = 0; i < 2; ++i) { int R, C; stage_rc(tid * 16 + i * 8192, R, C); const int Rb = Epi::WIDE ? ((R >> 5) * 64 + perm32(R & 31)) : (Epi::PERM ? ((R & ~31) + perm32(R & 31)) : R);
        voffA[i] = (unsigned)(R * K + C) * 2u; voffB[i] = (unsigned)(Rb * K + C) * 2u; }
    unsigned vA0[2] = {voffA[0], voffA[1]}, vA1[2] = {voffA[0], voffA[1]}, nA0[2] = {voffA[0], voffA[1]}, nA1[2] = {voffA[0], voffA[1]};
    int gR[2], gC[2];
#pragma unroll
    for (int i = 0; i < 2; ++i) { stage_rc(tid * 16 + i * 8192, gR[i], gC[i]); }
#define PG8_GOFF(dst0, dst1, u_) do { _Pragma("unroll") for (int _i = 0; _i < 2; ++_i) { \
        dst0[_i] = ((unsigned)arow[(u_) * 256 + gR[_i]] * (unsigned)K + (unsigned)gC[_i]) * 2u; dst1[_i] = ((unsigned)arow[(u_) * 256 + HALF + gR[_i]] * (unsigned)K + (unsigned)gC[_i]) * 2u; } } while (0)
    const size_t kstep = (size_t)(BK * 2);
    const size_t hstep = (size_t)HALF * K * 2;
    const size_t tstep = 2 * hstep;
    const size_t bhs = Epi::WIDE ? (size_t)32 * K * 2 : hstep;
    const size_t ahs = GATHER ? (size_t)0 : hstep, atstep = GATHER ? (size_t)0 : tstep;
    const unsigned ldsw = (unsigned)wid * 1024u;
    const int aoff = lds_byte(wr * 64 + fr, fq * 8), boff = lds_byte(wc * 32 + fr, fq * 8);
#define PG8_SA(b, h) (((b) * 2 + (h)) * HTB)
#define PG8_SB(b, h) ((4 + (b) * 2 + (h)) * HTB)
#define PG8_STAGE(bufoff, gbase, voff) do { _Pragma("unroll") for (int _i = 0; _i < 2; ++_i) \
        __builtin_amdgcn_global_load_lds((const unsigned*)((const char*)(gbase) + (voff)[_i]), (PG8_LAS unsigned*)(lds + (bufoff) + ldsw + _i * 8192), 16, 0, 0); } while (0)
#define PG8_LDA(dst, b, h) do { _Pragma("unroll") for (int m = 0; m < 4; ++m) _Pragma("unroll") for (int k = 0; k < 2; ++k) dst[m][k] = *(const PG8_LAS bf16x8*)(lds + PG8_SA(b, h) + aoff + m * 2048 + k * 1024); } while (0)
#define PG8_LDB(dst, b, h) do { _Pragma("unroll") for (int n = 0; n < 2; ++n) _Pragma("unroll") for (int k = 0; k < 2; ++k) dst[n][k] = *(const PG8_LAS bf16x8*)(lds + PG8_SB(b, h) + boff + n * 2048 + k * 1024); } while (0)
#define PG8_MMA(ai, bj, At, Bt) do { __builtin_amdgcn_s_setprio(1); _Pragma("unroll") for (int m = 0; m < 4; ++m) _Pragma("unroll") for (int n = 0; n < 2; ++n) _Pragma("unroll") for (int k = 0; k < 2; ++k) \
        acc[ai][bj][m][n] = __builtin_amdgcn_mfma_f32_16x16x32_bf16(Bt[n][k], At[m][k], acc[ai][bj][m][n], 0, 0, 0); __builtin_amdgcn_s_setprio(0); } while (0)
#define PG8_WAIT_V(n) asm volatile("s_waitcnt vmcnt(" #n ")" ::: "memory")
#define PG8_WAIT_L(n) asm volatile("s_waitcnt lgkmcnt(" #n ")" ::: "memory")
#define PG8_BAR __builtin_amdgcn_s_barrier()
#define PG8_SCHED __builtin_amdgcn_sched_barrier(0)
    Unit cur, nxt; int ui = 0;
    if (!S.next(0, cur)) return;
    f32x4 acc[2][2][4][2];
#pragma unroll
    for (int a = 0; a < 2; ++a)
#pragma unroll
        for (int b = 0; b < 2; ++b)
#pragma unroll
            for (int m = 0; m < 4; ++m)
#pragma unroll
                for (int n = 0; n < 2; ++n) acc[a][b][m][n] = (f32x4){0.f, 0.f, 0.f, 0.f};
    bf16x8 At[4][2], B0[2][2], B1[2][2];
    const char* cA = (const char*)g.A + (size_t)cur.pm * atstep; const char* cB = (const char*)g.Bt + (size_t)cur.pn * tstep;
    if constexpr (GATHER) { PG8_GOFF(vA0, vA1, 0); }
    S.a_ready(cur);
    if constexpr (SP2) {
        PG8_STAGE(PG8_SB(0, 0), cB, voffB); PG8_STAGE(PG8_SB(0, 1), cB + bhs, voffB); PG8_STAGE(PG8_SA(0, 0), cA, vA0); PG8_STAGE(PG8_SA(0, 1), cA + ahs, vA1);
        if (wr == 1) PG8_BAR;
        PG8_WAIT_V(2); PG8_BAR;
        PG8_STAGE(PG8_SB(1, 0), cB + kstep, voffB); PG8_STAGE(PG8_SA(1, 0), cA + kstep, vA0); PG8_STAGE(PG8_SB(1, 1), cB + bhs + kstep, voffB);
        PG8_WAIT_V(6); PG8_BAR;
    } else {
        PG8_STAGE(PG8_SB(0, 0), cB, voffB); PG8_STAGE(PG8_SA(0, 0), cA, voffA); PG8_STAGE(PG8_SB(0, 1), cB + bhs, voffB); PG8_STAGE(PG8_SA(0, 1), cA + hstep, voffA);
        if (wr == 1) PG8_BAR;
        PG8_WAIT_V(4); PG8_BAR;
        PG8_STAGE(PG8_SB(1, 0), cB + kstep, voffB); PG8_STAGE(PG8_SA(1, 0), cA + kstep, voffA); PG8_STAGE(PG8_SB(1, 1), cB + bhs + kstep, voffB);
        PG8_WAIT_V(6); PG8_BAR;
    }
    for (;;) {
        const bool has_next = S.next(ui + 1, nxt);
        const char* nA = has_next ? (const char*)g.A + (size_t)nxt.pm * atstep : cA; const char* nB = has_next ? (const char*)g.Bt + (size_t)nxt.pn * tstep : cB;
#pragma unroll 1
        for (int t = 0; t < nt; t += 2) {
            const bool last = (t == nt - 2);
            const char* a1 = cA + (size_t)(t + 1) * kstep;
            const char* a2 = last ? nA : cA + (size_t)(t + 2) * kstep; const char* b2 = last ? nB : cB + (size_t)(t + 2) * kstep;
            const char* a3 = a2 + kstep; const char* b3 = b2 + kstep;
            if (last && has_next) S.a_ready(nxt);
            unsigned s0[2] = {vA0[0], vA0[1]}, s1[2] = {vA1[0], vA1[1]};
            if constexpr (GATHER) { if (last && has_next) { PG8_GOFF(nA0, nA1, ui + 1); s0[0] = nA0[0]; s0[1] = nA0[1]; s1[0] = nA1[0]; s1[1] = nA1[1]; } }
            if constexpr (SP2) {
            PG8_LDB(B0, 0, 0); PG8_LDB(B1, 0, 1); PG8_SCHED; PG8_LDA(At, 0, 0); PG8_STAGE(PG8_SA(1, 1), a1 + ahs, vA1);
            PG8_WAIT_V(8); PG8_WAIT_L(0); PG8_BAR; PG8_MMA(0, 0, At, B0); PG8_MMA(0, 1, At, B1); PG8_BAR; PG8_SCHED;
            PG8_LDA(At, 0, 1); PG8_STAGE(PG8_SB(0, 0), b2, voffB); PG8_STAGE(PG8_SB(0, 1), b2 + bhs, voffB); PG8_STAGE(PG8_SA(0, 0), a2, s0);
            PG8_WAIT_V(8); PG8_WAIT_L(0); PG8_BAR; PG8_MMA(1, 0, At, B0); PG8_MMA(1, 1, At, B1); PG8_BAR; PG8_SCHED;
            PG8_LDB(B0, 1, 0); PG8_LDB(B1, 1, 1); PG8_SCHED; PG8_LDA(At, 1, 0); PG8_STAGE(PG8_SA(0, 1), a2 + ahs, s1);
            PG8_WAIT_V(8); PG8_WAIT_L(0); PG8_BAR; PG8_MMA(0, 0, At, B0); PG8_MMA(0, 1, At, B1); PG8_BAR; PG8_SCHED;
            PG8_LDA(At, 1, 1); PG8_STAGE(PG8_SB(1, 0), b3, voffB); PG8_STAGE(PG8_SB(1, 1), b3 + bhs, voffB); PG8_STAGE(PG8_SA(1, 0), a3, s0);
            PG8_WAIT_V(8); PG8_WAIT_L(0); PG8_BAR; PG8_MMA(1, 0, At, B0); PG8_MMA(1, 1, At, B1); PG8_BAR; PG8_SCHED;
            } else {
            PG8_LDB(B0, 0, 0); PG8_SCHED; PG8_LDA(At, 0, 0); PG8_STAGE(PG8_SA(1, 1), a1 + hstep, voffA);
            PG8_WAIT_L(8); PG8_BAR; PG8_WAIT_L(0); PG8_MMA(0, 0, At, B0); PG8_BAR; PG8_SCHED;
            PG8_LDB(B1, 0, 1); PG8_STAGE(PG8_SB(0, 0), b2, voffB);
            PG8_BAR; PG8_WAIT_L(0); PG8_MMA(0, 1, At, B1); PG8_BAR;
            PG8_LDA(At, 0, 1); PG8_STAGE(PG8_SA(0, 0), a2, voffA);
            PG8_BAR; PG8_WAIT_L(0); PG8_MMA(1, 0, At, B0); PG8_BAR; PG8_SCHED;
            PG8_STAGE(PG8_SB(0, 1), b2 + bhs, voffB);
            PG8_WAIT_V(6); PG8_BAR; PG8_MMA(1, 1, At, B1); PG8_BAR;
            PG8_LDB(B0, 1, 0); PG8_SCHED; PG8_LDA(At, 1, 0); PG8_STAGE(PG8_SA(0, 1), a2 + hstep, voffA);
            PG8_WAIT_L(8); PG8_BAR; PG8_WAIT_L(0); PG8_MMA(0, 0, At, B0); PG8_BAR; PG8_SCHED;
            PG8_LDB(B1, 1, 1); PG8_STAGE(PG8_SB(1, 0), b3, voffB);
            PG8_BAR; PG8_WAIT_L(0); PG8_MMA(0, 1, At, B1); PG8_BAR;
            PG8_LDA(At, 1, 1); PG8_STAGE(PG8_SA(1, 0), a3, voffA);
            PG8_BAR; PG8_WAIT_L(0); PG8_MMA(1, 0, At, B0); PG8_BAR; PG8_SCHED;
            PG8_STAGE(PG8_SB(1, 1), b3 + bhs, voffB);
            PG8_WAIT_V(6); PG8_BAR; PG8_MMA(1, 1, At, B1); PG8_BAR;
            }
        }
        if constexpr (ALIGN_EPI) { if (wr == 0) PG8_BAR; }
        if constexpr (!Epi::AFTER_DRAIN) { E(acc, cur, wr, wc, fr, fq); S.done(cur); }
        if (!has_next) break;
#pragma unroll
        for (int a = 0; a < 2; ++a)
#pragma unroll
            for (int b = 0; b < 2; ++b)
#pragma unroll
                for (int m = 0; m < 4; ++m)
#pragma unroll
                    for (int n = 0; n < 2; ++n) acc[a][b][m][n] = (f32x4){0.f, 0.f, 0.f, 0.f};
        cur = nxt; cA = nA; cB = nB; ++ui;
        if constexpr (GATHER) { vA0[0] = nA0[0]; vA0[1] = nA0[1]; vA1[0] = nA1[0]; vA1[1] = nA1[1]; }
        if constexpr (ALIGN_EPI) { if (wr == 1) PG8_BAR; }
    }
    PG8_WAIT_V(0);
    if constexpr (!ALIGN_EPI) { if (wr == 0) PG8_BAR; }
    PG8_BAR;
    if constexpr (Epi::AFTER_DRAIN) { E.fused(acc, cur, wr, wc, fr, fq, lds, wid, lane); S.done(cur); }
#undef PG8_SA
#undef PG8_SB
#undef PG8_STAGE
#undef PG8_LDA
#undef PG8_LDB
#undef PG8_MMA
#undef PG8_WAIT_V
#undef PG8_WAIT_L
#undef PG8_BAR
#undef PG8_SCHED
#undef PG8_GOFF
}

template <class Epi, class Sched>
__device__ __forceinline__ void gemm_phase_dual(int tid_, PG8_LAS unsigned char* lds, const Gemm g0, const Gemm g1, const Sched& S, const Epi& E) {
    asm volatile("" : "+v"(tid_));
    const int tid = tid_, wid = __builtin_amdgcn_readfirstlane(tid >> 6), lane = tid & 63, wr = wid >> 2, wc = wid & 3, fr = lane & 15, fq = lane >> 4;
    unsigned vA_0[2], vB_0[2], vA_1[2], vB_1[2];
#pragma unroll
    for (int i = 0; i < 2; ++i) { int R, C; stage_rc(tid * 16 + i * 8192, R, C); const int Rb = Epi::WIDE ? ((R >> 5) * 64 + perm32(R & 31)) : (Epi::PERM ? ((R & ~31) + perm32(R & 31)) : R);
        vA_0[i] = (unsigned)(R * g0.K + C) * 2u; vB_0[i] = (unsigned)(Rb * g0.K + C) * 2u; vA_1[i] = (unsigned)(R * g1.K + C) * 2u; vB_1[i] = (unsigned)(Rb * g1.K + C) * 2u; }
    const size_t kstep = (size_t)(BK * 2);
    const size_t hs_0 = (size_t)HALF * g0.K * 2, hs_1 = (size_t)HALF * g1.K * 2;
#define PG8_BH(x) (Epi::WIDE ? (x) / 4 : (x))
    const int nt_0 = g0.K / BK, nt_1 = g1.K / BK;
    const unsigned ldsw = (unsigned)wid * 1024u;
    const int aoff = lds_byte(wr * 64 + fr, fq * 8), boff = lds_byte(wc * 32 + fr, fq * 8);
#define PG8_SA(b, h) (((b) * 2 + (h)) * HTB)
#define PG8_SB(b, h) ((4 + (b) * 2 + (h)) * HTB)
#define PG8_STAGE(bufoff, gbase, voff) do { _Pragma("unroll") for (int _i = 0; _i < 2; ++_i) \
        __builtin_amdgcn_global_load_lds((const unsigned*)((const char*)(gbase) + (voff)[_i]), (PG8_LAS unsigned*)(lds + (bufoff) + ldsw + _i * 8192), 16, 0, 0); } while (0)
#define PG8_LDA(dst, b, h) do { _Pragma("unroll") for (int m = 0; m < 4; ++m) _Pragma("unroll") for (int k = 0; k < 2; ++k) dst[m][k] = *(const PG8_LAS bf16x8*)(lds + PG8_SA(b, h) + aoff + m * 2048 + k * 1024); } while (0)
#define PG8_LDB(dst, b, h) do { _Pragma("unroll") for (int n = 0; n < 2; ++n) _Pragma("unroll") for (int k = 0; k < 2; ++k) dst[n][k] = *(const PG8_LAS bf16x8*)(lds + PG8_SB(b, h) + boff + n * 2048 + k * 1024); } while (0)
#define PG8_MMA(ai, bj, At, Bt) do { __builtin_amdgcn_s_setprio(1); _Pragma("unroll") for (int m = 0; m < 4; ++m) _Pragma("unroll") for (int n = 0; n < 2; ++n) _Pragma("unroll") for (int k = 0; k < 2; ++k) \
        acc[ai][bj][m][n] = __builtin_amdgcn_mfma_f32_16x16x32_bf16(Bt[n][k], At[m][k], acc[ai][bj][m][n], 0, 0, 0); __builtin_amdgcn_s_setprio(0); } while (0)
#define PG8_WAIT_V(n) asm volatile("s_waitcnt vmcnt(" #n ")" ::: "memory")
#define PG8_WAIT_L(n) asm volatile("s_waitcnt lgkmcnt(" #n ")" ::: "memory")
#define PG8_BAR __builtin_amdgcn_s_barrier()
#define PG8_SCHED __builtin_amdgcn_sched_barrier(0)
    Unit cur, nxt; int ui = 0, s = 0;
    if (!S.next(0, cur)) return;
    f32x4 acc[2][2][4][2];
#pragma unroll
    for (int a = 0; a < 2; ++a)
#pragma unroll
        for (int b = 0; b < 2; ++b)
#pragma unroll
            for (int m = 0; m < 4; ++m)
#pragma unroll
                for (int n = 0; n < 2; ++n) acc[a][b][m][n] = (f32x4){0.f, 0.f, 0.f, 0.f};
    bf16x8 At[4][2], B0[2][2], B1[2][2];
    const char* cA = (const char*)g0.A + (size_t)cur.pm * 2 * hs_0; const char* cB = (const char*)g0.Bt + (size_t)cur.pn * 2 * hs_0;
    size_t hsC = hs_0; unsigned vAc[2] = {vA_0[0], vA_0[1]}, vBc[2] = {vB_0[0], vB_0[1]};
    PG8_STAGE(PG8_SB(0, 0), cB, vBc); PG8_STAGE(PG8_SB(0, 1), cB + PG8_BH(hsC), vBc); PG8_STAGE(PG8_SA(0, 0), cA, vAc); PG8_STAGE(PG8_SA(0, 1), cA + hsC, vAc);
    if (wr == 1) PG8_BAR;
    PG8_WAIT_V(2); PG8_BAR;
    PG8_STAGE(PG8_SB(1, 0), cB + kstep, vBc); PG8_STAGE(PG8_SA(1, 0), cA + kstep, vAc); PG8_STAGE(PG8_SB(1, 1), cB + PG8_BH(hsC) + kstep, vBc);
    PG8_WAIT_V(6); PG8_BAR;
    for (;;) {
        bool has_next = true; if (s == 1) has_next = S.next(ui + 1, nxt);
        const int npm = (s == 0) ? cur.pm : nxt.pm, npn = (s == 0) ? cur.pn : nxt.pn;
        const size_t hsN = has_next ? (s == 0 ? hs_1 : hs_0) : hsC;
        const char* nA = has_next ? (s == 0 ? (const char*)g1.A : (const char*)g0.A) + (size_t)npm * 2 * hsN : cA;
        const char* nB = has_next ? (s == 0 ? (const char*)g1.Bt : (const char*)g0.Bt) + (size_t)npn * 2 * hsN : cB;
        unsigned vAn[2], vBn[2];
#pragma unroll
        for (int i = 0; i < 2; ++i) { vAn[i] = has_next ? (s == 0 ? vA_1[i] : vA_0[i]) : vAc[i]; vBn[i] = has_next ? (s == 0 ? vB_1[i] : vB_0[i]) : vBc[i]; }
        const int nt = (s == 0) ? nt_0 : nt_1;
#pragma unroll 1
        for (int t = 0; t < nt; t += 2) {
            const bool last = (t == nt - 2);
            const char* a1 = cA + (size_t)(t + 1) * kstep;
            const char* a2 = last ? nA : cA + (size_t)(t + 2) * kstep; const char* b2 = last ? nB : cB + (size_t)(t + 2) * kstep;
            const char* a3 = a2 + kstep; const char* b3 = b2 + kstep;
            const size_t hs2 = last ? hsN : hsC;
            unsigned vA2[2], vB2[2];
#pragma unroll
            for (int i = 0; i < 2; ++i) { vA2[i] = last ? vAn[i] : vAc[i]; vB2[i] = last ? vBn[i] : vBc[i]; }
            PG8_LDB(B0, 0, 0); PG8_LDB(B1, 0, 1); PG8_SCHED; PG8_LDA(At, 0, 0); PG8_STAGE(PG8_SA(1, 1), a1 + hsC, vAc);
            PG8_WAIT_V(8); PG8_WAIT_L(0); PG8_BAR; PG8_MMA(0, 0, At, B0); PG8_MMA(0, 1, At, B1); PG8_BAR; PG8_SCHED;
            PG8_LDA(At, 0, 1); PG8_STAGE(PG8_SB(0, 0), b2, vB2); PG8_STAGE(PG8_SB(0, 1), b2 + PG8_BH(hs2), vB2); PG8_STAGE(PG8_SA(0, 0), a2, vA2);
            PG8_WAIT_V(8); PG8_WAIT_L(0); PG8_BAR; PG8_MMA(1, 0, At, B0); PG8_MMA(1, 1, At, B1); PG8_BAR; PG8_SCHED;
            PG8_LDB(B0, 1, 0); PG8_LDB(B1, 1, 1); PG8_SCHED; PG8_LDA(At, 1, 0); PG8_STAGE(PG8_SA(0, 1), a2 + hs2, vA2);
            PG8_WAIT_V(8); PG8_WAIT_L(0); PG8_BAR; PG8_MMA(0, 0, At, B0); PG8_MMA(0, 1, At, B1); PG8_BAR; PG8_SCHED;
            PG8_LDA(At, 1, 1); PG8_STAGE(PG8_SB(1, 0), b3, vB2); PG8_STAGE(PG8_SB(1, 1), b3 + PG8_BH(hs2), vB2); PG8_STAGE(PG8_SA(1, 0), a3, vA2);
            PG8_WAIT_V(8); PG8_WAIT_L(0); PG8_BAR; PG8_MMA(1, 0, At, B0); PG8_MMA(1, 1, At, B1); PG8_BAR; PG8_SCHED;
        }
        if (wr == 0) PG8_BAR;
        if (s == 0) E.mid(acc, cur, wr, wc, fr, fq); else E(acc, cur, wr, wc, fr, fq);
        if (!has_next) break;
        if (s == 1) {
#pragma unroll
            for (int a = 0; a < 2; ++a)
#pragma unroll
                for (int b = 0; b < 2; ++b)
#pragma unroll
                    for (int m = 0; m < 4; ++m)
#pragma unroll
                        for (int n = 0; n < 2; ++n) acc[a][b][m][n] = (f32x4){0.f, 0.f, 0.f, 0.f};
            cur = nxt; ++ui; }
        s ^= 1; cA = nA; cB = nB; hsC = hsN;
#pragma unroll
        for (int i = 0; i < 2; ++i) { vAc[i] = vAn[i]; vBc[i] = vBn[i]; }
        if (wr == 1) PG8_BAR;
    }
    PG8_WAIT_V(0);
    PG8_BAR;
#undef PG8_SA
#undef PG8_SB
#undef PG8_STAGE
#undef PG8_LDA
#undef PG8_LDB
#undef PG8_MMA
#undef PG8_WAIT_V
#undef PG8_WAIT_L
#undef PG8_BAR
#undef PG8_SCHED
#undef PG8_BH
}
}

constexpr int NWAVES = 8;
constexpr int NB = 32, SEQ = 2048, DM = 1024, MTOK = NB * SEQ, DEPTH = 4;
constexpr int INC = 5888, NE = 16, CAP = 256, DEX = 1024, MEXP = NE * NB * CAP;
constexpr float RMS_EPS = 1e-6f, LOG2E = 1.4426950408889634f;
constexpr float QSCALE = 0.125f * LOG2E;

constexpr size_t MiB = 1u << 20;
constexpr size_t WS_CTL = 0, CTL_ZERO_BYTES = 32768;
constexpr size_t WS_WIN = 1 * MiB;
constexpr size_t WS_WA = WS_WIN + (size_t)INC * DM * 2;
constexpr size_t WS_WB = WS_WA + (size_t)DM * 256 * 2;
constexpr size_t WS_WO = WS_WB + (size_t)DM * DM * 2;
constexpr size_t WS_WGU = WS_WO + (size_t)DM * DM * 2;
constexpr size_t WS_WD = WS_WGU + (size_t)NE * 2048 * DM * 2;
constexpr size_t WS_HN = WS_WD + (size_t)NE * DM * DEX * 2;
constexpr size_t WS_BIG = WS_HN + (size_t)MTOK * DM * 2;
constexpr size_t B_QA = 0, B_KA = 96 * MiB, B_VA = 192 * MiB, B_QW = 288 * MiB, B_KW = 416 * MiB, B_VW = 448 * MiB, B_G = 480 * MiB, B_OA = 736 * MiB, B_END = 768 * MiB;
constexpr size_t B_MERGED = 0;
constexpr size_t B_XE = 0, B_ACT = 256 * MiB, B_Y = 512 * MiB;
constexpr size_t WS_AFF = WS_BIG + B_END;
constexpr size_t WS_SEL = WS_AFF + (size_t)MTOK * NE * 4;
constexpr size_t WS_GATE = WS_SEL + (size_t)MTOK * NE * 4;
constexpr size_t WS_LSE = WS_GATE + (size_t)MEXP * 4;
constexpr size_t WS_IDX = WS_LSE + (size_t)3 * MTOK * 4 * 4;
constexpr size_t WS_HB = WS_IDX + (size_t)MEXP * 4;
constexpr size_t WS_END = WS_HB + (size_t)MTOK * DM * 2;
static_assert(WS_WIN % 256 == 0 && WS_WA % 256 == 0 && WS_WGU % 256 == 0 && WS_HN % 256 == 0 && WS_BIG % 256 == 0 && WS_AFF % 256 == 0, "alignment");
constexpr int CW_BAR = 4096;
constexpr int AROW_OFF = 131072;
constexpr int MISC_OFF = 147456, LDS_BYTES = 151552;

#define GAS __attribute__((address_space(1)))
#define LAS __attribute__((address_space(3)))
typedef unsigned short bf16;
typedef unsigned v4u __attribute__((ext_vector_type(4)));
typedef unsigned v2u __attribute__((ext_vector_type(2)));
typedef float f32x4 __attribute__((ext_vector_type(4)));
typedef float f32x16 __attribute__((ext_vector_type(16)));
typedef short bf16x8 __attribute__((ext_vector_type(8)));
#define LDS_WAIT() asm volatile("s_waitcnt lgkmcnt(0)" ::: "memory")
#define VM_WAIT() asm volatile("s_waitcnt vmcnt(0)" ::: "memory")

#define XB_TMO      128
#define XB_XCNT(j)  (256  + 64 * (j))
#define XB_XSUB(j)  (1280 + 64 * (j))
#define XB_XGEN(j)  (2304 + 64 * (j))
#define XB_TOP      3328
#define XB_TOPGEN   3392
#define XCD_BAR_WORDS 3456
#define XB_SPIN_CAP (1u << 18)

__device__ __forceinline__ unsigned xb_ld(unsigned* p)              { return __hip_atomic_load(p, __ATOMIC_RELAXED, __HIP_MEMORY_SCOPE_AGENT); }
__device__ __forceinline__ unsigned xb_add(unsigned* p, unsigned v) { return __hip_atomic_fetch_add(p, v, __ATOMIC_RELAXED, __HIP_MEMORY_SCOPE_AGENT); }
__device__ __forceinline__ unsigned xb_xcc_id() { return (unsigned)__builtin_amdgcn_s_getreg((3 << 11) | 20) & 0xFu; }
#define XB_SPIN(cond, bar) do { unsigned _sp = 0; while (cond) { __builtin_amdgcn_s_sleep(1); \
    if ((++_sp & 255u) == 0u) { if (xb_ld(&(bar)[XB_TMO])) break; if (_sp > XB_SPIN_CAP) { atomicAdd(&(bar)[XB_TMO], 1u); break; } } } } while (0)

__device__ __forceinline__ int xb_lane() { unsigned z = 0u; asm volatile("" : "+v"(z)); return (int)__builtin_amdgcn_mbcnt_hi(~0u, __builtin_amdgcn_mbcnt_lo(~0u, z)); }
struct XcdBarrier {
    int w;
    unsigned* bar; unsigned x;
    volatile LAS unsigned* st;
};

__device__ __forceinline__ XcdBarrier xcd_barrier_post(unsigned* bar, volatile LAS unsigned* st, int wave) {
    XcdBarrier b; b.w = wave; b.bar = bar; b.x = xb_xcc_id(); b.st = st;
    if (wave == 0 && xb_lane() == 0) (void)xb_add(&bar[XB_XCNT(b.x)], 1u);
    return b;
}
__device__ __forceinline__ void xcd_barrier_complete(unsigned* bar, unsigned x, unsigned& nloc, unsigned& nx) {
    const unsigned G = gridDim.x * gridDim.y * gridDim.z;
    unsigned sum, cnt, mine, sp = 0u;
    for (;;) {
        sum = 0u; cnt = 0u; mine = 0u;
#pragma unroll
        for (unsigned j = 0; j < 16; ++j) { const unsigned c = xb_ld(&bar[XB_XCNT(j)]); sum += c; cnt += (c > 0u) ? 1u : 0u; mine = (j == x) ? c : mine; }
        if (sum == G) break;
        __builtin_amdgcn_s_sleep(1);
        if ((++sp & 255u) == 0u) { if (xb_ld(&bar[XB_TMO])) break; if (sp > XB_SPIN_CAP) { atomicAdd(&bar[XB_TMO], 1u); break; } }
    }
    nloc = mine > 0u ? mine : 1u; nx = cnt > 0u ? cnt : 1u;
}

__device__ __forceinline__ void xcd_barrier(const XcdBarrier& b) {
    asm volatile("s_waitcnt vmcnt(0)" ::: "memory");
    __syncthreads();
    if (b.w == 0 && xb_lane() == 0) {
        unsigned* bar = b.bar;
        __builtin_amdgcn_s_waitcnt(0);
        unsigned nloc = b.st[0], nx = b.st[1];
        if (nloc == 0u) { xcd_barrier_complete(bar, b.x, nloc, nx); b.st[0] = nloc; b.st[1] = nx; }
        const unsigned old = xb_add(&bar[XB_XSUB(b.x)], 1u);
        const unsigned gen = old / nloc;
        if (old + 1u == (gen + 1u) * nloc) {
            __builtin_amdgcn_fence(__ATOMIC_RELEASE, "agent");
            asm volatile("s_waitcnt vmcnt(0)" ::: "memory");
            const unsigned og = xb_add(&bar[XB_TOP], 1u);
            const unsigned tg = og / nx;
            if (og + 1u == (tg + 1u) * nx) xb_add(&bar[XB_TOPGEN], 1u);
            else XB_SPIN(xb_ld(&bar[XB_TOPGEN]) == tg, bar);
            __builtin_amdgcn_fence(__ATOMIC_ACQUIRE, "agent");
            xb_add(&bar[XB_XGEN(b.x)], 1u);
            asm volatile("s_waitcnt vmcnt(0)" ::: "memory");
        } else {
            XB_SPIN(xb_ld(&bar[XB_XGEN(b.x)]) == gen, bar);
            __builtin_amdgcn_fence(__ATOMIC_ACQUIRE, "agent");
            asm volatile("s_waitcnt vmcnt(0)" ::: "memory");
        }
    }
    __syncthreads();
}

struct Frame {
    LAS unsigned char* lds;
    int tid, lane, wave, gw;
};
constexpr int PTAB_OFF = MISC_OFF + 256;
__device__ __forceinline__ unsigned long long ptab_get(LAS unsigned char* lds, int i) {
    LAS unsigned char* base = lds + PTAB_OFF; asm volatile("" : "+v"(base));
    const unsigned long long v = ((const volatile LAS unsigned long long*)base)[i];
    const unsigned lo = __builtin_amdgcn_readfirstlane((unsigned)v), hi = __builtin_amdgcn_readfirstlane((unsigned)(v >> 32));
    return ((unsigned long long)hi << 32) | lo;
}
#define P_IN(i) ((const float*)(const GAS float*)ptab_get(F.lds, (i)))
#define P_OUT ((float*)(GAS float*)ptab_get(F.lds, 14))
#define P_WS ((unsigned char*)(GAS unsigned char*)ptab_get(F.lds, 15))
__device__ __forceinline__ Frame make_frame(LAS unsigned char* lds, int wave_s) { Frame F; F.lds = lds; int bx = blockIdx.x; asm volatile("" : "+s"(bx));
    int ln = xb_lane(); asm volatile("" : "+v"(ln));
    F.lane = ln; F.wave = wave_s; F.tid = wave_s * 64 + ln; F.gw = bx * NWAVES + F.wave; return F; }
__device__ __forceinline__ float shx(float v, int o, int lane) { return __builtin_bit_cast(float, __builtin_amdgcn_ds_bpermute((lane ^ o) << 2, __builtin_bit_cast(int, v))); }
__device__ __forceinline__ unsigned shrel(unsigned v, int d, int lane) { return (unsigned)__builtin_amdgcn_ds_bpermute(((lane + d) & 63) << 2, (int)v); }
__device__ __forceinline__ float wave_sum(float v, int lane) {
#pragma unroll
    for (int o = 1; o < 64; o <<= 1) v += shx(v, o, lane);
    return v;
}
__device__ __forceinline__ void transpose_item(const float* W, int K, int N, bf16* dst, LAS float* scr, int k0, int n0, int lane) {
    float tv[32];
#pragma unroll
    for (int i = 0; i < 32; ++i) { const int kk = 2 * i + (lane >> 5); tv[i] = W[(size_t)(k0 + kk) * N + n0 + (lane & 31)]; }
#pragma unroll
    for (int i = 0; i < 32; ++i) { const int kk = 2 * i + (lane >> 5); scr[kk * 33 + (lane & 31)] = tv[i]; }
    LDS_WAIT(); asm volatile("" ::: "memory");
    const int c = lane & 7;
#pragma unroll
    for (int j = 0; j < 4; ++j) { const int n = (lane >> 3) + 8 * j; const LAS float* s = scr + (8 * c) * 33 + n;
        v4u o; o.x = pk2bf(s[0 * 33], s[1 * 33]); o.y = pk2bf(s[2 * 33], s[3 * 33]); o.z = pk2bf(s[4 * 33], s[5 * 33]); o.w = pk2bf(s[6 * 33], s[7 * 33]);
        *(GAS v4u*)(dst + (size_t)n * K + k0 + 8 * c) = o; }
    LDS_WAIT(); asm volatile("" ::: "memory");
}
__device__ __forceinline__ void convert_weights(Frame& F, int l) {
    LAS float* scr = (LAS float*)(F.lds + F.wave * 8448);
    const int NGW = 256 * NWAVES;
    unsigned char* ws = P_WS;
    bf16* WinT = (bf16*)(ws + WS_WIN); bf16* WaT = (bf16*)(ws + WS_WA); bf16* WbT = (bf16*)(ws + WS_WB); bf16* WoT = (bf16*)(ws + WS_WO);
    bf16* WguT = (bf16*)(ws + WS_WGU); bf16* WdT = (bf16*)(ws + WS_WD);
    const float* w_in = P_IN(2) + (size_t)l * DM * INC; const float* w_a = P_IN(3) + (size_t)l * 256 * DM; const float* w_b = P_IN(4) + (size_t)l * DM * DM;
    const float* w_o = P_IN(7) + (size_t)l * DM * DM;
    const float* w_g = P_IN(10) + (size_t)l * NE * DM * DEX; const float* w_u = P_IN(11) + (size_t)l * NE * DM * DEX; const float* w_d = P_IN(12) + (size_t)l * NE * DEX * DM;
    constexpr int I_IN = 16 * (INC / 32), I_A = 4 * 32, I_B = 16 * 32, I_O = 16 * 32, I_E = NE * 16 * 32;
    constexpr int NITEMS = I_IN + I_A + I_B + I_O + 3 * I_E;
    for (int it = F.gw; it < NITEMS; it += NGW) {
        int r = it;
        if (r < I_IN) { const int nb = r % (INC / 32), kb = r / (INC / 32), n0 = 32 * nb; int drow = n0;
            if (n0 >= 3840) { const int gc = n0 - 3840, br = gc >> 10, cc = gc & 1023; drow = 3840 + (cc >> 7) * 256 + ((cc & 127) >> 5) * 64 + br * 32; }
            transpose_item(w_in, DM, INC, WinT + (size_t)drow * DM, scr, 64 * kb, n0, F.lane); continue; } r -= I_IN;
        if (r < I_A) { const int nb = r % 32, kb = r / 32; transpose_item(w_a, 256, DM, WaT + (size_t)(32 * nb) * 256, scr, 64 * kb, 32 * nb, F.lane); continue; } r -= I_A;
        if (r < I_B) { const int nb = r % 32, kb = r / 32; transpose_item(w_b, DM, DM, WbT + (size_t)(32 * nb) * DM, scr, 64 * kb, 32 * nb, F.lane); continue; } r -= I_B;
        if (r < I_O) { const int nb = r % 32, kb = r / 32; transpose_item(w_o, DM, DM, WoT + (size_t)(32 * nb) * DM, scr, 64 * kb, 32 * nb, F.lane); continue; } r -= I_O;
        if (r < 2 * I_E) { const int up = r >= I_E; if (up) r -= I_E; const int e = r / 512, loc = r % 512, nb = loc % 32, kb = loc / 32, f0 = 32 * nb;
            const float* W = (up ? w_u : w_g) + (size_t)e * DM * DEX;
            transpose_item(W, DM, DEX, WguT + ((size_t)e * 2048 + (f0 >> 7) * 256 + (up ? 128 : 0) + (f0 & 127)) * DM, scr, 64 * kb, f0, F.lane); continue; } r -= 2 * I_E;
        { const int e = r / 512, loc = r % 512, nb = loc % 32, kb = loc / 32;
            transpose_item(w_d + (size_t)e * DEX * DM, DEX, DM, WdT + ((size_t)e * 1024 + 32 * nb) * DEX, scr, 64 * kb, 32 * nb, F.lane); }
    }
}
__device__ __forceinline__ void unpk8(const v4u w, float (&v)[8]) { v[0] = bflo(w.x); v[1] = bfhi(w.x); v[2] = bflo(w.y); v[3] = bfhi(w.y); v[4] = bflo(w.z); v[5] = bfhi(w.z); v[6] = bflo(w.w); v[7] = bfhi(w.w); }
__device__ __forceinline__ v4u pk8(const float (&v)[8]) { v4u w; w.x = pk2bf(v[0], v[1]); w.y = pk2bf(v[2], v[3]); w.z = pk2bf(v[4], v[5]); w.w = pk2bf(v[6], v[7]); return w; }
template <bool XIN, bool COMBINE, bool FINAL>
__device__ __forceinline__ void norm_rows(Frame& F, const float* xin, bf16* hb, const float* gain, bf16* hn, float* out) {
    const int NGW = 256 * NWAVES;
    unsigned char* ws = P_WS;
    const int* sel = (const int*)(ws + WS_SEL); const bf16* Y = (const bf16*)(ws + WS_BIG + B_Y);
    float gv[2][8];
#pragma unroll
    for (int j = 0; j < 2; ++j) { const f32x4 a = *(const f32x4*)(gain + (64 * j + F.lane) * 8), b = *(const f32x4*)(gain + (64 * j + F.lane) * 8 + 4);
        gv[j][0] = a.x; gv[j][1] = a.y; gv[j][2] = a.z; gv[j][3] = a.w; gv[j][4] = b.x; gv[j][5] = b.y; gv[j][6] = b.z; gv[j][7] = b.w; }
    constexpr int NR = 4;
    for (int m0 = F.gw; m0 < MTOK; m0 += NR * NGW) {
        float v[NR][2][8]; int sv[NR];
#pragma unroll
        for (int rr = 0; rr < NR; ++rr) { const int m = m0 + rr * NGW;
            if (COMBINE) sv[rr] = sel[(size_t)m * NE + (F.lane & 15)];
            if (XIN) {
#pragma unroll
                for (int j = 0; j < 2; ++j) { const f32x4 a = *(const f32x4*)(xin + (size_t)m * DM + (64 * j + F.lane) * 8), b = *(const f32x4*)(xin + (size_t)m * DM + (64 * j + F.lane) * 8 + 4);
                    v[rr][j][0] = a.x; v[rr][j][1] = a.y; v[rr][j][2] = a.z; v[rr][j][3] = a.w; v[rr][j][4] = b.x; v[rr][j][5] = b.y; v[rr][j][6] = b.z; v[rr][j][7] = b.w; }
            } else {
#pragma unroll
                for (int j = 0; j < 2; ++j) unpk8(*(const v4u*)(hb + (size_t)m * DM + (64 * j + F.lane) * 8), v[rr][j]);
            } }
        if (COMBINE) {
            unsigned msk[NR];
#pragma unroll
            for (int rr = 0; rr < NR; ++rr) msk[rr] = (unsigned)(__builtin_amdgcn_ballot_w64(sv[rr] >= 0) & 0xffffull);
            unsigned any = 0u;
#pragma unroll
            for (int rr = 0; rr < NR; ++rr) any |= msk[rr];
            while (any != 0u) {
                v4u yv[NR][2]; float wgt[NR];
#pragma unroll
                for (int rr = 0; rr < NR; ++rr) { const int m = m0 + rr * NGW, b = m >> 11; const bool has = msk[rr] != 0u;
                    const int e = has ? __builtin_ctz(msk[rr]) : 0; const int r = has ? __builtin_amdgcn_readlane(sv[rr], e) : 0;
                    const bf16* yr = Y + ((size_t)(e * NB + b) * CAP + r) * DM; wgt[rr] = has ? 1.0f : 0.0f; msk[rr] &= msk[rr] - 1u;
#pragma unroll
                    for (int j = 0; j < 2; ++j) yv[rr][j] = *(const v4u*)(yr + (64 * j + F.lane) * 8); }
                any = 0u;
#pragma unroll
                for (int rr = 0; rr < NR; ++rr) { any |= msk[rr];
#pragma unroll
                    for (int j = 0; j < 2; ++j) { float y[8]; unpk8(yv[rr][j], y);
#pragma unroll
                        for (int i = 0; i < 8; ++i) v[rr][j][i] += wgt[rr] * y[i]; } }
            }
        }
#pragma unroll
        for (int rr = 0; rr < NR; ++rr) { const int m = m0 + rr * NGW;
            if ((XIN || COMBINE) && !FINAL) {
#pragma unroll
                for (int j = 0; j < 2; ++j) *(v4u*)(hb + (size_t)m * DM + (64 * j + F.lane) * 8) = pk8(v[rr][j]);
            }
            float ss = 0.f;
#pragma unroll
            for (int j = 0; j < 2; ++j)
#pragma unroll
                for (int i = 0; i < 8; ++i) ss += v[rr][j][i] * v[rr][j][i];
            const float rs = 1.0f / sqrtf(wave_sum(ss, F.lane) * (1.0f / DM) + RMS_EPS);
#pragma unroll
            for (int j = 0; j < 2; ++j) { float o[8];
#pragma unroll
                for (int i = 0; i < 8; ++i) o[i] = v[rr][j][i] * rs * gv[j][i];
                if (FINAL) { float* op = out + (size_t)m * DM + (64 * j + F.lane) * 8; *(f32x4*)op = (f32x4){o[0], o[1], o[2], o[3]}; *(f32x4*)(op + 4) = (f32x4){o[4], o[5], o[6], o[7]}; }
                else *(v4u*)(hn + (size_t)m * DM + (64 * j + F.lane) * 8) = pk8(o); } }
    }
}
constexpr int RT_PITCH = 2048 + 16;
__device__ __forceinline__ void norm_router(Frame& F, const bf16* hb, const float* gain, const float* wr, bf16* hn, float* aff) {
    LAS unsigned char* whi = F.lds; LAS unsigned char* wlo = F.lds + 16 * RT_PITCH; LAS float* gl = (LAS float*)(F.lds + 32 * RT_PITCH);
    { const float g0 = gain[F.tid], g1 = gain[F.tid + NWAVES * 64]; gl[F.tid] = g0; gl[F.tid + NWAVES * 64] = g1; }
    __syncthreads();
    { f32x4 wv[8];
#pragma unroll
      for (int j = 0; j < 8; ++j) wv[j] = *(const f32x4*)(wr + 4 * (F.tid + j * NWAVES * 64));
      asm volatile("" ::: "memory");
#pragma unroll
      for (int j = 0; j < 8; ++j) { const int i0 = 4 * (F.tid + j * NWAVES * 64), k = i0 >> 4, e0 = i0 & 15; const float g = gl[k];
#pragma unroll
          for (int t = 0; t < 4; ++t) { const float w = wv[j][t] * g; const unsigned hi = pk2bf(w, 0.f) & 0xffffu; const float rem = w - bflo(hi);
              *(LAS unsigned short*)(whi + (e0 + t) * RT_PITCH + k * 2) = (unsigned short)hi; *(LAS unsigned short*)(wlo + (e0 + t) * RT_PITCH + k * 2) = (unsigned short)(pk2bf(rem, 0.f) & 0xffffu); } } }
    __syncthreads();
    const int NGW = 256 * NWAVES, r16 = F.lane & 15, q = F.lane >> 4;
    for (int grp = F.gw; grp < MTOK / 16; grp += NGW) {
        const size_t row = (size_t)grp * 16 + r16;
        v4u xs[32];
#pragma unroll
        for (int s = 0; s < 16; ++s) { const v4u* p = (const v4u*)(hb + row * DM + 64 * s + 16 * q); xs[2 * s] = p[0]; xs[2 * s + 1] = p[1]; }
        f32x4 acc = {0.f, 0.f, 0.f, 0.f}; float ss = 0.f;
#pragma unroll
        for (int s = 0; s < 16; ++s) {
#pragma unroll
            for (int h2 = 0; h2 < 2; ++h2) { const bf16x8 a = __builtin_bit_cast(bf16x8, xs[2 * s + h2]);
                const bf16x8 bh = *(const LAS bf16x8*)(whi + r16 * RT_PITCH + (64 * s + 16 * q + 8 * h2) * 2), bl = *(const LAS bf16x8*)(wlo + r16 * RT_PITCH + (64 * s + 16 * q + 8 * h2) * 2);
                acc = __builtin_amdgcn_mfma_f32_16x16x32_bf16(a, bh, acc, 0, 0, 0); acc = __builtin_amdgcn_mfma_f32_16x16x32_bf16(a, bl, acc, 0, 0, 0);
                float x[8]; unpk8(xs[2 * s + h2], x);
#pragma unroll
                for (int i = 0; i < 8; ++i) ss += x[i] * x[i]; }
            asm volatile("" ::: "memory"); }
        ss += shx(ss, 16, F.lane); ss += shx(ss, 32, F.lane);
        const float rs = 1.0f / sqrtf(ss * (1.0f / DM) + RMS_EPS);
        float lg[4];
#pragma unroll
        for (int r = 0; r < 4; ++r) { const float rr = __builtin_bit_cast(float, __builtin_amdgcn_ds_bpermute((4 * q + r) << 2, __builtin_bit_cast(int, rs))); lg[r] = acc[r] * rr; }
#pragma unroll
        for (int r = 0; r < 4; ++r) { float mx = lg[r];
#pragma unroll
            for (int o = 1; o < 16; o <<= 1) mx = fmaxf(mx, shx(mx, o, F.lane));
            const float ex = __expf(lg[r] - mx); float sm = ex;
#pragma unroll
            for (int o = 1; o < 16; o <<= 1) sm += shx(sm, o, F.lane);
            aff[((size_t)grp * 16 + 4 * q + r) * NE + r16] = ex / sm; }
#pragma unroll
        for (int s = 0; s < 16; ++s) {
#pragma unroll
            for (int h2 = 0; h2 < 2; ++h2) { v4u t = xs[2 * s + h2]; asm volatile("" : "+v"(t));
                float x[8]; unpk8(t, x); const int k0 = 64 * s + 16 * q + 8 * h2;
                const f32x4 ga = *(const LAS f32x4*)(gl + k0), gb = *(const LAS f32x4*)(gl + k0 + 4);
                x[0] *= rs * ga.x; x[1] *= rs * ga.y; x[2] *= rs * ga.z; x[3] *= rs * ga.w; x[4] *= rs * gb.x; x[5] *= rs * gb.y; x[6] *= rs * gb.z; x[7] *= rs * gb.w;
                *(v4u*)(hn + row * DM + k0) = pk8(x); }
            asm volatile("" ::: "memory"); }
    }
}
__device__ __forceinline__ void topk_gather(Frame& F, const float* aff, int* sel, float* gatev, int* idxg) {
    LAS unsigned* hist = (LAS unsigned*)F.lds;
    volatile LAS unsigned* st = (volatile LAS unsigned*)(F.lds + 1024);
    for (int u = blockIdx.x; u < NB * NE; u += 256) {
        const int b = u >> 4, e = u & 15;
        unsigned bits[4];
#pragma unroll
        for (int q = 0; q < 4; ++q) bits[q] = __float_as_uint(aff[((size_t)b * SEQ + 4 * F.tid + q) * NE + e]);
        unsigned prefix = 0u, kk = CAP;
#pragma unroll 1
        for (int pass = 0; pass < 4; ++pass) {
            const int shift = 24 - 8 * pass;
            if (F.tid < 256) hist[F.tid] = 0u;
            __syncthreads();
#pragma unroll
            for (int q = 0; q < 4; ++q) { const bool in = (pass == 0) || ((bits[q] >> (shift + 8)) == prefix); if (in) atomicAdd((unsigned*)&hist[(bits[q] >> shift) & 255u], 1u); }
            __syncthreads();
            if (F.wave == 0) {
                const unsigned c0 = hist[4 * F.lane], c1 = hist[4 * F.lane + 1], c2 = hist[4 * F.lane + 2], c3 = hist[4 * F.lane + 3];
                unsigned incl = c0 + c1 + c2 + c3;
#pragma unroll
                for (int o = 1; o < 64; o <<= 1) { const unsigned v = shrel(incl, o, F.lane); if (F.lane + o < 64) incl += v; }
                unsigned cum = incl - (c0 + c1 + c2 + c3);
                int found = -1; unsigned above = 0u;
                if (cum < kk && cum + c3 >= kk) { found = 3; above = cum; } cum += c3;
                if (cum < kk && cum + c2 >= kk) { found = 2; above = cum; } cum += c2;
                if (cum < kk && cum + c1 >= kk) { found = 1; above = cum; } cum += c1;
                if (cum < kk && cum + c0 >= kk) { found = 0; above = cum; }
                if (found >= 0) { st[0] = (prefix << 8) | (unsigned)(4 * F.lane + found); st[1] = kk - above; }
            }
            __syncthreads();
            prefix = st[0]; kk = st[1];
        }
        const unsigned T = prefix;
        unsigned ngt = 0u, neq = 0u;
#pragma unroll
        for (int q = 0; q < 4; ++q) { ngt += bits[q] > T ? 1u : 0u; neq += bits[q] == T ? 1u : 0u; }
        unsigned pk = ngt | (neq << 16), inc = pk;
#pragma unroll
        for (int o = 1; o < 64; o <<= 1) { const unsigned v = shrel(inc, -o, F.lane); if (F.lane >= o) inc += v; }
        if (F.lane == 63) st[8 + F.wave] = inc;
        __syncthreads();
        unsigned base = 0u;
#pragma unroll
        for (int w = 0; w < NWAVES; ++w) base += (w < F.wave) ? st[8 + w] : 0u;
        const unsigned excl = base + inc - pk;
        unsigned pgt = excl & 0xffffu, peq = excl >> 16;
#pragma unroll
        for (int q = 0; q < 4; ++q) { const int i = 4 * F.tid + q; const bool g = bits[q] > T, eq = bits[q] == T; const bool keep = g || (eq && peq < kk);
            const unsigned slot = pgt + (peq < kk ? peq : kk);
            if (keep) { idxg[(size_t)(e * NB + b) * CAP + slot] = b * SEQ + i; gatev[(size_t)(e * NB + b) * CAP + slot] = __uint_as_float(bits[q]); }
            sel[((size_t)b * SEQ + i) * NE + e] = keep ? (int)slot : -1;
            pgt += g ? 1u : 0u; peq += eq ? 1u : 0u; }
        __syncthreads();
    }
}


constexpr int ATT_KPITCH = 144, ATT_VT_OFF = 512 * ATT_KPITCH, ATT_VPITCH = 1040, ATT_SINK_OFF = MISC_OFF + 1024;
static_assert(ATT_VT_OFF + 64 * ATT_VPITCH <= MISC_OFF, "attention LDS");
#ifndef ATT_JT_UNROLL
#define ATT_JT_UNROLL 1
#endif
struct ChunkP { const bf16* K; const bf16* V; int ldkv, tok0, cstep, r, L, nseg, qs, i0; };
template <int W>
__device__ __forceinline__ void attn_issue(const ChunkP& p, int tid, v4u (&kreg)[8], v4u (&vreg)[2][4]) {
    asm volatile("" : "+v"(tid));
    const int KS = p.qs + 2 * W, nrows = p.nseg * KS, Lm1 = p.L - 1;
    constexpr int NKP = 8;
#pragma unroll
    for (int it = 0; it < NKP; ++it) { const int pc = tid + it * NWAVES * 64, row0 = pc >> 3, ch = pc & 7, row = row0 < nrows ? row0 : nrows - 1, s = row >= KS ? 1 : 0, rho = row - s * KS;
        int j = p.i0 - W + rho; j = j < 0 ? 0 : j; j = j > Lm1 ? Lm1 : j;
        kreg[it] = *(const v4u*)(p.K + (size_t)(p.tok0 + s * p.cstep + p.r * j) * p.ldkv + ch * 8); }
#pragma unroll
    for (int it = 0; it < 2; ++it) { const int t = tid + it * NWAVES * 64, r4 = t >> 3, ch = t & 7, rowa = 4 * r4, row0 = rowa < nrows ? rowa : nrows - 4, s = row0 >= KS ? 1 : 0, rho = row0 - s * KS, j0 = p.i0 - W + rho;
#pragma unroll
        for (int q = 0; q < 4; ++q) { int j = j0 + q; j = j < 0 ? 0 : j; j = j > Lm1 ? Lm1 : j;
            vreg[it][q] = *(const v4u*)(p.V + (size_t)(p.tok0 + s * p.cstep + p.r * j) * p.ldkv + ch * 8); } }
}
__device__ __forceinline__ void attn_loadq(const Frame& F, const ChunkP& p, const bf16* Q, int ldq, bf16x8 (&qf)[4]) {
    int lane_ = F.lane; asm volatile("" : "+v"(lane_));
    const int wq = F.wave * 32, sidx = (wq >= p.qs) ? 1 : 0, qo = wq - sidx * p.qs, ql = lane_ & 31, hh = lane_ >> 5, qi = p.i0 + qo + ql;
    const bf16* q0 = Q + (size_t)(p.tok0 + sidx * p.cstep + p.r * qi) * ldq;
#pragma unroll
    for (int ks = 0; ks < 4; ++ks) qf[ks] = *(const bf16x8*)(q0 + 16 * ks + 8 * hh);
}
template <int W>
__device__ __forceinline__ void attn_commit(Frame& F, const ChunkP& p, const v4u (&kreg)[8], const v4u (&vreg)[2][4]) {
    int tid = F.tid; asm volatile("" : "+v"(tid));
    const int KS = p.qs + 2 * W, nrows = p.nseg * KS;
    LAS unsigned char* ldsK = F.lds; LAS unsigned char* ldsV = F.lds + ATT_VT_OFF;
    constexpr int NKP = 8;
#pragma unroll
    for (int it = 0; it < NKP; ++it) { const int pc = tid + it * NWAVES * 64, row = pc >> 3, ch = pc & 7;
        if (pc < nrows * 8) *(LAS v4u*)(ldsK + row * ATT_KPITCH + ch * 16) = kreg[it]; }
#pragma unroll
    for (int it = 0; it < 2; ++it) { const int t = tid + it * NWAVES * 64, r4 = t >> 3, ch = t & 7, row0 = 4 * r4;
        if (t < nrows * 2) {
            const int kap = row0 & 31, slot = (kap >> 4) * 16 + ((kap >> 2) & 1) * 8 + ((kap >> 3) & 1) * 4, pos = (row0 & ~31) + slot;
#pragma unroll
            for (int w = 0; w < 4; ++w) {
                v2u lo, hi;
                lo.x = (vreg[it][0][w] & 0xffffu) | (vreg[it][1][w] << 16); lo.y = (vreg[it][2][w] & 0xffffu) | (vreg[it][3][w] << 16);
                hi.x = (vreg[it][0][w] >> 16) | (vreg[it][1][w] & 0xffff0000u); hi.y = (vreg[it][2][w] >> 16) | (vreg[it][3][w] & 0xffff0000u);
                *(LAS v2u*)(ldsV + (ch * 8 + 2 * w) * ATT_VPITCH + pos * 2) = lo;
                *(LAS v2u*)(ldsV + (ch * 8 + 2 * w + 1) * ATT_VPITCH + pos * 2) = hi;
            } } }
}
#ifndef ATT_THR
#define ATT_THR 8.0f
#endif
template <int W, int NH, bool SINK, bool WRITE_LSE>
__device__ __forceinline__ void attn_compute(Frame& F, const ChunkP& p, bf16* Q, int ldq, long odelta, float* lse, float slope1, const float* sinkp, int hbase, bf16x8 (&qf)[4]) {
    constexpr int NJT = 2 * W / 32 + 1, JC = W / 32;
    const int KS = p.qs + 2 * W, L = p.L, i0 = p.i0;
    LAS unsigned char* ldsK = F.lds; LAS unsigned char* ldsV = F.lds + ATT_VT_OFF;
    const int wq = F.wave * 32, sidx = (wq >= p.qs) ? 1 : 0, qo = wq - sidx * p.qs, segbase = sidx * KS;
    int lane_ = F.lane; asm volatile("" : "+v"(lane_));
    const int ql = lane_ & 31, hh = lane_ >> 5;
    const int qi = i0 + qo + ql;
    const size_t qtok = (size_t)(p.tok0 + sidx * p.cstep + p.r * qi);
    const float flo = (float)((-qi > -W) ? -qi : -W), fhi = (float)((L - 1 - qi < W) ? (L - 1 - qi) : W);
#pragma unroll 1
    for (int g = 0; g < NH; ++g) {
        bf16* qptr = Q + qtok * ldq + g * 64;
        f32x16 O0, O1;
        float m, l;
#ifdef PRB_REP
        constexpr int nrep = (NH == PRB_NH) ? PRB_REP : 1;
#pragma unroll 1
        for (int rep = 0; rep < nrep; ++rep) {
        asm volatile("" ::: "memory");
#endif
#pragma unroll
        for (int i = 0; i < 16; ++i) { O0[i] = 0.f; O1[i] = 0.f; }
        const float sl = (NH == 1) ? slope1 : __builtin_amdgcn_exp2f(-0.5f * (float)(hbase + g + 1)) * LOG2E;
        const float sk2 = SINK ? *(const LAS float*)(F.lds + ATT_SINK_OFF + 4 * (hbase + g)) : 0.f;
        {
            const int jbase = i0 + qo - W + 32 * JC, krow = segbase + qo + 32 * JC;
            const bool need_mask = (jbase < 0) || (jbase + 31 >= L);
            f32x16 S;
#pragma unroll
            for (int i = 0; i < 16; ++i) S[i] = 0.f;
#pragma unroll
            for (int ks = 0; ks < 4; ++ks) { const bf16x8 kf = *(const LAS bf16x8*)(ldsK + (krow + ql) * ATT_KPITCH + (16 * ks + 8 * hh) * 2); S = __builtin_amdgcn_mfma_f32_32x32x16_bf16(kf, qf[ks], S, 0, 0, 0); }
            const float fd0 = (float)(jbase + 4 * hh - qi);
#pragma unroll
            for (int i = 0; i < 16; ++i) { const float fd = fd0 + (float)((i & 3) + 8 * (i >> 2)); S[i] = S[i] - sl * fabsf(fd); }
            if (need_mask) {
#pragma unroll
                for (int i = 0; i < 16; ++i) { const float fd = fd0 + (float)((i & 3) + 8 * (i >> 2)); S[i] = (fd >= flo && fd <= fhi) ? S[i] : -INFINITY; } }
            float mloc = S[0];
#pragma unroll
            for (int i = 1; i < 16; ++i) mloc = fmaxf(mloc, S[i]);
            m = fmaxf(mloc, shx(mloc, 32, lane_));
            float ps = 0.f;
#pragma unroll
            for (int i = 0; i < 16; ++i) { const float pv = __builtin_amdgcn_exp2f(S[i] - m); S[i] = pv; ps += pv; }
            l = ps;
#pragma unroll
            for (int s2 = 0; s2 < 2; ++s2) {
                f32x8_t pp;
#pragma unroll
                for (int i = 0; i < 8; ++i) pp[i] = S[8 * s2 + i];
                const bf16x8 pf = __builtin_bit_cast(bf16x8, __builtin_convertvector(pp, nbf16x8));
                const bf16x8 v0 = *(const LAS bf16x8*)(ldsV + ql * ATT_VPITCH + (krow + 16 * s2 + 8 * hh) * 2);
                const bf16x8 v1 = *(const LAS bf16x8*)(ldsV + (ql + 32) * ATT_VPITCH + (krow + 16 * s2 + 8 * hh) * 2);
                O0 = __builtin_amdgcn_mfma_f32_32x32x16_bf16(v0, pf, O0, 0, 0, 0);
                O1 = __builtin_amdgcn_mfma_f32_32x32x16_bf16(v1, pf, O1, 0, 0, 0);
            }
        }
#pragma unroll 1
        for (int jt = 0; jt < NJT; ++jt) {
            if (jt == JC) continue;
            const int jbase = i0 + qo - W + 32 * jt;
            if (jbase + 31 < 0 || jbase >= L) continue;
            const bool need_mask = (jt == 0) || (jt == NJT - 1) || (jbase < 0) || (jbase + 31 >= L);
            const int krow = segbase + qo + 32 * jt;
            const float fd0 = (float)(jbase + 4 * hh - qi);
            bf16x8 kf[4];
#pragma unroll
            for (int ks = 0; ks < 4; ++ks) kf[ks] = *(const LAS bf16x8*)(ldsK + (krow + ql) * ATT_KPITCH + (16 * ks + 8 * hh) * 2);
            const bf16x8 vf00 = *(const LAS bf16x8*)(ldsV + ql * ATT_VPITCH + (krow + 8 * hh) * 2), vf10 = *(const LAS bf16x8*)(ldsV + (ql + 32) * ATT_VPITCH + (krow + 8 * hh) * 2);
            f32x16 S;
            if (jt < JC) { const float k1 = sl * fd0 - m;
#pragma unroll
                for (int i = 0; i < 16; ++i) S[i] = fmaf(sl, (float)((i & 3) + 8 * (i >> 2)), k1); }
            else { const float k1 = -sl * fd0 - m;
#pragma unroll
                for (int i = 0; i < 16; ++i) S[i] = fmaf(-sl, (float)((i & 3) + 8 * (i >> 2)), k1); }
            if (need_mask) {
#pragma unroll
                for (int i = 0; i < 16; ++i) { const float fd = fd0 + (float)((i & 3) + 8 * (i >> 2)); S[i] = (fd >= flo && fd <= fhi) ? S[i] : -INFINITY; } }
#pragma unroll
            for (int ks = 0; ks < 4; ++ks) S = __builtin_amdgcn_mfma_f32_32x32x16_bf16(kf[ks], qf[ks], S, 0, 0, 0);
            const bf16x8 vf01 = *(const LAS bf16x8*)(ldsV + ql * ATT_VPITCH + (krow + 16 + 8 * hh) * 2), vf11 = *(const LAS bf16x8*)(ldsV + (ql + 32) * ATT_VPITCH + (krow + 16 + 8 * hh) * 2);
            float tmax = S[0];
#pragma unroll
            for (int i = 1; i < 16; ++i) tmax = fmaxf(tmax, S[i]);
            if (__builtin_amdgcn_ballot_w64(tmax > ATT_THR) != 0ull) {
                float d = fmaxf(tmax, 0.f); d = fmaxf(d, shx(d, 32, lane_));
                const float sc = __builtin_amdgcn_exp2f(-d);
#pragma unroll
                for (int i = 0; i < 16; ++i) { S[i] -= d; O0[i] *= sc; O1[i] *= sc; }
                l *= sc; m += d;
            }
            float ps = 0.f;
#pragma unroll
            for (int i = 0; i < 16; ++i) { const float pv = __builtin_amdgcn_exp2f(S[i]); S[i] = pv; ps += pv; }
            l += ps;
            { f32x8_t pp;
#pragma unroll
              for (int i = 0; i < 8; ++i) pp[i] = S[i];
              const bf16x8 pf = __builtin_bit_cast(bf16x8, __builtin_convertvector(pp, nbf16x8));
              O0 = __builtin_amdgcn_mfma_f32_32x32x16_bf16(vf00, pf, O0, 0, 0, 0); O1 = __builtin_amdgcn_mfma_f32_32x32x16_bf16(vf10, pf, O1, 0, 0, 0); }
            { f32x8_t pp;
#pragma unroll
              for (int i = 0; i < 8; ++i) pp[i] = S[8 + i];
              const bf16x8 pf = __builtin_bit_cast(bf16x8, __builtin_convertvector(pp, nbf16x8));
              O0 = __builtin_amdgcn_mfma_f32_32x32x16_bf16(vf01, pf, O0, 0, 0, 0); O1 = __builtin_amdgcn_mfma_f32_32x32x16_bf16(vf11, pf, O1, 0, 0, 0); }
        }
#ifdef PRB_REP
        }
        const float sk2 = SINK ? *(const LAS float*)(F.lds + ATT_SINK_OFF + 4 * (hbase + g)) : 0.f;
#endif
        float lt = l + shx(l, 32, lane_);
        float osc = 1.0f;
        if (SINK) { const float mf = fmaxf(m, sk2); osc = __builtin_amdgcn_exp2f(m - mf); lt = lt * osc + __builtin_amdgcn_exp2f(sk2 - mf); }
        if (WRITE_LSE) { if (hh == 0) lse[qtok * 4] = m + __builtin_amdgcn_logf(lt); }
        const float inv = osc / lt;
        if (NH > 1 && g + 1 < NH) {
#pragma unroll
            for (int ks = 0; ks < 4; ++ks) qf[ks] = *(const bf16x8*)(qptr + 64 + 16 * ks + 8 * hh); }
        v2u WW[8];
#pragma unroll
        for (int g4 = 0; g4 < 4; ++g4) {
            WW[g4].x = pk2bf(O0[4 * g4] * inv, O0[4 * g4 + 1] * inv); WW[g4].y = pk2bf(O0[4 * g4 + 2] * inv, O0[4 * g4 + 3] * inv);
            WW[4 + g4].x = pk2bf(O1[4 * g4] * inv, O1[4 * g4 + 1] * inv); WW[4 + g4].y = pk2bf(O1[4 * g4 + 2] * inv, O1[4 * g4 + 3] * inv); }
#pragma unroll
        for (int s4 = 0; s4 < 4; ++s4) {
            v2u a = WW[2 * s4], b = WW[2 * s4 + 1];
            { const auto r = __builtin_amdgcn_permlane32_swap(a.x, b.x, false, false); a.x = r[0]; b.x = r[1]; }
            { const auto r = __builtin_amdgcn_permlane32_swap(a.y, b.y, false, false); a.y = r[0]; b.y = r[1]; }
            *(v4u*)(qptr + odelta + 16 * s4 + 8 * hh) = (v4u){a.x, a.y, b.x, b.y};
#ifdef PRB_ST2
            asm volatile("" ::: "memory");
            *(v4u*)(qptr + odelta + 16 * s4 + 8 * hh) = (v4u){a.x, a.y, b.x, b.y};
            asm volatile("" ::: "memory");
#endif
        }
    }
}
__device__ __forceinline__ ChunkP dil_chunk(const bf16* KA, const bf16* VA, int b, int hs, int sc) {
    const int grp = sc >> 3, ix = sc & 7, col = grp * 256 + hs * 64; ChunkP p; p.K = KA + col; p.V = VA + col; p.ldkv = 768;
    if (grp == 0) { p.tok0 = b * SEQ; p.cstep = 0; p.r = 1; p.L = 2048; p.nseg = 1; p.qs = 256; p.i0 = 256 * ix; }
    else if (grp == 1) { p.tok0 = b * SEQ + (ix >> 1); p.cstep = 0; p.r = 4; p.L = 512; p.nseg = 1; p.qs = 256; p.i0 = 256 * (ix & 1); }
    else { p.tok0 = b * SEQ + 2 * ix; p.cstep = 1; p.r = 16; p.L = 128; p.nseg = 2; p.qs = 128; p.i0 = 0; }
    return p;
}
__device__ __forceinline__ ChunkP win_chunk(const bf16* KW, const bf16* VW, int wc) {
    const int b = wc >> 5, kvh = (wc >> 3) & 3, ch = wc & 7; ChunkP p; p.K = KW + kvh * 64; p.V = VW + kvh * 64; p.ldkv = 256;
    p.tok0 = b * SEQ; p.cstep = 0; p.r = 1; p.L = SEQ; p.nseg = 1; p.qs = 256; p.i0 = 256 * ch; return p;
}
__device__ __forceinline__ void attention_phase(Frame& F, int l, long odA, long odW, int which = 3) {
    unsigned char* ws = P_WS;
    bf16* big = (bf16*)(ws + WS_BIG);
    bf16* QA = big + B_QA / 2; bf16* KA = big + B_KA / 2; bf16* VA = big + B_VA / 2; bf16* QW = big + B_QW / 2; bf16* KW = big + B_KW / 2; bf16* VW = big + B_VW / 2; bf16* OA = big + B_OA / 2;
    float* LSE = (float*)(ws + WS_LSE);
    const int c = blockIdx.x;
    int w_lo, w_hi;
    v4u kreg[8], vreg[2][4];
    bf16x8 qf[4];
#ifndef ATT_N1
#define ATT_N1 0
#endif
    static_assert(ATT_N1 == 0, "the dilated workgroups take no window chunks");
    if (c < 128) { w_lo = ATT_N1 * c; w_hi = w_lo + ATT_N1; } else { w_lo = 128 * ATT_N1 + (c - 128) * (8 - ATT_N1); w_hi = w_lo + (8 - ATT_N1); }
    if (c < 128) { if (which & 1) {
        const int b = c >> 2, hs = c & 3;
        { const ChunkP p0 = dil_chunk(KA, VA, b, hs, 0); attn_issue<64>(p0, F.tid, kreg, vreg); attn_loadq(F, p0, QA + hs * 64, 768, qf); attn_commit<64>(F, p0, kreg, vreg); }
        __syncthreads();
#pragma unroll 1
        for (int sc = 0; sc < 24; ++sc) {
            const ChunkP p = dil_chunk(KA, VA, b, hs, sc); const int grp = sc >> 3;
            const int scn = sc + 1 < 24 ? sc + 1 : sc;
            const ChunkP pn = dil_chunk(KA, VA, b, hs, scn);
            bf16x8 qn[4];
            attn_issue<64>(pn, F.tid, kreg, vreg); attn_loadq(F, pn, QA + (scn >> 3) * 256 + hs * 64, 768, qn);
            const float slope1 = __builtin_amdgcn_exp2f(-8.0f * (float)(grp * 4 + hs + 1) / 12.0f) * (float)p.r * LOG2E;
            attn_compute<64, 1, false, true>(F, p, QA + grp * 256 + hs * 64, 768, odA, LSE + (size_t)grp * MTOK * 4 + hs, slope1, nullptr, 0, qf);
            __syncthreads();
            if (sc + 1 < 24) attn_commit<64>(F, pn, kreg, vreg);
            __syncthreads();
#pragma unroll
            for (int ks = 0; ks < 4; ++ks) qf[ks] = qn[ks];
        }
        VM_WAIT(); __syncthreads(); __builtin_amdgcn_fence(__ATOMIC_ACQUIRE, "agent"); VM_WAIT();
        constexpr int CB = 8;
#pragma unroll 1
        for (int t0 = F.tid; t0 < SEQ * 8; t0 += NWAVES * 64 * CB) {
            float lv[CB][3]; v4u av[CB][3];
#pragma unroll
            for (int k = 0; k < CB; ++k) { const int t = t0 + k * NWAVES * 64, tok = t >> 3, ch = t & 7; const size_t row = (size_t)b * SEQ + tok;
                lv[k][0] = LSE[row * 4 + hs]; lv[k][1] = LSE[(size_t)MTOK * 4 + row * 4 + hs]; lv[k][2] = LSE[(size_t)2 * MTOK * 4 + row * 4 + hs];
                const bf16* og = QA + odA + row * 768 + hs * 64 + ch * 8; av[k][0] = *(const v4u*)(og); av[k][1] = *(const v4u*)(og + 256); av[k][2] = *(const v4u*)(og + 512); }
            asm volatile("" ::: "memory");
#pragma unroll
            for (int k = 0; k < CB; ++k) { const int t = t0 + k * NWAVES * 64, tok = t >> 3, ch = t & 7; const size_t row = (size_t)b * SEQ + tok;
                const float mx = fmaxf(lv[k][0], fmaxf(lv[k][1], lv[k][2]));
                float w0 = __builtin_amdgcn_exp2f(lv[k][0] - mx), w1 = __builtin_amdgcn_exp2f(lv[k][1] - mx), w2 = __builtin_amdgcn_exp2f(lv[k][2] - mx);
                const float inv = 1.0f / (w0 + w1 + w2); w0 *= inv; w1 *= inv; w2 *= inv;
                v4u o;
#pragma unroll
                for (int w = 0; w < 4; ++w) o[w] = pk2bf(w0 * bflo(av[k][0][w]) + w1 * bflo(av[k][1][w]) + w2 * bflo(av[k][2][w]), w0 * bfhi(av[k][0][w]) + w1 * bfhi(av[k][1][w]) + w2 * bfhi(av[k][2][w]));
                *(v4u*)(OA + row * 256 + hs * 64 + ch * 8) = o; }
        }
    } } else if (which & 2) {
        if (F.tid < 16) *(LAS float*)(F.lds + ATT_SINK_OFF + 4 * F.tid) = P_IN(6)[l * 16 + F.tid] * LOG2E;
        const ChunkP p0 = win_chunk(KW, VW, w_lo); attn_issue<128>(p0, F.tid, kreg, vreg); attn_loadq(F, p0, QW + ((w_lo >> 3) & 3) * 256, 1024, qf); attn_commit<128>(F, p0, kreg, vreg);
        __syncthreads();
    }
#pragma unroll 1
    for (int wc = w_lo; wc < ((which & 2) ? w_hi : w_lo); ++wc) {
        const ChunkP p = win_chunk(KW, VW, wc); const int kvh = (wc >> 3) & 3;
        const int wn = wc + 1 < w_hi ? wc + 1 : wc;
        const ChunkP pn = win_chunk(KW, VW, wn);
        bf16x8 qn[4];
        attn_issue<128>(pn, F.tid, kreg, vreg); attn_loadq(F, pn, QW + ((wn >> 3) & 3) * 256, 1024, qn);
        attn_compute<128, 4, true, false>(F, p, QW + kvh * 256, 1024, odW, nullptr, 0.f, nullptr, kvh * 4, qf);
        __syncthreads();
        if (wc + 1 < w_hi) attn_commit<128>(F, pn, kreg, vreg);
        __syncthreads();
#pragma unroll
        for (int ks = 0; ks < 4; ++ks) qf[ks] = qn[ks];
    }
}
#ifndef PH_A
#define PH_A 1
#endif
#ifndef PH_B
#define PH_B 1
#endif
#ifndef PH_C
#define PH_C 1
#endif
#ifndef PH_D
#define PH_D 1
#endif
#ifndef PH_E
#define PH_E 1
#endif
#ifndef PH_F
#define PH_F 1
#endif
#ifndef PH_G
#define PH_G 1
#endif
#ifndef PH_H
#define PH_H 1
#endif
#ifndef PH_I
#define PH_I 1
#endif
#ifndef PH_J
#define PH_J 1
#endif
#ifndef PH_Z
#define PH_Z 1
#endif

struct Args { const float* in[14]; float* out; unsigned char* ws; };
__global__ void __launch_bounds__(NWAVES * 64, 2) mk_fwd(Args args) {
    extern __shared__ __attribute__((aligned(16))) unsigned char lds_raw[];
    LAS unsigned char* const lds = (LAS unsigned char*)lds_raw;
    int wave_s = __builtin_amdgcn_readfirstlane((int)(threadIdx.x >> 6)); asm volatile("" : "+s"(wave_s));
    {
        const int t0 = wave_s * 64 + xb_lane();
        volatile LAS unsigned* MISC = (volatile LAS unsigned*)(lds + MISC_OFF);
        if (t0 < 32) MISC[t0] = 0u;
        if (t0 == 0) { volatile LAS unsigned long long* pt = (volatile LAS unsigned long long*)(lds + PTAB_OFF);
            pt[0] = (unsigned long long)args.in[0]; pt[1] = (unsigned long long)args.in[1]; pt[2] = (unsigned long long)args.in[2]; pt[3] = (unsigned long long)args.in[3];
            pt[4] = (unsigned long long)args.in[4]; pt[5] = (unsigned long long)args.in[5]; pt[6] = (unsigned long long)args.in[6]; pt[7] = (unsigned long long)args.in[7];
            pt[8] = (unsigned long long)args.in[8]; pt[9] = (unsigned long long)args.in[9]; pt[10] = (unsigned long long)args.in[10]; pt[11] = (unsigned long long)args.in[11];
            pt[12] = (unsigned long long)args.in[12]; pt[13] = (unsigned long long)args.in[13]; pt[14] = (unsigned long long)args.out; pt[15] = (unsigned long long)args.ws; }
        __syncthreads();
    }
    XcdBarrier bar = xcd_barrier_post((unsigned*)(args.ws + WS_CTL) + CW_BAR, (volatile LAS unsigned*)(lds + MISC_OFF) + 8, wave_s);
    const int G = 256;

#pragma unroll 1
    for (int l = 0; l < DEPTH; ++l) {
        int c = blockIdx.x; asm volatile("" : "+s"(c));
#if PH_A
        { Frame F = make_frame(lds, wave_s); convert_weights(F, l);
          unsigned char* ws = P_WS;
          if (l == 0) norm_rows<true, false, false>(F, P_IN(0), (bf16*)(ws + WS_HB), P_IN(1) + l * DM, (bf16*)(ws + WS_HN), nullptr);
          else norm_rows<false, true, false>(F, nullptr, (bf16*)(ws + WS_HB), P_IN(1) + l * DM, (bf16*)(ws + WS_HN), nullptr);
          }
#endif
        xcd_barrier(bar);
#if PH_B
        { Frame F = make_frame(lds, wave_s); unsigned char* ws = P_WS; bf16* big = (bf16*)(ws + WS_BIG);
          pg8::Gemm g{(const bf16*)(ws + WS_HN), (const bf16*)(ws + WS_WIN), MTOK, INC, DM}; pg8::StaticOrder S; S.init(MTOK, INC, G, c);
          pg8::EpiInProj E{big + B_QA / 2, big + B_KA / 2, big + B_VA / 2, big + B_QW / 2, big + B_KW / 2, big + B_VW / 2, big + B_G / 2, big + B_G / 2 + (size_t)MTOK * DM, P_IN(5) + l * 2048, QSCALE};
          pg8::gemm_phase<pg8::EpiInProj, pg8::StaticOrder, true, true>(F.tid, lds, g, S, E); }
#endif
        xcd_barrier(bar);
#ifdef DUP_C
        { Frame F = make_frame(lds, wave_s); attention_phase(F, l, ((long)WS_HN - (long)(WS_BIG + B_QA)) / 2, ((long)WS_HN - (long)(WS_BIG + B_QW)) / 2, DUP_C); }
        xcd_barrier(bar);
#endif
#if PH_C
        { Frame F = make_frame(lds, wave_s); attention_phase(F, l, 0, 0); }
#endif
        xcd_barrier(bar);
#if PH_E
        { Frame F = make_frame(lds, wave_s); unsigned char* ws = P_WS; bf16* big = (bf16*)(ws + WS_BIG);
          pg8::Gemm g0{big + B_OA / 2, (const bf16*)(ws + WS_WA), MTOK, DM, 256}; pg8::Gemm g1{big + B_QW / 2, (const bf16*)(ws + WS_WB), MTOK, DM, DM}; pg8::StaticOrder S; S.init(MTOK, DM, G, c);
          pg8::EpiMergeDual E{big + B_MERGED / 2, big + B_G / 2, big + B_G / 2 + (size_t)MTOK * DM};
          pg8::gemm_phase_dual<pg8::EpiMergeDual, pg8::StaticOrder>(F.tid, lds, g0, g1, S, E); }
#endif
        xcd_barrier(bar);
#if PH_F
        { Frame F = make_frame(lds, wave_s); unsigned char* ws = P_WS; bf16* big = (bf16*)(ws + WS_BIG); bf16* hb = (bf16*)(ws + WS_HB);
          pg8::Gemm g{big + B_MERGED / 2, (const bf16*)(ws + WS_WO), MTOK, DM, DM}; pg8::StaticOrder S; S.init(MTOK, DM, G, c);
          pg8::EpiResid E{hb, hb};
          pg8::gemm_phase<pg8::EpiResid, pg8::StaticOrder, true, true>(F.tid, lds, g, S, E); }
#endif
        xcd_barrier(bar);
#if PH_G
        { Frame F = make_frame(lds, wave_s); unsigned char* ws = P_WS;
          norm_router(F, (const bf16*)(ws + WS_HB), P_IN(8) + l * DM, P_IN(9) + (size_t)l * DM * NE, (bf16*)(ws + WS_HN), (float*)(ws + WS_AFF)); }
#endif
        xcd_barrier(bar);
#if PH_H
        { Frame F = make_frame(lds, wave_s); unsigned char* ws = P_WS;
          topk_gather(F, (const float*)(ws + WS_AFF), (int*)(ws + WS_SEL), (float*)(ws + WS_GATE), (int*)(ws + WS_IDX)); }
#endif
        xcd_barrier(bar);
#if PH_I
        { Frame F = make_frame(lds, wave_s); unsigned char* ws = P_WS; bf16* big = (bf16*)(ws + WS_BIG);
          pg8::Gemm g{(const bf16*)(ws + WS_HN), (const bf16*)(ws + WS_WGU), MEXP, NE * 2048, DM}; pg8::GroupedOrder S; S.init(NE, NB, 8, G, c);
          pg8::EpiSwiGLU E{big + B_ACT / 2};
          { const int* idxg = (const int*)(ws + WS_IDX); LAS int* arow = (LAS int*)(lds + AROW_OFF);
            int rv[NE]; const int r = F.tid & 255;
#pragma unroll
            for (int i = 0; i < NE; ++i) { pg8::Unit u; u.pm = 0; u.pn = 0; S.next(i, u); rv[i] = u.pm; }
            asm volatile("" ::: "memory");
#pragma unroll
            for (int i = 0; i < NE; ++i) rv[i] = idxg[(size_t)rv[i] * 256 + r];
#pragma unroll
            for (int i = 0; i < NE; ++i) if (F.tid < 256) arow[i * 256 + r] = rv[i];
            __syncthreads(); }
          pg8::gemm_phase<pg8::EpiSwiGLU, pg8::GroupedOrder, true, true, true>(F.tid, lds, g, S, E, (const LAS int*)(lds + AROW_OFF)); }
#endif
        xcd_barrier(bar);
#if PH_J
        { Frame F = make_frame(lds, wave_s); unsigned char* ws = P_WS; bf16* big = (bf16*)(ws + WS_BIG);
          pg8::Gemm g{big + B_ACT / 2, (const bf16*)(ws + WS_WD), MEXP, NE * 1024, DEX}; pg8::GroupedOrder S; S.init(NE, NB, 4, G, c);
          pg8::EpiDown E{big + B_Y / 2, (const LAS float*)(lds + AROW_OFF), 0};
          { const float* gatev = (const float*)(ws + WS_GATE); LAS float* gl = (LAS float*)(lds + AROW_OFF);
            float gv[8]; int pmv[8]; const int r = F.tid & 255;
#pragma unroll
            for (int i = 0; i < 8; ++i) { pg8::Unit u; u.pm = 0; u.pn = 0; S.next(i, u); pmv[i] = u.pm; }
            asm volatile("" ::: "memory");
#pragma unroll
            for (int i = 0; i < 8; ++i) gv[i] = gatev[(size_t)pmv[i] * 256 + r];
#pragma unroll
            for (int i = 0; i < 8; ++i) if (F.tid < 256) gl[i * 256 + r] = gv[i];
            __syncthreads(); }
          pg8::gemm_phase<pg8::EpiDown, pg8::GroupedOrder, true, true>(F.tid, lds, g, S, E); }
#endif
        xcd_barrier(bar);
    }
#if PH_Z
    { Frame F = make_frame(lds, wave_s); unsigned char* ws = P_WS; norm_rows<false, true, true>(F, nullptr, (bf16*)(ws + WS_HB), P_IN(13), nullptr, P_OUT); }
#endif
}

extern "C" void kernel_launch(void* const* d_in, const int* in_sizes, int n_in, void* d_out, int out_size, void* d_ws, size_t ws_size, hipStream_t stream) {
    static int grid = 0;
    if (grid == 0) {
        if (n_in != 14 || out_size != MTOK * DM || ws_size < WS_END) { fprintf(stderr, "kernel_launch: unexpected shapes (n_in %d, out %d, ws %zu < %zu); nothing launched\n", n_in, out_size, ws_size, (size_t)WS_END); grid = -1; return; }
        int dev = 0, cus = 0, per_cu = 0;
        if (hipGetDevice(&dev) != hipSuccess || hipDeviceGetAttribute(&cus, hipDeviceAttributeMultiprocessorCount, dev) != hipSuccess) { grid = -1; return; }
        if (hipFuncSetAttribute((const void*)mk_fwd, hipFuncAttributeMaxDynamicSharedMemorySize, LDS_BYTES) != hipSuccess) { fprintf(stderr, "kernel_launch: hipFuncSetAttribute failed\n"); grid = -1; return; }
        if (hipOccupancyMaxActiveBlocksPerMultiprocessor(&per_cu, (const void*)mk_fwd, NWAVES * 64, LDS_BYTES) != hipSuccess || per_cu < 1) fprintf(stderr, "kernel_launch: occupancy query reports %d\n", per_cu);
        (void)hipGetLastError();
        grid = 256;
        if (cus != 256) fprintf(stderr, "kernel_launch: device has %d CUs, built for 256\n", cus);
    }
    if (grid < 0) return;
    (void)in_sizes;
    hipMemsetAsync((char*)d_ws + WS_CTL, 0, CTL_ZERO_BYTES, stream);
    Args a{};
    for (int i = 0; i < 14; ++i) a.in[i] = (const float*)d_in[i];
    a.out = (float*)d_out; a.ws = (unsigned char*)d_ws;
    hipLaunchKernelGGL(mk_fwd, dim3(grid), dim3(NWAVES * 64), LDS_BYTES, stream, a);
}
```

```cpp
#include <hip/hip_runtime.h>
#include <cstdio>
#include <cstdint>
typedef __bf16 nbf16x2 __attribute__((ext_vector_type(2)));
typedef __bf16 nbf16x4 __attribute__((ext_vector_type(4)));
typedef __bf16 nbf16x8 __attribute__((ext_vector_type(8)));
typedef float f32x2_t __attribute__((ext_vector_type(2)));
typedef float f32x8_t __attribute__((ext_vector_type(8)));
__device__ __forceinline__ unsigned pk2bf(float lo, float hi) { f32x2_t v = {lo, hi}; return __builtin_bit_cast(unsigned, __builtin_convertvector(v, nbf16x2)); }
__device__ __forceinline__ float bflo(unsigned w) { return __builtin_bit_cast(float, w << 16); }
__device__ __forceinline__ float bfhi(unsigned w) { return __builtin_bit_cast(float, w & 0xffff0000u); }
namespace pg8 {
#define PG8_LAS __attribute__((address_space(3)))
typedef unsigned short bf16_t;
typedef short bf16x8 __attribute__((ext_vector_type(8)));
typedef float f32x4 __attribute__((ext_vector_type(4)));
typedef unsigned u32x4 __attribute__((ext_vector_type(4)));
constexpr int BM = 256, BK = 64, HALF = 128, HTB = HALF * BK * 2  , STAGE_BYTES = 8 * HTB, NXCD = 8;
#ifndef PG8_WGM
#define PG8_WGM 8
#endif
#ifndef PG8_WGM_G
#define PG8_WGM_G 8
#endif
constexpr int WGM = PG8_WGM, WGM_G = PG8_WGM_G;

__host__ __device__ __forceinline__ int lds_byte(int r, int c) { const int st = (r >> 4) * 2 + (c >> 5), rr = r & 15, cc = c & 31, ob = rr * 64 + cc * 2; return st * 1024 + (ob ^ (((ob >> 9) & 1) << 5)); }
__host__ __device__ __forceinline__ void stage_rc(int b, int& R, int& C) { const int st = b / 1024, sb = b % 1024, swz = sb ^ (((sb >> 9) & 1) << 5); R = (st >> 1) * 16 + swz / 64; C = (st & 1) * 32 + (swz % 64) / 2; }
__host__ __device__ __forceinline__ int perm32(int rho) { const int n = rho >> 4, i = rho & 15; return 8 * (i >> 2) + 4 * n + (i & 3); }

struct Unit { int pm, pn; };
struct Gemm { const bf16_t* A; const bf16_t* Bt; int M, N, K; };

struct StaticOrder {
    int nM, nN, nwg, G, c;
    __host__ __device__ void init(int M, int N, int G_, int c_) { nM = M / BM; nN = N / BM; nwg = nM * nN; G = G_; c = c_; }
    __host__ __device__ bool next(int i, Unit& u) const {
        const long L = (long)i * G + c; if (L >= nwg) return false;
        int wgid = (int)L; { const int q = nwg / NXCD, r = nwg % NXCD, xcd = wgid % NXCD, off = wgid / NXCD; wgid = (xcd < r ? xcd * (q + 1) : r * (q + 1) + (xcd - r) * q) + off; }
        const int nig = WGM * nN, gid = wgid / nig, fm = gid * WGM, gsz = (nM - fm) < WGM ? (nM - fm) : WGM;
        u.pm = fm + ((wgid % nig) % gsz); u.pn = (wgid % nig) / gsz; return true;
    }
    __device__ __forceinline__ void a_ready(const Unit&) const {}
    __device__ __forceinline__ void done(const Unit&) const {}
};

struct GroupedOrder {
    int nMg, nNg, upg, ntot, G, c;
    __host__ __device__ void init(int ngrp, int nMg_, int nNg_, int G_, int c_) { nMg = nMg_; nNg = nNg_; upg = nMg * nNg; ntot = ngrp * upg; G = G_; c = c_; }
    __host__ __device__ bool next(int i, Unit& u) const {
        const long L = (long)i * G + c; if (L >= ntot) return false;
        const int e = (int)(L / upg); int wgid = (int)(L % upg);
        { const int q = upg / NXCD, r = upg % NXCD, xcd = wgid % NXCD, off = wgid / NXCD; wgid = (xcd < r ? xcd * (q + 1) : r * (q + 1) + (xcd - r) * q) + off; }
        const int nig = WGM_G * nNg, gid = wgid / nig, fm = gid * WGM_G, gsz = (nMg - fm) < WGM_G ? (nMg - fm) : WGM_G;
        u.pm = e * nMg + fm + ((wgid % nig) % gsz); u.pn = e * nNg + (wgid % nig) / gsz; return true;
    }
    __device__ __forceinline__ void a_ready(const Unit&) const {}
    __device__ __forceinline__ void done(const Unit&) const {}
};

#ifndef EPI_NT
#define EPI_NT 0
#endif
#if EPI_NT
#define EPI_ST(ptr, val) __builtin_nontemporal_store((val), (ptr))
#else
#define EPI_ST(ptr, val) (*(ptr) = (val))
#endif
#ifndef EPI_NT_B
#define EPI_NT_B 0
#endif
#if EPI_NT_B
#define EPI_ST_B(ptr, val) __builtin_nontemporal_store((val), (ptr))
#else
#define EPI_ST_B(ptr, val) (*(ptr) = (val))
#endif
__device__ __forceinline__ u32x4 pack8(const f32x4 a, const f32x4 b) { u32x4 w; w.x = pk2bf(a[0], a[1]); w.y = pk2bf(a[2], a[3]); w.z = pk2bf(b[0], b[1]); w.w = pk2bf(b[2], b[3]); return w; }
__device__ __forceinline__ void unpack8(const u32x4 w, f32x4& a, f32x4& b) { a = (f32x4){bflo(w.x), bfhi(w.x), bflo(w.y), bfhi(w.y)}; b = (f32x4){bflo(w.z), bfhi(w.z), bflo(w.w), bfhi(w.w)}; }
__device__ __forceinline__ float sigmoidf_fast(float x) { return __builtin_amdgcn_rcpf(1.0f + __builtin_amdgcn_exp2f(-1.4426950408889634f * x)); }

__device__ __forceinline__ size_t gate_blk(int pm, int pn, int wave, int ai, int m, int bj, int lane) { return ((size_t)(((pm * 4 + pn) * 8 + wave) * 16 + (ai * 8 + m * 2 + bj)) * 64 + lane) * 8; }
__device__ __forceinline__ u32x4 xchg_pair(const u32x4 v) { u32x4 r;
#pragma unroll
    for (int w = 0; w < 4; ++w) r[w] = (unsigned)__builtin_amdgcn_mov_dpp((int)v[w], 0xB1, 0xF, 0xF, true);
    return r; }
__device__ __forceinline__ void wide_pair(const u32x4 p0, const u32x4 p1, bool odd, u32x4& a, u32x4& b) {
    const u32x4 recv = xchg_pair(odd ? p0 : p1); a = odd ? recv : p0; b = odd ? p1 : recv; }
struct EpiInProj {
    static constexpr bool PERM = true, AFTER_DRAIN = false, WIDE = true;
    bf16_t *qa, *ka, *va, *qw, *kw, *vw, *gr, *g1; const float* bgate; float qscale;
    __device__ __forceinline__ void operator()(const f32x4 (&acc)[2][2][4][2], const Unit& u, int wr, int wc, int fr, int fq) const {
        const int pn = u.pn; const int row0 = u.pm * BM + wr * 64 + fr;
        if (pn >= 15) {
            const int cc0 = (pn - 15) * HALF + wc * 32 + 8 * fq;
            f32x4 b0[2], b1[2];
#pragma unroll
            for (int n = 0; n < 2; ++n) { b0[n] = *(const f32x4*)(bgate + cc0 + 4 * n); b1[n] = *(const f32x4*)(bgate + 1024 + cc0 + 4 * n); }
#pragma unroll
            for (int ai = 0; ai < 2; ++ai)
#pragma unroll
                for (int m = 0; m < 4; ++m) { const size_t off = gate_blk(u.pm, (pn - 15) >> 1, wr * 4 + wc, ai, m, (pn - 15) & 1, fq * 16 + fr); f32x4 rr[2], gg[2];
#pragma unroll
                    for (int n = 0; n < 2; ++n)
#pragma unroll
                        for (int j = 0; j < 4; ++j) { float a0 = acc[ai][0][m][n][j] + b0[n][j], a1 = acc[ai][1][m][n][j] + b1[n][j];
                            a0 = fminf(fmaxf(a0, -30.f), 30.f); a1 = fminf(fmaxf(a1, -30.f), 30.f);
                            const float e0 = __builtin_amdgcn_exp2f(-1.4426950408889634f * a0), e1 = __builtin_amdgcn_exp2f(-1.4426950408889634f * a1);
                            gg[n][j] = __builtin_amdgcn_rcpf(1.0f + e1); rr[n][j] = (1.0f + e1) * __builtin_amdgcn_rcpf(1.0f + e0); }
                    EPI_ST_B((u32x4*)(gr + off), pack8(rr[0], rr[1])); EPI_ST_B((u32x4*)(g1 + off), pack8(gg[0], gg[1])); }
            return;
        }
        bf16_t* base; int ldc, ct; float sc = 1.0f;
        if (pn < 3) { base = qa; ldc = 768; ct = pn; sc = qscale; }
        else if (pn < 6) { base = ka; ldc = 768; ct = pn - 3; }
        else if (pn < 9) { base = va; ldc = 768; ct = pn - 6; }
        else if (pn < 13) { base = qw; ldc = 1024; ct = pn - 9; sc = qscale; }
        else if (pn == 13) { base = kw; ldc = 256; ct = 0; }
        else { base = vw; ldc = 256; ct = 0; }
        const bool odd = (fr & 1) != 0;
        const int col0 = ct * BM + wc * 64 + 8 * fq + (odd ? 32 : 0);
#pragma unroll
        for (int ai = 0; ai < 2; ++ai)
#pragma unroll
            for (int m = 0; m < 4; ++m) { bf16_t* rowp = base + (size_t)(row0 - (odd ? 1 : 0) + ai * HALF + m * 16) * ldc + col0;
                u32x4 a, b; wide_pair(pack8(acc[ai][0][m][0] * sc, acc[ai][0][m][1] * sc), pack8(acc[ai][1][m][0] * sc, acc[ai][1][m][1] * sc), odd, a, b);
                EPI_ST_B((u32x4*)rowp, a); EPI_ST_B((u32x4*)(rowp + ldc), b); }
    }
};
struct EpiMergeDual {
    static constexpr bool PERM = true, AFTER_DRAIN = false, WIDE = true;
    bf16_t* merged; const bf16_t* gr; const bf16_t* g1;
    __device__ __forceinline__ size_t gblk(const Unit& u, int wr, int wc, int ai, int m, int bj, int fr, int fq) const { return gate_blk(u.pm, u.pn, wr * 4 + 2 * (wc & 1) + bj, ai, m, wc >> 1, fq * 16 + fr); }
    __device__ __forceinline__ void mid(f32x4 (&acc)[2][2][4][2], const Unit& u, int wr, int wc, int fr, int fq) const {
        u32x4 w[2][4][2];
#pragma unroll
        for (int ai = 0; ai < 2; ++ai)
#pragma unroll
            for (int m = 0; m < 4; ++m) {
#pragma unroll
                for (int bj = 0; bj < 2; ++bj) w[ai][m][bj] = *(const u32x4*)(gr + gblk(u, wr, wc, ai, m, bj, fr, fq)); }
        asm volatile("" ::: "memory");
#pragma unroll
        for (int ai = 0; ai < 2; ++ai)
#pragma unroll
            for (int m = 0; m < 4; ++m) {
#pragma unroll
                for (int bj = 0; bj < 2; ++bj) { f32x4 r0, r1; unpack8(w[ai][m][bj], r0, r1); acc[ai][bj][m][0] *= r0; acc[ai][bj][m][1] *= r1; } }
    }
    __device__ __forceinline__ void operator()(const f32x4 (&acc)[2][2][4][2], const Unit& u, int wr, int wc, int fr, int fq) const {
        const bool odd = (fr & 1) != 0;
        const int rowe = u.pm * BM + wr * 64 + (fr & ~1), col = u.pn * BM + wc * 64 + 8 * fq + (odd ? 32 : 0);
        u32x4 w[2][4][2];
#pragma unroll
        for (int ai = 0; ai < 2; ++ai)
#pragma unroll
            for (int m = 0; m < 4; ++m) {
#pragma unroll
                for (int bj = 0; bj < 2; ++bj) w[ai][m][bj] = *(const u32x4*)(g1 + gblk(u, wr, wc, ai, m, bj, fr, fq)); }
        asm volatile("" ::: "memory");
#pragma unroll
        for (int ai = 0; ai < 2; ++ai)
#pragma unroll
            for (int m = 0; m < 4; ++m) { f32x4 a0, a1, c0, c1; unpack8(w[ai][m][0], a0, a1); unpack8(w[ai][m][1], c0, c1);
                u32x4 a, b; wide_pair(pack8(acc[ai][0][m][0] * a0, acc[ai][0][m][1] * a1), pack8(acc[ai][1][m][0] * c0, acc[ai][1][m][1] * c1), odd, a, b);
                bf16_t* p = merged + (size_t)(rowe + ai * HALF + m * 16) * 1024 + col;
                EPI_ST((u32x4*)p, a); EPI_ST((u32x4*)(p + 1024), b); }
    }
};
struct EpiResid {
    static constexpr bool PERM = true, AFTER_DRAIN = false, WIDE = true;
    const bf16_t* base; bf16_t* out;
    __device__ __forceinline__ void operator()(const f32x4 (&acc)[2][2][4][2], const Unit& u, int wr, int wc, int fr, int fq) const {
        const bool odd = (fr & 1) != 0;
        const int rowe = u.pm * BM + wr * 64 + (fr & ~1), col = u.pn * BM + wc * 64 + 8 * fq + (odd ? 32 : 0);
        u32x4 la[2][4], lb[2][4];
#pragma unroll
        for (int ai = 0; ai < 2; ++ai)
#pragma unroll
            for (int m = 0; m < 4; ++m) { const bf16_t* p = base + (size_t)(rowe + ai * HALF + m * 16) * 1024 + col; la[ai][m] = *(const u32x4*)p; lb[ai][m] = *(const u32x4*)(p + 1024); }
        asm volatile("" ::: "memory");
#pragma unroll
        for (int ai = 0; ai < 2; ++ai)
#pragma unroll
            for (int m = 0; m < 4; ++m) {
                const u32x4 recv = xchg_pair(odd ? la[ai][m] : lb[ai][m]); const u32x4 r0 = odd ? recv : la[ai][m], r1 = odd ? lb[ai][m] : recv;
                f32x4 b0, b1, c0, c1; unpack8(r0, b0, b1); unpack8(r1, c0, c1);
                u32x4 a, b; wide_pair(pack8(b0 + acc[ai][0][m][0], b1 + acc[ai][0][m][1]), pack8(c0 + acc[ai][1][m][0], c1 + acc[ai][1][m][1]), odd, a, b);
                bf16_t* p = out + (size_t)(rowe + ai * HALF + m * 16) * 1024 + col;
                EPI_ST((u32x4*)p, a); EPI_ST((u32x4*)(p + 1024), b); }
    }
};
struct EpiSwiGLU {
    static constexpr bool PERM = true, AFTER_DRAIN = false, WIDE = false;
    bf16_t* act; const PG8_LAS int* arow; mutable int ui;
    __device__ __forceinline__ void operator()(const f32x4 (&acc)[2][2][4][2], const Unit& u, int wr, int wc, int fr, int fq) const {
        const int row0 = u.pm * BM + wr * 64 + fr, col0 = (u.pn & 7) * HALF + wc * 32 + 8 * fq;
#pragma unroll
        for (int ai = 0; ai < 2; ++ai)
#pragma unroll
            for (int m = 0; m < 4; ++m) { f32x4 o[2];
                const float rs = (float)__builtin_bit_cast(_Float16, (unsigned short)((unsigned)arow[ui * 256 + wr * 64 + fr + ai * HALF + m * 16] >> 16));
#pragma unroll
                for (int n = 0; n < 2; ++n)
#pragma unroll
                    for (int j = 0; j < 4; ++j) { const float a = acc[ai][0][m][n][j] * rs, up = acc[ai][1][m][n][j] * rs; o[n][j] = a * sigmoidf_fast(a) * up; }
                EPI_ST((u32x4*)(act + (size_t)(row0 + ai * HALF + m * 16) * 1024 + col0), pack8(o[0], o[1])); }
        ++ui;
    }
};
struct EpiDown {
    static constexpr bool PERM = true, AFTER_DRAIN = false, WIDE = true;
    bf16_t* y; const PG8_LAS float* glds; mutable int ui;
    __device__ __forceinline__ void operator()(const f32x4 (&acc)[2][2][4][2], const Unit& u, int wr, int wc, int fr, int fq) const {
        const bool odd = (fr & 1) != 0;
        const int rowe = u.pm * BM + wr * 64 + (fr & ~1), col = (u.pn & 3) * BM + wc * 64 + 8 * fq + (odd ? 32 : 0);
#pragma unroll
        for (int ai = 0; ai < 2; ++ai)
#pragma unroll
            for (int m = 0; m < 4; ++m) { const float gv = glds[ui * 256 + wr * 64 + fr + ai * HALF + m * 16];
                u32x4 a, b; wide_pair(pack8(acc[ai][0][m][0] * gv, acc[ai][0][m][1] * gv), pack8(acc[ai][1][m][0] * gv, acc[ai][1][m][1] * gv), odd, a, b);
                bf16_t* p = y + (size_t)(rowe + ai * HALF + m * 16) * 1024 + col;
                EPI_ST((u32x4*)p, a); EPI_ST((u32x4*)(p + 1024), b); }
        ++ui;
    }
};

template <class Epi, class Sched, bool ALIGN_EPI = false, bool SP2 = false, bool GATHER = false>
__device__ __forceinline__ void gemm_phase(int tid_, PG8_LAS unsigned char* lds, const Gemm g, const Sched& S, const Epi& E, const PG8_LAS int* arow = nullptr) {
    static_assert(!GATHER || SP2, "GATHER is written for the SP2 loop");
    asm volatile("" : "+v"(tid_));
    const int tid = tid_, wid = __builtin_amdgcn_readfirstlane(tid >> 6), lane = tid & 63, wr = wid >> 2, wc = wid & 3, fr = lane & 15, fq = lane >> 4;
    const int K = g.K, nt = K / BK;
    unsigned voffA[2], voffB[2];
#pragma unroll
    for (int i = 0; i < 2; ++i) { int R, C; stage_rc(tid * 16 + i * 8192, R, C); const int Rb = Epi::WIDE ? ((R >> 5) * 64 + perm32(R & 31)) : (Epi::PERM ? ((R & ~31) + perm32(R & 31)) : R);
        voffA[i] = (unsigned)(R * K + C) * 2u; voffB[i] = (unsigned)(Rb * K + C) * 2u; }
    unsigned vA0[2] = {voffA[0], voffA[1]}, vA1[2] = {voffA[0], voffA[1]}, nA0[2] = {voffA[0], voffA[1]}, nA1[2] = {voffA[0], voffA[1]};
    int gR[2], gC[2];
#pragma unroll
    for (int i = 0; i < 2; ++i) { stage_rc(tid * 16 + i * 8192, gR[i], gC[i]); }
#define PG8_GOFF(dst0, dst1, u_) do { _Pragma("unroll") for (int _i = 0; _i < 2; ++_i) { \
        dst0[_i] = (((unsigned)arow[(u_) * 256 + gR[_i]] & 0xffffu) * (unsigned)K + (unsigned)gC[_i]) * 2u; dst1[_i] = (((unsigned)arow[(u_) * 256 + HALF + gR[_i]] & 0xffffu) * (unsigned)K + (unsigned)gC[_i]) * 2u; } } while (0)
    const size_t kstep = (size_t)(BK * 2);
    const size_t hstep = (size_t)HALF * K * 2;
    const size_t tstep = 2 * hstep;
    const size_t bhs = Epi::WIDE ? (size_t)32 * K * 2 : hstep;
    const size_t ahs = GATHER ? (size_t)0 : hstep, atstep = GATHER ? (size_t)0 : tstep;
    const unsigned ldsw = (unsigned)wid * 1024u;
    const int aoff = lds_byte(wr * 64 + fr, fq * 8), boff = lds_byte(wc * 32 + fr, fq * 8);
#define PG8_SA(b, h) (((b) * 2 + (h)) * HTB)
#define PG8_SB(b, h) ((4 + (b) * 2 + (h)) * HTB)
#define PG8_STAGE(bufoff, gbase, voff) do { _Pragma("unroll") for (int _i = 0; _i < 2; ++_i) \
        __builtin_amdgcn_global_load_lds((const unsigned*)((const char*)(gbase) + (voff)[_i]), (PG8_LAS unsigned*)(lds + (bufoff) + ldsw + _i * 8192), 16, 0, 0); } while (0)
#define PG8_LDA(dst, b, h) do { _Pragma("unroll") for (int m = 0; m < 4; ++m) _Pragma("unroll") for (int k = 0; k < 2; ++k) dst[m][k] = *(const PG8_LAS bf16x8*)(lds + PG8_SA(b, h) + aoff + m * 2048 + k * 1024); } while (0)
#define PG8_LDB(dst, b, h) do { _Pragma("unroll") for (int n = 0; n < 2; ++n) _Pragma("unroll") for (int k = 0; k < 2; ++k) dst[n][k] = *(const PG8_LAS bf16x8*)(lds + PG8_SB(b, h) + boff + n * 2048 + k * 1024); } while (0)
#define PG8_MMA(ai, bj, At, Bt) do { __builtin_amdgcn_s_setprio(1); _Pragma("unroll") for (int m = 0; m < 4; ++m) _Pragma("unroll") for (int n = 0; n < 2; ++n) _Pragma("unroll") for (int k = 0; k < 2; ++k) \
        acc[ai][bj][m][n] = __builtin_amdgcn_mfma_f32_16x16x32_bf16(Bt[n][k], At[m][k], acc[ai][bj][m][n], 0, 0, 0); __builtin_amdgcn_s_setprio(0); } while (0)
#define PG8_WAIT_V(n) asm volatile("s_waitcnt vmcnt(" #n ")" ::: "memory")
#define PG8_WAIT_L(n) asm volatile("s_waitcnt lgkmcnt(" #n ")" ::: "memory")
#define PG8_BAR __builtin_amdgcn_s_barrier()
#define PG8_SCHED __builtin_amdgcn_sched_barrier(0)
    Unit cur, nxt; int ui = 0;
    if (!S.next(0, cur)) return;
    f32x4 acc[2][2][4][2];
#pragma unroll
    for (int a = 0; a < 2; ++a)
#pragma unroll
        for (int b = 0; b < 2; ++b)
#pragma unroll
            for (int m = 0; m < 4; ++m)
#pragma unroll
                for (int n = 0; n < 2; ++n) acc[a][b][m][n] = (f32x4){0.f, 0.f, 0.f, 0.f};
    bf16x8 At[4][2], B0[2][2], B1[2][2];
    const char* cA = (const char*)g.A + (size_t)cur.pm * atstep; const char* cB = (const char*)g.Bt + (size_t)cur.pn * tstep;
    if constexpr (GATHER) { PG8_GOFF(vA0, vA1, 0); }
    S.a_ready(cur);
    if constexpr (SP2) {
        PG8_STAGE(PG8_SB(0, 0), cB, voffB); PG8_STAGE(PG8_SB(0, 1), cB + bhs, voffB); PG8_STAGE(PG8_SA(0, 0), cA, vA0); PG8_STAGE(PG8_SA(0, 1), cA + ahs, vA1);
        if (wr == 1) PG8_BAR;
        PG8_WAIT_V(2); PG8_BAR;
        PG8_STAGE(PG8_SB(1, 0), cB + kstep, voffB); PG8_STAGE(PG8_SA(1, 0), cA + kstep, vA0); PG8_STAGE(PG8_SB(1, 1), cB + bhs + kstep, voffB);
        PG8_WAIT_V(6); PG8_BAR;
    } else {
        PG8_STAGE(PG8_SB(0, 0), cB, voffB); PG8_STAGE(PG8_SA(0, 0), cA, voffA); PG8_STAGE(PG8_SB(0, 1), cB + bhs, voffB); PG8_STAGE(PG8_SA(0, 1), cA + hstep, voffA);
        if (wr == 1) PG8_BAR;
        PG8_WAIT_V(4); PG8_BAR;
        PG8_STAGE(PG8_SB(1, 0), cB + kstep, voffB); PG8_STAGE(PG8_SA(1, 0), cA + kstep, voffA); PG8_STAGE(PG8_SB(1, 1), cB + bhs + kstep, voffB);
        PG8_WAIT_V(6); PG8_BAR;
    }
    for (;;) {
        const bool has_next = S.next(ui + 1, nxt);
        const char* nA = has_next ? (const char*)g.A + (size_t)nxt.pm * atstep : cA; const char* nB = has_next ? (const char*)g.Bt + (size_t)nxt.pn * tstep : cB;
#pragma unroll 1
        for (int t = 0; t < nt; t += 2) {
            const bool last = (t == nt - 2);
            const char* a1 = cA + (size_t)(t + 1) * kstep;
            const char* a2 = last ? nA : cA + (size_t)(t + 2) * kstep; const char* b2 = last ? nB : cB + (size_t)(t + 2) * kstep;
            const char* a3 = a2 + kstep; const char* b3 = b2 + kstep;
            if (last && has_next) S.a_ready(nxt);
            unsigned s0[2] = {vA0[0], vA0[1]}, s1[2] = {vA1[0], vA1[1]};
            if constexpr (GATHER) { if (last && has_next) { PG8_GOFF(nA0, nA1, ui + 1); s0[0] = nA0[0]; s0[1] = nA0[1]; s1[0] = nA1[0]; s1[1] = nA1[1]; } }
            if constexpr (SP2) {
            PG8_LDB(B0, 0, 0); PG8_LDB(B1, 0, 1); PG8_SCHED; PG8_LDA(At, 0, 0); PG8_STAGE(PG8_SA(1, 1), a1 + ahs, vA1);
            PG8_WAIT_V(8); PG8_WAIT_L(0); PG8_BAR; PG8_MMA(0, 0, At, B0); PG8_MMA(0, 1, At, B1); PG8_BAR; PG8_SCHED;
            PG8_LDA(At, 0, 1); PG8_STAGE(PG8_SB(0, 0), b2, voffB); PG8_STAGE(PG8_SB(0, 1), b2 + bhs, voffB); PG8_STAGE(PG8_SA(0, 0), a2, s0);
            PG8_WAIT_V(8); PG8_WAIT_L(0); PG8_BAR; PG8_MMA(1, 0, At, B0); PG8_MMA(1, 1, At, B1); PG8_BAR; PG8_SCHED;
            PG8_LDB(B0, 1, 0); PG8_LDB(B1, 1, 1); PG8_SCHED; PG8_LDA(At, 1, 0); PG8_STAGE(PG8_SA(0, 1), a2 + ahs, s1);
            PG8_WAIT_V(8); PG8_WAIT_L(0); PG8_BAR; PG8_MMA(0, 0, At, B0); PG8_MMA(0, 1, At, B1); PG8_BAR; PG8_SCHED;
            PG8_LDA(At, 1, 1); PG8_STAGE(PG8_SB(1, 0), b3, voffB); PG8_STAGE(PG8_SB(1, 1), b3 + bhs, voffB); PG8_STAGE(PG8_SA(1, 0), a3, s0);
            PG8_WAIT_V(8); PG8_WAIT_L(0); PG8_BAR; PG8_MMA(1, 0, At, B0); PG8_MMA(1, 1, At, B1); PG8_BAR; PG8_SCHED;
            } else {
            PG8_LDB(B0, 0, 0); PG8_SCHED; PG8_LDA(At, 0, 0); PG8_STAGE(PG8_SA(1, 1), a1 + hstep, voffA);
            PG8_WAIT_L(8); PG8_BAR; PG8_WAIT_L(0); PG8_MMA(0, 0, At, B0); PG8_BAR; PG8_SCHED;
            PG8_LDB(B1, 0, 1); PG8_STAGE(PG8_SB(0, 0), b2, voffB);
            PG8_BAR; PG8_WAIT_L(0); PG8_MMA(0, 1, At, B1); PG8_BAR;
            PG8_LDA(At, 0, 1); PG8_STAGE(PG8_SA(0, 0), a2, voffA);
            PG8_BAR; PG8_WAIT_L(0); PG8_MMA(1, 0, At, B0); PG8_BAR; PG8_SCHED;
            PG8_STAGE(PG8_SB(0, 1), b2 + bhs, voffB);
            PG8_WAIT_V(6); PG8_BAR; PG8_MMA(1, 1, At, B1); PG8_BAR;
            PG8_LDB(B0, 1, 0); PG8_SCHED; PG8_LDA(At, 1, 0); PG8_STAGE(PG8_SA(0, 1), a2 + hstep, voffA);
            PG8_WAIT_L(8); PG8_BAR; PG8_WAIT_L(0); PG8_MMA(0, 0, At, B0); PG8_BAR; PG8_SCHED;
            PG8_LDB(B1, 1, 1); PG8_STAGE(PG8_SB(1, 0), b3, voffB);
            PG8_BAR; PG8_WAIT_L(0); PG8_MMA(0, 1, At, B1); PG8_BAR;
            PG8_LDA(At, 1, 1); PG8_STAGE(PG8_SA(1, 0), a3, voffA);
            PG8_BAR; PG8_WAIT_L(0); PG8_MMA(1, 0, At, B0); PG8_BAR; PG8_SCHED;
            PG8_STAGE(PG8_SB(1, 1), b3 + bhs, voffB);
            PG8_WAIT_V(6); PG8_BAR; PG8_MMA(1, 1, At, B1); PG8_BAR;
            }
        }
        if constexpr (ALIGN_EPI) { if (wr == 0) PG8_BAR; }
        if constexpr (!Epi::AFTER_DRAIN) { E(acc, cur, wr, wc, fr, fq); S.done(cur); }
        if (!has_next) break;
#pragma unroll
        for (int a = 0; a < 2; ++a)
#pragma unroll
            for (int b = 0; b < 2; ++b)
#pragma unroll
                for (int m = 0; m < 4; ++m)
#pragma unroll
                    for (int n = 0; n < 2; ++n) acc[a][b][m][n] = (f32x4){0.f, 0.f, 0.f, 0.f};
        cur = nxt; cA = nA; cB = nB; ++ui;
        if constexpr (GATHER) { vA0[0] = nA0[0]; vA0[1] = nA0[1]; vA1[0] = nA1[0]; vA1[1] = nA1[1]; }
        if constexpr (ALIGN_EPI) { if (wr == 1) PG8_BAR; }
    }
    PG8_WAIT_V(0);
    if constexpr (!ALIGN_EPI) { if (wr == 0) PG8_BAR; }
    PG8_BAR;
    if constexpr (Epi::AFTER_DRAIN) { E.fused(acc, cur, wr, wc, fr, fq, lds, wid, lane); S.done(cur); }
#undef PG8_SA
#undef PG8_SB
#undef PG8_STAGE
#undef PG8_LDA
#undef PG8_LDB
#undef PG8_MMA
#undef PG8_WAIT_V
#undef PG8_WAIT_L
#undef PG8_BAR
#undef PG8_SCHED
#undef PG8_GOFF
}

template <class Epi, class Sched>
__device__ __forceinline__ void gemm_phase_dual(int tid_, PG8_LAS unsigned char* lds, const Gemm g0, const Gemm g1, const Sched& S, const Epi& E) {
    asm volatile("" : "+v"(tid_));
    const int tid = tid_, wid = __builtin_amdgcn_readfirstlane(tid >> 6), lane = tid & 63, wr = wid >> 2, wc = wid & 3, fr = lane & 15, fq = lane >> 4;
    unsigned vA_0[2], vB_0[2], vA_1[2], vB_1[2];
#pragma unroll
    for (int i = 0; i < 2; ++i) { int R, C; stage_rc(tid * 16 + i * 8192, R, C); const int Rb = Epi::WIDE ? ((R >> 5) * 64 + perm32(R & 31)) : (Epi::PERM ? ((R & ~31) + perm32(R & 31)) : R);
        vA_0[i] = (unsigned)(R * g0.K + C) * 2u; vB_0[i] = (unsigned)(Rb * g0.K + C) * 2u; vA_1[i] = (unsigned)(R * g1.K + C) * 2u; vB_1[i] = (unsigned)(Rb * g1.K + C) * 2u; }
    const size_t kstep = (size_t)(BK * 2);
    const size_t hs_0 = (size_t)HALF * g0.K * 2, hs_1 = (size_t)HALF * g1.K * 2;
#define PG8_BH(x) (Epi::WIDE ? (x) / 4 : (x))
    const int nt_0 = g0.K / BK, nt_1 = g1.K / BK;
    const unsigned ldsw = (unsigned)wid * 1024u;
    const int aoff = lds_byte(wr * 64 + fr, fq * 8), boff = lds_byte(wc * 32 + fr, fq * 8);
#define PG8_SA(b, h) (((b) * 2 + (h)) * HTB)
#define PG8_SB(b, h) ((4 + (b) * 2 + (h)) * HTB)
#define PG8_STAGE(bufoff, gbase, voff) do { _Pragma("unroll") for (int _i = 0; _i < 2; ++_i) \
        __builtin_amdgcn_global_load_lds((const unsigned*)((const char*)(gbase) + (voff)[_i]), (PG8_LAS unsigned*)(lds + (bufoff) + ldsw + _i * 8192), 16, 0, 0); } while (0)
#define PG8_LDA(dst, b, h) do { _Pragma("unroll") for (int m = 0; m < 4; ++m) _Pragma("unroll") for (int k = 0; k < 2; ++k) dst[m][k] = *(const PG8_LAS bf16x8*)(lds + PG8_SA(b, h) + aoff + m * 2048 + k * 1024); } while (0)
#define PG8_LDB(dst, b, h) do { _Pragma("unroll") for (int n = 0; n < 2; ++n) _Pragma("unroll") for (int k = 0; k < 2; ++k) dst[n][k] = *(const PG8_LAS bf16x8*)(lds + PG8_SB(b, h) + boff + n * 2048 + k * 1024); } while (0)
#define PG8_MMA(ai, bj, At, Bt) do { __builtin_amdgcn_s_setprio(1); _Pragma("unroll") for (int m = 0; m < 4; ++m) _Pragma("unroll") for (int n = 0; n < 2; ++n) _Pragma("unroll") for (int k = 0; k < 2; ++k) \
        acc[ai][bj][m][n] = __builtin_amdgcn_mfma_f32_16x16x32_bf16(Bt[n][k], At[m][k], acc[ai][bj][m][n], 0, 0, 0); __builtin_amdgcn_s_setprio(0); } while (0)
#define PG8_WAIT_V(n) asm volatile("s_waitcnt vmcnt(" #n ")" ::: "memory")
#define PG8_WAIT_L(n) asm volatile("s_waitcnt lgkmcnt(" #n ")" ::: "memory")
#define PG8_BAR __builtin_amdgcn_s_barrier()
#define PG8_SCHED __builtin_amdgcn_sched_barrier(0)
    Unit cur, nxt; int ui = 0, s = 0;
    if (!S.next(0, cur)) return;
    f32x4 acc[2][2][4][2];
#pragma unroll
    for (int a = 0; a < 2; ++a)
#pragma unroll
        for (int b = 0; b < 2; ++b)
#pragma unroll
            for (int m = 0; m < 4; ++m)
#pragma unroll
                for (int n = 0; n < 2; ++n) acc[a][b][m][n] = (f32x4){0.f, 0.f, 0.f, 0.f};
    bf16x8 At[4][2], B0[2][2], B1[2][2];
    const char* cA = (const char*)g0.A + (size_t)cur.pm * 2 * hs_0; const char* cB = (const char*)g0.Bt + (size_t)cur.pn * 2 * hs_0;
    size_t hsC = hs_0; unsigned vAc[2] = {vA_0[0], vA_0[1]}, vBc[2] = {vB_0[0], vB_0[1]};
    PG8_STAGE(PG8_SB(0, 0), cB, vBc); PG8_STAGE(PG8_SB(0, 1), cB + PG8_BH(hsC), vBc); PG8_STAGE(PG8_SA(0, 0), cA, vAc); PG8_STAGE(PG8_SA(0, 1), cA + hsC, vAc);
    if (wr == 1) PG8_BAR;
    PG8_WAIT_V(2); PG8_BAR;
    PG8_STAGE(PG8_SB(1, 0), cB + kstep, vBc); PG8_STAGE(PG8_SA(1, 0), cA + kstep, vAc); PG8_STAGE(PG8_SB(1, 1), cB + PG8_BH(hsC) + kstep, vBc);
    PG8_WAIT_V(6); PG8_BAR;
    for (;;) {
        bool has_next = true; if (s == 1) has_next = S.next(ui + 1, nxt);
        const int npm = (s == 0) ? cur.pm : nxt.pm, npn = (s == 0) ? cur.pn : nxt.pn;
        const size_t hsN = has_next ? (s == 0 ? hs_1 : hs_0) : hsC;
        const char* nA = has_next ? (s == 0 ? (const char*)g1.A : (const char*)g0.A) + (size_t)npm * 2 * hsN : cA;
        const char* nB = has_next ? (s == 0 ? (const char*)g1.Bt : (const char*)g0.Bt) + (size_t)npn * 2 * hsN : cB;
        unsigned vAn[2], vBn[2];
#pragma unroll
        for (int i = 0; i < 2; ++i) { vAn[i] = has_next ? (s == 0 ? vA_1[i] : vA_0[i]) : vAc[i]; vBn[i] = has_next ? (s == 0 ? vB_1[i] : vB_0[i]) : vBc[i]; }
        const int nt = (s == 0) ? nt_0 : nt_1;
#pragma unroll 1
        for (int t = 0; t < nt; t += 2) {
            const bool last = (t == nt - 2);
            const char* a1 = cA + (size_t)(t + 1) * kstep;
            const char* a2 = last ? nA : cA + (size_t)(t + 2) * kstep; const char* b2 = last ? nB : cB + (size_t)(t + 2) * kstep;
            const char* a3 = a2 + kstep; const char* b3 = b2 + kstep;
            const size_t hs2 = last ? hsN : hsC;
            unsigned vA2[2], vB2[2];
#pragma unroll
            for (int i = 0; i < 2; ++i) { vA2[i] = last ? vAn[i] : vAc[i]; vB2[i] = last ? vBn[i] : vBc[i]; }
            PG8_LDB(B0, 0, 0); PG8_LDB(B1, 0, 1); PG8_SCHED; PG8_LDA(At, 0, 0); PG8_STAGE(PG8_SA(1, 1), a1 + hsC, vAc);
            PG8_WAIT_V(8); PG8_WAIT_L(0); PG8_BAR; PG8_MMA(0, 0, At, B0); PG8_MMA(0, 1, At, B1); PG8_BAR; PG8_SCHED;
            PG8_LDA(At, 0, 1); PG8_STAGE(PG8_SB(0, 0), b2, vB2); PG8_STAGE(PG8_SB(0, 1), b2 + PG8_BH(hs2), vB2); PG8_STAGE(PG8_SA(0, 0), a2, vA2);
            PG8_WAIT_V(8); PG8_WAIT_L(0); PG8_BAR; PG8_MMA(1, 0, At, B0); PG8_MMA(1, 1, At, B1); PG8_BAR; PG8_SCHED;
            PG8_LDB(B0, 1, 0); PG8_LDB(B1, 1, 1); PG8_SCHED; PG8_LDA(At, 1, 0); PG8_STAGE(PG8_SA(0, 1), a2 + hs2, vA2);
            PG8_WAIT_V(8); PG8_WAIT_L(0); PG8_BAR; PG8_MMA(0, 0, At, B0); PG8_MMA(0, 1, At, B1); PG8_BAR; PG8_SCHED;
            PG8_LDA(At, 1, 1); PG8_STAGE(PG8_SB(1, 0), b3, vB2); PG8_STAGE(PG8_SB(1, 1), b3 + PG8_BH(hs2), vB2); PG8_STAGE(PG8_SA(1, 0), a3, vA2);
            PG8_WAIT_V(8); PG8_WAIT_L(0); PG8_BAR; PG8_MMA(1, 0, At, B0); PG8_MMA(1, 1, At, B1); PG8_BAR; PG8_SCHED;
        }
        if (wr == 0) PG8_BAR;
        if (s == 0) E.mid(acc, cur, wr, wc, fr, fq); else E(acc, cur, wr, wc, fr, fq);
        if (!has_next) break;
        if (s == 1) {
#pragma unroll
            for (int a = 0; a < 2; ++a)
#pragma unroll
                for (int b = 0; b < 2; ++b)
#pragma unroll
                    for (int m = 0; m < 4; ++m)
#pragma unroll
                        for (int n = 0; n < 2; ++n) acc[a][b][m][n] = (f32x4){0.f, 0.f, 0.f, 0.f};
            cur = nxt; ++ui; }
        s ^= 1; cA = nA; cB = nB; hsC = hsN;
#pragma unroll
        for (int i = 0; i < 2; ++i) { vAc[i] = vAn[i]; vBc[i] = vBn[i]; }
        if (wr == 1) PG8_BAR;
    }
    PG8_WAIT_V(0);
    PG8_BAR;
#undef PG8_SA
#undef PG8_SB
#undef PG8_STAGE
#undef PG8_LDA
#undef PG8_LDB
#undef PG8_MMA
#undef PG8_WAIT_V
#undef PG8_WAIT_L
#undef PG8_BAR
#undef PG8_SCHED
#undef PG8_BH
}
}

constexpr int NWAVES = 8;
constexpr int NB = 32, SEQ = 2048, DM = 1024, MTOK = NB * SEQ, DEPTH = 4;
constexpr int INC = 5888, NE = 16, CAP = 256, DEX = 1024, MEXP = NE * NB * CAP;
constexpr float RMS_EPS = 1e-6f, LOG2E = 1.4426950408889634f;
constexpr float QSCALE = 0.125f * LOG2E;

constexpr size_t MiB = 1u << 20;
constexpr size_t WS_CTL = 0, CTL_ZERO_BYTES = 32768;
constexpr size_t WS_WIN = 1 * MiB;
constexpr size_t WS_WA = WS_WIN + (size_t)INC * DM * 2;
constexpr size_t WS_WB = WS_WA + (size_t)DM * 256 * 2;
constexpr size_t WS_WO = WS_WB + (size_t)DM * DM * 2;
constexpr size_t WS_WGU = WS_WO + (size_t)DM * DM * 2;
constexpr size_t WS_WD = WS_WGU + (size_t)NE * 2048 * DM * 2;
constexpr size_t WS_HN = WS_WD + (size_t)NE * DM * DEX * 2;
constexpr size_t WS_BIG = WS_HN + (size_t)MTOK * DM * 2;
constexpr size_t B_QA = 0, B_KA = 96 * MiB, B_VA = 192 * MiB, B_QW = 288 * MiB, B_KW = 416 * MiB, B_VW = 448 * MiB, B_G = 480 * MiB, B_OA = 736 * MiB, B_END = 768 * MiB;
constexpr size_t B_MERGED = 0;
constexpr size_t B_XE = 0, B_ACT = 256 * MiB, B_Y = 512 * MiB;
constexpr size_t WS_AFF = WS_BIG + B_END;
constexpr size_t WS_SEL = WS_AFF + (size_t)MTOK * NE * 4;
constexpr size_t WS_GATE = WS_SEL + (size_t)MTOK * NE * 4;
constexpr size_t WS_LSE = WS_GATE + (size_t)MEXP * 4;
constexpr size_t WS_IDX = WS_LSE + (size_t)3 * MTOK * 4 * 4;
constexpr size_t WS_HB = WS_IDX + (size_t)MEXP * 4;
constexpr size_t WS_END = WS_HB + (size_t)MTOK * DM * 2;
static_assert(WS_WIN % 256 == 0 && WS_WA % 256 == 0 && WS_WGU % 256 == 0 && WS_HN % 256 == 0 && WS_BIG % 256 == 0 && WS_AFF % 256 == 0, "alignment");
constexpr int CW_BAR = 4096;
constexpr int AROW_OFF = 131072;
constexpr int MISC_OFF = 147456, LDS_BYTES = 151552;

#define GAS __attribute__((address_space(1)))
#define LAS __attribute__((address_space(3)))
typedef unsigned short bf16;
typedef unsigned v4u __attribute__((ext_vector_type(4)));
typedef unsigned v2u __attribute__((ext_vector_type(2)));
typedef float f32x4 __attribute__((ext_vector_type(4)));
typedef float f32x16 __attribute__((ext_vector_type(16)));
typedef short bf16x8 __attribute__((ext_vector_type(8)));
#define LDS_WAIT() asm volatile("s_waitcnt lgkmcnt(0)" ::: "memory")
#define VM_WAIT() asm volatile("s_waitcnt vmcnt(0)" ::: "memory")

#define XB_TMO      128
#define XB_XCNT(j)  (256  + 64 * (j))
#define XB_XSUB(j)  (1280 + 64 * (j))
#define XB_XGEN(j)  (2304 + 64 * (j))
#define XB_TOP      3328
#define XB_TOPGEN   3392
#define XCD_BAR_WORDS 3456
#define XB_SPIN_CAP (1u << 18)

__device__ __forceinline__ unsigned xb_ld(unsigned* p)              { return __hip_atomic_load(p, __ATOMIC_RELAXED, __HIP_MEMORY_SCOPE_AGENT); }
__device__ __forceinline__ unsigned xb_add(unsigned* p, unsigned v) { return __hip_atomic_fetch_add(p, v, __ATOMIC_RELAXED, __HIP_MEMORY_SCOPE_AGENT); }
__device__ __forceinline__ unsigned xb_xcc_id() { return (unsigned)__builtin_amdgcn_s_getreg((3 << 11) | 20) & 0xFu; }
#define XB_SPIN(cond, bar) do { unsigned _sp = 0; while (cond) { __builtin_amdgcn_s_sleep(1); \
    if ((++_sp & 255u) == 0u) { if (xb_ld(&(bar)[XB_TMO])) break; if (_sp > XB_SPIN_CAP) { atomicAdd(&(bar)[XB_TMO], 1u); break; } } } } while (0)

__device__ __forceinline__ int xb_lane() { unsigned z = 0u; asm volatile("" : "+v"(z)); return (int)__builtin_amdgcn_mbcnt_hi(~0u, __builtin_amdgcn_mbcnt_lo(~0u, z)); }
struct XcdBarrier {
    int w;
    unsigned* bar; unsigned x;
    volatile LAS unsigned* st;
};

__device__ __forceinline__ XcdBarrier xcd_barrier_post(unsigned* bar, volatile LAS unsigned* st, int wave) {
    XcdBarrier b; b.w = wave; b.bar = bar; b.x = xb_xcc_id(); b.st = st;
    if (wave == 0 && xb_lane() == 0) (void)xb_add(&bar[XB_XCNT(b.x)], 1u);
    return b;
}
__device__ __forceinline__ void xcd_barrier_complete(unsigned* bar, unsigned x, unsigned& nloc, unsigned& nx) {
    const unsigned G = gridDim.x * gridDim.y * gridDim.z;
    unsigned sum, cnt, mine, sp = 0u;
    for (;;) {
        sum = 0u; cnt = 0u; mine = 0u;
#pragma unroll
        for (unsigned j = 0; j < 16; ++j) { const unsigned c = xb_ld(&bar[XB_XCNT(j)]); sum += c; cnt += (c > 0u) ? 1u : 0u; mine = (j == x) ? c : mine; }
        if (sum == G) break;
        __builtin_amdgcn_s_sleep(1);
        if ((++sp & 255u) == 0u) { if (xb_ld(&bar[XB_TMO])) break; if (sp > XB_SPIN_CAP) { atomicAdd(&bar[XB_TMO], 1u); break; } }
    }
    nloc = mine > 0u ? mine : 1u; nx = cnt > 0u ? cnt : 1u;
}

__device__ __forceinline__ void xcd_barrier(const XcdBarrier& b) {
    asm volatile("s_waitcnt vmcnt(0)" ::: "memory");
    __syncthreads();
    if (b.w == 0 && xb_lane() == 0) {
        unsigned* bar = b.bar;
        __builtin_amdgcn_s_waitcnt(0);
        unsigned nloc = b.st[0], nx = b.st[1];
        if (nloc == 0u) { xcd_barrier_complete(bar, b.x, nloc, nx); b.st[0] = nloc; b.st[1] = nx; }
        const unsigned old = xb_add(&bar[XB_XSUB(b.x)], 1u);
        const unsigned gen = old / nloc;
        if (old + 1u == (gen + 1u) * nloc) {
            __builtin_amdgcn_fence(__ATOMIC_RELEASE, "agent");
            asm volatile("s_waitcnt vmcnt(0)" ::: "memory");
            const unsigned og = xb_add(&bar[XB_TOP], 1u);
            const unsigned tg = og / nx;
            if (og + 1u == (tg + 1u) * nx) xb_add(&bar[XB_TOPGEN], 1u);
            else XB_SPIN(xb_ld(&bar[XB_TOPGEN]) == tg, bar);
            __builtin_amdgcn_fence(__ATOMIC_ACQUIRE, "agent");
            xb_add(&bar[XB_XGEN(b.x)], 1u);
            asm volatile("s_waitcnt vmcnt(0)" ::: "memory");
        } else {
            XB_SPIN(xb_ld(&bar[XB_XGEN(b.x)]) == gen, bar);
            __builtin_amdgcn_fence(__ATOMIC_ACQUIRE, "agent");
            asm volatile("s_waitcnt vmcnt(0)" ::: "memory");
        }
    }
    __syncthreads();
}

struct Frame {
    LAS unsigned char* lds;
    int tid, lane, wave, gw;
};
constexpr int PTAB_OFF = MISC_OFF + 256;
__device__ __forceinline__ unsigned long long ptab_get(LAS unsigned char* lds, int i) {
    LAS unsigned char* base = lds + PTAB_OFF; asm volatile("" : "+v"(base));
    const unsigned long long v = ((const volatile LAS unsigned long long*)base)[i];
    const unsigned lo = __builtin_amdgcn_readfirstlane((unsigned)v), hi = __builtin_amdgcn_readfirstlane((unsigned)(v >> 32));
    return ((unsigned long long)hi << 32) | lo;
}
#define P_IN(i) ((const float*)(const GAS float*)ptab_get(F.lds, (i)))
#define P_OUT ((float*)(GAS float*)ptab_get(F.lds, 14))
#define P_WS ((unsigned char*)(GAS unsigned char*)ptab_get(F.lds, 15))
__device__ __forceinline__ Frame make_frame(LAS unsigned char* lds, int wave_s) { Frame F; F.lds = lds; int bx = blockIdx.x; asm volatile("" : "+s"(bx));
    int ln = xb_lane(); asm volatile("" : "+v"(ln));
    F.lane = ln; F.wave = wave_s; F.tid = wave_s * 64 + ln; F.gw = bx * NWAVES + F.wave; return F; }
__device__ __forceinline__ float shx(float v, int o, int lane) { return __builtin_bit_cast(float, __builtin_amdgcn_ds_bpermute((lane ^ o) << 2, __builtin_bit_cast(int, v))); }
__device__ __forceinline__ unsigned shrel(unsigned v, int d, int lane) { return (unsigned)__builtin_amdgcn_ds_bpermute(((lane + d) & 63) << 2, (int)v); }
__device__ __forceinline__ float wave_sum(float v, int lane) {
#pragma unroll
    for (int o = 1; o < 64; o <<= 1) v += shx(v, o, lane);
    return v;
}
template <bool SCALE = false>
__device__ __forceinline__ void transpose_item(const float* W, int K, int N, bf16* dst, LAS float* scr, int k0, int n0, int lane, const float* gk = nullptr) {
    float tv[32];
#pragma unroll
    for (int i = 0; i < 32; ++i) { const int kk = 2 * i + (lane >> 5); tv[i] = W[(size_t)(k0 + kk) * N + n0 + (lane & 31)]; }
#pragma unroll
    for (int i = 0; i < 32; ++i) { const int kk = 2 * i + (lane >> 5); scr[kk * 33 + (lane & 31)] = tv[i]; }
    LDS_WAIT(); asm volatile("" ::: "memory");
    const int c = lane & 7;
    f32x4 ga = {1.f, 1.f, 1.f, 1.f}, gb = {1.f, 1.f, 1.f, 1.f};
    if (SCALE) { ga = *(const f32x4*)(gk + k0 + 8 * c); gb = *(const f32x4*)(gk + k0 + 8 * c + 4); }
#pragma unroll
    for (int j = 0; j < 4; ++j) { const int n = (lane >> 3) + 8 * j; const LAS float* s = scr + (8 * c) * 33 + n;
        v4u o; o.x = pk2bf(s[0 * 33] * ga.x, s[1 * 33] * ga.y); o.y = pk2bf(s[2 * 33] * ga.z, s[3 * 33] * ga.w); o.z = pk2bf(s[4 * 33] * gb.x, s[5 * 33] * gb.y); o.w = pk2bf(s[6 * 33] * gb.z, s[7 * 33] * gb.w);
        *(GAS v4u*)(dst + (size_t)n * K + k0 + 8 * c) = o; }
    LDS_WAIT(); asm volatile("" ::: "memory");
}
__device__ __forceinline__ void convert_weights(Frame& F, int l) {
    LAS float* scr = (LAS float*)(F.lds + F.wave * 8448);
    const int NGW = 256 * NWAVES;
    unsigned char* ws = P_WS;
    bf16* WinT = (bf16*)(ws + WS_WIN); bf16* WaT = (bf16*)(ws + WS_WA); bf16* WbT = (bf16*)(ws + WS_WB); bf16* WoT = (bf16*)(ws + WS_WO);
    bf16* WguT = (bf16*)(ws + WS_WGU); bf16* WdT = (bf16*)(ws + WS_WD);
    const float* w_in = P_IN(2) + (size_t)l * DM * INC; const float* w_a = P_IN(3) + (size_t)l * 256 * DM; const float* w_b = P_IN(4) + (size_t)l * DM * DM;
    const float* w_o = P_IN(7) + (size_t)l * DM * DM; const float* g2 = P_IN(8) + (size_t)l * DM;
    const float* w_g = P_IN(10) + (size_t)l * NE * DM * DEX; const float* w_u = P_IN(11) + (size_t)l * NE * DM * DEX; const float* w_d = P_IN(12) + (size_t)l * NE * DEX * DM;
    constexpr int I_IN = 16 * (INC / 32), I_A = 4 * 32, I_B = 16 * 32, I_O = 16 * 32, I_E = NE * 16 * 32;
    constexpr int NITEMS = I_IN + I_A + I_B + I_O + 3 * I_E;
    for (int it = F.gw; it < NITEMS; it += NGW) {
        int r = it;
        if (r < I_IN) { const int nb = r % (INC / 32), kb = r / (INC / 32), n0 = 32 * nb; int drow = n0;
            if (n0 >= 3840) { const int gc = n0 - 3840, br = gc >> 10, cc = gc & 1023; drow = 3840 + (cc >> 7) * 256 + ((cc & 127) >> 5) * 64 + br * 32; }
            transpose_item(w_in, DM, INC, WinT + (size_t)drow * DM, scr, 64 * kb, n0, F.lane); continue; } r -= I_IN;
        if (r < I_A) { const int nb = r % 32, kb = r / 32; transpose_item(w_a, 256, DM, WaT + (size_t)(32 * nb) * 256, scr, 64 * kb, 32 * nb, F.lane); continue; } r -= I_A;
        if (r < I_B) { const int nb = r % 32, kb = r / 32; transpose_item(w_b, DM, DM, WbT + (size_t)(32 * nb) * DM, scr, 64 * kb, 32 * nb, F.lane); continue; } r -= I_B;
        if (r < I_O) { const int nb = r % 32, kb = r / 32; transpose_item(w_o, DM, DM, WoT + (size_t)(32 * nb) * DM, scr, 64 * kb, 32 * nb, F.lane); continue; } r -= I_O;
        if (r < 2 * I_E) { const int up = r >= I_E; if (up) r -= I_E; const int e = r / 512, loc = r % 512, nb = loc % 32, kb = loc / 32, f0 = 32 * nb;
            const float* W = (up ? w_u : w_g) + (size_t)e * DM * DEX;
            transpose_item<true>(W, DM, DEX, WguT + ((size_t)e * 2048 + (f0 >> 7) * 256 + (up ? 128 : 0) + (f0 & 127)) * DM, scr, 64 * kb, f0, F.lane, g2); continue; } r -= 2 * I_E;
        { const int e = r / 512, loc = r % 512, nb = loc % 32, kb = loc / 32;
            transpose_item(w_d + (size_t)e * DEX * DM, DEX, DM, WdT + ((size_t)e * 1024 + 32 * nb) * DEX, scr, 64 * kb, 32 * nb, F.lane); }
    }
}
__device__ __forceinline__ void unpk8(const v4u w, float (&v)[8]) { v[0] = bflo(w.x); v[1] = bfhi(w.x); v[2] = bflo(w.y); v[3] = bfhi(w.y); v[4] = bflo(w.z); v[5] = bfhi(w.z); v[6] = bflo(w.w); v[7] = bfhi(w.w); }
__device__ __forceinline__ v4u pk8(const float (&v)[8]) { v4u w; w.x = pk2bf(v[0], v[1]); w.y = pk2bf(v[2], v[3]); w.z = pk2bf(v[4], v[5]); w.w = pk2bf(v[6], v[7]); return w; }
template <bool XIN, bool COMBINE, bool FINAL>
__device__ __forceinline__ void norm_rows(Frame& F, const float* xin, bf16* hb, const float* gain, bf16* hn, float* out) {
    const int NGW = 256 * NWAVES;
    unsigned char* ws = P_WS;
    const int* sel = (const int*)(ws + WS_SEL); const bf16* Y = (const bf16*)(ws + WS_BIG + B_Y);
    float gv[2][8];
#pragma unroll
    for (int j = 0; j < 2; ++j) { const f32x4 a = *(const f32x4*)(gain + (64 * j + F.lane) * 8), b = *(const f32x4*)(gain + (64 * j + F.lane) * 8 + 4);
        gv[j][0] = a.x; gv[j][1] = a.y; gv[j][2] = a.z; gv[j][3] = a.w; gv[j][4] = b.x; gv[j][5] = b.y; gv[j][6] = b.z; gv[j][7] = b.w; }
    constexpr int NR = 4;
    for (int m0 = F.gw; m0 < MTOK; m0 += NR * NGW) {
        float v[NR][2][8]; int sv[NR];
#pragma unroll
        for (int rr = 0; rr < NR; ++rr) { const int m = m0 + rr * NGW;
            if (COMBINE) sv[rr] = sel[(size_t)m * NE + (F.lane & 15)];
            if (XIN) {
#pragma unroll
                for (int j = 0; j < 2; ++j) { const f32x4 a = *(const f32x4*)(xin + (size_t)m * DM + (64 * j + F.lane) * 8), b = *(const f32x4*)(xin + (size_t)m * DM + (64 * j + F.lane) * 8 + 4);
                    v[rr][j][0] = a.x; v[rr][j][1] = a.y; v[rr][j][2] = a.z; v[rr][j][3] = a.w; v[rr][j][4] = b.x; v[rr][j][5] = b.y; v[rr][j][6] = b.z; v[rr][j][7] = b.w; }
            } else {
#pragma unroll
                for (int j = 0; j < 2; ++j) unpk8(*(const v4u*)(hb + (size_t)m * DM + (64 * j + F.lane) * 8), v[rr][j]);
            } }
        if (COMBINE) {
            unsigned msk[NR];
#pragma unroll
            for (int rr = 0; rr < NR; ++rr) msk[rr] = (unsigned)(__builtin_amdgcn_ballot_w64(sv[rr] >= 0) & 0xffffull);
            unsigned any = 0u;
#pragma unroll
            for (int rr = 0; rr < NR; ++rr) any |= msk[rr];
            while (any != 0u) {
                v4u yv[NR][2]; float wgt[NR];
#pragma unroll
                for (int rr = 0; rr < NR; ++rr) { const int m = m0 + rr * NGW, b = m >> 11; const bool has = msk[rr] != 0u;
                    const int e = has ? __builtin_ctz(msk[rr]) : 0; const int r = has ? __builtin_amdgcn_readlane(sv[rr], e) : 0;
                    const bf16* yr = Y + ((size_t)(e * NB + b) * CAP + r) * DM; wgt[rr] = has ? 1.0f : 0.0f; msk[rr] &= msk[rr] - 1u;
#pragma unroll
                    for (int j = 0; j < 2; ++j) yv[rr][j] = *(const v4u*)(yr + (64 * j + F.lane) * 8); }
                any = 0u;
#pragma unroll
                for (int rr = 0; rr < NR; ++rr) { any |= msk[rr];
#pragma unroll
                    for (int j = 0; j < 2; ++j) { float y[8]; unpk8(yv[rr][j], y);
#pragma unroll
                        for (int i = 0; i < 8; ++i) v[rr][j][i] += wgt[rr] * y[i]; } }
            }
        }
#pragma unroll
        for (int rr = 0; rr < NR; ++rr) { const int m = m0 + rr * NGW;
            if ((XIN || COMBINE) && !FINAL) {
#pragma unroll
                for (int j = 0; j < 2; ++j) *(v4u*)(hb + (size_t)m * DM + (64 * j + F.lane) * 8) = pk8(v[rr][j]);
            }
            float ss = 0.f;
#pragma unroll
            for (int j = 0; j < 2; ++j)
#pragma unroll
                for (int i = 0; i < 8; ++i) ss += v[rr][j][i] * v[rr][j][i];
            const float rs = 1.0f / sqrtf(wave_sum(ss, F.lane) * (1.0f / DM) + RMS_EPS);
#pragma unroll
            for (int j = 0; j < 2; ++j) { float o[8];
#pragma unroll
                for (int i = 0; i < 8; ++i) o[i] = v[rr][j][i] * rs * gv[j][i];
                if (FINAL) { float* op = out + (size_t)m * DM + (64 * j + F.lane) * 8; *(f32x4*)op = (f32x4){o[0], o[1], o[2], o[3]}; *(f32x4*)(op + 4) = (f32x4){o[4], o[5], o[6], o[7]}; }
                else *(v4u*)(hn + (size_t)m * DM + (64 * j + F.lane) * 8) = pk8(o); } }
    }
}
constexpr int RT_PITCH = 2048 + 16;
__device__ __forceinline__ void norm_router(Frame& F, const bf16* hb, const float* gain, const float* wr, float* rsv, float* aff) {
    LAS unsigned char* whi = F.lds; LAS unsigned char* wlo = F.lds + 16 * RT_PITCH; LAS float* gl = (LAS float*)(F.lds + 32 * RT_PITCH);
    { const float g0 = gain[F.tid], g1 = gain[F.tid + NWAVES * 64]; gl[F.tid] = g0; gl[F.tid + NWAVES * 64] = g1; }
    __syncthreads();
    { f32x4 wv[8];
#pragma unroll
      for (int j = 0; j < 8; ++j) wv[j] = *(const f32x4*)(wr + 4 * (F.tid + j * NWAVES * 64));
      asm volatile("" ::: "memory");
#pragma unroll
      for (int j = 0; j < 8; ++j) { const int i0 = 4 * (F.tid + j * NWAVES * 64), k = i0 >> 4, e0 = i0 & 15; const float g = gl[k];
#pragma unroll
          for (int t = 0; t < 4; ++t) { const float w = wv[j][t] * g; const unsigned hi = pk2bf(w, 0.f) & 0xffffu; const float rem = w - bflo(hi);
              *(LAS unsigned short*)(whi + (e0 + t) * RT_PITCH + k * 2) = (unsigned short)hi; *(LAS unsigned short*)(wlo + (e0 + t) * RT_PITCH + k * 2) = (unsigned short)(pk2bf(rem, 0.f) & 0xffffu); } } }
    __syncthreads();
    const int NGW = 256 * NWAVES, r16 = F.lane & 15, q = F.lane >> 4;
    for (int grp = F.gw; grp < MTOK / 16; grp += NGW) {
        const size_t row = (size_t)grp * 16 + r16;
        v4u xs[32];
#pragma unroll
        for (int s = 0; s < 16; ++s) { const v4u* p = (const v4u*)(hb + row * DM + 64 * s + 16 * q); xs[2 * s] = p[0]; xs[2 * s + 1] = p[1]; }
        f32x4 acc = {0.f, 0.f, 0.f, 0.f}; float ss = 0.f;
#pragma unroll
        for (int s = 0; s < 16; ++s) {
#pragma unroll
            for (int h2 = 0; h2 < 2; ++h2) { const bf16x8 a = __builtin_bit_cast(bf16x8, xs[2 * s + h2]);
                const bf16x8 bh = *(const LAS bf16x8*)(whi + r16 * RT_PITCH + (64 * s + 16 * q + 8 * h2) * 2), bl = *(const LAS bf16x8*)(wlo + r16 * RT_PITCH + (64 * s + 16 * q + 8 * h2) * 2);
                acc = __builtin_amdgcn_mfma_f32_16x16x32_bf16(a, bh, acc, 0, 0, 0); acc = __builtin_amdgcn_mfma_f32_16x16x32_bf16(a, bl, acc, 0, 0, 0);
                float x[8]; unpk8(xs[2 * s + h2], x);
#pragma unroll
                for (int i = 0; i < 8; ++i) ss += x[i] * x[i]; }
            asm volatile("" ::: "memory"); }
        ss += shx(ss, 16, F.lane); ss += shx(ss, 32, F.lane);
        const float rs = 1.0f / sqrtf(ss * (1.0f / DM) + RMS_EPS);
        float lg[4];
#pragma unroll
        for (int r = 0; r < 4; ++r) { const float rr = __builtin_bit_cast(float, __builtin_amdgcn_ds_bpermute((4 * q + r) << 2, __builtin_bit_cast(int, rs))); lg[r] = acc[r] * rr; }
#pragma unroll
        for (int r = 0; r < 4; ++r) { float mx = lg[r];
#pragma unroll
            for (int o = 1; o < 16; o <<= 1) mx = fmaxf(mx, shx(mx, o, F.lane));
            const float ex = __expf(lg[r] - mx); float sm = ex;
#pragma unroll
            for (int o = 1; o < 16; o <<= 1) sm += shx(sm, o, F.lane);
            aff[((size_t)grp * 16 + 4 * q + r) * NE + r16] = ex / sm; }
        if (q == 0) rsv[row] = rs;
    }
}
__device__ __forceinline__ void topk_gather(Frame& F, const float* aff, const float* rsv, int* sel, float* gatev, int* idxg) {
    LAS unsigned* hist = (LAS unsigned*)F.lds;
    volatile LAS unsigned* st = (volatile LAS unsigned*)(F.lds + 1024);
    for (int u = blockIdx.x; u < NB * NE; u += 256) {
        const int b = u >> 4, e = u & 15;
        unsigned bits[4];
#pragma unroll
        for (int q = 0; q < 4; ++q) bits[q] = __float_as_uint(aff[((size_t)b * SEQ + 4 * F.tid + q) * NE + e]);
        const f32x4 rs4 = *(const f32x4*)(rsv + (size_t)b * SEQ + 4 * F.tid);
        unsigned prefix = 0u, kk = CAP;
#pragma unroll 1
        for (int pass = 0; pass < 4; ++pass) {
            const int shift = 24 - 8 * pass;
            if (F.tid < 256) hist[F.tid] = 0u;
            __syncthreads();
#pragma unroll
            for (int q = 0; q < 4; ++q) { const bool in = (pass == 0) || ((bits[q] >> (shift + 8)) == prefix); if (in) atomicAdd((unsigned*)&hist[(bits[q] >> shift) & 255u], 1u); }
            __syncthreads();
            if (F.wave == 0) {
                const unsigned c0 = hist[4 * F.lane], c1 = hist[4 * F.lane + 1], c2 = hist[4 * F.lane + 2], c3 = hist[4 * F.lane + 3];
                unsigned incl = c0 + c1 + c2 + c3;
#pragma unroll
                for (int o = 1; o < 64; o <<= 1) { const unsigned v = shrel(incl, o, F.lane); if (F.lane + o < 64) incl += v; }
                unsigned cum = incl - (c0 + c1 + c2 + c3);
                int found = -1; unsigned above = 0u;
                if (cum < kk && cum + c3 >= kk) { found = 3; above = cum; } cum += c3;
                if (cum < kk && cum + c2 >= kk) { found = 2; above = cum; } cum += c2;
                if (cum < kk && cum + c1 >= kk) { found = 1; above = cum; } cum += c1;
                if (cum < kk && cum + c0 >= kk) { found = 0; above = cum; }
                if (found >= 0) { st[0] = (prefix << 8) | (unsigned)(4 * F.lane + found); st[1] = kk - above; }
            }
            __syncthreads();
            prefix = st[0]; kk = st[1];
        }
        const unsigned T = prefix;
        unsigned ngt = 0u, neq = 0u;
#pragma unroll
        for (int q = 0; q < 4; ++q) { ngt += bits[q] > T ? 1u : 0u; neq += bits[q] == T ? 1u : 0u; }
        unsigned pk = ngt | (neq << 16), inc = pk;
#pragma unroll
        for (int o = 1; o < 64; o <<= 1) { const unsigned v = shrel(inc, -o, F.lane); if (F.lane >= o) inc += v; }
        if (F.lane == 63) st[8 + F.wave] = inc;
        __syncthreads();
        unsigned base = 0u;
#pragma unroll
        for (int w = 0; w < NWAVES; ++w) base += (w < F.wave) ? st[8 + w] : 0u;
        const unsigned excl = base + inc - pk;
        unsigned pgt = excl & 0xffffu, peq = excl >> 16;
#pragma unroll
        for (int q = 0; q < 4; ++q) { const int i = 4 * F.tid + q; const bool g = bits[q] > T, eq = bits[q] == T; const bool keep = g || (eq && peq < kk);
            const unsigned slot = pgt + (peq < kk ? peq : kk);
            if (keep) { idxg[(size_t)(e * NB + b) * CAP + slot] = (int)((unsigned)(b * SEQ + i) | ((unsigned)__builtin_bit_cast(unsigned short, (_Float16)rs4[q]) << 16)); gatev[(size_t)(e * NB + b) * CAP + slot] = __uint_as_float(bits[q]); }
            sel[((size_t)b * SEQ + i) * NE + e] = keep ? (int)slot : -1;
            pgt += g ? 1u : 0u; peq += eq ? 1u : 0u; }
        __syncthreads();
    }
}


constexpr int ATT_KPITCH = 144, ATT_VT_OFF = 512 * ATT_KPITCH, ATT_VPITCH = 1040, ATT_SINK_OFF = MISC_OFF + 1024;
static_assert(ATT_VT_OFF + 64 * ATT_VPITCH <= MISC_OFF, "attention LDS");
#ifndef ATT_JT_UNROLL
#define ATT_JT_UNROLL 1
#endif
struct ChunkP { const bf16* K; const bf16* V; int ldkv, tok0, cstep, r, L, nseg, qs, i0; };
template <int W>
__device__ __forceinline__ void attn_issue(const ChunkP& p, int tid, v4u (&kreg)[8], v4u (&vreg)[2][4]) {
    asm volatile("" : "+v"(tid));
    const int KS = p.qs + 2 * W, nrows = p.nseg * KS, Lm1 = p.L - 1;
    constexpr int NKP = 8;
#pragma unroll
    for (int it = 0; it < NKP; ++it) { const int pc = tid + it * NWAVES * 64, row0 = pc >> 3, ch = pc & 7, row = row0 < nrows ? row0 : nrows - 1, s = row >= KS ? 1 : 0, rho = row - s * KS;
        int j = p.i0 - W + rho; j = j < 0 ? 0 : j; j = j > Lm1 ? Lm1 : j;
        kreg[it] = *(const v4u*)(p.K + (size_t)(p.tok0 + s * p.cstep + p.r * j) * p.ldkv + ch * 8); }
#pragma unroll
    for (int it = 0; it < 2; ++it) { const int t = tid + it * NWAVES * 64, r4 = t >> 3, ch = t & 7, rowa = 4 * r4, row0 = rowa < nrows ? rowa : nrows - 4, s = row0 >= KS ? 1 : 0, rho = row0 - s * KS, j0 = p.i0 - W + rho;
#pragma unroll
        for (int q = 0; q < 4; ++q) { int j = j0 + q; j = j < 0 ? 0 : j; j = j > Lm1 ? Lm1 : j;
            vreg[it][q] = *(const v4u*)(p.V + (size_t)(p.tok0 + s * p.cstep + p.r * j) * p.ldkv + ch * 8); } }
}
__device__ __forceinline__ void attn_loadq(const Frame& F, const ChunkP& p, const bf16* Q, int ldq, bf16x8 (&qf)[4]) {
    int lane_ = F.lane; asm volatile("" : "+v"(lane_));
    const int wq = F.wave * 32, sidx = (wq >= p.qs) ? 1 : 0, qo = wq - sidx * p.qs, ql = lane_ & 31, hh = lane_ >> 5, qi = p.i0 + qo + ql;
    const bf16* q0 = Q + (size_t)(p.tok0 + sidx * p.cstep + p.r * qi) * ldq;
#pragma unroll
    for (int ks = 0; ks < 4; ++ks) qf[ks] = *(const bf16x8*)(q0 + 16 * ks + 8 * hh);
}
template <int W>
__device__ __forceinline__ void attn_commit(Frame& F, const ChunkP& p, const v4u (&kreg)[8], const v4u (&vreg)[2][4]) {
    int tid = F.tid; asm volatile("" : "+v"(tid));
    const int KS = p.qs + 2 * W, nrows = p.nseg * KS;
    LAS unsigned char* ldsK = F.lds; LAS unsigned char* ldsV = F.lds + ATT_VT_OFF;
    constexpr int NKP = 8;
#pragma unroll
    for (int it = 0; it < NKP; ++it) { const int pc = tid + it * NWAVES * 64, row = pc >> 3, ch = pc & 7;
        if (pc < nrows * 8) *(LAS v4u*)(ldsK + row * ATT_KPITCH + ch * 16) = kreg[it]; }
#pragma unroll
    for (int it = 0; it < 2; ++it) { const int t = tid + it * NWAVES * 64, r4 = t >> 3, ch = t & 7, row0 = 4 * r4;
        if (t < nrows * 2) {
            const int kap = row0 & 31, slot = (kap >> 4) * 16 + ((kap >> 2) & 1) * 8 + ((kap >> 3) & 1) * 4, pos = (row0 & ~31) + slot;
#pragma unroll
            for (int w = 0; w < 4; ++w) {
                v2u lo, hi;
                lo.x = (vreg[it][0][w] & 0xffffu) | (vreg[it][1][w] << 16); lo.y = (vreg[it][2][w] & 0xffffu) | (vreg[it][3][w] << 16);
                hi.x = (vreg[it][0][w] >> 16) | (vreg[it][1][w] & 0xffff0000u); hi.y = (vreg[it][2][w] >> 16) | (vreg[it][3][w] & 0xffff0000u);
                *(LAS v2u*)(ldsV + (ch * 8 + 2 * w) * ATT_VPITCH + pos * 2) = lo;
                *(LAS v2u*)(ldsV + (ch * 8 + 2 * w + 1) * ATT_VPITCH + pos * 2) = hi;
            } } }
}
#ifndef ATT_THR
#define ATT_THR 8.0f
#endif
template <int W, int NH, bool SINK, bool WRITE_LSE>
__device__ __forceinline__ void attn_compute(Frame& F, const ChunkP& p, bf16* Q, int ldq, long odelta, float* lse, float slope1, const float* sinkp, int hbase, bf16x8 (&qf)[4]) {
    constexpr int NJT = 2 * W / 32 + 1, JC = W / 32;
    const int KS = p.qs + 2 * W, L = p.L, i0 = p.i0;
    LAS unsigned char* ldsK = F.lds; LAS unsigned char* ldsV = F.lds + ATT_VT_OFF;
    const int wq = F.wave * 32, sidx = (wq >= p.qs) ? 1 : 0, qo = wq - sidx * p.qs, segbase = sidx * KS;
    int lane_ = F.lane; asm volatile("" : "+v"(lane_));
    const int ql = lane_ & 31, hh = lane_ >> 5;
    const int qi = i0 + qo + ql;
    const size_t qtok = (size_t)(p.tok0 + sidx * p.cstep + p.r * qi);
    const float flo = (float)((-qi > -W) ? -qi : -W), fhi = (float)((L - 1 - qi < W) ? (L - 1 - qi) : W);
#pragma unroll 1
    for (int g = 0; g < NH; ++g) {
        bf16* qptr = Q + qtok * ldq + g * 64;
        f32x16 O0, O1;
        float m, l;
#ifdef PRB_REP
        constexpr int nrep = (NH == PRB_NH) ? PRB_REP : 1;
#pragma unroll 1
        for (int rep = 0; rep < nrep; ++rep) {
        asm volatile("" ::: "memory");
#endif
#pragma unroll
        for (int i = 0; i < 16; ++i) { O0[i] = 0.f; O1[i] = 0.f; }
        const float sl = (NH == 1) ? slope1 : __builtin_amdgcn_exp2f(-0.5f * (float)(hbase + g + 1)) * LOG2E;
        const float sk2 = SINK ? *(const LAS float*)(F.lds + ATT_SINK_OFF + 4 * (hbase + g)) : 0.f;
        {
            const int jbase = i0 + qo - W + 32 * JC, krow = segbase + qo + 32 * JC;
            const bool need_mask = (jbase < 0) || (jbase + 31 >= L);
            f32x16 S;
#pragma unroll
            for (int i = 0; i < 16; ++i) S[i] = 0.f;
#pragma unroll
            for (int ks = 0; ks < 4; ++ks) { const bf16x8 kf = *(const LAS bf16x8*)(ldsK + (krow + ql) * ATT_KPITCH + (16 * ks + 8 * hh) * 2); S = __builtin_amdgcn_mfma_f32_32x32x16_bf16(kf, qf[ks], S, 0, 0, 0); }
            const float fd0 = (float)(jbase + 4 * hh - qi);
#pragma unroll
            for (int i = 0; i < 16; ++i) { const float fd = fd0 + (float)((i & 3) + 8 * (i >> 2)); S[i] = S[i] - sl * fabsf(fd); }
            if (need_mask) {
#pragma unroll
                for (int i = 0; i < 16; ++i) { const float fd = fd0 + (float)((i & 3) + 8 * (i >> 2)); S[i] = (fd >= flo && fd <= fhi) ? S[i] : -INFINITY; } }
            float mloc = S[0];
#pragma unroll
            for (int i = 1; i < 16; ++i) mloc = fmaxf(mloc, S[i]);
            m = fmaxf(mloc, shx(mloc, 32, lane_));
            float ps = 0.f;
#pragma unroll
            for (int i = 0; i < 16; ++i) { const float pv = __builtin_amdgcn_exp2f(S[i] - m); S[i] = pv; ps += pv; }
            l = ps;
#pragma unroll
            for (int s2 = 0; s2 < 2; ++s2) {
                f32x8_t pp;
#pragma unroll
                for (int i = 0; i < 8; ++i) pp[i] = S[8 * s2 + i];
                const bf16x8 pf = __builtin_bit_cast(bf16x8, __builtin_convertvector(pp, nbf16x8));
                const bf16x8 v0 = *(const LAS bf16x8*)(ldsV + ql * ATT_VPITCH + (krow + 16 * s2 + 8 * hh) * 2);
                const bf16x8 v1 = *(const LAS bf16x8*)(ldsV + (ql + 32) * ATT_VPITCH + (krow + 16 * s2 + 8 * hh) * 2);
                O0 = __builtin_amdgcn_mfma_f32_32x32x16_bf16(v0, pf, O0, 0, 0, 0);
                O1 = __builtin_amdgcn_mfma_f32_32x32x16_bf16(v1, pf, O1, 0, 0, 0);
            }
        }
#pragma unroll 1
        for (int jt = 0; jt < NJT; ++jt) {
            if (jt == JC) continue;
            const int jbase = i0 + qo - W + 32 * jt;
            if (jbase + 31 < 0 || jbase >= L) continue;
            const bool need_mask = (jt == 0) || (jt == NJT - 1) || (jbase < 0) || (jbase + 31 >= L);
            const int krow = segbase + qo + 32 * jt;
            const float fd0 = (float)(jbase + 4 * hh - qi);
            bf16x8 kf[4];
#pragma unroll
            for (int ks = 0; ks < 4; ++ks) kf[ks] = *(const LAS bf16x8*)(ldsK + (krow + ql) * ATT_KPITCH + (16 * ks + 8 * hh) * 2);
            const bf16x8 vf00 = *(const LAS bf16x8*)(ldsV + ql * ATT_VPITCH + (krow + 8 * hh) * 2), vf10 = *(const LAS bf16x8*)(ldsV + (ql + 32) * ATT_VPITCH + (krow + 8 * hh) * 2);
            f32x16 S;
            if (jt < JC) { const float k1 = sl * fd0 - m;
#pragma unroll
                for (int i = 0; i < 16; ++i) S[i] = fmaf(sl, (float)((i & 3) + 8 * (i >> 2)), k1); }
            else { const float k1 = -sl * fd0 - m;
#pragma unroll
                for (int i = 0; i < 16; ++i) S[i] = fmaf(-sl, (float)((i & 3) + 8 * (i >> 2)), k1); }
            if (need_mask) {
#pragma unroll
                for (int i = 0; i < 16; ++i) { const float fd = fd0 + (float)((i & 3) + 8 * (i >> 2)); S[i] = (fd >= flo && fd <= fhi) ? S[i] : -INFINITY; } }
#pragma unroll
            for (int ks = 0; ks < 4; ++ks) S = __builtin_amdgcn_mfma_f32_32x32x16_bf16(kf[ks], qf[ks], S, 0, 0, 0);
            const bf16x8 vf01 = *(const LAS bf16x8*)(ldsV + ql * ATT_VPITCH + (krow + 16 + 8 * hh) * 2), vf11 = *(const LAS bf16x8*)(ldsV + (ql + 32) * ATT_VPITCH + (krow + 16 + 8 * hh) * 2);
            float tmax = S[0];
#pragma unroll
            for (int i = 1; i < 16; ++i) tmax = fmaxf(tmax, S[i]);
            if (__builtin_amdgcn_ballot_w64(tmax > ATT_THR) != 0ull) {
                float d = fmaxf(tmax, 0.f); d = fmaxf(d, shx(d, 32, lane_));
                const float sc = __builtin_amdgcn_exp2f(-d);
#pragma unroll
                for (int i = 0; i < 16; ++i) { S[i] -= d; O0[i] *= sc; O1[i] *= sc; }
                l *= sc; m += d;
            }
            float ps = 0.f;
#pragma unroll
            for (int i = 0; i < 16; ++i) { const float pv = __builtin_amdgcn_exp2f(S[i]); S[i] = pv; ps += pv; }
            l += ps;
            { f32x8_t pp;
#pragma unroll
              for (int i = 0; i < 8; ++i) pp[i] = S[i];
              const bf16x8 pf = __builtin_bit_cast(bf16x8, __builtin_convertvector(pp, nbf16x8));
              O0 = __builtin_amdgcn_mfma_f32_32x32x16_bf16(vf00, pf, O0, 0, 0, 0); O1 = __builtin_amdgcn_mfma_f32_32x32x16_bf16(vf10, pf, O1, 0, 0, 0); }
            { f32x8_t pp;
#pragma unroll
              for (int i = 0; i < 8; ++i) pp[i] = S[8 + i];
              const bf16x8 pf = __builtin_bit_cast(bf16x8, __builtin_convertvector(pp, nbf16x8));
              O0 = __builtin_amdgcn_mfma_f32_32x32x16_bf16(vf01, pf, O0, 0, 0, 0); O1 = __builtin_amdgcn_mfma_f32_32x32x16_bf16(vf11, pf, O1, 0, 0, 0); }
        }
#ifdef PRB_REP
        }
        const float sk2 = SINK ? *(const LAS float*)(F.lds + ATT_SINK_OFF + 4 * (hbase + g)) : 0.f;
#endif
        float lt = l + shx(l, 32, lane_);
        float osc = 1.0f;
        if (SINK) { const float mf = fmaxf(m, sk2); osc = __builtin_amdgcn_exp2f(m - mf); lt = lt * osc + __builtin_amdgcn_exp2f(sk2 - mf); }
        if (WRITE_LSE) { if (hh == 0) lse[qtok * 4] = m + __builtin_amdgcn_logf(lt); }
        const float inv = osc / lt;
        if (NH > 1 && g + 1 < NH) {
#pragma unroll
            for (int ks = 0; ks < 4; ++ks) qf[ks] = *(const bf16x8*)(qptr + 64 + 16 * ks + 8 * hh); }
        v2u WW[8];
#pragma unroll
        for (int g4 = 0; g4 < 4; ++g4) {
            WW[g4].x = pk2bf(O0[4 * g4] * inv, O0[4 * g4 + 1] * inv); WW[g4].y = pk2bf(O0[4 * g4 + 2] * inv, O0[4 * g4 + 3] * inv);
            WW[4 + g4].x = pk2bf(O1[4 * g4] * inv, O1[4 * g4 + 1] * inv); WW[4 + g4].y = pk2bf(O1[4 * g4 + 2] * inv, O1[4 * g4 + 3] * inv); }
#pragma unroll
        for (int s4 = 0; s4 < 4; ++s4) {
            v2u a = WW[2 * s4], b = WW[2 * s4 + 1];
            { const auto r = __builtin_amdgcn_permlane32_swap(a.x, b.x, false, false); a.x = r[0]; b.x = r[1]; }
            { const auto r = __builtin_amdgcn_permlane32_swap(a.y, b.y, false, false); a.y = r[0]; b.y = r[1]; }
            *(v4u*)(qptr + odelta + 16 * s4 + 8 * hh) = (v4u){a.x, a.y, b.x, b.y};
#ifdef PRB_ST2
            asm volatile("" ::: "memory");
            *(v4u*)(qptr + odelta + 16 * s4 + 8 * hh) = (v4u){a.x, a.y, b.x, b.y};
            asm volatile("" ::: "memory");
#endif
        }
    }
}
__device__ __forceinline__ ChunkP dil_chunk(const bf16* KA, const bf16* VA, int b, int hs, int sc) {
    const int grp = sc >> 3, ix = sc & 7, col = grp * 256 + hs * 64; ChunkP p; p.K = KA + col; p.V = VA + col; p.ldkv = 768;
    if (grp == 0) { p.tok0 = b * SEQ; p.cstep = 0; p.r = 1; p.L = 2048; p.nseg = 1; p.qs = 256; p.i0 = 256 * ix; }
    else if (grp == 1) { p.tok0 = b * SEQ + (ix >> 1); p.cstep = 0; p.r = 4; p.L = 512; p.nseg = 1; p.qs = 256; p.i0 = 256 * (ix & 1); }
    else { p.tok0 = b * SEQ + 2 * ix; p.cstep = 1; p.r = 16; p.L = 128; p.nseg = 2; p.qs = 128; p.i0 = 0; }
    return p;
}
__device__ __forceinline__ ChunkP win_chunk(const bf16* KW, const bf16* VW, int wc) {
    const int b = wc >> 5, kvh = (wc >> 3) & 3, ch = wc & 7; ChunkP p; p.K = KW + kvh * 64; p.V = VW + kvh * 64; p.ldkv = 256;
    p.tok0 = b * SEQ; p.cstep = 0; p.r = 1; p.L = SEQ; p.nseg = 1; p.qs = 256; p.i0 = 256 * ch; return p;
}
__device__ __forceinline__ void attention_phase(Frame& F, int l, long odA, long odW, int which = 3) {
    unsigned char* ws = P_WS;
    bf16* big = (bf16*)(ws + WS_BIG);
    bf16* QA = big + B_QA / 2; bf16* KA = big + B_KA / 2; bf16* VA = big + B_VA / 2; bf16* QW = big + B_QW / 2; bf16* KW = big + B_KW / 2; bf16* VW = big + B_VW / 2; bf16* OA = big + B_OA / 2;
    float* LSE = (float*)(ws + WS_LSE);
    const int c = blockIdx.x;
    int w_lo, w_hi;
    v4u kreg[8], vreg[2][4];
    bf16x8 qf[4];
#ifndef ATT_N1
#define ATT_N1 0
#endif
    static_assert(ATT_N1 == 0, "the dilated workgroups take no window chunks");
    if (c < 128) { w_lo = ATT_N1 * c; w_hi = w_lo + ATT_N1; } else { w_lo = 128 * ATT_N1 + (c - 128) * (8 - ATT_N1); w_hi = w_lo + (8 - ATT_N1); }
    if (c < 128) { if (which & 1) {
        const int b = c >> 2, hs = c & 3;
        { const ChunkP p0 = dil_chunk(KA, VA, b, hs, 0); attn_issue<64>(p0, F.tid, kreg, vreg); attn_loadq(F, p0, QA + hs * 64, 768, qf); attn_commit<64>(F, p0, kreg, vreg); }
        __syncthreads();
#pragma unroll 1
        for (int sc = 0; sc < 24; ++sc) {
            const ChunkP p = dil_chunk(KA, VA, b, hs, sc); const int grp = sc >> 3;
            const int scn = sc + 1 < 24 ? sc + 1 : sc;
            const ChunkP pn = dil_chunk(KA, VA, b, hs, scn);
            bf16x8 qn[4];
            attn_issue<64>(pn, F.tid, kreg, vreg); attn_loadq(F, pn, QA + (scn >> 3) * 256 + hs * 64, 768, qn);
            const float slope1 = __builtin_amdgcn_exp2f(-8.0f * (float)(grp * 4 + hs + 1) / 12.0f) * (float)p.r * LOG2E;
            attn_compute<64, 1, false, true>(F, p, QA + grp * 256 + hs * 64, 768, odA, LSE + (size_t)grp * MTOK * 4 + hs, slope1, nullptr, 0, qf);
            __syncthreads();
            if (sc + 1 < 24) attn_commit<64>(F, pn, kreg, vreg);
            __syncthreads();
#pragma unroll
            for (int ks = 0; ks < 4; ++ks) qf[ks] = qn[ks];
        }
        VM_WAIT(); __syncthreads(); __builtin_amdgcn_fence(__ATOMIC_ACQUIRE, "agent"); VM_WAIT();
        constexpr int CB = 8;
#pragma unroll 1
        for (int t0 = F.tid; t0 < SEQ * 8; t0 += NWAVES * 64 * CB) {
            float lv[CB][3]; v4u av[CB][3];
#pragma unroll
            for (int k = 0; k < CB; ++k) { const int t = t0 + k * NWAVES * 64, tok = t >> 3, ch = t & 7; const size_t row = (size_t)b * SEQ + tok;
                lv[k][0] = LSE[row * 4 + hs]; lv[k][1] = LSE[(size_t)MTOK * 4 + row * 4 + hs]; lv[k][2] = LSE[(size_t)2 * MTOK * 4 + row * 4 + hs];
                const bf16* og = QA + odA + row * 768 + hs * 64 + ch * 8; av[k][0] = *(const v4u*)(og); av[k][1] = *(const v4u*)(og + 256); av[k][2] = *(const v4u*)(og + 512); }
            asm volatile("" ::: "memory");
#pragma unroll
            for (int k = 0; k < CB; ++k) { const int t = t0 + k * NWAVES * 64, tok = t >> 3, ch = t & 7; const size_t row = (size_t)b * SEQ + tok;
                const float mx = fmaxf(lv[k][0], fmaxf(lv[k][1], lv[k][2]));
                float w0 = __builtin_amdgcn_exp2f(lv[k][0] - mx), w1 = __builtin_amdgcn_exp2f(lv[k][1] - mx), w2 = __builtin_amdgcn_exp2f(lv[k][2] - mx);
                const float inv = 1.0f / (w0 + w1 + w2); w0 *= inv; w1 *= inv; w2 *= inv;
                v4u o;
#pragma unroll
                for (int w = 0; w < 4; ++w) o[w] = pk2bf(w0 * bflo(av[k][0][w]) + w1 * bflo(av[k][1][w]) + w2 * bflo(av[k][2][w]), w0 * bfhi(av[k][0][w]) + w1 * bfhi(av[k][1][w]) + w2 * bfhi(av[k][2][w]));
                *(v4u*)(OA + row * 256 + hs * 64 + ch * 8) = o; }
        }
    } } else if (which & 2) {
        if (F.tid < 16) *(LAS float*)(F.lds + ATT_SINK_OFF + 4 * F.tid) = P_IN(6)[l * 16 + F.tid] * LOG2E;
        const ChunkP p0 = win_chunk(KW, VW, w_lo); attn_issue<128>(p0, F.tid, kreg, vreg); attn_loadq(F, p0, QW + ((w_lo >> 3) & 3) * 256, 1024, qf); attn_commit<128>(F, p0, kreg, vreg);
        __syncthreads();
    }
#pragma unroll 1
    for (int wc = w_lo; wc < ((which & 2) ? w_hi : w_lo); ++wc) {
        const ChunkP p = win_chunk(KW, VW, wc); const int kvh = (wc >> 3) & 3;
        const int wn = wc + 1 < w_hi ? wc + 1 : wc;
        const ChunkP pn = win_chunk(KW, VW, wn);
        bf16x8 qn[4];
        attn_issue<128>(pn, F.tid, kreg, vreg); attn_loadq(F, pn, QW + ((wn >> 3) & 3) * 256, 1024, qn);
        attn_compute<128, 4, true, false>(F, p, QW + kvh * 256, 1024, odW, nullptr, 0.f, nullptr, kvh * 4, qf);
        __syncthreads();
        if (wc + 1 < w_hi) attn_commit<128>(F, pn, kreg, vreg);
        __syncthreads();
#pragma unroll
        for (int ks = 0; ks < 4; ++ks) qf[ks] = qn[ks];
    }
}
#ifndef PH_A
#define PH_A 1
#endif
#ifndef PH_B
#define PH_B 1
#endif
#ifndef PH_C
#define PH_C 1
#endif
#ifndef PH_D
#define PH_D 1
#endif
#ifndef PH_E
#define PH_E 1
#endif
#ifndef PH_F
#define PH_F 1
#endif
#ifndef PH_G
#define PH_G 1
#endif
#ifndef PH_H
#define PH_H 1
#endif
#ifndef PH_I
#define PH_I 1
#endif
#ifndef PH_J
#define PH_J 1
#endif
#ifndef PH_Z
#define PH_Z 1
#endif

struct Args { const float* in[14]; float* out; unsigned char* ws; };
__global__ void __launch_bounds__(NWAVES * 64, 2) mk_fwd(Args args) {
    extern __shared__ __attribute__((aligned(16))) unsigned char lds_raw[];
    LAS unsigned char* const lds = (LAS unsigned char*)lds_raw;
    int wave_s = __builtin_amdgcn_readfirstlane((int)(threadIdx.x >> 6)); asm volatile("" : "+s"(wave_s));
    {
        const int t0 = wave_s * 64 + xb_lane();
        volatile LAS unsigned* MISC = (volatile LAS unsigned*)(lds + MISC_OFF);
        if (t0 < 32) MISC[t0] = 0u;
        if (t0 == 0) { volatile LAS unsigned long long* pt = (volatile LAS unsigned long long*)(lds + PTAB_OFF);
            pt[0] = (unsigned long long)args.in[0]; pt[1] = (unsigned long long)args.in[1]; pt[2] = (unsigned long long)args.in[2]; pt[3] = (unsigned long long)args.in[3];
            pt[4] = (unsigned long long)args.in[4]; pt[5] = (unsigned long long)args.in[5]; pt[6] = (unsigned long long)args.in[6]; pt[7] = (unsigned long long)args.in[7];
            pt[8] = (unsigned long long)args.in[8]; pt[9] = (unsigned long long)args.in[9]; pt[10] = (unsigned long long)args.in[10]; pt[11] = (unsigned long long)args.in[11];
            pt[12] = (unsigned long long)args.in[12]; pt[13] = (unsigned long long)args.in[13]; pt[14] = (unsigned long long)args.out; pt[15] = (unsigned long long)args.ws; }
        __syncthreads();
    }
    XcdBarrier bar = xcd_barrier_post((unsigned*)(args.ws + WS_CTL) + CW_BAR, (volatile LAS unsigned*)(lds + MISC_OFF) + 8, wave_s);
    const int G = 256;

#pragma unroll 1
    for (int l = 0; l < DEPTH; ++l) {
        int c = blockIdx.x; asm volatile("" : "+s"(c));
#if PH_A
        { Frame F = make_frame(lds, wave_s); convert_weights(F, l);
          unsigned char* ws = P_WS;
          if (l == 0) norm_rows<true, false, false>(F, P_IN(0), (bf16*)(ws + WS_HB), P_IN(1) + l * DM, (bf16*)(ws + WS_HN), nullptr);
          else norm_rows<false, true, false>(F, nullptr, (bf16*)(ws + WS_HB), P_IN(1) + l * DM, (bf16*)(ws + WS_HN), nullptr);
          }
#endif
        xcd_barrier(bar);
#if PH_B
        { Frame F = make_frame(lds, wave_s); unsigned char* ws = P_WS; bf16* big = (bf16*)(ws + WS_BIG);
          pg8::Gemm g{(const bf16*)(ws + WS_HN), (const bf16*)(ws + WS_WIN), MTOK, INC, DM}; pg8::StaticOrder S; S.init(MTOK, INC, G, c);
          pg8::EpiInProj E{big + B_QA / 2, big + B_KA / 2, big + B_VA / 2, big + B_QW / 2, big + B_KW / 2, big + B_VW / 2, big + B_G / 2, big + B_G / 2 + (size_t)MTOK * DM, P_IN(5) + l * 2048, QSCALE};
          pg8::gemm_phase<pg8::EpiInProj, pg8::StaticOrder, true, true>(F.tid, lds, g, S, E); }
#endif
        xcd_barrier(bar);
#ifdef DUP_C
        { Frame F = make_frame(lds, wave_s); attention_phase(F, l, ((long)WS_HN - (long)(WS_BIG + B_QA)) / 2, ((long)WS_HN - (long)(WS_BIG + B_QW)) / 2, DUP_C); }
        xcd_barrier(bar);
#endif
#if PH_C
        { Frame F = make_frame(lds, wave_s); attention_phase(F, l, 0, 0); }
#endif
        xcd_barrier(bar);
#if PH_E
        { Frame F = make_frame(lds, wave_s); unsigned char* ws = P_WS; bf16* big = (bf16*)(ws + WS_BIG);
          pg8::Gemm g0{big + B_OA / 2, (const bf16*)(ws + WS_WA), MTOK, DM, 256}; pg8::Gemm g1{big + B_QW / 2, (const bf16*)(ws + WS_WB), MTOK, DM, DM}; pg8::StaticOrder S; S.init(MTOK, DM, G, c);
          pg8::EpiMergeDual E{big + B_MERGED / 2, big + B_G / 2, big + B_G / 2 + (size_t)MTOK * DM};
          pg8::gemm_phase_dual<pg8::EpiMergeDual, pg8::StaticOrder>(F.tid, lds, g0, g1, S, E); }
#endif
        xcd_barrier(bar);
#if PH_F
        { Frame F = make_frame(lds, wave_s); unsigned char* ws = P_WS; bf16* big = (bf16*)(ws + WS_BIG); bf16* hb = (bf16*)(ws + WS_HB);
          pg8::Gemm g{big + B_MERGED / 2, (const bf16*)(ws + WS_WO), MTOK, DM, DM}; pg8::StaticOrder S; S.init(MTOK, DM, G, c);
          pg8::EpiResid E{hb, hb};
          pg8::gemm_phase<pg8::EpiResid, pg8::StaticOrder, true, true>(F.tid, lds, g, S, E); }
#endif
        xcd_barrier(bar);
#if PH_G
        { Frame F = make_frame(lds, wave_s); unsigned char* ws = P_WS;
          norm_router(F, (const bf16*)(ws + WS_HB), P_IN(8) + l * DM, P_IN(9) + (size_t)l * DM * NE, (float*)(ws + WS_LSE), (float*)(ws + WS_AFF)); }
#endif
        xcd_barrier(bar);
#if PH_H
        { Frame F = make_frame(lds, wave_s); unsigned char* ws = P_WS;
          topk_gather(F, (const float*)(ws + WS_AFF), (const float*)(ws + WS_LSE), (int*)(ws + WS_SEL), (float*)(ws + WS_GATE), (int*)(ws + WS_IDX)); }
#endif
        xcd_barrier(bar);
#if PH_I
        { Frame F = make_frame(lds, wave_s); unsigned char* ws = P_WS; bf16* big = (bf16*)(ws + WS_BIG);
          pg8::Gemm g{(const bf16*)(ws + WS_HB), (const bf16*)(ws + WS_WGU), MEXP, NE * 2048, DM}; pg8::GroupedOrder S; S.init(NE, NB, 8, G, c);
          pg8::EpiSwiGLU E{big + B_ACT / 2, (const LAS int*)(lds + AROW_OFF), 0};
          { const int* idxg = (const int*)(ws + WS_IDX); LAS int* arow = (LAS int*)(lds + AROW_OFF);
            int rv[NE]; const int r = F.tid & 255;
#pragma unroll
            for (int i = 0; i < NE; ++i) { pg8::Unit u; u.pm = 0; u.pn = 0; S.next(i, u); rv[i] = u.pm; }
            asm volatile("" ::: "memory");
#pragma unroll
            for (int i = 0; i < NE; ++i) rv[i] = idxg[(size_t)rv[i] * 256 + r];
#pragma unroll
            for (int i = 0; i < NE; ++i) if (F.tid < 256) arow[i * 256 + r] = rv[i];
            __syncthreads(); }
          pg8::gemm_phase<pg8::EpiSwiGLU, pg8::GroupedOrder, true, true, true>(F.tid, lds, g, S, E, (const LAS int*)(lds + AROW_OFF)); }
#endif
        xcd_barrier(bar);
#if PH_J
        { Frame F = make_frame(lds, wave_s); unsigned char* ws = P_WS; bf16* big = (bf16*)(ws + WS_BIG);
          pg8::Gemm g{big + B_ACT / 2, (const bf16*)(ws + WS_WD), MEXP, NE * 1024, DEX}; pg8::GroupedOrder S; S.init(NE, NB, 4, G, c);
          pg8::EpiDown E{big + B_Y / 2, (const LAS float*)(lds + AROW_OFF), 0};
          { const float* gatev = (const float*)(ws + WS_GATE); LAS float* gl = (LAS float*)(lds + AROW_OFF);
            float gv[8]; int pmv[8]; const int r = F.tid & 255;
#pragma unroll
            for (int i = 0; i < 8; ++i) { pg8::Unit u; u.pm = 0; u.pn = 0; S.next(i, u); pmv[i] = u.pm; }
            asm volatile("" ::: "memory");
#pragma unroll
            for (int i = 0; i < 8; ++i) gv[i] = gatev[(size_t)pmv[i] * 256 + r];
#pragma unroll
            for (int i = 0; i < 8; ++i) if (F.tid < 256) gl[i * 256 + r] = gv[i];
            __syncthreads(); }
          pg8::gemm_phase<pg8::EpiDown, pg8::GroupedOrder, true, true>(F.tid, lds, g, S, E); }
#endif
        xcd_barrier(bar);
    }
#if PH_Z
    { Frame F = make_frame(lds, wave_s); unsigned char* ws = P_WS; norm_rows<false, true, true>(F, nullptr, (bf16*)(ws + WS_HB), P_IN(13), nullptr, P_OUT); }
#endif
}

extern "C" void kernel_launch(void* const* d_in, const int* in_sizes, int n_in, void* d_out, int out_size, void* d_ws, size_t ws_size, hipStream_t stream) {
    static int grid = 0;
    if (grid == 0) {
        if (n_in != 14 || out_size != MTOK * DM || ws_size < WS_END) { fprintf(stderr, "kernel_launch: unexpected shapes (n_in %d, out %d, ws %zu < %zu); nothing launched\n", n_in, out_size, ws_size, (size_t)WS_END); grid = -1; return; }
        int dev = 0, cus = 0, per_cu = 0;
        if (hipGetDevice(&dev) != hipSuccess || hipDeviceGetAttribute(&cus, hipDeviceAttributeMultiprocessorCount, dev) != hipSuccess) { grid = -1; return; }
        if (hipFuncSetAttribute((const void*)mk_fwd, hipFuncAttributeMaxDynamicSharedMemorySize, LDS_BYTES) != hipSuccess) { fprintf(stderr, "kernel_launch: hipFuncSetAttribute failed\n"); grid = -1; return; }
        if (hipOccupancyMaxActiveBlocksPerMultiprocessor(&per_cu, (const void*)mk_fwd, NWAVES * 64, LDS_BYTES) != hipSuccess || per_cu < 1) fprintf(stderr, "kernel_launch: occupancy query reports %d\n", per_cu);
        (void)hipGetLastError();
        grid = 256;
        if (cus != 256) fprintf(stderr, "kernel_launch: device has %d CUs, built for 256\n", cus);
    }
    if (grid < 0) return;
    (void)in_sizes;
    hipMemsetAsync((char*)d_ws + WS_CTL, 0, CTL_ZERO_BYTES, stream);
    Args a{};
    for (int i = 0; i < 14; ++i) a.in[i] = (const float*)d_in[i];
    a.out = (float*)d_out; a.ws = (unsigned char*)d_ws;
    hipLaunchKernelGGL(mk_fwd, dim3(grid), dim3(NWAVES * 64), LDS_BYTES, stream, a);
}
```

```cpp
#include <hip/hip_runtime.h>
#include <cstdio>
#include <cstdint>
typedef __bf16 nbf16x2 __attribute__((ext_vector_type(2)));
typedef __bf16 nbf16x4 __attribute__((ext_vector_type(4)));
typedef __bf16 nbf16x8 __attribute__((ext_vector_type(8)));
typedef float f32x2_t __attribute__((ext_vector_type(2)));
typedef float f32x8_t __attribute__((ext_vector_type(8)));
__device__ __forceinline__ unsigned pk2bf(float lo, float hi) { f32x2_t v = {lo, hi}; return __builtin_bit_cast(unsigned, __builtin_convertvector(v, nbf16x2)); }
__device__ __forceinline__ float bflo(unsigned w) { return __builtin_bit_cast(float, w << 16); }
__device__ __forceinline__ float bfhi(unsigned w) { return __builtin_bit_cast(float, w & 0xffff0000u); }
namespace pg8 {
#define PG8_LAS __attribute__((address_space(3)))
typedef unsigned short bf16_t;
typedef short bf16x8 __attribute__((ext_vector_type(8)));
typedef float f32x4 __attribute__((ext_vector_type(4)));
typedef unsigned u32x4 __attribute__((ext_vector_type(4)));
constexpr int BM = 256, BK = 64, HALF = 128, HTB = HALF * BK * 2  , STAGE_BYTES = 8 * HTB, NXCD = 8;
#ifndef PG8_WGM
#define PG8_WGM 8
#endif
#ifndef PG8_WGM_G
#define PG8_WGM_G 8
#endif
constexpr int WGM = PG8_WGM, WGM_G = PG8_WGM_G;

__host__ __device__ __forceinline__ int lds_byte(int r, int c) { const int st = (r >> 4) * 2 + (c >> 5), rr = r & 15, cc = c & 31, ob = rr * 64 + cc * 2; return st * 1024 + (ob ^ (((ob >> 9) & 1) << 5)); }
__host__ __device__ __forceinline__ void stage_rc(int b, int& R, int& C) { const int st = b / 1024, sb = b % 1024, swz = sb ^ (((sb >> 9) & 1) << 5); R = (st >> 1) * 16 + swz / 64; C = (st & 1) * 32 + (swz % 64) / 2; }
__host__ __device__ __forceinline__ int perm32(int rho) { const int n = rho >> 4, i = rho & 15; return 8 * (i >> 2) + 4 * n + (i & 3); }

struct Unit { int pm, pn; };
struct Gemm { const bf16_t* A; const bf16_t* Bt; int M, N, K; };

struct StaticOrder {
    int nM, nN, nwg, G, c;
    __host__ __device__ void init(int M, int N, int G_, int c_) { nM = M / BM; nN = N / BM; nwg = nM * nN; G = G_; c = c_; }
    __host__ __device__ bool next(int i, Unit& u) const {
        const long L = (long)i * G + c; if (L >= nwg) return false;
        int wgid = (int)L; { const int q = nwg / NXCD, r = nwg % NXCD, xcd = wgid % NXCD, off = wgid / NXCD; wgid = (xcd < r ? xcd * (q + 1) : r * (q + 1) + (xcd - r) * q) + off; }
        const int nig = WGM * nN, gid = wgid / nig, fm = gid * WGM, gsz = (nM - fm) < WGM ? (nM - fm) : WGM;
        u.pm = fm + ((wgid % nig) % gsz); u.pn = (wgid % nig) / gsz; return true;
    }
    __device__ __forceinline__ void a_ready(const Unit&) const {}
    __device__ __forceinline__ void done(const Unit&) const {}
};

struct GroupedOrder {
    int nMg, nNg, upg, ntot, G, c;
    __host__ __device__ void init(int ngrp, int nMg_, int nNg_, int G_, int c_) { nMg = nMg_; nNg = nNg_; upg = nMg * nNg; ntot = ngrp * upg; G = G_; c = c_; }
    __host__ __device__ bool next(int i, Unit& u) const {
        const long L = (long)i * G + c; if (L >= ntot) return false;
        const int e = (int)(L / upg); int wgid = (int)(L % upg);
        { const int q = upg / NXCD, r = upg % NXCD, xcd = wgid % NXCD, off = wgid / NXCD; wgid = (xcd < r ? xcd * (q + 1) : r * (q + 1) + (xcd - r) * q) + off; }
        const int nig = WGM_G * nNg, gid = wgid / nig, fm = gid * WGM_G, gsz = (nMg - fm) < WGM_G ? (nMg - fm) : WGM_G;
        u.pm = e * nMg + fm + ((wgid % nig) % gsz); u.pn = e * nNg + (wgid % nig) / gsz; return true;
    }
    __device__ __forceinline__ void a_ready(const Unit&) const {}
    __device__ __forceinline__ void done(const Unit&) const {}
};

#ifndef EPI_NT
#define EPI_NT 0
#endif
#if EPI_NT
#define EPI_ST(ptr, val) __builtin_nontemporal_store((val), (ptr))
#else
#define EPI_ST(ptr, val) (*(ptr) = (val))
#endif
#ifndef EPI_NT_B
#define EPI_NT_B 0
#endif
#if EPI_NT_B
#define EPI_ST_B(ptr, val) __builtin_nontemporal_store((val), (ptr))
#else
#define EPI_ST_B(ptr, val) (*(ptr) = (val))
#endif
__device__ __forceinline__ u32x4 pack8(const f32x4 a, const f32x4 b) { u32x4 w; w.x = pk2bf(a[0], a[1]); w.y = pk2bf(a[2], a[3]); w.z = pk2bf(b[0], b[1]); w.w = pk2bf(b[2], b[3]); return w; }
__device__ __forceinline__ void unpack8(const u32x4 w, f32x4& a, f32x4& b) { a = (f32x4){bflo(w.x), bfhi(w.x), bflo(w.y), bfhi(w.y)}; b = (f32x4){bflo(w.z), bfhi(w.z), bflo(w.w), bfhi(w.w)}; }
__device__ __forceinline__ float sigmoidf_fast(float x) { return __builtin_amdgcn_rcpf(1.0f + __builtin_amdgcn_exp2f(-1.4426950408889634f * x)); }

__device__ __forceinline__ size_t gate_blk(int pm, int pn, int wave, int ai, int m, int bj, int lane) { return ((size_t)(((pm * 4 + pn) * 8 + wave) * 16 + (ai * 8 + m * 2 + bj)) * 64 + lane) * 8; }
__device__ __forceinline__ u32x4 xchg_pair(const u32x4 v) { u32x4 r;
#pragma unroll
    for (int w = 0; w < 4; ++w) r[w] = (unsigned)__builtin_amdgcn_mov_dpp((int)v[w], 0xB1, 0xF, 0xF, true);
    return r; }
__device__ __forceinline__ void wide_pair(const u32x4 p0, const u32x4 p1, bool odd, u32x4& a, u32x4& b) {
    const u32x4 recv = xchg_pair(odd ? p0 : p1); a = odd ? recv : p0; b = odd ? p1 : recv; }
struct EpiInProj {
    static constexpr bool PERM = true, AFTER_DRAIN = false, WIDE = true, ROWSCALE = true;
    bf16_t *qa, *ka, *va, *qw, *kw, *vw, *gr, *g1; const float* bgate; float qscale;
    const float* rsv; mutable float rs0, rs1;
    __device__ __forceinline__ float row_rs(int ai, int m, int fr) const { return __builtin_bit_cast(float, __builtin_amdgcn_ds_bpermute((fr + 16 * m) << 2, __builtin_bit_cast(int, ai ? rs1 : rs0))); }
    __device__ __forceinline__ void operator()(const f32x4 (&acc)[2][2][4][2], const Unit& u, int wr, int wc, int fr, int fq) const {
        const int pn = u.pn; const int row0 = u.pm * BM + wr * 64 + fr;
        if (pn >= 15) {
            const int cc0 = (pn - 15) * HALF + wc * 32 + 8 * fq;
            f32x4 b0[2], b1[2];
#pragma unroll
            for (int n = 0; n < 2; ++n) { b0[n] = *(const f32x4*)(bgate + cc0 + 4 * n); b1[n] = *(const f32x4*)(bgate + 1024 + cc0 + 4 * n); }
#pragma unroll
            for (int ai = 0; ai < 2; ++ai)
#pragma unroll
                for (int m = 0; m < 4; ++m) { const size_t off = gate_blk(u.pm, (pn - 15) >> 1, wr * 4 + wc, ai, m, (pn - 15) & 1, fq * 16 + fr); f32x4 rr[2], gg[2]; const float rs = row_rs(ai, m, fr);
#pragma unroll
                    for (int n = 0; n < 2; ++n)
#pragma unroll
                        for (int j = 0; j < 4; ++j) { float a0 = acc[ai][0][m][n][j] * rs + b0[n][j], a1 = acc[ai][1][m][n][j] * rs + b1[n][j];
                            a0 = fminf(fmaxf(a0, -30.f), 30.f); a1 = fminf(fmaxf(a1, -30.f), 30.f);
                            const float e0 = __builtin_amdgcn_exp2f(-1.4426950408889634f * a0), e1 = __builtin_amdgcn_exp2f(-1.4426950408889634f * a1);
                            gg[n][j] = __builtin_amdgcn_rcpf(1.0f + e1); rr[n][j] = (1.0f + e1) * __builtin_amdgcn_rcpf(1.0f + e0); }
                    EPI_ST_B((u32x4*)(gr + off), pack8(rr[0], rr[1])); EPI_ST_B((u32x4*)(g1 + off), pack8(gg[0], gg[1])); }
            return;
        }
        bf16_t* base; int ldc, ct; float sc = 1.0f;
        if (pn < 3) { base = qa; ldc = 768; ct = pn; sc = qscale; }
        else if (pn < 6) { base = ka; ldc = 768; ct = pn - 3; }
        else if (pn < 9) { base = va; ldc = 768; ct = pn - 6; }
        else if (pn < 13) { base = qw; ldc = 1024; ct = pn - 9; sc = qscale; }
        else if (pn == 13) { base = kw; ldc = 256; ct = 0; }
        else { base = vw; ldc = 256; ct = 0; }
        const bool odd = (fr & 1) != 0;
        const int col0 = ct * BM + wc * 64 + 8 * fq + (odd ? 32 : 0);
#pragma unroll
        for (int ai = 0; ai < 2; ++ai)
#pragma unroll
            for (int m = 0; m < 4; ++m) { bf16_t* rowp = base + (size_t)(row0 - (odd ? 1 : 0) + ai * HALF + m * 16) * ldc + col0;
                const float s2 = sc * row_rs(ai, m, fr);
                u32x4 a, b; wide_pair(pack8(acc[ai][0][m][0] * s2, acc[ai][0][m][1] * s2), pack8(acc[ai][1][m][0] * s2, acc[ai][1][m][1] * s2), odd, a, b);
                EPI_ST_B((u32x4*)rowp, a); EPI_ST_B((u32x4*)(rowp + ldc), b); }
    }
};
struct EpiMergeDual {
    static constexpr bool PERM = true, AFTER_DRAIN = false, WIDE = true, ROWSCALE = false;
    bf16_t* merged; const bf16_t* gr; const bf16_t* g1;
    __device__ __forceinline__ size_t gblk(const Unit& u, int wr, int wc, int ai, int m, int bj, int fr, int fq) const { return gate_blk(u.pm, u.pn, wr * 4 + 2 * (wc & 1) + bj, ai, m, wc >> 1, fq * 16 + fr); }
    __device__ __forceinline__ void mid(f32x4 (&acc)[2][2][4][2], const Unit& u, int wr, int wc, int fr, int fq) const {
        u32x4 w[2][4][2];
#pragma unroll
        for (int ai = 0; ai < 2; ++ai)
#pragma unroll
            for (int m = 0; m < 4; ++m) {
#pragma unroll
                for (int bj = 0; bj < 2; ++bj) w[ai][m][bj] = *(const u32x4*)(gr + gblk(u, wr, wc, ai, m, bj, fr, fq)); }
        asm volatile("" ::: "memory");
#pragma unroll
        for (int ai = 0; ai < 2; ++ai)
#pragma unroll
            for (int m = 0; m < 4; ++m) {
#pragma unroll
                for (int bj = 0; bj < 2; ++bj) { f32x4 r0, r1; unpack8(w[ai][m][bj], r0, r1); acc[ai][bj][m][0] *= r0; acc[ai][bj][m][1] *= r1; } }
    }
    __device__ __forceinline__ void operator()(const f32x4 (&acc)[2][2][4][2], const Unit& u, int wr, int wc, int fr, int fq) const {
        const bool odd = (fr & 1) != 0;
        const int rowe = u.pm * BM + wr * 64 + (fr & ~1), col = u.pn * BM + wc * 64 + 8 * fq + (odd ? 32 : 0);
        u32x4 w[2][4][2];
#pragma unroll
        for (int ai = 0; ai < 2; ++ai)
#pragma unroll
            for (int m = 0; m < 4; ++m) {
#pragma unroll
                for (int bj = 0; bj < 2; ++bj) w[ai][m][bj] = *(const u32x4*)(g1 + gblk(u, wr, wc, ai, m, bj, fr, fq)); }
        asm volatile("" ::: "memory");
#pragma unroll
        for (int ai = 0; ai < 2; ++ai)
#pragma unroll
            for (int m = 0; m < 4; ++m) { f32x4 a0, a1, c0, c1; unpack8(w[ai][m][0], a0, a1); unpack8(w[ai][m][1], c0, c1);
                u32x4 a, b; wide_pair(pack8(acc[ai][0][m][0] * a0, acc[ai][0][m][1] * a1), pack8(acc[ai][1][m][0] * c0, acc[ai][1][m][1] * c1), odd, a, b);
                bf16_t* p = merged + (size_t)(rowe + ai * HALF + m * 16) * 1024 + col;
                EPI_ST((u32x4*)p, a); EPI_ST((u32x4*)(p + 1024), b); }
    }
};
struct EpiResid {
    static constexpr bool PERM = true, AFTER_DRAIN = false, WIDE = true, ROWSCALE = false;
    const bf16_t* base; bf16_t* out;
    __device__ __forceinline__ void operator()(const f32x4 (&acc)[2][2][4][2], const Unit& u, int wr, int wc, int fr, int fq) const {
        const bool odd = (fr & 1) != 0;
        const int rowe = u.pm * BM + wr * 64 + (fr & ~1), col = u.pn * BM + wc * 64 + 8 * fq + (odd ? 32 : 0);
        u32x4 la[2][4], lb[2][4];
#pragma unroll
        for (int ai = 0; ai < 2; ++ai)
#pragma unroll
            for (int m = 0; m < 4; ++m) { const bf16_t* p = base + (size_t)(rowe + ai * HALF + m * 16) * 1024 + col; la[ai][m] = *(const u32x4*)p; lb[ai][m] = *(const u32x4*)(p + 1024); }
        asm volatile("" ::: "memory");
#pragma unroll
        for (int ai = 0; ai < 2; ++ai)
#pragma unroll
            for (int m = 0; m < 4; ++m) {
                const u32x4 recv = xchg_pair(odd ? la[ai][m] : lb[ai][m]); const u32x4 r0 = odd ? recv : la[ai][m], r1 = odd ? lb[ai][m] : recv;
                f32x4 b0, b1, c0, c1; unpack8(r0, b0, b1); unpack8(r1, c0, c1);
                u32x4 a, b; wide_pair(pack8(b0 + acc[ai][0][m][0], b1 + acc[ai][0][m][1]), pack8(c0 + acc[ai][1][m][0], c1 + acc[ai][1][m][1]), odd, a, b);
                bf16_t* p = out + (size_t)(rowe + ai * HALF + m * 16) * 1024 + col;
                EPI_ST((u32x4*)p, a); EPI_ST((u32x4*)(p + 1024), b); }
    }
};
struct EpiSwiGLU {
    static constexpr bool PERM = true, AFTER_DRAIN = false, WIDE = false, ROWSCALE = false;
    bf16_t* act; const PG8_LAS int* arow; mutable int ui;
    __device__ __forceinline__ void operator()(const f32x4 (&acc)[2][2][4][2], const Unit& u, int wr, int wc, int fr, int fq) const {
        const int row0 = u.pm * BM + wr * 64 + fr, col0 = (u.pn & 7) * HALF + wc * 32 + 8 * fq;
#pragma unroll
        for (int ai = 0; ai < 2; ++ai)
#pragma unroll
            for (int m = 0; m < 4; ++m) { f32x4 o[2];
                const float rs = (float)__builtin_bit_cast(_Float16, (unsigned short)((unsigned)arow[ui * 256 + wr * 64 + fr + ai * HALF + m * 16] >> 16));
#pragma unroll
                for (int n = 0; n < 2; ++n)
#pragma unroll
                    for (int j = 0; j < 4; ++j) { const float a = acc[ai][0][m][n][j] * rs, up = acc[ai][1][m][n][j] * rs; o[n][j] = a * sigmoidf_fast(a) * up; }
                EPI_ST((u32x4*)(act + (size_t)(row0 + ai * HALF + m * 16) * 1024 + col0), pack8(o[0], o[1])); }
        ++ui;
    }
};
struct EpiDown {
    static constexpr bool PERM = true, AFTER_DRAIN = false, WIDE = true, ROWSCALE = false;
    bf16_t* y; const PG8_LAS float* glds; mutable int ui;
    __device__ __forceinline__ void operator()(const f32x4 (&acc)[2][2][4][2], const Unit& u, int wr, int wc, int fr, int fq) const {
        const bool odd = (fr & 1) != 0;
        const int rowe = u.pm * BM + wr * 64 + (fr & ~1), col = (u.pn & 3) * BM + wc * 64 + 8 * fq + (odd ? 32 : 0);
#pragma unroll
        for (int ai = 0; ai < 2; ++ai)
#pragma unroll
            for (int m = 0; m < 4; ++m) { const float gv = glds[ui * 256 + wr * 64 + fr + ai * HALF + m * 16];
                u32x4 a, b; wide_pair(pack8(acc[ai][0][m][0] * gv, acc[ai][0][m][1] * gv), pack8(acc[ai][1][m][0] * gv, acc[ai][1][m][1] * gv), odd, a, b);
                bf16_t* p = y + (size_t)(rowe + ai * HALF + m * 16) * 1024 + col;
                EPI_ST((u32x4*)p, a); EPI_ST((u32x4*)(p + 1024), b); }
        ++ui;
    }
};

template <class Epi, class Sched, bool ALIGN_EPI = false, bool SP2 = false, bool GATHER = false>
__device__ __forceinline__ void gemm_phase(int tid_, PG8_LAS unsigned char* lds, const Gemm g, const Sched& S, const Epi& E, const PG8_LAS int* arow = nullptr) {
    static_assert(!GATHER || SP2, "GATHER is written for the SP2 loop");
    asm volatile("" : "+v"(tid_));
    const int tid = tid_, wid = __builtin_amdgcn_readfirstlane(tid >> 6), lane = tid & 63, wr = wid >> 2, wc = wid & 3, fr = lane & 15, fq = lane >> 4;
    const int K = g.K, nt = K / BK;
    unsigned voffA[2], voffB[2];
#pragma unroll
    for (int i = 0; i < 2; ++i) { int R, C; stage_rc(tid * 16 + i * 8192, R, C); const int Rb = Epi::WIDE ? ((R >> 5) * 64 + perm32(R & 31)) : (Epi::PERM ? ((R & ~31) + perm32(R & 31)) : R);
        voffA[i] = (unsigned)(R * K + C) * 2u; voffB[i] = (unsigned)(Rb * K + C) * 2u; }
    unsigned vA0[2] = {voffA[0], voffA[1]}, vA1[2] = {voffA[0], voffA[1]}, nA0[2] = {voffA[0], voffA[1]}, nA1[2] = {voffA[0], voffA[1]};
    int gR[2], gC[2];
#pragma unroll
    for (int i = 0; i < 2; ++i) { stage_rc(tid * 16 + i * 8192, gR[i], gC[i]); }
#define PG8_GOFF(dst0, dst1, u_) do { _Pragma("unroll") for (int _i = 0; _i < 2; ++_i) { \
        dst0[_i] = (((unsigned)arow[(u_) * 256 + gR[_i]] & 0xffffu) * (unsigned)K + (unsigned)gC[_i]) * 2u; dst1[_i] = (((unsigned)arow[(u_) * 256 + HALF + gR[_i]] & 0xffffu) * (unsigned)K + (unsigned)gC[_i]) * 2u; } } while (0)
    const size_t kstep = (size_t)(BK * 2);
    const size_t hstep = (size_t)HALF * K * 2;
    const size_t tstep = 2 * hstep;
    const size_t bhs = Epi::WIDE ? (size_t)32 * K * 2 : hstep;
    const size_t ahs = GATHER ? (size_t)0 : hstep, atstep = GATHER ? (size_t)0 : tstep;
    const unsigned ldsw = (unsigned)wid * 1024u;
    const int aoff = lds_byte(wr * 64 + fr, fq * 8), boff = lds_byte(wc * 32 + fr, fq * 8);
#define PG8_SA(b, h) (((b) * 2 + (h)) * HTB)
#define PG8_SB(b, h) ((4 + (b) * 2 + (h)) * HTB)
#define PG8_STAGE(bufoff, gbase, voff) do { _Pragma("unroll") for (int _i = 0; _i < 2; ++_i) \
        __builtin_amdgcn_global_load_lds((const unsigned*)((const char*)(gbase) + (voff)[_i]), (PG8_LAS unsigned*)(lds + (bufoff) + ldsw + _i * 8192), 16, 0, 0); } while (0)
#define PG8_LDA(dst, b, h) do { _Pragma("unroll") for (int m = 0; m < 4; ++m) _Pragma("unroll") for (int k = 0; k < 2; ++k) dst[m][k] = *(const PG8_LAS bf16x8*)(lds + PG8_SA(b, h) + aoff + m * 2048 + k * 1024); } while (0)
#define PG8_LDB(dst, b, h) do { _Pragma("unroll") for (int n = 0; n < 2; ++n) _Pragma("unroll") for (int k = 0; k < 2; ++k) dst[n][k] = *(const PG8_LAS bf16x8*)(lds + PG8_SB(b, h) + boff + n * 2048 + k * 1024); } while (0)
#define PG8_MMA(ai, bj, At, Bt) do { __builtin_amdgcn_s_setprio(1); _Pragma("unroll") for (int m = 0; m < 4; ++m) _Pragma("unroll") for (int n = 0; n < 2; ++n) _Pragma("unroll") for (int k = 0; k < 2; ++k) \
        acc[ai][bj][m][n] = __builtin_amdgcn_mfma_f32_16x16x32_bf16(Bt[n][k], At[m][k], acc[ai][bj][m][n], 0, 0, 0); __builtin_amdgcn_s_setprio(0); } while (0)
#define PG8_WAIT_V(n) asm volatile("s_waitcnt vmcnt(" #n ")" ::: "memory")
#define PG8_WAIT_L(n) asm volatile("s_waitcnt lgkmcnt(" #n ")" ::: "memory")
#define PG8_BAR __builtin_amdgcn_s_barrier()
#define PG8_SCHED __builtin_amdgcn_sched_barrier(0)
    Unit cur, nxt; int ui = 0;
    if (!S.next(0, cur)) return;
    f32x4 acc[2][2][4][2];
#pragma unroll
    for (int a = 0; a < 2; ++a)
#pragma unroll
        for (int b = 0; b < 2; ++b)
#pragma unroll
            for (int m = 0; m < 4; ++m)
#pragma unroll
                for (int n = 0; n < 2; ++n) acc[a][b][m][n] = (f32x4){0.f, 0.f, 0.f, 0.f};
    bf16x8 At[4][2], B0[2][2], B1[2][2];
    const char* cA = (const char*)g.A + (size_t)cur.pm * atstep; const char* cB = (const char*)g.Bt + (size_t)cur.pn * tstep;
    if constexpr (GATHER) { PG8_GOFF(vA0, vA1, 0); }
    S.a_ready(cur);
    if constexpr (SP2) {
        PG8_STAGE(PG8_SB(0, 0), cB, voffB); PG8_STAGE(PG8_SB(0, 1), cB + bhs, voffB); PG8_STAGE(PG8_SA(0, 0), cA, vA0); PG8_STAGE(PG8_SA(0, 1), cA + ahs, vA1);
        if (wr == 1) PG8_BAR;
        PG8_WAIT_V(2); PG8_BAR;
        PG8_STAGE(PG8_SB(1, 0), cB + kstep, voffB); PG8_STAGE(PG8_SA(1, 0), cA + kstep, vA0); PG8_STAGE(PG8_SB(1, 1), cB + bhs + kstep, voffB);
        PG8_WAIT_V(6); PG8_BAR;
    } else {
        PG8_STAGE(PG8_SB(0, 0), cB, voffB); PG8_STAGE(PG8_SA(0, 0), cA, voffA); PG8_STAGE(PG8_SB(0, 1), cB + bhs, voffB); PG8_STAGE(PG8_SA(0, 1), cA + hstep, voffA);
        if (wr == 1) PG8_BAR;
        PG8_WAIT_V(4); PG8_BAR;
        PG8_STAGE(PG8_SB(1, 0), cB + kstep, voffB); PG8_STAGE(PG8_SA(1, 0), cA + kstep, voffA); PG8_STAGE(PG8_SB(1, 1), cB + bhs + kstep, voffB);
        PG8_WAIT_V(6); PG8_BAR;
    }
    for (;;) {
        const bool has_next = S.next(ui + 1, nxt);
        const char* nA = has_next ? (const char*)g.A + (size_t)nxt.pm * atstep : cA; const char* nB = has_next ? (const char*)g.Bt + (size_t)nxt.pn * tstep : cB;
#pragma unroll 1
        for (int t = 0; t < nt; t += 2) {
            const bool last = (t == nt - 2);
            const char* a1 = cA + (size_t)(t + 1) * kstep;
            const char* a2 = last ? nA : cA + (size_t)(t + 2) * kstep; const char* b2 = last ? nB : cB + (size_t)(t + 2) * kstep;
            const char* a3 = a2 + kstep; const char* b3 = b2 + kstep;
            if (last && has_next) S.a_ready(nxt);
            if constexpr (Epi::ROWSCALE) { if (last) { E.rs0 = E.rsv[cur.pm * BM + wr * 64 + lane]; E.rs1 = E.rsv[cur.pm * BM + HALF + wr * 64 + lane]; } }
            unsigned s0[2] = {vA0[0], vA0[1]}, s1[2] = {vA1[0], vA1[1]};
            if constexpr (GATHER) { if (last && has_next) { PG8_GOFF(nA0, nA1, ui + 1); s0[0] = nA0[0]; s0[1] = nA0[1]; s1[0] = nA1[0]; s1[1] = nA1[1]; } }
            if constexpr (SP2) {
            PG8_LDB(B0, 0, 0); PG8_LDB(B1, 0, 1); PG8_SCHED; PG8_LDA(At, 0, 0); PG8_STAGE(PG8_SA(1, 1), a1 + ahs, vA1);
            PG8_WAIT_V(8); PG8_WAIT_L(0); PG8_BAR; PG8_MMA(0, 0, At, B0); PG8_MMA(0, 1, At, B1); PG8_BAR; PG8_SCHED;
            PG8_LDA(At, 0, 1); PG8_STAGE(PG8_SB(0, 0), b2, voffB); PG8_STAGE(PG8_SB(0, 1), b2 + bhs, voffB); PG8_STAGE(PG8_SA(0, 0), a2, s0);
            PG8_WAIT_V(8); PG8_WAIT_L(0); PG8_BAR; PG8_MMA(1, 0, At, B0); PG8_MMA(1, 1, At, B1); PG8_BAR; PG8_SCHED;
            PG8_LDB(B0, 1, 0); PG8_LDB(B1, 1, 1); PG8_SCHED; PG8_LDA(At, 1, 0); PG8_STAGE(PG8_SA(0, 1), a2 + ahs, s1);
            PG8_WAIT_V(8); PG8_WAIT_L(0); PG8_BAR; PG8_MMA(0, 0, At, B0); PG8_MMA(0, 1, At, B1); PG8_BAR; PG8_SCHED;
            PG8_LDA(At, 1, 1); PG8_STAGE(PG8_SB(1, 0), b3, voffB); PG8_STAGE(PG8_SB(1, 1), b3 + bhs, voffB); PG8_STAGE(PG8_SA(1, 0), a3, s0);
            PG8_WAIT_V(8); PG8_WAIT_L(0); PG8_BAR; PG8_MMA(1, 0, At, B0); PG8_MMA(1, 1, At, B1); PG8_BAR; PG8_SCHED;
            } else {
            PG8_LDB(B0, 0, 0); PG8_SCHED; PG8_LDA(At, 0, 0); PG8_STAGE(PG8_SA(1, 1), a1 + hstep, voffA);
            PG8_WAIT_L(8); PG8_BAR; PG8_WAIT_L(0); PG8_MMA(0, 0, At, B0); PG8_BAR; PG8_SCHED;
            PG8_LDB(B1, 0, 1); PG8_STAGE(PG8_SB(0, 0), b2, voffB);
            PG8_BAR; PG8_WAIT_L(0); PG8_MMA(0, 1, At, B1); PG8_BAR;
            PG8_LDA(At, 0, 1); PG8_STAGE(PG8_SA(0, 0), a2, voffA);
            PG8_BAR; PG8_WAIT_L(0); PG8_MMA(1, 0, At, B0); PG8_BAR; PG8_SCHED;
            PG8_STAGE(PG8_SB(0, 1), b2 + bhs, voffB);
            PG8_WAIT_V(6); PG8_BAR; PG8_MMA(1, 1, At, B1); PG8_BAR;
            PG8_LDB(B0, 1, 0); PG8_SCHED; PG8_LDA(At, 1, 0); PG8_STAGE(PG8_SA(0, 1), a2 + hstep, voffA);
            PG8_WAIT_L(8); PG8_BAR; PG8_WAIT_L(0); PG8_MMA(0, 0, At, B0); PG8_BAR; PG8_SCHED;
            PG8_LDB(B1, 1, 1); PG8_STAGE(PG8_SB(1, 0), b3, voffB);
            PG8_BAR; PG8_WAIT_L(0); PG8_MMA(0, 1, At, B1); PG8_BAR;
            PG8_LDA(At, 1, 1); PG8_STAGE(PG8_SA(1, 0), a3, voffA);
            PG8_BAR; PG8_WAIT_L(0); PG8_MMA(1, 0, At, B0); PG8_BAR; PG8_SCHED;
            PG8_STAGE(PG8_SB(1, 1), b3 + bhs, voffB);
            PG8_WAIT_V(6); PG8_BAR; PG8_MMA(1, 1, At, B1); PG8_BAR;
            }
        }
        if constexpr (ALIGN_EPI) { if (wr == 0) PG8_BAR; }
        if constexpr (!Epi::AFTER_DRAIN) { E(acc, cur, wr, wc, fr, fq); S.done(cur); }
        if (!has_next) break;
#pragma unroll
        for (int a = 0; a < 2; ++a)
#pragma unroll
            for (int b = 0; b < 2; ++b)
#pragma unroll
                for (int m = 0; m < 4; ++m)
#pragma unroll
                    for (int n = 0; n < 2; ++n) acc[a][b][m][n] = (f32x4){0.f, 0.f, 0.f, 0.f};
        cur = nxt; cA = nA; cB = nB; ++ui;
        if constexpr (GATHER) { vA0[0] = nA0[0]; vA0[1] = nA0[1]; vA1[0] = nA1[0]; vA1[1] = nA1[1]; }
        if constexpr (ALIGN_EPI) { if (wr == 1) PG8_BAR; }
    }
    PG8_WAIT_V(0);
    if constexpr (!ALIGN_EPI) { if (wr == 0) PG8_BAR; }
    PG8_BAR;
    if constexpr (Epi::AFTER_DRAIN) { E.fused(acc, cur, wr, wc, fr, fq, lds, wid, lane); S.done(cur); }
#undef PG8_SA
#undef PG8_SB
#undef PG8_STAGE
#undef PG8_LDA
#undef PG8_LDB
#undef PG8_MMA
#undef PG8_WAIT_V
#undef PG8_WAIT_L
#undef PG8_BAR
#undef PG8_SCHED
#undef PG8_GOFF
}

template <class Epi, class Sched>
__device__ __forceinline__ void gemm_phase_dual(int tid_, PG8_LAS unsigned char* lds, const Gemm g0, const Gemm g1, const Sched& S, const Epi& E) {
    asm volatile("" : "+v"(tid_));
    const int tid = tid_, wid = __builtin_amdgcn_readfirstlane(tid >> 6), lane = tid & 63, wr = wid >> 2, wc = wid & 3, fr = lane & 15, fq = lane >> 4;
    unsigned vA_0[2], vB_0[2], vA_1[2], vB_1[2];
#pragma unroll
    for (int i = 0; i < 2; ++i) { int R, C; stage_rc(tid * 16 + i * 8192, R, C); const int Rb = Epi::WIDE ? ((R >> 5) * 64 + perm32(R & 31)) : (Epi::PERM ? ((R & ~31) + perm32(R & 31)) : R);
        vA_0[i] = (unsigned)(R * g0.K + C) * 2u; vB_0[i] = (unsigned)(Rb * g0.K + C) * 2u; vA_1[i] = (unsigned)(R * g1.K + C) * 2u; vB_1[i] = (unsigned)(Rb * g1.K + C) * 2u; }
    const size_t kstep = (size_t)(BK * 2);
    const size_t hs_0 = (size_t)HALF * g0.K * 2, hs_1 = (size_t)HALF * g1.K * 2;
#define PG8_BH(x) (Epi::WIDE ? (x) / 4 : (x))
    const int nt_0 = g0.K / BK, nt_1 = g1.K / BK;
    const unsigned ldsw = (unsigned)wid * 1024u;
    const int aoff = lds_byte(wr * 64 + fr, fq * 8), boff = lds_byte(wc * 32 + fr, fq * 8);
#define PG8_SA(b, h) (((b) * 2 + (h)) * HTB)
#define PG8_SB(b, h) ((4 + (b) * 2 + (h)) * HTB)
#define PG8_STAGE(bufoff, gbase, voff) do { _Pragma("unroll") for (int _i = 0; _i < 2; ++_i) \
        __builtin_amdgcn_global_load_lds((const unsigned*)((const char*)(gbase) + (voff)[_i]), (PG8_LAS unsigned*)(lds + (bufoff) + ldsw + _i * 8192), 16, 0, 0); } while (0)
#define PG8_LDA(dst, b, h) do { _Pragma("unroll") for (int m = 0; m < 4; ++m) _Pragma("unroll") for (int k = 0; k < 2; ++k) dst[m][k] = *(const PG8_LAS bf16x8*)(lds + PG8_SA(b, h) + aoff + m * 2048 + k * 1024); } while (0)
#define PG8_LDB(dst, b, h) do { _Pragma("unroll") for (int n = 0; n < 2; ++n) _Pragma("unroll") for (int k = 0; k < 2; ++k) dst[n][k] = *(const PG8_LAS bf16x8*)(lds + PG8_SB(b, h) + boff + n * 2048 + k * 1024); } while (0)
#define PG8_MMA(ai, bj, At, Bt) do { __builtin_amdgcn_s_setprio(1); _Pragma("unroll") for (int m = 0; m < 4; ++m) _Pragma("unroll") for (int n = 0; n < 2; ++n) _Pragma("unroll") for (int k = 0; k < 2; ++k) \
        acc[ai][bj][m][n] = __builtin_amdgcn_mfma_f32_16x16x32_bf16(Bt[n][k], At[m][k], acc[ai][bj][m][n], 0, 0, 0); __builtin_amdgcn_s_setprio(0); } while (0)
#define PG8_WAIT_V(n) asm volatile("s_waitcnt vmcnt(" #n ")" ::: "memory")
#define PG8_WAIT_L(n) asm volatile("s_waitcnt lgkmcnt(" #n ")" ::: "memory")
#define PG8_BAR __builtin_amdgcn_s_barrier()
#define PG8_SCHED __builtin_amdgcn_sched_barrier(0)
    Unit cur, nxt; int ui = 0, s = 0;
    if (!S.next(0, cur)) return;
    f32x4 acc[2][2][4][2];
#pragma unroll
    for (int a = 0; a < 2; ++a)
#pragma unroll
        for (int b = 0; b < 2; ++b)
#pragma unroll
            for (int m = 0; m < 4; ++m)
#pragma unroll
                for (int n = 0; n < 2; ++n) acc[a][b][m][n] = (f32x4){0.f, 0.f, 0.f, 0.f};
    bf16x8 At[4][2], B0[2][2], B1[2][2];
    const char* cA = (const char*)g0.A + (size_t)cur.pm * 2 * hs_0; const char* cB = (const char*)g0.Bt + (size_t)cur.pn * 2 * hs_0;
    size_t hsC = hs_0; unsigned vAc[2] = {vA_0[0], vA_0[1]}, vBc[2] = {vB_0[0], vB_0[1]};
    PG8_STAGE(PG8_SB(0, 0), cB, vBc); PG8_STAGE(PG8_SB(0, 1), cB + PG8_BH(hsC), vBc); PG8_STAGE(PG8_SA(0, 0), cA, vAc); PG8_STAGE(PG8_SA(0, 1), cA + hsC, vAc);
    if (wr == 1) PG8_BAR;
    PG8_WAIT_V(2); PG8_BAR;
    PG8_STAGE(PG8_SB(1, 0), cB + kstep, vBc); PG8_STAGE(PG8_SA(1, 0), cA + kstep, vAc); PG8_STAGE(PG8_SB(1, 1), cB + PG8_BH(hsC) + kstep, vBc);
    PG8_WAIT_V(6); PG8_BAR;
    for (;;) {
        bool has_next = true; if (s == 1) has_next = S.next(ui + 1, nxt);
        const int npm = (s == 0) ? cur.pm : nxt.pm, npn = (s == 0) ? cur.pn : nxt.pn;
        const size_t hsN = has_next ? (s == 0 ? hs_1 : hs_0) : hsC;
        const char* nA = has_next ? (s == 0 ? (const char*)g1.A : (const char*)g0.A) + (size_t)npm * 2 * hsN : cA;
        const char* nB = has_next ? (s == 0 ? (const char*)g1.Bt : (const char*)g0.Bt) + (size_t)npn * 2 * hsN : cB;
        unsigned vAn[2], vBn[2];
#pragma unroll
        for (int i = 0; i < 2; ++i) { vAn[i] = has_next ? (s == 0 ? vA_1[i] : vA_0[i]) : vAc[i]; vBn[i] = has_next ? (s == 0 ? vB_1[i] : vB_0[i]) : vBc[i]; }
        const int nt = (s == 0) ? nt_0 : nt_1;
#pragma unroll 1
        for (int t = 0; t < nt; t += 2) {
            const bool last = (t == nt - 2);
            const char* a1 = cA + (size_t)(t + 1) * kstep;
            const char* a2 = last ? nA : cA + (size_t)(t + 2) * kstep; const char* b2 = last ? nB : cB + (size_t)(t + 2) * kstep;
            const char* a3 = a2 + kstep; const char* b3 = b2 + kstep;
            const size_t hs2 = last ? hsN : hsC;
            unsigned vA2[2], vB2[2];
#pragma unroll
            for (int i = 0; i < 2; ++i) { vA2[i] = last ? vAn[i] : vAc[i]; vB2[i] = last ? vBn[i] : vBc[i]; }
            PG8_LDB(B0, 0, 0); PG8_LDB(B1, 0, 1); PG8_SCHED; PG8_LDA(At, 0, 0); PG8_STAGE(PG8_SA(1, 1), a1 + hsC, vAc);
            PG8_WAIT_V(8); PG8_WAIT_L(0); PG8_BAR; PG8_MMA(0, 0, At, B0); PG8_MMA(0, 1, At, B1); PG8_BAR; PG8_SCHED;
            PG8_LDA(At, 0, 1); PG8_STAGE(PG8_SB(0, 0), b2, vB2); PG8_STAGE(PG8_SB(0, 1), b2 + PG8_BH(hs2), vB2); PG8_STAGE(PG8_SA(0, 0), a2, vA2);
            PG8_WAIT_V(8); PG8_WAIT_L(0); PG8_BAR; PG8_MMA(1, 0, At, B0); PG8_MMA(1, 1, At, B1); PG8_BAR; PG8_SCHED;
            PG8_LDB(B0, 1, 0); PG8_LDB(B1, 1, 1); PG8_SCHED; PG8_LDA(At, 1, 0); PG8_STAGE(PG8_SA(0, 1), a2 + hs2, vA2);
            PG8_WAIT_V(8); PG8_WAIT_L(0); PG8_BAR; PG8_MMA(0, 0, At, B0); PG8_MMA(0, 1, At, B1); PG8_BAR; PG8_SCHED;
            PG8_LDA(At, 1, 1); PG8_STAGE(PG8_SB(1, 0), b3, vB2); PG8_STAGE(PG8_SB(1, 1), b3 + PG8_BH(hs2), vB2); PG8_STAGE(PG8_SA(1, 0), a3, vA2);
            PG8_WAIT_V(8); PG8_WAIT_L(0); PG8_BAR; PG8_MMA(1, 0, At, B0); PG8_MMA(1, 1, At, B1); PG8_BAR; PG8_SCHED;
        }
        if (wr == 0) PG8_BAR;
        if (s == 0) E.mid(acc, cur, wr, wc, fr, fq); else E(acc, cur, wr, wc, fr, fq);
        if (!has_next) break;
        if (s == 1) {
#pragma unroll
            for (int a = 0; a < 2; ++a)
#pragma unroll
                for (int b = 0; b < 2; ++b)
#pragma unroll
                    for (int m = 0; m < 4; ++m)
#pragma unroll
                        for (int n = 0; n < 2; ++n) acc[a][b][m][n] = (f32x4){0.f, 0.f, 0.f, 0.f};
            cur = nxt; ++ui; }
        s ^= 1; cA = nA; cB = nB; hsC = hsN;
#pragma unroll
        for (int i = 0; i < 2; ++i) { vAc[i] = vAn[i]; vBc[i] = vBn[i]; }
        if (wr == 1) PG8_BAR;
    }
    PG8_WAIT_V(0);
    PG8_BAR;
#undef PG8_SA
#undef PG8_SB
#undef PG8_STAGE
#undef PG8_LDA
#undef PG8_LDB
#undef PG8_MMA
#undef PG8_WAIT_V
#undef PG8_WAIT_L
#undef PG8_BAR
#undef PG8_SCHED
#undef PG8_BH
}
}

constexpr int NWAVES = 8;
constexpr int NB = 32, SEQ = 2048, DM = 1024, MTOK = NB * SEQ, DEPTH = 4;
constexpr int INC = 5888, NE = 16, CAP = 256, DEX = 1024, MEXP = NE * NB * CAP;
constexpr float RMS_EPS = 1e-6f, LOG2E = 1.4426950408889634f;
constexpr float QSCALE = 0.125f * LOG2E;

constexpr size_t MiB = 1u << 20;
constexpr size_t WS_CTL = 0, CTL_ZERO_BYTES = 32768;
constexpr size_t WS_WIN = 1 * MiB;
constexpr size_t WS_WA = WS_WIN + (size_t)INC * DM * 2;
constexpr size_t WS_WB = WS_WA + (size_t)DM * 256 * 2;
constexpr size_t WS_WO = WS_WB + (size_t)DM * DM * 2;
constexpr size_t WS_WGU = WS_WO + (size_t)DM * DM * 2;
constexpr size_t WS_WD = WS_WGU + (size_t)NE * 2048 * DM * 2;
constexpr size_t WS_HN = WS_WD + (size_t)NE * DM * DEX * 2;
constexpr size_t WS_BIG = WS_HN + (size_t)MTOK * DM * 2;
constexpr size_t B_QA = 0, B_KA = 96 * MiB, B_VA = 192 * MiB, B_QW = 288 * MiB, B_KW = 416 * MiB, B_VW = 448 * MiB, B_G = 480 * MiB, B_OA = 736 * MiB, B_END = 768 * MiB;
constexpr size_t B_MERGED = 0;
constexpr size_t B_XE = 0, B_ACT = 256 * MiB, B_Y = 512 * MiB;
constexpr size_t WS_AFF = WS_BIG + B_END;
constexpr size_t WS_SEL = WS_AFF + (size_t)MTOK * NE * 4;
constexpr size_t WS_GATE = WS_SEL + (size_t)MTOK * NE * 4;
constexpr size_t WS_LSE = WS_GATE + (size_t)MEXP * 4;
constexpr size_t WS_IDX = WS_LSE + (size_t)3 * MTOK * 4 * 4;
constexpr size_t WS_HB = WS_IDX + (size_t)MEXP * 4;
constexpr size_t WS_END = WS_HB + (size_t)MTOK * DM * 2;
static_assert(WS_WIN % 256 == 0 && WS_WA % 256 == 0 && WS_WGU % 256 == 0 && WS_HN % 256 == 0 && WS_BIG % 256 == 0 && WS_AFF % 256 == 0, "alignment");
constexpr int CW_BAR = 4096;
constexpr int AROW_OFF = 131072;
constexpr int MISC_OFF = 147456, LDS_BYTES = 151552;

#define GAS __attribute__((address_space(1)))
#define LAS __attribute__((address_space(3)))
typedef unsigned short bf16;
typedef unsigned v4u __attribute__((ext_vector_type(4)));
typedef unsigned v2u __attribute__((ext_vector_type(2)));
typedef float f32x4 __attribute__((ext_vector_type(4)));
typedef float f32x16 __attribute__((ext_vector_type(16)));
typedef short bf16x8 __attribute__((ext_vector_type(8)));
#define LDS_WAIT() asm volatile("s_waitcnt lgkmcnt(0)" ::: "memory")
#define VM_WAIT() asm volatile("s_waitcnt vmcnt(0)" ::: "memory")

#define XB_TMO      128
#define XB_XCNT(j)  (256  + 64 * (j))
#define XB_XSUB(j)  (1280 + 64 * (j))
#define XB_XGEN(j)  (2304 + 64 * (j))
#define XB_TOP      3328
#define XB_TOPGEN   3392
#define XCD_BAR_WORDS 3456
#define XB_SPIN_CAP (1u << 18)

__device__ __forceinline__ unsigned xb_ld(unsigned* p)              { return __hip_atomic_load(p, __ATOMIC_RELAXED, __HIP_MEMORY_SCOPE_AGENT); }
__device__ __forceinline__ unsigned xb_add(unsigned* p, unsigned v) { return __hip_atomic_fetch_add(p, v, __ATOMIC_RELAXED, __HIP_MEMORY_SCOPE_AGENT); }
__device__ __forceinline__ unsigned xb_xcc_id() { return (unsigned)__builtin_amdgcn_s_getreg((3 << 11) | 20) & 0xFu; }
#define XB_SPIN(cond, bar) do { unsigned _sp = 0; while (cond) { __builtin_amdgcn_s_sleep(1); \
    if ((++_sp & 255u) == 0u) { if (xb_ld(&(bar)[XB_TMO])) break; if (_sp > XB_SPIN_CAP) { atomicAdd(&(bar)[XB_TMO], 1u); break; } } } } while (0)

__device__ __forceinline__ int xb_lane() { unsigned z = 0u; asm volatile("" : "+v"(z)); return (int)__builtin_amdgcn_mbcnt_hi(~0u, __builtin_amdgcn_mbcnt_lo(~0u, z)); }
struct XcdBarrier {
    int w;
    unsigned* bar; unsigned x;
    volatile LAS unsigned* st;
};

__device__ __forceinline__ XcdBarrier xcd_barrier_post(unsigned* bar, volatile LAS unsigned* st, int wave) {
    XcdBarrier b; b.w = wave; b.bar = bar; b.x = xb_xcc_id(); b.st = st;
    if (wave == 0 && xb_lane() == 0) (void)xb_add(&bar[XB_XCNT(b.x)], 1u);
    return b;
}
__device__ __forceinline__ void xcd_barrier_complete(unsigned* bar, unsigned x, unsigned& nloc, unsigned& nx) {
    const unsigned G = gridDim.x * gridDim.y * gridDim.z;
    unsigned sum, cnt, mine, sp = 0u;
    for (;;) {
        sum = 0u; cnt = 0u; mine = 0u;
#pragma unroll
        for (unsigned j = 0; j < 16; ++j) { const unsigned c = xb_ld(&bar[XB_XCNT(j)]); sum += c; cnt += (c > 0u) ? 1u : 0u; mine = (j == x) ? c : mine; }
        if (sum == G) break;
        __builtin_amdgcn_s_sleep(1);
        if ((++sp & 255u) == 0u) { if (xb_ld(&bar[XB_TMO])) break; if (sp > XB_SPIN_CAP) { atomicAdd(&bar[XB_TMO], 1u); break; } }
    }
    nloc = mine > 0u ? mine : 1u; nx = cnt > 0u ? cnt : 1u;
}

__device__ __forceinline__ void xcd_barrier(const XcdBarrier& b) {
    asm volatile("s_waitcnt vmcnt(0)" ::: "memory");
    __syncthreads();
    if (b.w == 0 && xb_lane() == 0) {
        unsigned* bar = b.bar;
        __builtin_amdgcn_s_waitcnt(0);
        unsigned nloc = b.st[0], nx = b.st[1];
        if (nloc == 0u) { xcd_barrier_complete(bar, b.x, nloc, nx); b.st[0] = nloc; b.st[1] = nx; }
        const unsigned old = xb_add(&bar[XB_XSUB(b.x)], 1u);
        const unsigned gen = old / nloc;
        if (old + 1u == (gen + 1u) * nloc) {
            __builtin_amdgcn_fence(__ATOMIC_RELEASE, "agent");
            asm volatile("s_waitcnt vmcnt(0)" ::: "memory");
            const unsigned og = xb_add(&bar[XB_TOP], 1u);
            const unsigned tg = og / nx;
            if (og + 1u == (tg + 1u) * nx) xb_add(&bar[XB_TOPGEN], 1u);
            else XB_SPIN(xb_ld(&bar[XB_TOPGEN]) == tg, bar);
            __builtin_amdgcn_fence(__ATOMIC_ACQUIRE, "agent");
            xb_add(&bar[XB_XGEN(b.x)], 1u);
            asm volatile("s_waitcnt vmcnt(0)" ::: "memory");
        } else {
            XB_SPIN(xb_ld(&bar[XB_XGEN(b.x)]) == gen, bar);
            __builtin_amdgcn_fence(__ATOMIC_ACQUIRE, "agent");
            asm volatile("s_waitcnt vmcnt(0)" ::: "memory");
        }
    }
    __syncthreads();
}

struct Frame {
    LAS unsigned char* lds;
    int tid, lane, wave, gw;
};
constexpr int PTAB_OFF = MISC_OFF + 256;
__device__ __forceinline__ unsigned long long ptab_get(LAS unsigned char* lds, int i) {
    LAS unsigned char* base = lds + PTAB_OFF; asm volatile("" : "+v"(base));
    const unsigned long long v = ((const volatile LAS unsigned long long*)base)[i];
    const unsigned lo = __builtin_amdgcn_readfirstlane((unsigned)v), hi = __builtin_amdgcn_readfirstlane((unsigned)(v >> 32));
    return ((unsigned long long)hi << 32) | lo;
}
#define P_IN(i) ((const float*)(const GAS float*)ptab_get(F.lds, (i)))
#define P_OUT ((float*)(GAS float*)ptab_get(F.lds, 14))
#define P_WS ((unsigned char*)(GAS unsigned char*)ptab_get(F.lds, 15))
__device__ __forceinline__ Frame make_frame(LAS unsigned char* lds, int wave_s) { Frame F; F.lds = lds; int bx = blockIdx.x; asm volatile("" : "+s"(bx));
    int ln = xb_lane(); asm volatile("" : "+v"(ln));
    F.lane = ln; F.wave = wave_s; F.tid = wave_s * 64 + ln; F.gw = bx * NWAVES + F.wave; return F; }
__device__ __forceinline__ float shx(float v, int o, int lane) { return __builtin_bit_cast(float, __builtin_amdgcn_ds_bpermute((lane ^ o) << 2, __builtin_bit_cast(int, v))); }
__device__ __forceinline__ unsigned shrel(unsigned v, int d, int lane) { return (unsigned)__builtin_amdgcn_ds_bpermute(((lane + d) & 63) << 2, (int)v); }
__device__ __forceinline__ float wave_sum(float v, int lane) {
#pragma unroll
    for (int o = 1; o < 64; o <<= 1) v += shx(v, o, lane);
    return v;
}
template <bool SCALE = false>
__device__ __forceinline__ void transpose_item(const float* W, int K, int N, bf16* dst, LAS float* scr, int k0, int n0, int lane, const float* gk = nullptr) {
    float tv[32];
#pragma unroll
    for (int i = 0; i < 32; ++i) { const int kk = 2 * i + (lane >> 5); tv[i] = W[(size_t)(k0 + kk) * N + n0 + (lane & 31)]; }
#pragma unroll
    for (int i = 0; i < 32; ++i) { const int kk = 2 * i + (lane >> 5); scr[kk * 33 + (lane & 31)] = tv[i]; }
    LDS_WAIT(); asm volatile("" ::: "memory");
    const int c = lane & 7;
    f32x4 ga = {1.f, 1.f, 1.f, 1.f}, gb = {1.f, 1.f, 1.f, 1.f};
    if (SCALE) { ga = *(const f32x4*)(gk + k0 + 8 * c); gb = *(const f32x4*)(gk + k0 + 8 * c + 4); }
#pragma unroll
    for (int j = 0; j < 4; ++j) { const int n = (lane >> 3) + 8 * j; const LAS float* s = scr + (8 * c) * 33 + n;
        v4u o; o.x = pk2bf(s[0 * 33] * ga.x, s[1 * 33] * ga.y); o.y = pk2bf(s[2 * 33] * ga.z, s[3 * 33] * ga.w); o.z = pk2bf(s[4 * 33] * gb.x, s[5 * 33] * gb.y); o.w = pk2bf(s[6 * 33] * gb.z, s[7 * 33] * gb.w);
        *(GAS v4u*)(dst + (size_t)n * K + k0 + 8 * c) = o; }
    LDS_WAIT(); asm volatile("" ::: "memory");
}
__device__ __forceinline__ void convert_weights(Frame& F, int l) {
    LAS float* scr = (LAS float*)(F.lds + F.wave * 8448);
    const int NGW = 256 * NWAVES;
    unsigned char* ws = P_WS;
    bf16* WinT = (bf16*)(ws + WS_WIN); bf16* WaT = (bf16*)(ws + WS_WA); bf16* WbT = (bf16*)(ws + WS_WB); bf16* WoT = (bf16*)(ws + WS_WO);
    bf16* WguT = (bf16*)(ws + WS_WGU); bf16* WdT = (bf16*)(ws + WS_WD);
    const float* w_in = P_IN(2) + (size_t)l * DM * INC; const float* w_a = P_IN(3) + (size_t)l * 256 * DM; const float* w_b = P_IN(4) + (size_t)l * DM * DM;
    const float* w_o = P_IN(7) + (size_t)l * DM * DM; const float* g2 = P_IN(8) + (size_t)l * DM; const float* g1n = P_IN(1) + (size_t)l * DM;
    const float* w_g = P_IN(10) + (size_t)l * NE * DM * DEX; const float* w_u = P_IN(11) + (size_t)l * NE * DM * DEX; const float* w_d = P_IN(12) + (size_t)l * NE * DEX * DM;
    constexpr int I_IN = 16 * (INC / 32), I_A = 4 * 32, I_B = 16 * 32, I_O = 16 * 32, I_E = NE * 16 * 32;
    constexpr int NITEMS = I_IN + I_A + I_B + I_O + 3 * I_E;
    for (int it = F.gw; it < NITEMS; it += NGW) {
        int r = it;
        if (r < I_IN) { const int nb = r % (INC / 32), kb = r / (INC / 32), n0 = 32 * nb; int drow = n0;
            if (n0 >= 3840) { const int gc = n0 - 3840, br = gc >> 10, cc = gc & 1023; drow = 3840 + (cc >> 7) * 256 + ((cc & 127) >> 5) * 64 + br * 32; }
            transpose_item<true>(w_in, DM, INC, WinT + (size_t)drow * DM, scr, 64 * kb, n0, F.lane, g1n); continue; } r -= I_IN;
        if (r < I_A) { const int nb = r % 32, kb = r / 32; transpose_item(w_a, 256, DM, WaT + (size_t)(32 * nb) * 256, scr, 64 * kb, 32 * nb, F.lane); continue; } r -= I_A;
        if (r < I_B) { const int nb = r % 32, kb = r / 32; transpose_item(w_b, DM, DM, WbT + (size_t)(32 * nb) * DM, scr, 64 * kb, 32 * nb, F.lane); continue; } r -= I_B;
        if (r < I_O) { const int nb = r % 32, kb = r / 32; transpose_item(w_o, DM, DM, WoT + (size_t)(32 * nb) * DM, scr, 64 * kb, 32 * nb, F.lane); continue; } r -= I_O;
        if (r < 2 * I_E) { const int up = r >= I_E; if (up) r -= I_E; const int e = r / 512, loc = r % 512, nb = loc % 32, kb = loc / 32, f0 = 32 * nb;
            const float* W = (up ? w_u : w_g) + (size_t)e * DM * DEX;
            transpose_item<true>(W, DM, DEX, WguT + ((size_t)e * 2048 + (f0 >> 7) * 256 + (up ? 128 : 0) + (f0 & 127)) * DM, scr, 64 * kb, f0, F.lane, g2); continue; } r -= 2 * I_E;
        { const int e = r / 512, loc = r % 512, nb = loc % 32, kb = loc / 32;
            transpose_item(w_d + (size_t)e * DEX * DM, DEX, DM, WdT + ((size_t)e * 1024 + 32 * nb) * DEX, scr, 64 * kb, 32 * nb, F.lane); }
    }
}
__device__ __forceinline__ void unpk8(const v4u w, float (&v)[8]) { v[0] = bflo(w.x); v[1] = bfhi(w.x); v[2] = bflo(w.y); v[3] = bfhi(w.y); v[4] = bflo(w.z); v[5] = bfhi(w.z); v[6] = bflo(w.w); v[7] = bfhi(w.w); }
__device__ __forceinline__ v4u pk8(const float (&v)[8]) { v4u w; w.x = pk2bf(v[0], v[1]); w.y = pk2bf(v[2], v[3]); w.z = pk2bf(v[4], v[5]); w.w = pk2bf(v[6], v[7]); return w; }
template <bool XIN, bool COMBINE, bool FINAL>
__device__ __forceinline__ void norm_rows(Frame& F, const float* xin, bf16* hb, const float* gain, float* rsv, float* out) {
    const int NGW = 256 * NWAVES;
    unsigned char* ws = P_WS;
    const int* sel = (const int*)(ws + WS_SEL); const bf16* Y = (const bf16*)(ws + WS_BIG + B_Y);
    float gv[2][8];
#pragma unroll
    for (int j = 0; j < 2; ++j) { const f32x4 a = *(const f32x4*)(gain + (64 * j + F.lane) * 8), b = *(const f32x4*)(gain + (64 * j + F.lane) * 8 + 4);
        gv[j][0] = a.x; gv[j][1] = a.y; gv[j][2] = a.z; gv[j][3] = a.w; gv[j][4] = b.x; gv[j][5] = b.y; gv[j][6] = b.z; gv[j][7] = b.w; }
    constexpr int NR = 4;
    for (int m0 = F.gw; m0 < MTOK; m0 += NR * NGW) {
        float v[NR][2][8]; int sv[NR];
#pragma unroll
        for (int rr = 0; rr < NR; ++rr) { const int m = m0 + rr * NGW;
            if (COMBINE) sv[rr] = sel[(size_t)m * NE + (F.lane & 15)];
            if (XIN) {
#pragma unroll
                for (int j = 0; j < 2; ++j) { const f32x4 a = *(const f32x4*)(xin + (size_t)m * DM + (64 * j + F.lane) * 8), b = *(const f32x4*)(xin + (size_t)m * DM + (64 * j + F.lane) * 8 + 4);
                    v[rr][j][0] = a.x; v[rr][j][1] = a.y; v[rr][j][2] = a.z; v[rr][j][3] = a.w; v[rr][j][4] = b.x; v[rr][j][5] = b.y; v[rr][j][6] = b.z; v[rr][j][7] = b.w; }
            } else {
#pragma unroll
                for (int j = 0; j < 2; ++j) unpk8(*(const v4u*)(hb + (size_t)m * DM + (64 * j + F.lane) * 8), v[rr][j]);
            } }
        if (COMBINE) {
            unsigned msk[NR];
#pragma unroll
            for (int rr = 0; rr < NR; ++rr) msk[rr] = (unsigned)(__builtin_amdgcn_ballot_w64(sv[rr] >= 0) & 0xffffull);
            unsigned any = 0u;
#pragma unroll
            for (int rr = 0; rr < NR; ++rr) any |= msk[rr];
            while (any != 0u) {
                v4u yv[NR][2]; float wgt[NR];
#pragma unroll
                for (int rr = 0; rr < NR; ++rr) { const int m = m0 + rr * NGW, b = m >> 11; const bool has = msk[rr] != 0u;
                    const int e = has ? __builtin_ctz(msk[rr]) : 0; const int r = has ? __builtin_amdgcn_readlane(sv[rr], e) : 0;
                    const bf16* yr = Y + ((size_t)(e * NB + b) * CAP + r) * DM; wgt[rr] = has ? 1.0f : 0.0f; msk[rr] &= msk[rr] - 1u;
#pragma unroll
                    for (int j = 0; j < 2; ++j) yv[rr][j] = *(const v4u*)(yr + (64 * j + F.lane) * 8); }
                any = 0u;
#pragma unroll
                for (int rr = 0; rr < NR; ++rr) { any |= msk[rr];
#pragma unroll
                    for (int j = 0; j < 2; ++j) { float y[8]; unpk8(yv[rr][j], y);
#pragma unroll
                        for (int i = 0; i < 8; ++i) v[rr][j][i] += wgt[rr] * y[i]; } }
            }
        }
#pragma unroll
        for (int rr = 0; rr < NR; ++rr) { const int m = m0 + rr * NGW;
            if ((XIN || COMBINE) && !FINAL) {
#pragma unroll
                for (int j = 0; j < 2; ++j) *(v4u*)(hb + (size_t)m * DM + (64 * j + F.lane) * 8) = pk8(v[rr][j]);
            }
            float ss = 0.f;
#pragma unroll
            for (int j = 0; j < 2; ++j)
#pragma unroll
                for (int i = 0; i < 8; ++i) ss += v[rr][j][i] * v[rr][j][i];
            const float rs = 1.0f / sqrtf(wave_sum(ss, F.lane) * (1.0f / DM) + RMS_EPS);
            if (FINAL) {
#pragma unroll
                for (int j = 0; j < 2; ++j) { float o[8];
#pragma unroll
                    for (int i = 0; i < 8; ++i) o[i] = v[rr][j][i] * rs * gv[j][i];
                    float* op = out + (size_t)m * DM + (64 * j + F.lane) * 8; *(f32x4*)op = (f32x4){o[0], o[1], o[2], o[3]}; *(f32x4*)(op + 4) = (f32x4){o[4], o[5], o[6], o[7]}; }
            } else if (F.lane == 0) rsv[m] = rs; }
    }
}
constexpr int RT_PITCH = 2048 + 16;
__device__ __forceinline__ void norm_router(Frame& F, const bf16* hb, const float* gain, const float* wr, float* rsv, float* aff) {
    LAS unsigned char* whi = F.lds; LAS unsigned char* wlo = F.lds + 16 * RT_PITCH; LAS float* gl = (LAS float*)(F.lds + 32 * RT_PITCH);
    { const float g0 = gain[F.tid], g1 = gain[F.tid + NWAVES * 64]; gl[F.tid] = g0; gl[F.tid + NWAVES * 64] = g1; }
    __syncthreads();
    { f32x4 wv[8];
#pragma unroll
      for (int j = 0; j < 8; ++j) wv[j] = *(const f32x4*)(wr + 4 * (F.tid + j * NWAVES * 64));
      asm volatile("" ::: "memory");
#pragma unroll
      for (int j = 0; j < 8; ++j) { const int i0 = 4 * (F.tid + j * NWAVES * 64), k = i0 >> 4, e0 = i0 & 15; const float g = gl[k];
#pragma unroll
          for (int t = 0; t < 4; ++t) { const float w = wv[j][t] * g; const unsigned hi = pk2bf(w, 0.f) & 0xffffu; const float rem = w - bflo(hi);
              *(LAS unsigned short*)(whi + (e0 + t) * RT_PITCH + k * 2) = (unsigned short)hi; *(LAS unsigned short*)(wlo + (e0 + t) * RT_PITCH + k * 2) = (unsigned short)(pk2bf(rem, 0.f) & 0xffffu); } } }
    __syncthreads();
    const int NGW = 256 * NWAVES, r16 = F.lane & 15, q = F.lane >> 4;
    for (int grp = F.gw; grp < MTOK / 16; grp += NGW) {
        const size_t row = (size_t)grp * 16 + r16;
        v4u xs[32];
#pragma unroll
        for (int s = 0; s < 16; ++s) { const v4u* p = (const v4u*)(hb + row * DM + 64 * s + 16 * q); xs[2 * s] = p[0]; xs[2 * s + 1] = p[1]; }
        f32x4 acc = {0.f, 0.f, 0.f, 0.f}; float ss = 0.f;
#pragma unroll
        for (int s = 0; s < 16; ++s) {
#pragma unroll
            for (int h2 = 0; h2 < 2; ++h2) { const bf16x8 a = __builtin_bit_cast(bf16x8, xs[2 * s + h2]);
                const bf16x8 bh = *(const LAS bf16x8*)(whi + r16 * RT_PITCH + (64 * s + 16 * q + 8 * h2) * 2), bl = *(const LAS bf16x8*)(wlo + r16 * RT_PITCH + (64 * s + 16 * q + 8 * h2) * 2);
                acc = __builtin_amdgcn_mfma_f32_16x16x32_bf16(a, bh, acc, 0, 0, 0); acc = __builtin_amdgcn_mfma_f32_16x16x32_bf16(a, bl, acc, 0, 0, 0);
                float x[8]; unpk8(xs[2 * s + h2], x);
#pragma unroll
                for (int i = 0; i < 8; ++i) ss += x[i] * x[i]; }
            asm volatile("" ::: "memory"); }
        ss += shx(ss, 16, F.lane); ss += shx(ss, 32, F.lane);
        const float rs = 1.0f / sqrtf(ss * (1.0f / DM) + RMS_EPS);
        float lg[4];
#pragma unroll
        for (int r = 0; r < 4; ++r) { const float rr = __builtin_bit_cast(float, __builtin_amdgcn_ds_bpermute((4 * q + r) << 2, __builtin_bit_cast(int, rs))); lg[r] = acc[r] * rr; }
#pragma unroll
        for (int r = 0; r < 4; ++r) { float mx = lg[r];
#pragma unroll
            for (int o = 1; o < 16; o <<= 1) mx = fmaxf(mx, shx(mx, o, F.lane));
            const float ex = __expf(lg[r] - mx); float sm = ex;
#pragma unroll
            for (int o = 1; o < 16; o <<= 1) sm += shx(sm, o, F.lane);
            aff[((size_t)grp * 16 + 4 * q + r) * NE + r16] = ex / sm; }
        if (q == 0) rsv[row] = rs;
    }
}
__device__ __forceinline__ void topk_gather(Frame& F, const float* aff, const float* rsv, int* sel, float* gatev, int* idxg) {
    LAS unsigned* hist = (LAS unsigned*)F.lds;
    volatile LAS unsigned* st = (volatile LAS unsigned*)(F.lds + 1024);
    for (int u = blockIdx.x; u < NB * NE; u += 256) {
        const int b = u >> 4, e = u & 15;
        unsigned bits[4];
#pragma unroll
        for (int q = 0; q < 4; ++q) bits[q] = __float_as_uint(aff[((size_t)b * SEQ + 4 * F.tid + q) * NE + e]);
        const f32x4 rs4 = *(const f32x4*)(rsv + (size_t)b * SEQ + 4 * F.tid);
        unsigned prefix = 0u, kk = CAP;
#pragma unroll 1
        for (int pass = 0; pass < 4; ++pass) {
            const int shift = 24 - 8 * pass;
            if (F.tid < 256) hist[F.tid] = 0u;
            __syncthreads();
#pragma unroll
            for (int q = 0; q < 4; ++q) { const bool in = (pass == 0) || ((bits[q] >> (shift + 8)) == prefix); if (in) atomicAdd((unsigned*)&hist[(bits[q] >> shift) & 255u], 1u); }
            __syncthreads();
            if (F.wave == 0) {
                const unsigned c0 = hist[4 * F.lane], c1 = hist[4 * F.lane + 1], c2 = hist[4 * F.lane + 2], c3 = hist[4 * F.lane + 3];
                unsigned incl = c0 + c1 + c2 + c3;
#pragma unroll
                for (int o = 1; o < 64; o <<= 1) { const unsigned v = shrel(incl, o, F.lane); if (F.lane + o < 64) incl += v; }
                unsigned cum = incl - (c0 + c1 + c2 + c3);
                int found = -1; unsigned above = 0u;
                if (cum < kk && cum + c3 >= kk) { found = 3; above = cum; } cum += c3;
                if (cum < kk && cum + c2 >= kk) { found = 2; above = cum; } cum += c2;
                if (cum < kk && cum + c1 >= kk) { found = 1; above = cum; } cum += c1;
                if (cum < kk && cum + c0 >= kk) { found = 0; above = cum; }
                if (found >= 0) { st[0] = (prefix << 8) | (unsigned)(4 * F.lane + found); st[1] = kk - above; }
            }
            __syncthreads();
            prefix = st[0]; kk = st[1];
        }
        const unsigned T = prefix;
        unsigned ngt = 0u, neq = 0u;
#pragma unroll
        for (int q = 0; q < 4; ++q) { ngt += bits[q] > T ? 1u : 0u; neq += bits[q] == T ? 1u : 0u; }
        unsigned pk = ngt | (neq << 16), inc = pk;
#pragma unroll
        for (int o = 1; o < 64; o <<= 1) { const unsigned v = shrel(inc, -o, F.lane); if (F.lane >= o) inc += v; }
        if (F.lane == 63) st[8 + F.wave] = inc;
        __syncthreads();
        unsigned base = 0u;
#pragma unroll
        for (int w = 0; w < NWAVES; ++w) base += (w < F.wave) ? st[8 + w] : 0u;
        const unsigned excl = base + inc - pk;
        unsigned pgt = excl & 0xffffu, peq = excl >> 16;
#pragma unroll
        for (int q = 0; q < 4; ++q) { const int i = 4 * F.tid + q; const bool g = bits[q] > T, eq = bits[q] == T; const bool keep = g || (eq && peq < kk);
            const unsigned slot = pgt + (peq < kk ? peq : kk);
            if (keep) { idxg[(size_t)(e * NB + b) * CAP + slot] = (int)((unsigned)(b * SEQ + i) | ((unsigned)__builtin_bit_cast(unsigned short, (_Float16)rs4[q]) << 16)); gatev[(size_t)(e * NB + b) * CAP + slot] = __uint_as_float(bits[q]); }
            sel[((size_t)b * SEQ + i) * NE + e] = keep ? (int)slot : -1;
            pgt += g ? 1u : 0u; peq += eq ? 1u : 0u; }
        __syncthreads();
    }
}


constexpr int ATT_KPITCH = 144, ATT_VT_OFF = 512 * ATT_KPITCH, ATT_VPITCH = 1040, ATT_SINK_OFF = MISC_OFF + 1024;
static_assert(ATT_VT_OFF + 64 * ATT_VPITCH <= MISC_OFF, "attention LDS");
#ifndef ATT_JT_UNROLL
#define ATT_JT_UNROLL 1
#endif
struct ChunkP { const bf16* K; const bf16* V; int ldkv, tok0, cstep, r, L, nseg, qs, i0; };
template <int W>
__device__ __forceinline__ void attn_issue(const ChunkP& p, int tid, v4u (&kreg)[8], v4u (&vreg)[2][4]) {
    asm volatile("" : "+v"(tid));
    const int KS = p.qs + 2 * W, nrows = p.nseg * KS, Lm1 = p.L - 1;
    constexpr int NKP = 8;
#pragma unroll
    for (int it = 0; it < NKP; ++it) { const int pc = tid + it * NWAVES * 64, row0 = pc >> 3, ch = pc & 7, row = row0 < nrows ? row0 : nrows - 1, s = row >= KS ? 1 : 0, rho = row - s * KS;
        int j = p.i0 - W + rho; j = j < 0 ? 0 : j; j = j > Lm1 ? Lm1 : j;
        kreg[it] = *(const v4u*)(p.K + (size_t)(p.tok0 + s * p.cstep + p.r * j) * p.ldkv + ch * 8); }
#pragma unroll
    for (int it = 0; it < 2; ++it) { const int t = tid + it * NWAVES * 64, r4 = t >> 3, ch = t & 7, rowa = 4 * r4, row0 = rowa < nrows ? rowa : nrows - 4, s = row0 >= KS ? 1 : 0, rho = row0 - s * KS, j0 = p.i0 - W + rho;
#pragma unroll
        for (int q = 0; q < 4; ++q) { int j = j0 + q; j = j < 0 ? 0 : j; j = j > Lm1 ? Lm1 : j;
            vreg[it][q] = *(const v4u*)(p.V + (size_t)(p.tok0 + s * p.cstep + p.r * j) * p.ldkv + ch * 8); } }
}
__device__ __forceinline__ void attn_loadq(const Frame& F, const ChunkP& p, const bf16* Q, int ldq, bf16x8 (&qf)[4]) {
    int lane_ = F.lane; asm volatile("" : "+v"(lane_));
    const int wq = F.wave * 32, sidx = (wq >= p.qs) ? 1 : 0, qo = wq - sidx * p.qs, ql = lane_ & 31, hh = lane_ >> 5, qi = p.i0 + qo + ql;
    const bf16* q0 = Q + (size_t)(p.tok0 + sidx * p.cstep + p.r * qi) * ldq;
#pragma unroll
    for (int ks = 0; ks < 4; ++ks) qf[ks] = *(const bf16x8*)(q0 + 16 * ks + 8 * hh);
}
template <int W>
__device__ __forceinline__ void attn_commit(Frame& F, const ChunkP& p, const v4u (&kreg)[8], const v4u (&vreg)[2][4]) {
    int tid = F.tid; asm volatile("" : "+v"(tid));
    const int KS = p.qs + 2 * W, nrows = p.nseg * KS;
    LAS unsigned char* ldsK = F.lds; LAS unsigned char* ldsV = F.lds + ATT_VT_OFF;
    constexpr int NKP = 8;
#pragma unroll
    for (int it = 0; it < NKP; ++it) { const int pc = tid + it * NWAVES * 64, row = pc >> 3, ch = pc & 7;
        if (pc < nrows * 8) *(LAS v4u*)(ldsK + row * ATT_KPITCH + ch * 16) = kreg[it]; }
#pragma unroll
    for (int it = 0; it < 2; ++it) { const int t = tid + it * NWAVES * 64, r4 = t >> 3, ch = t & 7, row0 = 4 * r4;
        if (t < nrows * 2) {
            const int kap = row0 & 31, slot = (kap >> 4) * 16 + ((kap >> 2) & 1) * 8 + ((kap >> 3) & 1) * 4, pos = (row0 & ~31) + slot;
#pragma unroll
            for (int w = 0; w < 4; ++w) {
                v2u lo, hi;
                lo.x = (vreg[it][0][w] & 0xffffu) | (vreg[it][1][w] << 16); lo.y = (vreg[it][2][w] & 0xffffu) | (vreg[it][3][w] << 16);
                hi.x = (vreg[it][0][w] >> 16) | (vreg[it][1][w] & 0xffff0000u); hi.y = (vreg[it][2][w] >> 16) | (vreg[it][3][w] & 0xffff0000u);
                *(LAS v2u*)(ldsV + (ch * 8 + 2 * w) * ATT_VPITCH + pos * 2) = lo;
                *(LAS v2u*)(ldsV + (ch * 8 + 2 * w + 1) * ATT_VPITCH + pos * 2) = hi;
            } } }
}
#ifndef ATT_THR
#define ATT_THR 8.0f
#endif
template <int W, int NH, bool SINK, bool WRITE_LSE>
__device__ __forceinline__ void attn_compute(Frame& F, const ChunkP& p, bf16* Q, int ldq, long odelta, float* lse, float slope1, const float* sinkp, int hbase, bf16x8 (&qf)[4]) {
    constexpr int NJT = 2 * W / 32 + 1, JC = W / 32;
    const int KS = p.qs + 2 * W, L = p.L, i0 = p.i0;
    LAS unsigned char* ldsK = F.lds; LAS unsigned char* ldsV = F.lds + ATT_VT_OFF;
    const int wq = F.wave * 32, sidx = (wq >= p.qs) ? 1 : 0, qo = wq - sidx * p.qs, segbase = sidx * KS;
    int lane_ = F.lane; asm volatile("" : "+v"(lane_));
    const int ql = lane_ & 31, hh = lane_ >> 5;
    const int qi = i0 + qo + ql;
    const size_t qtok = (size_t)(p.tok0 + sidx * p.cstep + p.r * qi);
    const float flo = (float)((-qi > -W) ? -qi : -W), fhi = (float)((L - 1 - qi < W) ? (L - 1 - qi) : W);
#pragma unroll 1
    for (int g = 0; g < NH; ++g) {
        bf16* qptr = Q + qtok * ldq + g * 64;
        f32x16 O0, O1;
        float m, l;
#ifdef PRB_REP
        constexpr int nrep = (NH == PRB_NH) ? PRB_REP : 1;
#pragma unroll 1
        for (int rep = 0; rep < nrep; ++rep) {
        asm volatile("" ::: "memory");
#endif
#pragma unroll
        for (int i = 0; i < 16; ++i) { O0[i] = 0.f; O1[i] = 0.f; }
        const float sl = (NH == 1) ? slope1 : __builtin_amdgcn_exp2f(-0.5f * (float)(hbase + g + 1)) * LOG2E;
        const float sk2 = SINK ? *(const LAS float*)(F.lds + ATT_SINK_OFF + 4 * (hbase + g)) : 0.f;
        {
            const int jbase = i0 + qo - W + 32 * JC, krow = segbase + qo + 32 * JC;
            const bool need_mask = (jbase < 0) || (jbase + 31 >= L);
            f32x16 S;
#pragma unroll
            for (int i = 0; i < 16; ++i) S[i] = 0.f;
#pragma unroll
            for (int ks = 0; ks < 4; ++ks) { const bf16x8 kf = *(const LAS bf16x8*)(ldsK + (krow + ql) * ATT_KPITCH + (16 * ks + 8 * hh) * 2); S = __builtin_amdgcn_mfma_f32_32x32x16_bf16(kf, qf[ks], S, 0, 0, 0); }
            const float fd0 = (float)(jbase + 4 * hh - qi);
#pragma unroll
            for (int i = 0; i < 16; ++i) { const float fd = fd0 + (float)((i & 3) + 8 * (i >> 2)); S[i] = S[i] - sl * fabsf(fd); }
            if (need_mask) {
#pragma unroll
                for (int i = 0; i < 16; ++i) { const float fd = fd0 + (float)((i & 3) + 8 * (i >> 2)); S[i] = (fd >= flo && fd <= fhi) ? S[i] : -INFINITY; } }
            float mloc = S[0];
#pragma unroll
            for (int i = 1; i < 16; ++i) mloc = fmaxf(mloc, S[i]);
            m = fmaxf(mloc, shx(mloc, 32, lane_));
            float ps = 0.f;
#pragma unroll
            for (int i = 0; i < 16; ++i) { const float pv = __builtin_amdgcn_exp2f(S[i] - m); S[i] = pv; ps += pv; }
            l = ps;
#pragma unroll
            for (int s2 = 0; s2 < 2; ++s2) {
                f32x8_t pp;
#pragma unroll
                for (int i = 0; i < 8; ++i) pp[i] = S[8 * s2 + i];
                const bf16x8 pf = __builtin_bit_cast(bf16x8, __builtin_convertvector(pp, nbf16x8));
                const bf16x8 v0 = *(const LAS bf16x8*)(ldsV + ql * ATT_VPITCH + (krow + 16 * s2 + 8 * hh) * 2);
                const bf16x8 v1 = *(const LAS bf16x8*)(ldsV + (ql + 32) * ATT_VPITCH + (krow + 16 * s2 + 8 * hh) * 2);
                O0 = __builtin_amdgcn_mfma_f32_32x32x16_bf16(v0, pf, O0, 0, 0, 0);
                O1 = __builtin_amdgcn_mfma_f32_32x32x16_bf16(v1, pf, O1, 0, 0, 0);
            }
        }
#pragma unroll 1
        for (int jt = 0; jt < NJT; ++jt) {
            if (jt == JC) continue;
            const int jbase = i0 + qo - W + 32 * jt;
            if (jbase + 31 < 0 || jbase >= L) continue;
            const bool need_mask = (jt == 0) || (jt == NJT - 1) || (jbase < 0) || (jbase + 31 >= L);
            const int krow = segbase + qo + 32 * jt;
            const float fd0 = (float)(jbase + 4 * hh - qi);
            bf16x8 kf[4];
#pragma unroll
            for (int ks = 0; ks < 4; ++ks) kf[ks] = *(const LAS bf16x8*)(ldsK + (krow + ql) * ATT_KPITCH + (16 * ks + 8 * hh) * 2);
            const bf16x8 vf00 = *(const LAS bf16x8*)(ldsV + ql * ATT_VPITCH + (krow + 8 * hh) * 2), vf10 = *(const LAS bf16x8*)(ldsV + (ql + 32) * ATT_VPITCH + (krow + 8 * hh) * 2);
            f32x16 S;
            if (jt < JC) { const float k1 = sl * fd0 - m;
#pragma unroll
                for (int i = 0; i < 16; ++i) S[i] = fmaf(sl, (float)((i & 3) + 8 * (i >> 2)), k1); }
            else { const float k1 = -sl * fd0 - m;
#pragma unroll
                for (int i = 0; i < 16; ++i) S[i] = fmaf(-sl, (float)((i & 3) + 8 * (i >> 2)), k1); }
            if (need_mask) {
#pragma unroll
                for (int i = 0; i < 16; ++i) { const float fd = fd0 + (float)((i & 3) + 8 * (i >> 2)); S[i] = (fd >= flo && fd <= fhi) ? S[i] : -INFINITY; } }
#pragma unroll
            for (int ks = 0; ks < 4; ++ks) S = __builtin_amdgcn_mfma_f32_32x32x16_bf16(kf[ks], qf[ks], S, 0, 0, 0);
            const bf16x8 vf01 = *(const LAS bf16x8*)(ldsV + ql * ATT_VPITCH + (krow + 16 + 8 * hh) * 2), vf11 = *(const LAS bf16x8*)(ldsV + (ql + 32) * ATT_VPITCH + (krow + 16 + 8 * hh) * 2);
            float tmax = S[0];
#pragma unroll
            for (int i = 1; i < 16; ++i) tmax = fmaxf(tmax, S[i]);
            if (__builtin_amdgcn_ballot_w64(tmax > ATT_THR) != 0ull) {
                float d = fmaxf(tmax, 0.f); d = fmaxf(d, shx(d, 32, lane_));
                const float sc = __builtin_amdgcn_exp2f(-d);
#pragma unroll
                for (int i = 0; i < 16; ++i) { S[i] -= d; O0[i] *= sc; O1[i] *= sc; }
                l *= sc; m += d;
            }
            float ps = 0.f;
#pragma unroll
            for (int i = 0; i < 16; ++i) { const float pv = __builtin_amdgcn_exp2f(S[i]); S[i] = pv; ps += pv; }
            l += ps;
            { f32x8_t pp;
#pragma unroll
              for (int i = 0; i < 8; ++i) pp[i] = S[i];
              const bf16x8 pf = __builtin_bit_cast(bf16x8, __builtin_convertvector(pp, nbf16x8));
              O0 = __builtin_amdgcn_mfma_f32_32x32x16_bf16(vf00, pf, O0, 0, 0, 0); O1 = __builtin_amdgcn_mfma_f32_32x32x16_bf16(vf10, pf, O1, 0, 0, 0); }
            { f32x8_t pp;
#pragma unroll
              for (int i = 0; i < 8; ++i) pp[i] = S[8 + i];
              const bf16x8 pf = __builtin_bit_cast(bf16x8, __builtin_convertvector(pp, nbf16x8));
              O0 = __builtin_amdgcn_mfma_f32_32x32x16_bf16(vf01, pf, O0, 0, 0, 0); O1 = __builtin_amdgcn_mfma_f32_32x32x16_bf16(vf11, pf, O1, 0, 0, 0); }
        }
#ifdef PRB_REP
        }
        const float sk2 = SINK ? *(const LAS float*)(F.lds + ATT_SINK_OFF + 4 * (hbase + g)) : 0.f;
#endif
        float lt = l + shx(l, 32, lane_);
        float osc = 1.0f;
        if (SINK) { const float mf = fmaxf(m, sk2); osc = __builtin_amdgcn_exp2f(m - mf); lt = lt * osc + __builtin_amdgcn_exp2f(sk2 - mf); }
        if (WRITE_LSE) { if (hh == 0) lse[qtok * 4] = m + __builtin_amdgcn_logf(lt); }
        const float inv = osc / lt;
        if (NH > 1 && g + 1 < NH) {
#pragma unroll
            for (int ks = 0; ks < 4; ++ks) qf[ks] = *(const bf16x8*)(qptr + 64 + 16 * ks + 8 * hh); }
        v2u WW[8];
#pragma unroll
        for (int g4 = 0; g4 < 4; ++g4) {
            WW[g4].x = pk2bf(O0[4 * g4] * inv, O0[4 * g4 + 1] * inv); WW[g4].y = pk2bf(O0[4 * g4 + 2] * inv, O0[4 * g4 + 3] * inv);
            WW[4 + g4].x = pk2bf(O1[4 * g4] * inv, O1[4 * g4 + 1] * inv); WW[4 + g4].y = pk2bf(O1[4 * g4 + 2] * inv, O1[4 * g4 + 3] * inv); }
#pragma unroll
        for (int s4 = 0; s4 < 4; ++s4) {
            v2u a = WW[2 * s4], b = WW[2 * s4 + 1];
            { const auto r = __builtin_amdgcn_permlane32_swap(a.x, b.x, false, false); a.x = r[0]; b.x = r[1]; }
            { const auto r = __builtin_amdgcn_permlane32_swap(a.y, b.y, false, false); a.y = r[0]; b.y = r[1]; }
            *(v4u*)(qptr + odelta + 16 * s4 + 8 * hh) = (v4u){a.x, a.y, b.x, b.y};
#ifdef PRB_ST2
            asm volatile("" ::: "memory");
            *(v4u*)(qptr + odelta + 16 * s4 + 8 * hh) = (v4u){a.x, a.y, b.x, b.y};
            asm volatile("" ::: "memory");
#endif
        }
    }
}
__device__ __forceinline__ ChunkP dil_chunk(const bf16* KA, const bf16* VA, int b, int hs, int sc) {
    const int grp = sc >> 3, ix = sc & 7, col = grp * 256 + hs * 64; ChunkP p; p.K = KA + col; p.V = VA + col; p.ldkv = 768;
    if (grp == 0) { p.tok0 = b * SEQ; p.cstep = 0; p.r = 1; p.L = 2048; p.nseg = 1; p.qs = 256; p.i0 = 256 * ix; }
    else if (grp == 1) { p.tok0 = b * SEQ + (ix >> 1); p.cstep = 0; p.r = 4; p.L = 512; p.nseg = 1; p.qs = 256; p.i0 = 256 * (ix & 1); }
    else { p.tok0 = b * SEQ + 2 * ix; p.cstep = 1; p.r = 16; p.L = 128; p.nseg = 2; p.qs = 128; p.i0 = 0; }
    return p;
}
__device__ __forceinline__ ChunkP win_chunk(const bf16* KW, const bf16* VW, int wc) {
    const int b = wc >> 5, kvh = (wc >> 3) & 3, ch = wc & 7; ChunkP p; p.K = KW + kvh * 64; p.V = VW + kvh * 64; p.ldkv = 256;
    p.tok0 = b * SEQ; p.cstep = 0; p.r = 1; p.L = SEQ; p.nseg = 1; p.qs = 256; p.i0 = 256 * ch; return p;
}
__device__ __forceinline__ void attention_phase(Frame& F, int l, long odA, long odW, int which = 3) {
    unsigned char* ws = P_WS;
    bf16* big = (bf16*)(ws + WS_BIG);
    bf16* QA = big + B_QA / 2; bf16* KA = big + B_KA / 2; bf16* VA = big + B_VA / 2; bf16* QW = big + B_QW / 2; bf16* KW = big + B_KW / 2; bf16* VW = big + B_VW / 2; bf16* OA = big + B_OA / 2;
    float* LSE = (float*)(ws + WS_LSE);
    const int c = blockIdx.x;
    int w_lo, w_hi;
    v4u kreg[8], vreg[2][4];
    bf16x8 qf[4];
#ifndef ATT_N1
#define ATT_N1 0
#endif
    static_assert(ATT_N1 == 0, "the dilated workgroups take no window chunks");
    if (c < 128) { w_lo = ATT_N1 * c; w_hi = w_lo + ATT_N1; } else { w_lo = 128 * ATT_N1 + (c - 128) * (8 - ATT_N1); w_hi = w_lo + (8 - ATT_N1); }
    if (c < 128) { if (which & 1) {
        const int b = c >> 2, hs = c & 3;
        { const ChunkP p0 = dil_chunk(KA, VA, b, hs, 0); attn_issue<64>(p0, F.tid, kreg, vreg); attn_loadq(F, p0, QA + hs * 64, 768, qf); attn_commit<64>(F, p0, kreg, vreg); }
        __syncthreads();
#pragma unroll 1
        for (int sc = 0; sc < 24; ++sc) {
            const ChunkP p = dil_chunk(KA, VA, b, hs, sc); const int grp = sc >> 3;
            const int scn = sc + 1 < 24 ? sc + 1 : sc;
            const ChunkP pn = dil_chunk(KA, VA, b, hs, scn);
            bf16x8 qn[4];
            attn_issue<64>(pn, F.tid, kreg, vreg); attn_loadq(F, pn, QA + (scn >> 3) * 256 + hs * 64, 768, qn);
            const float slope1 = __builtin_amdgcn_exp2f(-8.0f * (float)(grp * 4 + hs + 1) / 12.0f) * (float)p.r * LOG2E;
            attn_compute<64, 1, false, true>(F, p, QA + grp * 256 + hs * 64, 768, odA, LSE + (size_t)grp * MTOK * 4 + hs, slope1, nullptr, 0, qf);
            __syncthreads();
            if (sc + 1 < 24) attn_commit<64>(F, pn, kreg, vreg);
            __syncthreads();
#pragma unroll
            for (int ks = 0; ks < 4; ++ks) qf[ks] = qn[ks];
        }
        VM_WAIT(); __syncthreads(); __builtin_amdgcn_fence(__ATOMIC_ACQUIRE, "agent"); VM_WAIT();
        constexpr int CB = 8;
#pragma unroll 1
        for (int t0 = F.tid; t0 < SEQ * 8; t0 += NWAVES * 64 * CB) {
            float lv[CB][3]; v4u av[CB][3];
#pragma unroll
            for (int k = 0; k < CB; ++k) { const int t = t0 + k * NWAVES * 64, tok = t >> 3, ch = t & 7; const size_t row = (size_t)b * SEQ + tok;
                lv[k][0] = LSE[row * 4 + hs]; lv[k][1] = LSE[(size_t)MTOK * 4 + row * 4 + hs]; lv[k][2] = LSE[(size_t)2 * MTOK * 4 + row * 4 + hs];
                const bf16* og = QA + odA + row * 768 + hs * 64 + ch * 8; av[k][0] = *(const v4u*)(og); av[k][1] = *(const v4u*)(og + 256); av[k][2] = *(const v4u*)(og + 512); }
            asm volatile("" ::: "memory");
#pragma unroll
            for (int k = 0; k < CB; ++k) { const int t = t0 + k * NWAVES * 64, tok = t >> 3, ch = t & 7; const size_t row = (size_t)b * SEQ + tok;
                const float mx = fmaxf(lv[k][0], fmaxf(lv[k][1], lv[k][2]));
                float w0 = __builtin_amdgcn_exp2f(lv[k][0] - mx), w1 = __builtin_amdgcn_exp2f(lv[k][1] - mx), w2 = __builtin_amdgcn_exp2f(lv[k][2] - mx);
                const float inv = 1.0f / (w0 + w1 + w2); w0 *= inv; w1 *= inv; w2 *= inv;
                v4u o;
#pragma unroll
                for (int w = 0; w < 4; ++w) o[w] = pk2bf(w0 * bflo(av[k][0][w]) + w1 * bflo(av[k][1][w]) + w2 * bflo(av[k][2][w]), w0 * bfhi(av[k][0][w]) + w1 * bfhi(av[k][1][w]) + w2 * bfhi(av[k][2][w]));
                *(v4u*)(OA + row * 256 + hs * 64 + ch * 8) = o; }
        }
    } } else if (which & 2) {
        if (F.tid < 16) *(LAS float*)(F.lds + ATT_SINK_OFF + 4 * F.tid) = P_IN(6)[l * 16 + F.tid] * LOG2E;
        const ChunkP p0 = win_chunk(KW, VW, w_lo); attn_issue<128>(p0, F.tid, kreg, vreg); attn_loadq(F, p0, QW + ((w_lo >> 3) & 3) * 256, 1024, qf); attn_commit<128>(F, p0, kreg, vreg);
        __syncthreads();
    }
#pragma unroll 1
    for (int wc = w_lo; wc < ((which & 2) ? w_hi : w_lo); ++wc) {
        const ChunkP p = win_chunk(KW, VW, wc); const int kvh = (wc >> 3) & 3;
        const int wn = wc + 1 < w_hi ? wc + 1 : wc;
        const ChunkP pn = win_chunk(KW, VW, wn);
        bf16x8 qn[4];
        attn_issue<128>(pn, F.tid, kreg, vreg); attn_loadq(F, pn, QW + ((wn >> 3) & 3) * 256, 1024, qn);
        attn_compute<128, 4, true, false>(F, p, QW + kvh * 256, 1024, odW, nullptr, 0.f, nullptr, kvh * 4, qf);
        __syncthreads();
        if (wc + 1 < w_hi) attn_commit<128>(F, pn, kreg, vreg);
        __syncthreads();
#pragma unroll
        for (int ks = 0; ks < 4; ++ks) qf[ks] = qn[ks];
    }
}
#ifndef PH_A
#define PH_A 1
#endif
#ifndef PH_B
#define PH_B 1
#endif
#ifndef PH_C
#define PH_C 1
#endif
#ifndef PH_D
#define PH_D 1
#endif
#ifndef PH_E
#define PH_E 1
#endif
#ifndef PH_F
#define PH_F 1
#endif
#ifndef PH_G
#define PH_G 1
#endif
#ifndef PH_H
#define PH_H 1
#endif
#ifndef PH_I
#define PH_I 1
#endif
#ifndef PH_J
#define PH_J 1
#endif
#ifndef PH_Z
#define PH_Z 1
#endif

struct Args { const float* in[14]; float* out; unsigned char* ws; };
__global__ void __launch_bounds__(NWAVES * 64, 2) mk_fwd(Args args) {
    extern __shared__ __attribute__((aligned(16))) unsigned char lds_raw[];
    LAS unsigned char* const lds = (LAS unsigned char*)lds_raw;
    int wave_s = __builtin_amdgcn_readfirstlane((int)(threadIdx.x >> 6)); asm volatile("" : "+s"(wave_s));
    {
        const int t0 = wave_s * 64 + xb_lane();
        volatile LAS unsigned* MISC = (volatile LAS unsigned*)(lds + MISC_OFF);
        if (t0 < 32) MISC[t0] = 0u;
        if (t0 == 0) { volatile LAS unsigned long long* pt = (volatile LAS unsigned long long*)(lds + PTAB_OFF);
            pt[0] = (unsigned long long)args.in[0]; pt[1] = (unsigned long long)args.in[1]; pt[2] = (unsigned long long)args.in[2]; pt[3] = (unsigned long long)args.in[3];
            pt[4] = (unsigned long long)args.in[4]; pt[5] = (unsigned long long)args.in[5]; pt[6] = (unsigned long long)args.in[6]; pt[7] = (unsigned long long)args.in[7];
            pt[8] = (unsigned long long)args.in[8]; pt[9] = (unsigned long long)args.in[9]; pt[10] = (unsigned long long)args.in[10]; pt[11] = (unsigned long long)args.in[11];
            pt[12] = (unsigned long long)args.in[12]; pt[13] = (unsigned long long)args.in[13]; pt[14] = (unsigned long long)args.out; pt[15] = (unsigned long long)args.ws; }
        __syncthreads();
    }
    XcdBarrier bar = xcd_barrier_post((unsigned*)(args.ws + WS_CTL) + CW_BAR, (volatile LAS unsigned*)(lds + MISC_OFF) + 8, wave_s);
    const int G = 256;

#pragma unroll 1
    for (int l = 0; l < DEPTH; ++l) {
        int c = blockIdx.x; asm volatile("" : "+s"(c));
#if PH_A
        { Frame F = make_frame(lds, wave_s); convert_weights(F, l);
          unsigned char* ws = P_WS;
          if (l == 0) norm_rows<true, false, false>(F, P_IN(0), (bf16*)(ws + WS_HB), P_IN(1) + l * DM, (float*)(ws + WS_LSE), nullptr);
          else norm_rows<false, true, false>(F, nullptr, (bf16*)(ws + WS_HB), P_IN(1) + l * DM, (float*)(ws + WS_LSE), nullptr);
          }
#endif
        xcd_barrier(bar);
#if PH_B
        { Frame F = make_frame(lds, wave_s); unsigned char* ws = P_WS; bf16* big = (bf16*)(ws + WS_BIG);
          pg8::Gemm g{(const bf16*)(ws + WS_HB), (const bf16*)(ws + WS_WIN), MTOK, INC, DM}; pg8::StaticOrder S; S.init(MTOK, INC, G, c);
          pg8::EpiInProj E{big + B_QA / 2, big + B_KA / 2, big + B_VA / 2, big + B_QW / 2, big + B_KW / 2, big + B_VW / 2, big + B_G / 2, big + B_G / 2 + (size_t)MTOK * DM, P_IN(5) + l * 2048, QSCALE, (const float*)(ws + WS_LSE), 0.f, 0.f};
          pg8::gemm_phase<pg8::EpiInProj, pg8::StaticOrder, true, true>(F.tid, lds, g, S, E); }
#endif
        xcd_barrier(bar);
#ifdef DUP_C
        { Frame F = make_frame(lds, wave_s); attention_phase(F, l, ((long)WS_HN - (long)(WS_BIG + B_QA)) / 2, ((long)WS_HN - (long)(WS_BIG + B_QW)) / 2, DUP_C); }
        xcd_barrier(bar);
#endif
#if PH_C
        { Frame F = make_frame(lds, wave_s); attention_phase(F, l, 0, 0); }
#endif
        xcd_barrier(bar);
#if PH_E
        { Frame F = make_frame(lds, wave_s); unsigned char* ws = P_WS; bf16* big = (bf16*)(ws + WS_BIG);
          pg8::Gemm g0{big + B_OA / 2, (const bf16*)(ws + WS_WA), MTOK, DM, 256}; pg8::Gemm g1{big + B_QW / 2, (const bf16*)(ws + WS_WB), MTOK, DM, DM}; pg8::StaticOrder S; S.init(MTOK, DM, G, c);
          pg8::EpiMergeDual E{big + B_MERGED / 2, big + B_G / 2, big + B_G / 2 + (size_t)MTOK * DM};
          pg8::gemm_phase_dual<pg8::EpiMergeDual, pg8::StaticOrder>(F.tid, lds, g0, g1, S, E); }
#endif
        xcd_barrier(bar);
#if PH_F
        { Frame F = make_frame(lds, wave_s); unsigned char* ws = P_WS; bf16* big = (bf16*)(ws + WS_BIG); bf16* hb = (bf16*)(ws + WS_HB);
          pg8::Gemm g{big + B_MERGED / 2, (const bf16*)(ws + WS_WO), MTOK, DM, DM}; pg8::StaticOrder S; S.init(MTOK, DM, G, c);
          pg8::EpiResid E{hb, hb};
          pg8::gemm_phase<pg8::EpiResid, pg8::StaticOrder, true, true>(F.tid, lds, g, S, E); }
#endif
        xcd_barrier(bar);
#if PH_G
        { Frame F = make_frame(lds, wave_s); unsigned char* ws = P_WS;
          norm_router(F, (const bf16*)(ws + WS_HB), P_IN(8) + l * DM, P_IN(9) + (size_t)l * DM * NE, (float*)(ws + WS_LSE), (float*)(ws + WS_AFF)); }
#endif
        xcd_barrier(bar);
#if PH_H
        { Frame F = make_frame(lds, wave_s); unsigned char* ws = P_WS;
          topk_gather(F, (const float*)(ws + WS_AFF), (const float*)(ws + WS_LSE), (int*)(ws + WS_SEL), (float*)(ws + WS_GATE), (int*)(ws + WS_IDX)); }
#endif
        xcd_barrier(bar);
#if PH_I
        { Frame F = make_frame(lds, wave_s); unsigned char* ws = P_WS; bf16* big = (bf16*)(ws + WS_BIG);
          pg8::Gemm g{(const bf16*)(ws + WS_HB), (const bf16*)(ws + WS_WGU), MEXP, NE * 2048, DM}; pg8::GroupedOrder S; S.init(NE, NB, 8, G, c);
          pg8::EpiSwiGLU E{big + B_ACT / 2, (const LAS int*)(lds + AROW_OFF), 0};
          { const int* idxg = (const int*)(ws + WS_IDX); LAS int* arow = (LAS int*)(lds + AROW_OFF);
            int rv[NE]; const int r = F.tid & 255;
#pragma unroll
            for (int i = 0; i < NE; ++i) { pg8::Unit u; u.pm = 0; u.pn = 0; S.next(i, u); rv[i] = u.pm; }
            asm volatile("" ::: "memory");
#pragma unroll
            for (int i = 0; i < NE; ++i) rv[i] = idxg[(size_t)rv[i] * 256 + r];
#pragma unroll
            for (int i = 0; i < NE; ++i) if (F.tid < 256) arow[i * 256 + r] = rv[i];
            __syncthreads(); }
          pg8::gemm_phase<pg8::EpiSwiGLU, pg8::GroupedOrder, true, true, true>(F.tid, lds, g, S, E, (const LAS int*)(lds + AROW_OFF)); }
#endif
        xcd_barrier(bar);
#if PH_J
        { Frame F = make_frame(lds, wave_s); unsigned char* ws = P_WS; bf16* big = (bf16*)(ws + WS_BIG);
          pg8::Gemm g{big + B_ACT / 2, (const bf16*)(ws + WS_WD), MEXP, NE * 1024, DEX}; pg8::GroupedOrder S; S.init(NE, NB, 4, G, c);
          pg8::EpiDown E{big + B_Y / 2, (const LAS float*)(lds + AROW_OFF), 0};
          { const float* gatev = (const float*)(ws + WS_GATE); LAS float* gl = (LAS float*)(lds + AROW_OFF);
            float gv[8]; int pmv[8]; const int r = F.tid & 255;
#pragma unroll
            for (int i = 0; i < 8; ++i) { pg8::Unit u; u.pm = 0; u.pn = 0; S.next(i, u); pmv[i] = u.pm; }
            asm volatile("" ::: "memory");
#pragma unroll
            for (int i = 0; i < 8; ++i) gv[i] = gatev[(size_t)pmv[i] * 256 + r];
#pragma unroll
            for (int i = 0; i < 8; ++i) if (F.tid < 256) gl[i * 256 + r] = gv[i];
            __syncthreads(); }
          pg8::gemm_phase<pg8::EpiDown, pg8::GroupedOrder, true, true>(F.tid, lds, g, S, E); }
#endif
        xcd_barrier(bar);
    }
#if PH_Z
    { Frame F = make_frame(lds, wave_s); unsigned char* ws = P_WS; norm_rows<false, true, true>(F, nullptr, (bf16*)(ws + WS_HB), P_IN(13), nullptr, P_OUT); }
#endif
}

extern "C" void kernel_launch(void* const* d_in, const int* in_sizes, int n_in, void* d_out, int out_size, void* d_ws, size_t ws_size, hipStream_t stream) {
    static int grid = 0;
    if (grid == 0) {
        if (n_in != 14 || out_size != MTOK * DM || ws_size < WS_END) { fprintf(stderr, "kernel_launch: unexpected shapes (n_in %d, out %d, ws %zu < %zu); nothing launched\n", n_in, out_size, ws_size, (size_t)WS_END); grid = -1; return; }
        int dev = 0, cus = 0, per_cu = 0;
        if (hipGetDevice(&dev) != hipSuccess || hipDeviceGetAttribute(&cus, hipDeviceAttributeMultiprocessorCount, dev) != hipSuccess) { grid = -1; return; }
        if (hipFuncSetAttribute((const void*)mk_fwd, hipFuncAttributeMaxDynamicSharedMemorySize, LDS_BYTES) != hipSuccess) { fprintf(stderr, "kernel_launch: hipFuncSetAttribute failed\n"); grid = -1; return; }
        if (hipOccupancyMaxActiveBlocksPerMultiprocessor(&per_cu, (const void*)mk_fwd, NWAVES * 64, LDS_BYTES) != hipSuccess || per_cu < 1) fprintf(stderr, "kernel_launch: occupancy query reports %d\n", per_cu);
        (void)hipGetLastError();
        grid = 256;
        if (cus != 256) fprintf(stderr, "kernel_launch: device has %d CUs, built for 256\n", cus);
    }
    if (grid < 0) return;
    (void)in_sizes;
    hipMemsetAsync((char*)d_ws + WS_CTL, 0, CTL_ZERO_BYTES, stream);
    Args a{};
    for (int i = 0; i < 14; ++i) a.in[i] = (const float*)d_in[i];
    a.out = (float*)d_out; a.ws = (unsigned char*)d_ws;
    hipLaunchKernelGGL(mk_fwd, dim3(grid), dim3(NWAVES * 64), LDS_BYTES, stream, a);
}
```

```cpp
#include <hip/hip_runtime.h>
#include <cstdio>
#include <cstdint>
typedef __bf16 nbf16x2 __attribute__((ext_vector_type(2)));
typedef __bf16 nbf16x4 __attribute__((ext_vector_type(4)));
typedef __bf16 nbf16x8 __attribute__((ext_vector_type(8)));
typedef float f32x2_t __attribute__((ext_vector_type(2)));
typedef float f32x8_t __attribute__((ext_vector_type(8)));
__device__ __forceinline__ unsigned pk2bf(float lo, float hi) { f32x2_t v = {lo, hi}; return __builtin_bit_cast(unsigned, __builtin_convertvector(v, nbf16x2)); }
__device__ __forceinline__ float bflo(unsigned w) { return __builtin_bit_cast(float, w << 16); }
__device__ __forceinline__ float bfhi(unsigned w) { return __builtin_bit_cast(float, w & 0xffff0000u); }
namespace pg8 {
#define PG8_LAS __attribute__((address_space(3)))
typedef unsigned short bf16_t;
typedef short bf16x8 __attribute__((ext_vector_type(8)));
typedef float f32x4 __attribute__((ext_vector_type(4)));
typedef unsigned u32x4 __attribute__((ext_vector_type(4)));
typedef int i32x4_t __attribute__((ext_vector_type(4)));
constexpr int BM = 256, BK = 64, HALF = 128, HTB = HALF * BK * 2  , STAGE_BYTES = 8 * HTB, NXCD = 8;
#ifndef PG8_WGM
#define PG8_WGM 8
#endif
#ifndef PG8_WGM_G
#define PG8_WGM_G 8
#endif
constexpr int WGM = PG8_WGM, WGM_G = PG8_WGM_G;

__host__ __device__ __forceinline__ int lds_byte(int r, int c) { const int st = (r >> 4) * 2 + (c >> 5), rr = r & 15, cc = c & 31, ob = rr * 64 + cc * 2; return st * 1024 + (ob ^ (((ob >> 9) & 1) << 5)); }
__host__ __device__ __forceinline__ void stage_rc(int b, int& R, int& C) { const int st = b / 1024, sb = b % 1024, swz = sb ^ (((sb >> 9) & 1) << 5); R = (st >> 1) * 16 + swz / 64; C = (st & 1) * 32 + (swz % 64) / 2; }
__host__ __device__ __forceinline__ int perm32(int rho) { const int n = rho >> 4, i = rho & 15; return 8 * (i >> 2) + 4 * n + (i & 3); }

struct Unit { int pm, pn; };
struct Gemm { const bf16_t* A; const bf16_t* Bt; int M, N, K; };

struct StaticOrder {
    int nM, nN, nwg, G, c;
    __host__ __device__ void init(int M, int N, int G_, int c_) { nM = M / BM; nN = N / BM; nwg = nM * nN; G = G_; c = c_; }
    __host__ __device__ bool next(int i, Unit& u) const {
        const long L = (long)i * G + c; if (L >= nwg) return false;
        int wgid = (int)L; { const int q = nwg / NXCD, r = nwg % NXCD, xcd = wgid % NXCD, off = wgid / NXCD; wgid = (xcd < r ? xcd * (q + 1) : r * (q + 1) + (xcd - r) * q) + off; }
        const int nig = WGM * nN, gid = wgid / nig, fm = gid * WGM, gsz = (nM - fm) < WGM ? (nM - fm) : WGM;
        u.pm = fm + ((wgid % nig) % gsz); u.pn = (wgid % nig) / gsz; return true;
    }
    __device__ __forceinline__ void a_ready(const Unit&) const {}
    __device__ __forceinline__ void done(const Unit&) const {}
};

struct GroupedOrder {
    int nMg, nNg, upg, ntot, G, c;
    __host__ __device__ void init(int ngrp, int nMg_, int nNg_, int G_, int c_) { nMg = nMg_; nNg = nNg_; upg = nMg * nNg; ntot = ngrp * upg; G = G_; c = c_; }
    __host__ __device__ bool next(int i, Unit& u) const {
        const long L = (long)i * G + c; if (L >= ntot) return false;
        const int e = (int)(L / upg); int wgid = (int)(L % upg);
        { const int q = upg / NXCD, r = upg % NXCD, xcd = wgid % NXCD, off = wgid / NXCD; wgid = (xcd < r ? xcd * (q + 1) : r * (q + 1) + (xcd - r) * q) + off; }
        const int nig = WGM_G * nNg, gid = wgid / nig, fm = gid * WGM_G, gsz = (nMg - fm) < WGM_G ? (nMg - fm) : WGM_G;
        u.pm = e * nMg + fm + ((wgid % nig) % gsz); u.pn = e * nNg + (wgid % nig) / gsz; return true;
    }
    __device__ __forceinline__ void a_ready(const Unit&) const {}
    __device__ __forceinline__ void done(const Unit&) const {}
};

#ifndef EPI_NT
#define EPI_NT 0
#endif
#if EPI_NT
#define EPI_ST(ptr, val) __builtin_nontemporal_store((val), (ptr))
#else
#define EPI_ST(ptr, val) (*(ptr) = (val))
#endif
#ifndef EPI_NT_B
#define EPI_NT_B 0
#endif
#if EPI_NT_B
#define EPI_ST_B(ptr, val) __builtin_nontemporal_store((val), (ptr))
#else
#define EPI_ST_B(ptr, val) (*(ptr) = (val))
#endif
__device__ __forceinline__ u32x4 pack8(const f32x4 a, const f32x4 b) { u32x4 w; w.x = pk2bf(a[0], a[1]); w.y = pk2bf(a[2], a[3]); w.z = pk2bf(b[0], b[1]); w.w = pk2bf(b[2], b[3]); return w; }
__device__ __forceinline__ void unpack8(const u32x4 w, f32x4& a, f32x4& b) { a = (f32x4){bflo(w.x), bfhi(w.x), bflo(w.y), bfhi(w.y)}; b = (f32x4){bflo(w.z), bfhi(w.z), bflo(w.w), bfhi(w.w)}; }
typedef unsigned u32x2 __attribute__((ext_vector_type(2)));
__device__ __forceinline__ unsigned pk4f8u(const f32x4 v) { int w = __builtin_amdgcn_cvt_pk_fp8_f32(v[0], v[1], 0, false); w = __builtin_amdgcn_cvt_pk_fp8_f32(v[2], v[3], w, true); return (unsigned)w; }
__device__ __forceinline__ float sigmoidf_fast(float x) { return __builtin_amdgcn_rcpf(1.0f + __builtin_amdgcn_exp2f(-1.4426950408889634f * x)); }

__device__ __forceinline__ size_t gate_blk(int pm, int pn, int wave, int ai, int m, int bj, int lane) { return ((size_t)(((pm * 4 + pn) * 8 + wave) * 16 + (ai * 8 + m * 2 + bj)) * 64 + lane) * 8; }
__device__ __forceinline__ u32x4 xchg_pair(const u32x4 v) { u32x4 r;
#pragma unroll
    for (int w = 0; w < 4; ++w) r[w] = (unsigned)__builtin_amdgcn_mov_dpp((int)v[w], 0xB1, 0xF, 0xF, true);
    return r; }
__device__ __forceinline__ void wide_pair(const u32x4 p0, const u32x4 p1, bool odd, u32x4& a, u32x4& b) {
    const u32x4 recv = xchg_pair(odd ? p0 : p1); a = odd ? recv : p0; b = odd ? p1 : recv; }
struct EpiInProj {
    static constexpr bool PERM = true, AFTER_DRAIN = false, WIDE = true, ROWSCALE = true; static constexpr int F8_SW = 0, F8_SA = 0;
    bf16_t *qa, *ka, *va, *qw, *kw, *vw, *gr, *g1; const float* bgate; float qscale;
    const float* rsv; mutable float rs0, rs1;
    __device__ __forceinline__ float row_rs(int ai, int m, int fr) const { return __builtin_bit_cast(float, __builtin_amdgcn_ds_bpermute((fr + 16 * m) << 2, __builtin_bit_cast(int, ai ? rs1 : rs0))); }
    __device__ __forceinline__ void operator()(const f32x4 (&acc)[2][2][4][2], const Unit& u, int wr, int wc, int fr, int fq) const {
        const int pn = u.pn; const int row0 = u.pm * BM + wr * 64 + fr;
        if (pn >= 15) {
            const int cc0 = (pn - 15) * HALF + wc * 32 + 8 * fq;
            f32x4 b0[2], b1[2];
#pragma unroll
            for (int n = 0; n < 2; ++n) { b0[n] = *(const f32x4*)(bgate + cc0 + 4 * n); b1[n] = *(const f32x4*)(bgate + 1024 + cc0 + 4 * n); }
#pragma unroll
            for (int ai = 0; ai < 2; ++ai)
#pragma unroll
                for (int m = 0; m < 4; ++m) { const size_t off = gate_blk(u.pm, (pn - 15) >> 1, wr * 4 + wc, ai, m, (pn - 15) & 1, fq * 16 + fr); f32x4 rr[2], gg[2]; const float rs = row_rs(ai, m, fr);
#pragma unroll
                    for (int n = 0; n < 2; ++n)
#pragma unroll
                        for (int j = 0; j < 4; ++j) { float a0 = acc[ai][0][m][n][j] * rs + b0[n][j], a1 = acc[ai][1][m][n][j] * rs + b1[n][j];
                            a0 = fminf(fmaxf(a0, -30.f), 30.f); a1 = fminf(fmaxf(a1, -30.f), 30.f);
                            const float e0 = __builtin_amdgcn_exp2f(-1.4426950408889634f * a0), e1 = __builtin_amdgcn_exp2f(-1.4426950408889634f * a1);
                            gg[n][j] = __builtin_amdgcn_rcpf(1.0f + e1); rr[n][j] = (1.0f + e1) * __builtin_amdgcn_rcpf(1.0f + e0); }
                    EPI_ST_B((u32x4*)(gr + off), pack8(rr[0], rr[1])); EPI_ST_B((u32x4*)(g1 + off), pack8(gg[0], gg[1])); }
            return;
        }
        bf16_t* base; int ldc, ct; float sc = 1.0f;
        if (pn < 3) { base = qa; ldc = 768; ct = pn; sc = qscale; }
        else if (pn < 6) { base = ka; ldc = 768; ct = pn - 3; }
        else if (pn < 9) { base = va; ldc = 768; ct = pn - 6; }
        else if (pn < 13) { base = qw; ldc = 1024; ct = pn - 9; sc = qscale; }
        else if (pn == 13) { base = kw; ldc = 256; ct = 0; }
        else { base = vw; ldc = 256; ct = 0; }
        const bool odd = (fr & 1) != 0;
        const int col0 = ct * BM + wc * 64 + 8 * fq + (odd ? 32 : 0);
#pragma unroll
        for (int ai = 0; ai < 2; ++ai)
#pragma unroll
            for (int m = 0; m < 4; ++m) { bf16_t* rowp = base + (size_t)(row0 - (odd ? 1 : 0) + ai * HALF + m * 16) * ldc + col0;
                const float s2 = sc * row_rs(ai, m, fr);
                u32x4 a, b; wide_pair(pack8(acc[ai][0][m][0] * s2, acc[ai][0][m][1] * s2), pack8(acc[ai][1][m][0] * s2, acc[ai][1][m][1] * s2), odd, a, b);
                EPI_ST_B((u32x4*)rowp, a); EPI_ST_B((u32x4*)(rowp + ldc), b); }
    }
};
struct EpiMergeDual {
    static constexpr bool PERM = true, AFTER_DRAIN = false, WIDE = true, ROWSCALE = false; static constexpr int F8_SW = 0, F8_SA = 0;
    bf16_t* merged; const bf16_t* gr; const bf16_t* g1;
    __device__ __forceinline__ size_t gblk(const Unit& u, int wr, int wc, int ai, int m, int bj, int fr, int fq) const { return gate_blk(u.pm, u.pn, wr * 4 + 2 * (wc & 1) + bj, ai, m, wc >> 1, fq * 16 + fr); }
    __device__ __forceinline__ void mid(f32x4 (&acc)[2][2][4][2], const Unit& u, int wr, int wc, int fr, int fq) const {
        u32x4 w[2][4][2];
#pragma unroll
        for (int ai = 0; ai < 2; ++ai)
#pragma unroll
            for (int m = 0; m < 4; ++m) {
#pragma unroll
                for (int bj = 0; bj < 2; ++bj) w[ai][m][bj] = *(const u32x4*)(gr + gblk(u, wr, wc, ai, m, bj, fr, fq)); }
        asm volatile("" ::: "memory");
#pragma unroll
        for (int ai = 0; ai < 2; ++ai)
#pragma unroll
            for (int m = 0; m < 4; ++m) {
#pragma unroll
                for (int bj = 0; bj < 2; ++bj) { f32x4 r0, r1; unpack8(w[ai][m][bj], r0, r1); acc[ai][bj][m][0] *= r0; acc[ai][bj][m][1] *= r1; } }
    }
    __device__ __forceinline__ void operator()(const f32x4 (&acc)[2][2][4][2], const Unit& u, int wr, int wc, int fr, int fq) const {
        const bool odd = (fr & 1) != 0;
        const int rowe = u.pm * BM + wr * 64 + (fr & ~1), col = u.pn * BM + wc * 64 + 8 * fq + (odd ? 32 : 0);
        u32x4 w[2][4][2];
#pragma unroll
        for (int ai = 0; ai < 2; ++ai)
#pragma unroll
            for (int m = 0; m < 4; ++m) {
#pragma unroll
                for (int bj = 0; bj < 2; ++bj) w[ai][m][bj] = *(const u32x4*)(g1 + gblk(u, wr, wc, ai, m, bj, fr, fq)); }
        asm volatile("" ::: "memory");
#pragma unroll
        for (int ai = 0; ai < 2; ++ai)
#pragma unroll
            for (int m = 0; m < 4; ++m) { f32x4 a0, a1, c0, c1; unpack8(w[ai][m][0], a0, a1); unpack8(w[ai][m][1], c0, c1);
                u32x4 a, b; wide_pair(pack8(acc[ai][0][m][0] * a0, acc[ai][0][m][1] * a1), pack8(acc[ai][1][m][0] * c0, acc[ai][1][m][1] * c1), odd, a, b);
                bf16_t* p = merged + (size_t)(rowe + ai * HALF + m * 16) * 1024 + col;
                EPI_ST((u32x4*)p, a); EPI_ST((u32x4*)(p + 1024), b); }
    }
};
struct EpiResid {
    static constexpr bool PERM = true, AFTER_DRAIN = false, WIDE = true, ROWSCALE = false; static constexpr int F8_SW = 0, F8_SA = 0;
    const bf16_t* base; bf16_t* out;
    __device__ __forceinline__ void operator()(const f32x4 (&acc)[2][2][4][2], const Unit& u, int wr, int wc, int fr, int fq) const {
        const bool odd = (fr & 1) != 0;
        const int rowe = u.pm * BM + wr * 64 + (fr & ~1), col = u.pn * BM + wc * 64 + 8 * fq + (odd ? 32 : 0);
        u32x4 la[2][4], lb[2][4];
#pragma unroll
        for (int ai = 0; ai < 2; ++ai)
#pragma unroll
            for (int m = 0; m < 4; ++m) { const bf16_t* p = base + (size_t)(rowe + ai * HALF + m * 16) * 1024 + col; la[ai][m] = *(const u32x4*)p; lb[ai][m] = *(const u32x4*)(p + 1024); }
        asm volatile("" ::: "memory");
#pragma unroll
        for (int ai = 0; ai < 2; ++ai)
#pragma unroll
            for (int m = 0; m < 4; ++m) {
                const u32x4 recv = xchg_pair(odd ? la[ai][m] : lb[ai][m]); const u32x4 r0 = odd ? recv : la[ai][m], r1 = odd ? lb[ai][m] : recv;
                f32x4 b0, b1, c0, c1; unpack8(r0, b0, b1); unpack8(r1, c0, c1);
                u32x4 a, b; wide_pair(pack8(b0 + acc[ai][0][m][0], b1 + acc[ai][0][m][1]), pack8(c0 + acc[ai][1][m][0], c1 + acc[ai][1][m][1]), odd, a, b);
                bf16_t* p = out + (size_t)(rowe + ai * HALF + m * 16) * 1024 + col;
                EPI_ST((u32x4*)p, a); EPI_ST((u32x4*)(p + 1024), b); }
    }
};
struct EpiSwiGLU {
    static constexpr bool PERM = true, AFTER_DRAIN = false, WIDE = false, ROWSCALE = false; static constexpr int F8_SW = 0, F8_SA = 0;
    unsigned char* act; const PG8_LAS int* arow; mutable int ui;
    __device__ __forceinline__ void operator()(const f32x4 (&acc)[2][2][4][2], const Unit& u, int wr, int wc, int fr, int fq) const {
        const int row0 = u.pm * BM + wr * 64 + fr, col0 = (u.pn & 7) * HALF + wc * 32 + 8 * fq;
#pragma unroll
        for (int ai = 0; ai < 2; ++ai)
#pragma unroll
            for (int m = 0; m < 4; ++m) { f32x4 o[2];
                const float rs = (float)__builtin_bit_cast(_Float16, (unsigned short)((unsigned)arow[ui * 256 + wr * 64 + fr + ai * HALF + m * 16] >> 16));
#pragma unroll
                for (int n = 0; n < 2; ++n)
#pragma unroll
                    for (int j = 0; j < 4; ++j) { const float a = acc[ai][0][m][n][j] * rs, up = acc[ai][1][m][n][j] * rs; o[n][j] = fminf(fmaxf(8.0f * a * sigmoidf_fast(a) * up, -440.f), 440.f); }
                u32x2 w8; w8.x = pk4f8u(o[0]); w8.y = pk4f8u(o[1]);
                *(u32x2*)(act + (size_t)(row0 + ai * HALF + m * 16) * 1024 + col0) = w8; }
        ++ui;
    }
};
struct EpiDown {
    static constexpr bool PERM = true, AFTER_DRAIN = false, WIDE = true, ROWSCALE = false; static constexpr int F8_SW = 0, F8_SA = 0;
    bf16_t* y; const PG8_LAS float* glds; mutable int ui;
    __device__ __forceinline__ void operator()(const f32x4 (&acc)[2][2][4][2], const Unit& u, int wr, int wc, int fr, int fq) const {
        const bool odd = (fr & 1) != 0;
        const int rowe = u.pm * BM + wr * 64 + (fr & ~1), col = (u.pn & 3) * BM + wc * 64 + 8 * fq + (odd ? 32 : 0);
#pragma unroll
        for (int ai = 0; ai < 2; ++ai)
#pragma unroll
            for (int m = 0; m < 4; ++m) { const float gv = glds[ui * 256 + wr * 64 + fr + ai * HALF + m * 16] * (1.0f / 512.0f);
                u32x4 a, b; wide_pair(pack8(acc[ai][0][m][0] * gv, acc[ai][0][m][1] * gv), pack8(acc[ai][1][m][0] * gv, acc[ai][1][m][1] * gv), odd, a, b);
                bf16_t* p = y + (size_t)(rowe + ai * HALF + m * 16) * 1024 + col;
                EPI_ST((u32x4*)p, a); EPI_ST((u32x4*)(p + 1024), b); }
        ++ui;
    }
};

template <class Epi, class Sched, bool ALIGN_EPI = false, bool SP2 = false, bool GATHER = false, bool FP8 = false>
__device__ __forceinline__ void gemm_phase(int tid_, PG8_LAS unsigned char* lds, const Gemm g, const Sched& S, const Epi& E, const PG8_LAS int* arow = nullptr) {
    static_assert(!GATHER || SP2, "GATHER is written for the SP2 loop");
    asm volatile("" : "+v"(tid_));
    const int tid = tid_, wid = __builtin_amdgcn_readfirstlane(tid >> 6), lane = tid & 63, wr = wid >> 2, wc = wid & 3, fr = lane & 15, fq = lane >> 4;
    const int K = g.K, nt = K / BK;
    unsigned voffA[2], voffB[2];
#pragma unroll
    for (int i = 0; i < 2; ++i) { int R, C; stage_rc(tid * 16 + i * 8192, R, C); const int Rb = Epi::WIDE ? ((R >> 5) * 64 + perm32(R & 31)) : (Epi::PERM ? ((R & ~31) + perm32(R & 31)) : R);
        voffA[i] = (unsigned)(R * K + C) * 2u; voffB[i] = (unsigned)(Rb * K + C) * 2u; }
    unsigned vA0[2] = {voffA[0], voffA[1]}, vA1[2] = {voffA[0], voffA[1]}, nA0[2] = {voffA[0], voffA[1]}, nA1[2] = {voffA[0], voffA[1]};
    int gR[2], gC[2];
#pragma unroll
    for (int i = 0; i < 2; ++i) { stage_rc(tid * 16 + i * 8192, gR[i], gC[i]); }
#define PG8_GOFF(dst0, dst1, u_) do { _Pragma("unroll") for (int _i = 0; _i < 2; ++_i) { \
        dst0[_i] = (((unsigned)arow[(u_) * 256 + gR[_i]] & 0xffffu) * (unsigned)K + (unsigned)gC[_i]) * 2u; dst1[_i] = (((unsigned)arow[(u_) * 256 + HALF + gR[_i]] & 0xffffu) * (unsigned)K + (unsigned)gC[_i]) * 2u; } } while (0)
    const size_t kstep = (size_t)(BK * 2);
    const size_t hstep = (size_t)HALF * K * 2;
    const size_t tstep = 2 * hstep;
    const size_t bhs = Epi::WIDE ? (size_t)32 * K * 2 : hstep;
    const size_t ahs = GATHER ? (size_t)0 : hstep, atstep = GATHER ? (size_t)0 : tstep;
    const unsigned ldsw = (unsigned)wid * 1024u;
    const int aoff = lds_byte(wr * 64 + fr, fq * 8), boff = lds_byte(wc * 32 + fr, fq * 8);
#define PG8_SA(b, h) (((b) * 2 + (h)) * HTB)
#define PG8_SB(b, h) ((4 + (b) * 2 + (h)) * HTB)
#define PG8_STAGE(bufoff, gbase, voff) do { _Pragma("unroll") for (int _i = 0; _i < 2; ++_i) \
        __builtin_amdgcn_global_load_lds((const unsigned*)((const char*)(gbase) + (voff)[_i]), (PG8_LAS unsigned*)(lds + (bufoff) + ldsw + _i * 8192), 16, 0, 0); } while (0)
#define PG8_LDA(dst, b, h) do { _Pragma("unroll") for (int m = 0; m < 4; ++m) _Pragma("unroll") for (int k = 0; k < 2; ++k) dst[m][k] = *(const PG8_LAS bf16x8*)(lds + PG8_SA(b, h) + aoff + m * 2048 + k * 1024); } while (0)
#define PG8_LDB(dst, b, h) do { _Pragma("unroll") for (int n = 0; n < 2; ++n) _Pragma("unroll") for (int k = 0; k < 2; ++k) dst[n][k] = *(const PG8_LAS bf16x8*)(lds + PG8_SB(b, h) + boff + n * 2048 + k * 1024); } while (0)
#define PG8_CAT8(x0, x1) __builtin_shufflevector(__builtin_bit_cast(i32x4_t, (x0)), __builtin_bit_cast(i32x4_t, (x1)), 0, 1, 2, 3, 4, 5, 6, 7)
#define PG8_MMA(ai, bj, At, Bt) do { __builtin_amdgcn_s_setprio(1); \
        if constexpr (FP8) { _Pragma("unroll") for (int m = 0; m < 4; ++m) _Pragma("unroll") for (int n = 0; n < 2; ++n) \
            asm volatile("v_mfma_f32_16x16x128_f8f6f4 %0, %1, %2, %0" : "+v"(acc[ai][bj][m][n]) : "v"(PG8_CAT8(Bt[n][0], Bt[n][1])), "v"(PG8_CAT8(At[m][0], At[m][1]))); } \
        else { _Pragma("unroll") for (int m = 0; m < 4; ++m) _Pragma("unroll") for (int n = 0; n < 2; ++n) _Pragma("unroll") for (int k = 0; k < 2; ++k) \
            acc[ai][bj][m][n] = __builtin_amdgcn_mfma_f32_16x16x32_bf16(Bt[n][k], At[m][k], acc[ai][bj][m][n], 0, 0, 0); } \
        __builtin_amdgcn_s_setprio(0); } while (0)
#define PG8_WAIT_V(n) asm volatile("s_waitcnt vmcnt(" #n ")" ::: "memory")
#define PG8_WAIT_L(n) asm volatile("s_waitcnt lgkmcnt(" #n ")" ::: "memory")
#define PG8_BAR __builtin_amdgcn_s_barrier()
#define PG8_SCHED __builtin_amdgcn_sched_barrier(0)
    Unit cur, nxt; int ui = 0;
    if (!S.next(0, cur)) return;
    f32x4 acc[2][2][4][2];
#pragma unroll
    for (int a = 0; a < 2; ++a)
#pragma unroll
        for (int b = 0; b < 2; ++b)
#pragma unroll
            for (int m = 0; m < 4; ++m)
#pragma unroll
                for (int n = 0; n < 2; ++n) acc[a][b][m][n] = (f32x4){0.f, 0.f, 0.f, 0.f};
    bf16x8 At[4][2], B0[2][2], B1[2][2];
    const char* cA = (const char*)g.A + (size_t)cur.pm * atstep; const char* cB = (const char*)g.Bt + (size_t)cur.pn * tstep;
    if constexpr (GATHER) { PG8_GOFF(vA0, vA1, 0); }
    S.a_ready(cur);
    if constexpr (SP2) {
        PG8_STAGE(PG8_SB(0, 0), cB, voffB); PG8_STAGE(PG8_SB(0, 1), cB + bhs, voffB); PG8_STAGE(PG8_SA(0, 0), cA, vA0); PG8_STAGE(PG8_SA(0, 1), cA + ahs, vA1);
        if (wr == 1) PG8_BAR;
        PG8_WAIT_V(2); PG8_BAR;
        PG8_STAGE(PG8_SB(1, 0), cB + kstep, voffB); PG8_STAGE(PG8_SA(1, 0), cA + kstep, vA0); PG8_STAGE(PG8_SB(1, 1), cB + bhs + kstep, voffB);
        PG8_WAIT_V(6); PG8_BAR;
    } else {
        PG8_STAGE(PG8_SB(0, 0), cB, voffB); PG8_STAGE(PG8_SA(0, 0), cA, voffA); PG8_STAGE(PG8_SB(0, 1), cB + bhs, voffB); PG8_STAGE(PG8_SA(0, 1), cA + hstep, voffA);
        if (wr == 1) PG8_BAR;
        PG8_WAIT_V(4); PG8_BAR;
        PG8_STAGE(PG8_SB(1, 0), cB + kstep, voffB); PG8_STAGE(PG8_SA(1, 0), cA + kstep, voffA); PG8_STAGE(PG8_SB(1, 1), cB + bhs + kstep, voffB);
        PG8_WAIT_V(6); PG8_BAR;
    }
    for (;;) {
        const bool has_next = S.next(ui + 1, nxt);
        const char* nA = has_next ? (const char*)g.A + (size_t)nxt.pm * atstep : cA; const char* nB = has_next ? (const char*)g.Bt + (size_t)nxt.pn * tstep : cB;
#pragma unroll 1
        for (int t = 0; t < nt; t += 2) {
            const bool last = (t == nt - 2);
            const char* a1 = cA + (size_t)(t + 1) * kstep;
            const char* a2 = last ? nA : cA + (size_t)(t + 2) * kstep; const char* b2 = last ? nB : cB + (size_t)(t + 2) * kstep;
            const char* a3 = a2 + kstep; const char* b3 = b2 + kstep;
            if (last && has_next) S.a_ready(nxt);
            if constexpr (Epi::ROWSCALE) { if (last) { E.rs0 = E.rsv[cur.pm * BM + wr * 64 + lane]; E.rs1 = E.rsv[cur.pm * BM + HALF + wr * 64 + lane]; } }
            unsigned s0[2] = {vA0[0], vA0[1]}, s1[2] = {vA1[0], vA1[1]};
            if constexpr (GATHER) { if (last && has_next) { PG8_GOFF(nA0, nA1, ui + 1); s0[0] = nA0[0]; s0[1] = nA0[1]; s1[0] = nA1[0]; s1[1] = nA1[1]; } }
            if constexpr (SP2) {
            PG8_LDB(B0, 0, 0); PG8_LDB(B1, 0, 1); PG8_SCHED; PG8_LDA(At, 0, 0); PG8_STAGE(PG8_SA(1, 1), a1 + ahs, vA1);
            PG8_WAIT_V(8); PG8_WAIT_L(0); PG8_BAR; PG8_MMA(0, 0, At, B0); PG8_MMA(0, 1, At, B1); PG8_BAR; PG8_SCHED;
            PG8_LDA(At, 0, 1); PG8_STAGE(PG8_SB(0, 0), b2, voffB); PG8_STAGE(PG8_SB(0, 1), b2 + bhs, voffB); PG8_STAGE(PG8_SA(0, 0), a2, s0);
            PG8_WAIT_V(8); PG8_WAIT_L(0); PG8_BAR; PG8_MMA(1, 0, At, B0); PG8_MMA(1, 1, At, B1); PG8_BAR; PG8_SCHED;
            PG8_LDB(B0, 1, 0); PG8_LDB(B1, 1, 1); PG8_SCHED; PG8_LDA(At, 1, 0); PG8_STAGE(PG8_SA(0, 1), a2 + ahs, s1);
            PG8_WAIT_V(8); PG8_WAIT_L(0); PG8_BAR; PG8_MMA(0, 0, At, B0); PG8_MMA(0, 1, At, B1); PG8_BAR; PG8_SCHED;
            PG8_LDA(At, 1, 1); PG8_STAGE(PG8_SB(1, 0), b3, voffB); PG8_STAGE(PG8_SB(1, 1), b3 + bhs, voffB); PG8_STAGE(PG8_SA(1, 0), a3, s0);
            PG8_WAIT_V(8); PG8_WAIT_L(0); PG8_BAR; PG8_MMA(1, 0, At, B0); PG8_MMA(1, 1, At, B1); PG8_BAR; PG8_SCHED;
            } else {
            PG8_LDB(B0, 0, 0); PG8_SCHED; PG8_LDA(At, 0, 0); PG8_STAGE(PG8_SA(1, 1), a1 + hstep, voffA);
            PG8_WAIT_L(8); PG8_BAR; PG8_WAIT_L(0); PG8_MMA(0, 0, At, B0); PG8_BAR; PG8_SCHED;
            PG8_LDB(B1, 0, 1); PG8_STAGE(PG8_SB(0, 0), b2, voffB);
            PG8_BAR; PG8_WAIT_L(0); PG8_MMA(0, 1, At, B1); PG8_BAR;
            PG8_LDA(At, 0, 1); PG8_STAGE(PG8_SA(0, 0), a2, voffA);
            PG8_BAR; PG8_WAIT_L(0); PG8_MMA(1, 0, At, B0); PG8_BAR; PG8_SCHED;
            PG8_STAGE(PG8_SB(0, 1), b2 + bhs, voffB);
            PG8_WAIT_V(6); PG8_BAR; PG8_MMA(1, 1, At, B1); PG8_BAR;
            PG8_LDB(B0, 1, 0); PG8_SCHED; PG8_LDA(At, 1, 0); PG8_STAGE(PG8_SA(0, 1), a2 + hstep, voffA);
            PG8_WAIT_L(8); PG8_BAR; PG8_WAIT_L(0); PG8_MMA(0, 0, At, B0); PG8_BAR; PG8_SCHED;
            PG8_LDB(B1, 1, 1); PG8_STAGE(PG8_SB(1, 0), b3, voffB);
            PG8_BAR; PG8_WAIT_L(0); PG8_MMA(0, 1, At, B1); PG8_BAR;
            PG8_LDA(At, 1, 1); PG8_STAGE(PG8_SA(1, 0), a3, voffA);
            PG8_BAR; PG8_WAIT_L(0); PG8_MMA(1, 0, At, B0); PG8_BAR; PG8_SCHED;
            PG8_STAGE(PG8_SB(1, 1), b3 + bhs, voffB);
            PG8_WAIT_V(6); PG8_BAR; PG8_MMA(1, 1, At, B1); PG8_BAR;
            }
        }
        if constexpr (ALIGN_EPI) { if (wr == 0) PG8_BAR; }
        if constexpr (FP8) asm volatile("s_nop 15\n\ts_nop 15" ::: "memory");
        if constexpr (!Epi::AFTER_DRAIN) { E(acc, cur, wr, wc, fr, fq); S.done(cur); }
        if (!has_next) break;
#pragma unroll
        for (int a = 0; a < 2; ++a)
#pragma unroll
            for (int b = 0; b < 2; ++b)
#pragma unroll
                for (int m = 0; m < 4; ++m)
#pragma unroll
                    for (int n = 0; n < 2; ++n) acc[a][b][m][n] = (f32x4){0.f, 0.f, 0.f, 0.f};
        cur = nxt; cA = nA; cB = nB; ++ui;
        if constexpr (GATHER) { vA0[0] = nA0[0]; vA0[1] = nA0[1]; vA1[0] = nA1[0]; vA1[1] = nA1[1]; }
        if constexpr (ALIGN_EPI) { if (wr == 1) PG8_BAR; }
    }
    PG8_WAIT_V(0);
    if constexpr (!ALIGN_EPI) { if (wr == 0) PG8_BAR; }
    PG8_BAR;
    if constexpr (Epi::AFTER_DRAIN) { E.fused(acc, cur, wr, wc, fr, fq, lds, wid, lane); S.done(cur); }
#undef PG8_SA
#undef PG8_SB
#undef PG8_STAGE
#undef PG8_LDA
#undef PG8_LDB
#undef PG8_MMA
#undef PG8_CAT8
#undef PG8_WAIT_V
#undef PG8_WAIT_L
#undef PG8_BAR
#undef PG8_SCHED
#undef PG8_GOFF
}

template <class Epi, class Sched>
__device__ __forceinline__ void gemm_phase_dual(int tid_, PG8_LAS unsigned char* lds, const Gemm g0, const Gemm g1, const Sched& S, const Epi& E) {
    asm volatile("" : "+v"(tid_));
    const int tid = tid_, wid = __builtin_amdgcn_readfirstlane(tid >> 6), lane = tid & 63, wr = wid >> 2, wc = wid & 3, fr = lane & 15, fq = lane >> 4;
    unsigned vA_0[2], vB_0[2], vA_1[2], vB_1[2];
#pragma unroll
    for (int i = 0; i < 2; ++i) { int R, C; stage_rc(tid * 16 + i * 8192, R, C); const int Rb = Epi::WIDE ? ((R >> 5) * 64 + perm32(R & 31)) : (Epi::PERM ? ((R & ~31) + perm32(R & 31)) : R);
        vA_0[i] = (unsigned)(R * g0.K + C) * 2u; vB_0[i] = (unsigned)(Rb * g0.K + C) * 2u; vA_1[i] = (unsigned)(R * g1.K + C) * 2u; vB_1[i] = (unsigned)(Rb * g1.K + C) * 2u; }
    const size_t kstep = (size_t)(BK * 2);
    const size_t hs_0 = (size_t)HALF * g0.K * 2, hs_1 = (size_t)HALF * g1.K * 2;
#define PG8_BH(x) (Epi::WIDE ? (x) / 4 : (x))
    const int nt_0 = g0.K / BK, nt_1 = g1.K / BK;
    const unsigned ldsw = (unsigned)wid * 1024u;
    const int aoff = lds_byte(wr * 64 + fr, fq * 8), boff = lds_byte(wc * 32 + fr, fq * 8);
#define PG8_SA(b, h) (((b) * 2 + (h)) * HTB)
#define PG8_SB(b, h) ((4 + (b) * 2 + (h)) * HTB)
#define PG8_STAGE(bufoff, gbase, voff) do { _Pragma("unroll") for (int _i = 0; _i < 2; ++_i) \
        __builtin_amdgcn_global_load_lds((const unsigned*)((const char*)(gbase) + (voff)[_i]), (PG8_LAS unsigned*)(lds + (bufoff) + ldsw + _i * 8192), 16, 0, 0); } while (0)
#define PG8_LDA(dst, b, h) do { _Pragma("unroll") for (int m = 0; m < 4; ++m) _Pragma("unroll") for (int k = 0; k < 2; ++k) dst[m][k] = *(const PG8_LAS bf16x8*)(lds + PG8_SA(b, h) + aoff + m * 2048 + k * 1024); } while (0)
#define PG8_LDB(dst, b, h) do { _Pragma("unroll") for (int n = 0; n < 2; ++n) _Pragma("unroll") for (int k = 0; k < 2; ++k) dst[n][k] = *(const PG8_LAS bf16x8*)(lds + PG8_SB(b, h) + boff + n * 2048 + k * 1024); } while (0)
#define PG8_MMA(ai, bj, At, Bt) do { __builtin_amdgcn_s_setprio(1); _Pragma("unroll") for (int m = 0; m < 4; ++m) _Pragma("unroll") for (int n = 0; n < 2; ++n) _Pragma("unroll") for (int k = 0; k < 2; ++k) \
        acc[ai][bj][m][n] = __builtin_amdgcn_mfma_f32_16x16x32_bf16(Bt[n][k], At[m][k], acc[ai][bj][m][n], 0, 0, 0); __builtin_amdgcn_s_setprio(0); } while (0)
#define PG8_WAIT_V(n) asm volatile("s_waitcnt vmcnt(" #n ")" ::: "memory")
#define PG8_WAIT_L(n) asm volatile("s_waitcnt lgkmcnt(" #n ")" ::: "memory")
#define PG8_BAR __builtin_amdgcn_s_barrier()
#define PG8_SCHED __builtin_amdgcn_sched_barrier(0)
    Unit cur, nxt; int ui = 0, s = 0;
    if (!S.next(0, cur)) return;
    f32x4 acc[2][2][4][2];
#pragma unroll
    for (int a = 0; a < 2; ++a)
#pragma unroll
        for (int b = 0; b < 2; ++b)
#pragma unroll
            for (int m = 0; m < 4; ++m)
#pragma unroll
                for (int n = 0; n < 2; ++n) acc[a][b][m][n] = (f32x4){0.f, 0.f, 0.f, 0.f};
    bf16x8 At[4][2], B0[2][2], B1[2][2];
    const char* cA = (const char*)g0.A + (size_t)cur.pm * 2 * hs_0; const char* cB = (const char*)g0.Bt + (size_t)cur.pn * 2 * hs_0;
    size_t hsC = hs_0; unsigned vAc[2] = {vA_0[0], vA_0[1]}, vBc[2] = {vB_0[0], vB_0[1]};
    PG8_STAGE(PG8_SB(0, 0), cB, vBc); PG8_STAGE(PG8_SB(0, 1), cB + PG8_BH(hsC), vBc); PG8_STAGE(PG8_SA(0, 0), cA, vAc); PG8_STAGE(PG8_SA(0, 1), cA + hsC, vAc);
    if (wr == 1) PG8_BAR;
    PG8_WAIT_V(2); PG8_BAR;
    PG8_STAGE(PG8_SB(1, 0), cB + kstep, vBc); PG8_STAGE(PG8_SA(1, 0), cA + kstep, vAc); PG8_STAGE(PG8_SB(1, 1), cB + PG8_BH(hsC) + kstep, vBc);
    PG8_WAIT_V(6); PG8_BAR;
    for (;;) {
        bool has_next = true; if (s == 1) has_next = S.next(ui + 1, nxt);
        const int npm = (s == 0) ? cur.pm : nxt.pm, npn = (s == 0) ? cur.pn : nxt.pn;
        const size_t hsN = has_next ? (s == 0 ? hs_1 : hs_0) : hsC;
        const char* nA = has_next ? (s == 0 ? (const char*)g1.A : (const char*)g0.A) + (size_t)npm * 2 * hsN : cA;
        const char* nB = has_next ? (s == 0 ? (const char*)g1.Bt : (const char*)g0.Bt) + (size_t)npn * 2 * hsN : cB;
        unsigned vAn[2], vBn[2];
#pragma unroll
        for (int i = 0; i < 2; ++i) { vAn[i] = has_next ? (s == 0 ? vA_1[i] : vA_0[i]) : vAc[i]; vBn[i] = has_next ? (s == 0 ? vB_1[i] : vB_0[i]) : vBc[i]; }
        const int nt = (s == 0) ? nt_0 : nt_1;
#pragma unroll 1
        for (int t = 0; t < nt; t += 2) {
            const bool last = (t == nt - 2);
            const char* a1 = cA + (size_t)(t + 1) * kstep;
            const char* a2 = last ? nA : cA + (size_t)(t + 2) * kstep; const char* b2 = last ? nB : cB + (size_t)(t + 2) * kstep;
            const char* a3 = a2 + kstep; const char* b3 = b2 + kstep;
            const size_t hs2 = last ? hsN : hsC;
            unsigned vA2[2], vB2[2];
#pragma unroll
            for (int i = 0; i < 2; ++i) { vA2[i] = last ? vAn[i] : vAc[i]; vB2[i] = last ? vBn[i] : vBc[i]; }
            PG8_LDB(B0, 0, 0); PG8_LDB(B1, 0, 1); PG8_SCHED; PG8_LDA(At, 0, 0); PG8_STAGE(PG8_SA(1, 1), a1 + hsC, vAc);
            PG8_WAIT_V(8); PG8_WAIT_L(0); PG8_BAR; PG8_MMA(0, 0, At, B0); PG8_MMA(0, 1, At, B1); PG8_BAR; PG8_SCHED;
            PG8_LDA(At, 0, 1); PG8_STAGE(PG8_SB(0, 0), b2, vB2); PG8_STAGE(PG8_SB(0, 1), b2 + PG8_BH(hs2), vB2); PG8_STAGE(PG8_SA(0, 0), a2, vA2);
            PG8_WAIT_V(8); PG8_WAIT_L(0); PG8_BAR; PG8_MMA(1, 0, At, B0); PG8_MMA(1, 1, At, B1); PG8_BAR; PG8_SCHED;
            PG8_LDB(B0, 1, 0); PG8_LDB(B1, 1, 1); PG8_SCHED; PG8_LDA(At, 1, 0); PG8_STAGE(PG8_SA(0, 1), a2 + hs2, vA2);
            PG8_WAIT_V(8); PG8_WAIT_L(0); PG8_BAR; PG8_MMA(0, 0, At, B0); PG8_MMA(0, 1, At, B1); PG8_BAR; PG8_SCHED;
            PG8_LDA(At, 1, 1); PG8_STAGE(PG8_SB(1, 0), b3, vB2); PG8_STAGE(PG8_SB(1, 1), b3 + PG8_BH(hs2), vB2); PG8_STAGE(PG8_SA(1, 0), a3, vA2);
            PG8_WAIT_V(8); PG8_WAIT_L(0); PG8_BAR; PG8_MMA(1, 0, At, B0); PG8_MMA(1, 1, At, B1); PG8_BAR; PG8_SCHED;
        }
        if (wr == 0) PG8_BAR;
        if (s == 0) E.mid(acc, cur, wr, wc, fr, fq); else E(acc, cur, wr, wc, fr, fq);
        if (!has_next) break;
        if (s == 1) {
#pragma unroll
            for (int a = 0; a < 2; ++a)
#pragma unroll
                for (int b = 0; b < 2; ++b)
#pragma unroll
                    for (int m = 0; m < 4; ++m)
#pragma unroll
                        for (int n = 0; n < 2; ++n) acc[a][b][m][n] = (f32x4){0.f, 0.f, 0.f, 0.f};
            cur = nxt; ++ui; }
        s ^= 1; cA = nA; cB = nB; hsC = hsN;
#pragma unroll
        for (int i = 0; i < 2; ++i) { vAc[i] = vAn[i]; vBc[i] = vBn[i]; }
        if (wr == 1) PG8_BAR;
    }
    PG8_WAIT_V(0);
    PG8_BAR;
#undef PG8_SA
#undef PG8_SB
#undef PG8_STAGE
#undef PG8_LDA
#undef PG8_LDB
#undef PG8_MMA
#undef PG8_WAIT_V
#undef PG8_WAIT_L
#undef PG8_BAR
#undef PG8_SCHED
#undef PG8_BH
}
}

constexpr int NWAVES = 8;
constexpr int NB = 32, SEQ = 2048, DM = 1024, MTOK = NB * SEQ, DEPTH = 4;
constexpr int INC = 5888, NE = 16, CAP = 256, DEX = 1024, MEXP = NE * NB * CAP;
constexpr float RMS_EPS = 1e-6f, LOG2E = 1.4426950408889634f;
constexpr float QSCALE = 0.125f * LOG2E;

constexpr size_t MiB = 1u << 20;
constexpr size_t WS_CTL = 0, CTL_ZERO_BYTES = 32768;
constexpr size_t WS_WIN = 1 * MiB;
constexpr size_t WS_WA = WS_WIN + (size_t)INC * DM * 2;
constexpr size_t WS_WB = WS_WA + (size_t)DM * 256 * 2;
constexpr size_t WS_WO = WS_WB + (size_t)DM * DM * 2;
constexpr size_t WS_WGU = WS_WO + (size_t)DM * DM * 2;
constexpr size_t WS_WD = WS_WGU + (size_t)NE * 2048 * DM * 2;
constexpr size_t WS_HN = WS_WD + (size_t)NE * DM * DEX * 2;
constexpr size_t WS_BIG = WS_HN + (size_t)MTOK * DM * 2;
constexpr size_t B_QA = 0, B_KA = 96 * MiB, B_VA = 192 * MiB, B_QW = 288 * MiB, B_KW = 416 * MiB, B_VW = 448 * MiB, B_G = 480 * MiB, B_OA = 736 * MiB, B_END = 768 * MiB;
constexpr size_t B_MERGED = 0;
constexpr size_t B_XE = 0, B_ACT = 256 * MiB, B_Y = 512 * MiB;
constexpr size_t WS_AFF = WS_BIG + B_END;
constexpr size_t WS_SEL = WS_AFF + (size_t)MTOK * NE * 4;
constexpr size_t WS_GATE = WS_SEL + (size_t)MTOK * NE * 4;
constexpr size_t WS_LSE = WS_GATE + (size_t)MEXP * 4;
constexpr size_t WS_IDX = WS_LSE + (size_t)3 * MTOK * 4 * 4;
constexpr size_t WS_HB = WS_IDX + (size_t)MEXP * 4;
constexpr size_t WS_END = WS_HB + (size_t)MTOK * DM * 2;
static_assert(WS_WIN % 256 == 0 && WS_WA % 256 == 0 && WS_WGU % 256 == 0 && WS_HN % 256 == 0 && WS_BIG % 256 == 0 && WS_AFF % 256 == 0, "alignment");
constexpr int CW_BAR = 4096;
constexpr int AROW_OFF = 131072;
constexpr int MISC_OFF = 147456, LDS_BYTES = 151552;

#define GAS __attribute__((address_space(1)))
#define LAS __attribute__((address_space(3)))
typedef unsigned short bf16;
typedef unsigned v4u __attribute__((ext_vector_type(4)));
typedef unsigned v2u __attribute__((ext_vector_type(2)));
typedef float f32x4 __attribute__((ext_vector_type(4)));
typedef float f32x16 __attribute__((ext_vector_type(16)));
typedef short bf16x8 __attribute__((ext_vector_type(8)));
#define LDS_WAIT() asm volatile("s_waitcnt lgkmcnt(0)" ::: "memory")
#define VM_WAIT() asm volatile("s_waitcnt vmcnt(0)" ::: "memory")

#define XB_TMO      128
#define XB_XCNT(j)  (256  + 64 * (j))
#define XB_XSUB(j)  (1280 + 64 * (j))
#define XB_XGEN(j)  (2304 + 64 * (j))
#define XB_TOP      3328
#define XB_TOPGEN   3392
#define XCD_BAR_WORDS 3456
#define XB_SPIN_CAP (1u << 18)

__device__ __forceinline__ unsigned xb_ld(unsigned* p)              { return __hip_atomic_load(p, __ATOMIC_RELAXED, __HIP_MEMORY_SCOPE_AGENT); }
__device__ __forceinline__ unsigned xb_add(unsigned* p, unsigned v) { return __hip_atomic_fetch_add(p, v, __ATOMIC_RELAXED, __HIP_MEMORY_SCOPE_AGENT); }
__device__ __forceinline__ unsigned xb_xcc_id() { return (unsigned)__builtin_amdgcn_s_getreg((3 << 11) | 20) & 0xFu; }
#define XB_SPIN(cond, bar) do { unsigned _sp = 0; while (cond) { __builtin_amdgcn_s_sleep(1); \
    if ((++_sp & 255u) == 0u) { if (xb_ld(&(bar)[XB_TMO])) break; if (_sp > XB_SPIN_CAP) { atomicAdd(&(bar)[XB_TMO], 1u); break; } } } } while (0)

__device__ __forceinline__ int xb_lane() { unsigned z = 0u; asm volatile("" : "+v"(z)); return (int)__builtin_amdgcn_mbcnt_hi(~0u, __builtin_amdgcn_mbcnt_lo(~0u, z)); }
struct XcdBarrier {
    int w;
    unsigned* bar; unsigned x;
    volatile LAS unsigned* st;
};

__device__ __forceinline__ XcdBarrier xcd_barrier_post(unsigned* bar, volatile LAS unsigned* st, int wave) {
    XcdBarrier b; b.w = wave; b.bar = bar; b.x = xb_xcc_id(); b.st = st;
    if (wave == 0 && xb_lane() == 0) (void)xb_add(&bar[XB_XCNT(b.x)], 1u);
    return b;
}
__device__ __forceinline__ void xcd_barrier_complete(unsigned* bar, unsigned x, unsigned& nloc, unsigned& nx) {
    const unsigned G = gridDim.x * gridDim.y * gridDim.z;
    unsigned sum, cnt, mine, sp = 0u;
    for (;;) {
        sum = 0u; cnt = 0u; mine = 0u;
#pragma unroll
        for (unsigned j = 0; j < 16; ++j) { const unsigned c = xb_ld(&bar[XB_XCNT(j)]); sum += c; cnt += (c > 0u) ? 1u : 0u; mine = (j == x) ? c : mine; }
        if (sum == G) break;
        __builtin_amdgcn_s_sleep(1);
        if ((++sp & 255u) == 0u) { if (xb_ld(&bar[XB_TMO])) break; if (sp > XB_SPIN_CAP) { atomicAdd(&bar[XB_TMO], 1u); break; } }
    }
    nloc = mine > 0u ? mine : 1u; nx = cnt > 0u ? cnt : 1u;
}

__device__ __forceinline__ void xcd_barrier(const XcdBarrier& b) {
    asm volatile("s_waitcnt vmcnt(0)" ::: "memory");
    __syncthreads();
    if (b.w == 0 && xb_lane() == 0) {
        unsigned* bar = b.bar;
        __builtin_amdgcn_s_waitcnt(0);
        unsigned nloc = b.st[0], nx = b.st[1];
        if (nloc == 0u) { xcd_barrier_complete(bar, b.x, nloc, nx); b.st[0] = nloc; b.st[1] = nx; }
        const unsigned old = xb_add(&bar[XB_XSUB(b.x)], 1u);
        const unsigned gen = old / nloc;
        if (old + 1u == (gen + 1u) * nloc) {
            __builtin_amdgcn_fence(__ATOMIC_RELEASE, "agent");
            asm volatile("s_waitcnt vmcnt(0)" ::: "memory");
            const unsigned og = xb_add(&bar[XB_TOP], 1u);
            const unsigned tg = og / nx;
            if (og + 1u == (tg + 1u) * nx) xb_add(&bar[XB_TOPGEN], 1u);
            else XB_SPIN(xb_ld(&bar[XB_TOPGEN]) == tg, bar);
            __builtin_amdgcn_fence(__ATOMIC_ACQUIRE, "agent");
            xb_add(&bar[XB_XGEN(b.x)], 1u);
            asm volatile("s_waitcnt vmcnt(0)" ::: "memory");
        } else {
            XB_SPIN(xb_ld(&bar[XB_XGEN(b.x)]) == gen, bar);
            __builtin_amdgcn_fence(__ATOMIC_ACQUIRE, "agent");
            asm volatile("s_waitcnt vmcnt(0)" ::: "memory");
        }
    }
    __syncthreads();
}

struct Frame {
    LAS unsigned char* lds;
    int tid, lane, wave, gw;
};
constexpr int PTAB_OFF = MISC_OFF + 256;
__device__ __forceinline__ unsigned long long ptab_get(LAS unsigned char* lds, int i) {
    LAS unsigned char* base = lds + PTAB_OFF; asm volatile("" : "+v"(base));
    const unsigned long long v = ((const volatile LAS unsigned long long*)base)[i];
    const unsigned lo = __builtin_amdgcn_readfirstlane((unsigned)v), hi = __builtin_amdgcn_readfirstlane((unsigned)(v >> 32));
    return ((unsigned long long)hi << 32) | lo;
}
#define P_IN(i) ((const float*)(const GAS float*)ptab_get(F.lds, (i)))
#define P_OUT ((float*)(GAS float*)ptab_get(F.lds, 14))
#define P_WS ((unsigned char*)(GAS unsigned char*)ptab_get(F.lds, 15))
__device__ __forceinline__ Frame make_frame(LAS unsigned char* lds, int wave_s) { Frame F; F.lds = lds; int bx = blockIdx.x; asm volatile("" : "+s"(bx));
    int ln = xb_lane(); asm volatile("" : "+v"(ln));
    F.lane = ln; F.wave = wave_s; F.tid = wave_s * 64 + ln; F.gw = bx * NWAVES + F.wave; return F; }
__device__ __forceinline__ float shx(float v, int o, int lane) { return __builtin_bit_cast(float, __builtin_amdgcn_ds_bpermute((lane ^ o) << 2, __builtin_bit_cast(int, v))); }
__device__ __forceinline__ unsigned shrel(unsigned v, int d, int lane) { return (unsigned)__builtin_amdgcn_ds_bpermute(((lane + d) & 63) << 2, (int)v); }
__device__ __forceinline__ float wave_sum(float v, int lane) {
#pragma unroll
    for (int o = 1; o < 64; o <<= 1) v += shx(v, o, lane);
    return v;
}
template <bool SCALE = false>
__device__ __forceinline__ void transpose_item(const float* W, int K, int N, bf16* dst, LAS float* scr, int k0, int n0, int lane, const float* gk = nullptr) {
    float tv[32];
#pragma unroll
    for (int i = 0; i < 32; ++i) { const int kk = 2 * i + (lane >> 5); tv[i] = W[(size_t)(k0 + kk) * N + n0 + (lane & 31)]; }
#pragma unroll
    for (int i = 0; i < 32; ++i) { const int kk = 2 * i + (lane >> 5); scr[kk * 33 + (lane & 31)] = tv[i]; }
    LDS_WAIT(); asm volatile("" ::: "memory");
    const int c = lane & 7;
    f32x4 ga = {1.f, 1.f, 1.f, 1.f}, gb = {1.f, 1.f, 1.f, 1.f};
    if (SCALE) { ga = *(const f32x4*)(gk + k0 + 8 * c); gb = *(const f32x4*)(gk + k0 + 8 * c + 4); }
#pragma unroll
    for (int j = 0; j < 4; ++j) { const int n = (lane >> 3) + 8 * j; const LAS float* s = scr + (8 * c) * 33 + n;
        v4u o; o.x = pk2bf(s[0 * 33] * ga.x, s[1 * 33] * ga.y); o.y = pk2bf(s[2 * 33] * ga.z, s[3 * 33] * ga.w); o.z = pk2bf(s[4 * 33] * gb.x, s[5 * 33] * gb.y); o.w = pk2bf(s[6 * 33] * gb.z, s[7 * 33] * gb.w);
        *(GAS v4u*)(dst + (size_t)n * K + k0 + 8 * c) = o; }
    LDS_WAIT(); asm volatile("" ::: "memory");
}
__device__ __forceinline__ float f8clamp(float x) { return fminf(fmaxf(x, -440.f), 440.f); }
__device__ __forceinline__ unsigned pk4f8(float a, float b, float c, float d) {
    int w = __builtin_amdgcn_cvt_pk_fp8_f32(f8clamp(a), f8clamp(b), 0, false); w = __builtin_amdgcn_cvt_pk_fp8_f32(f8clamp(c), f8clamp(d), w, true); return (unsigned)w; }
template <bool SCALE = false>
__device__ __forceinline__ void transpose_item8(const float* W, int K, int N, unsigned char* dst8, LAS float* scr, int k0, int n0, int lane, float mul, const float* gk = nullptr) {
    float tv[32];
#pragma unroll
    for (int i = 0; i < 32; ++i) { const int kk = 2 * i + (lane >> 5); tv[i] = W[(size_t)(k0 + kk) * N + n0 + (lane & 31)]; }
#pragma unroll
    for (int i = 0; i < 32; ++i) { const int kk = 2 * i + (lane >> 5); scr[kk * 33 + (lane & 31)] = tv[i]; }
    LDS_WAIT(); asm volatile("" ::: "memory");
    const int c = lane & 7;
    f32x4 ga = {mul, mul, mul, mul}, gb = {mul, mul, mul, mul};
    if (SCALE) { ga = *(const f32x4*)(gk + k0 + 8 * c) * mul; gb = *(const f32x4*)(gk + k0 + 8 * c + 4) * mul; }
#pragma unroll
    for (int j = 0; j < 4; ++j) { const int n = (lane >> 3) + 8 * j; const LAS float* s = scr + (8 * c) * 33 + n;
        v2u o; o.x = pk4f8(s[0 * 33] * ga.x, s[1 * 33] * ga.y, s[2 * 33] * ga.z, s[3 * 33] * ga.w); o.y = pk4f8(s[4 * 33] * gb.x, s[5 * 33] * gb.y, s[6 * 33] * gb.z, s[7 * 33] * gb.w);
        *(GAS v2u*)(dst8 + (size_t)n * K + k0 + 8 * c) = o; }
    LDS_WAIT(); asm volatile("" ::: "memory");
}
__device__ __forceinline__ void convert_weights(Frame& F, int l) {
    LAS float* scr = (LAS float*)(F.lds + F.wave * 8448);
    const int NGW = 256 * NWAVES;
    unsigned char* ws = P_WS;
    bf16* WinT = (bf16*)(ws + WS_WIN); bf16* WaT = (bf16*)(ws + WS_WA); bf16* WbT = (bf16*)(ws + WS_WB); bf16* WoT = (bf16*)(ws + WS_WO);
    bf16* WguT = (bf16*)(ws + WS_WGU); bf16* WdT = (bf16*)(ws + WS_WD);
    const float* w_in = P_IN(2) + (size_t)l * DM * INC; const float* w_a = P_IN(3) + (size_t)l * 256 * DM; const float* w_b = P_IN(4) + (size_t)l * DM * DM;
    const float* w_o = P_IN(7) + (size_t)l * DM * DM; const float* g2 = P_IN(8) + (size_t)l * DM; const float* g1n = P_IN(1) + (size_t)l * DM;
    const float* w_g = P_IN(10) + (size_t)l * NE * DM * DEX; const float* w_u = P_IN(11) + (size_t)l * NE * DM * DEX; const float* w_d = P_IN(12) + (size_t)l * NE * DEX * DM;
    constexpr int I_IN = 16 * (INC / 32), I_A = 4 * 32, I_B = 16 * 32, I_O = 16 * 32, I_E = NE * 16 * 32;
    constexpr int NITEMS = I_IN + I_A + I_B + I_O + 3 * I_E;
    for (int it = F.gw; it < NITEMS; it += NGW) {
        int r = it;
        if (r < I_IN) { const int nb = r % (INC / 32), kb = r / (INC / 32), n0 = 32 * nb; int drow = n0;
            if (n0 >= 3840) { const int gc = n0 - 3840, br = gc >> 10, cc = gc & 1023; drow = 3840 + (cc >> 7) * 256 + ((cc & 127) >> 5) * 64 + br * 32; }
            transpose_item<true>(w_in, DM, INC, WinT + (size_t)drow * DM, scr, 64 * kb, n0, F.lane, g1n); continue; } r -= I_IN;
        if (r < I_A) { const int nb = r % 32, kb = r / 32; transpose_item(w_a, 256, DM, WaT + (size_t)(32 * nb) * 256, scr, 64 * kb, 32 * nb, F.lane); continue; } r -= I_A;
        if (r < I_B) { const int nb = r % 32, kb = r / 32; transpose_item(w_b, DM, DM, WbT + (size_t)(32 * nb) * DM, scr, 64 * kb, 32 * nb, F.lane); continue; } r -= I_B;
        if (r < I_O) { const int nb = r % 32, kb = r / 32; transpose_item(w_o, DM, DM, WoT + (size_t)(32 * nb) * DM, scr, 64 * kb, 32 * nb, F.lane); continue; } r -= I_O;
        if (r < 2 * I_E) { const int up = r >= I_E; if (up) r -= I_E; const int e = r / 512, loc = r % 512, nb = loc % 32, kb = loc / 32, f0 = 32 * nb;
            const float* W = (up ? w_u : w_g) + (size_t)e * DM * DEX;
            transpose_item<true>(W, DM, DEX, WguT + ((size_t)e * 2048 + (f0 >> 7) * 256 + (up ? 128 : 0) + (f0 & 127)) * DM, scr, 64 * kb, f0, F.lane, g2); continue; } r -= 2 * I_E;
        { const int e = r / 512, loc = r % 512, nb = loc % 32, kb = loc / 32;
            transpose_item8(w_d + (size_t)e * DEX * DM, DEX, DM, (unsigned char*)WdT + ((size_t)e * 1024 + 32 * nb) * DEX, scr, 64 * kb, 32 * nb, F.lane, 64.0f); }
    }
}
__device__ __forceinline__ void unpk8(const v4u w, float (&v)[8]) { v[0] = bflo(w.x); v[1] = bfhi(w.x); v[2] = bflo(w.y); v[3] = bfhi(w.y); v[4] = bflo(w.z); v[5] = bfhi(w.z); v[6] = bflo(w.w); v[7] = bfhi(w.w); }
__device__ __forceinline__ v4u pk8(const float (&v)[8]) { v4u w; w.x = pk2bf(v[0], v[1]); w.y = pk2bf(v[2], v[3]); w.z = pk2bf(v[4], v[5]); w.w = pk2bf(v[6], v[7]); return w; }
template <bool XIN, bool COMBINE, bool FINAL>
__device__ __forceinline__ void norm_rows(Frame& F, const float* xin, bf16* hb, const float* gain, float* rsv, float* out) {
    const int NGW = 256 * NWAVES;
    unsigned char* ws = P_WS;
    const int* sel = (const int*)(ws + WS_SEL); const bf16* Y = (const bf16*)(ws + WS_BIG + B_Y);
    float gv[2][8];
#pragma unroll
    for (int j = 0; j < 2; ++j) { const f32x4 a = *(const f32x4*)(gain + (64 * j + F.lane) * 8), b = *(const f32x4*)(gain + (64 * j + F.lane) * 8 + 4);
        gv[j][0] = a.x; gv[j][1] = a.y; gv[j][2] = a.z; gv[j][3] = a.w; gv[j][4] = b.x; gv[j][5] = b.y; gv[j][6] = b.z; gv[j][7] = b.w; }
    constexpr int NR = 4;
    for (int m0 = F.gw; m0 < MTOK; m0 += NR * NGW) {
        float v[NR][2][8]; int sv[NR];
#pragma unroll
        for (int rr = 0; rr < NR; ++rr) { const int m = m0 + rr * NGW;
            if (COMBINE) sv[rr] = sel[(size_t)m * NE + (F.lane & 15)];
            if (XIN) {
#pragma unroll
                for (int j = 0; j < 2; ++j) { const f32x4 a = *(const f32x4*)(xin + (size_t)m * DM + (64 * j + F.lane) * 8), b = *(const f32x4*)(xin + (size_t)m * DM + (64 * j + F.lane) * 8 + 4);
                    v[rr][j][0] = a.x; v[rr][j][1] = a.y; v[rr][j][2] = a.z; v[rr][j][3] = a.w; v[rr][j][4] = b.x; v[rr][j][5] = b.y; v[rr][j][6] = b.z; v[rr][j][7] = b.w; }
            } else {
#pragma unroll
                for (int j = 0; j < 2; ++j) unpk8(*(const v4u*)(hb + (size_t)m * DM + (64 * j + F.lane) * 8), v[rr][j]);
            } }
        if (COMBINE) {
            unsigned msk[NR];
#pragma unroll
            for (int rr = 0; rr < NR; ++rr) msk[rr] = (unsigned)(__builtin_amdgcn_ballot_w64(sv[rr] >= 0) & 0xffffull);
            unsigned any = 0u;
#pragma unroll
            for (int rr = 0; rr < NR; ++rr) any |= msk[rr];
            while (any != 0u) {
                v4u yv[NR][2]; float wgt[NR];
#pragma unroll
                for (int rr = 0; rr < NR; ++rr) { const int m = m0 + rr * NGW, b = m >> 11; const bool has = msk[rr] != 0u;
                    const int e = has ? __builtin_ctz(msk[rr]) : 0; const int r = has ? __builtin_amdgcn_readlane(sv[rr], e) : 0;
                    const bf16* yr = Y + ((size_t)(e * NB + b) * CAP + r) * DM; wgt[rr] = has ? 1.0f : 0.0f; msk[rr] &= msk[rr] - 1u;
#pragma unroll
                    for (int j = 0; j < 2; ++j) yv[rr][j] = *(const v4u*)(yr + (64 * j + F.lane) * 8); }
                any = 0u;
#pragma unroll
                for (int rr = 0; rr < NR; ++rr) { any |= msk[rr];
#pragma unroll
                    for (int j = 0; j < 2; ++j) { float y[8]; unpk8(yv[rr][j], y);
#pragma unroll
                        for (int i = 0; i < 8; ++i) v[rr][j][i] += wgt[rr] * y[i]; } }
            }
        }
#pragma unroll
        for (int rr = 0; rr < NR; ++rr) { const int m = m0 + rr * NGW;
            if ((XIN || COMBINE) && !FINAL) {
#pragma unroll
                for (int j = 0; j < 2; ++j) *(v4u*)(hb + (size_t)m * DM + (64 * j + F.lane) * 8) = pk8(v[rr][j]);
            }
            float ss = 0.f;
#pragma unroll
            for (int j = 0; j < 2; ++j)
#pragma unroll
                for (int i = 0; i < 8; ++i) ss += v[rr][j][i] * v[rr][j][i];
            const float rs = 1.0f / sqrtf(wave_sum(ss, F.lane) * (1.0f / DM) + RMS_EPS);
            if (FINAL) {
#pragma unroll
                for (int j = 0; j < 2; ++j) { float o[8];
#pragma unroll
                    for (int i = 0; i < 8; ++i) o[i] = v[rr][j][i] * rs * gv[j][i];
                    float* op = out + (size_t)m * DM + (64 * j + F.lane) * 8; *(f32x4*)op = (f32x4){o[0], o[1], o[2], o[3]}; *(f32x4*)(op + 4) = (f32x4){o[4], o[5], o[6], o[7]}; }
            } else if (F.lane == 0) rsv[m] = rs; }
    }
}
constexpr int RT_PITCH = 2048 + 16;
__device__ __forceinline__ void norm_router(Frame& F, const bf16* hb, const float* gain, const float* wr, float* rsv, float* aff) {
    LAS unsigned char* whi = F.lds; LAS unsigned char* wlo = F.lds + 16 * RT_PITCH; LAS float* gl = (LAS float*)(F.lds + 32 * RT_PITCH);
    { const float g0 = gain[F.tid], g1 = gain[F.tid + NWAVES * 64]; gl[F.tid] = g0; gl[F.tid + NWAVES * 64] = g1; }
    __syncthreads();
    { f32x4 wv[8];
#pragma unroll
      for (int j = 0; j < 8; ++j) wv[j] = *(const f32x4*)(wr + 4 * (F.tid + j * NWAVES * 64));
      asm volatile("" ::: "memory");
#pragma unroll
      for (int j = 0; j < 8; ++j) { const int i0 = 4 * (F.tid + j * NWAVES * 64), k = i0 >> 4, e0 = i0 & 15; const float g = gl[k];
#pragma unroll
          for (int t = 0; t < 4; ++t) { const float w = wv[j][t] * g; const unsigned hi = pk2bf(w, 0.f) & 0xffffu; const float rem = w - bflo(hi);
              *(LAS unsigned short*)(whi + (e0 + t) * RT_PITCH + k * 2) = (unsigned short)hi; *(LAS unsigned short*)(wlo + (e0 + t) * RT_PITCH + k * 2) = (unsigned short)(pk2bf(rem, 0.f) & 0xffffu); } } }
    __syncthreads();
    const int NGW = 256 * NWAVES, r16 = F.lane & 15, q = F.lane >> 4;
    for (int grp = F.gw; grp < MTOK / 16; grp += NGW) {
        const size_t row = (size_t)grp * 16 + r16;
        v4u xs[32];
#pragma unroll
        for (int s = 0; s < 16; ++s) { const v4u* p = (const v4u*)(hb + row * DM + 64 * s + 16 * q); xs[2 * s] = p[0]; xs[2 * s + 1] = p[1]; }
        f32x4 acc = {0.f, 0.f, 0.f, 0.f}; float ss = 0.f;
#pragma unroll
        for (int s = 0; s < 16; ++s) {
#pragma unroll
            for (int h2 = 0; h2 < 2; ++h2) { const bf16x8 a = __builtin_bit_cast(bf16x8, xs[2 * s + h2]);
                const bf16x8 bh = *(const LAS bf16x8*)(whi + r16 * RT_PITCH + (64 * s + 16 * q + 8 * h2) * 2), bl = *(const LAS bf16x8*)(wlo + r16 * RT_PITCH + (64 * s + 16 * q + 8 * h2) * 2);
                acc = __builtin_amdgcn_mfma_f32_16x16x32_bf16(a, bh, acc, 0, 0, 0); acc = __builtin_amdgcn_mfma_f32_16x16x32_bf16(a, bl, acc, 0, 0, 0);
                float x[8]; unpk8(xs[2 * s + h2], x);
#pragma unroll
                for (int i = 0; i < 8; ++i) ss += x[i] * x[i]; }
            asm volatile("" ::: "memory"); }
        ss += shx(ss, 16, F.lane); ss += shx(ss, 32, F.lane);
        const float rs = 1.0f / sqrtf(ss * (1.0f / DM) + RMS_EPS);
        float lg[4];
#pragma unroll
        for (int r = 0; r < 4; ++r) { const float rr = __builtin_bit_cast(float, __builtin_amdgcn_ds_bpermute((4 * q + r) << 2, __builtin_bit_cast(int, rs))); lg[r] = acc[r] * rr; }
#pragma unroll
        for (int r = 0; r < 4; ++r) { float mx = lg[r];
#pragma unroll
            for (int o = 1; o < 16; o <<= 1) mx = fmaxf(mx, shx(mx, o, F.lane));
            const float ex = __expf(lg[r] - mx); float sm = ex;
#pragma unroll
            for (int o = 1; o < 16; o <<= 1) sm += shx(sm, o, F.lane);
            aff[((size_t)grp * 16 + 4 * q + r) * NE + r16] = ex / sm; }
        if (q == 0) rsv[row] = rs;
    }
}
__device__ __forceinline__ void topk_gather(Frame& F, const float* aff, const float* rsv, int* sel, float* gatev, int* idxg) {
    LAS unsigned* hist = (LAS unsigned*)F.lds;
    volatile LAS unsigned* st = (volatile LAS unsigned*)(F.lds + 1024);
    for (int u = blockIdx.x; u < NB * NE; u += 256) {
        const int b = u >> 4, e = u & 15;
        unsigned bits[4];
#pragma unroll
        for (int q = 0; q < 4; ++q) bits[q] = __float_as_uint(aff[((size_t)b * SEQ + 4 * F.tid + q) * NE + e]);
        const f32x4 rs4 = *(const f32x4*)(rsv + (size_t)b * SEQ + 4 * F.tid);
        unsigned prefix = 0u, kk = CAP;
#pragma unroll 1
        for (int pass = 0; pass < 4; ++pass) {
            const int shift = 24 - 8 * pass;
            if (F.tid < 256) hist[F.tid] = 0u;
            __syncthreads();
#pragma unroll
            for (int q = 0; q < 4; ++q) { const bool in = (pass == 0) || ((bits[q] >> (shift + 8)) == prefix); if (in) atomicAdd((unsigned*)&hist[(bits[q] >> shift) & 255u], 1u); }
            __syncthreads();
            if (F.wave == 0) {
                const unsigned c0 = hist[4 * F.lane], c1 = hist[4 * F.lane + 1], c2 = hist[4 * F.lane + 2], c3 = hist[4 * F.lane + 3];
                unsigned incl = c0 + c1 + c2 + c3;
#pragma unroll
                for (int o = 1; o < 64; o <<= 1) { const unsigned v = shrel(incl, o, F.lane); if (F.lane + o < 64) incl += v; }
                unsigned cum = incl - (c0 + c1 + c2 + c3);
                int found = -1; unsigned above = 0u;
                if (cum < kk && cum + c3 >= kk) { found = 3; above = cum; } cum += c3;
                if (cum < kk && cum + c2 >= kk) { found = 2; above = cum; } cum += c2;
                if (cum < kk && cum + c1 >= kk) { found = 1; above = cum; } cum += c1;
                if (cum < kk && cum + c0 >= kk) { found = 0; above = cum; }
                if (found >= 0) { st[0] = (prefix << 8) | (unsigned)(4 * F.lane + found); st[1] = kk - above; }
            }
            __syncthreads();
            prefix = st[0]; kk = st[1];
        }
        const unsigned T = prefix;
        unsigned ngt = 0u, neq = 0u;
#pragma unroll
        for (int q = 0; q < 4; ++q) { ngt += bits[q] > T ? 1u : 0u; neq += bits[q] == T ? 1u : 0u; }
        unsigned pk = ngt | (neq << 16), inc = pk;
#pragma unroll
        for (int o = 1; o < 64; o <<= 1) { const unsigned v = shrel(inc, -o, F.lane); if (F.lane >= o) inc += v; }
        if (F.lane == 63) st[8 + F.wave] = inc;
        __syncthreads();
        unsigned base = 0u;
#pragma unroll
        for (int w = 0; w < NWAVES; ++w) base += (w < F.wave) ? st[8 + w] : 0u;
        const unsigned excl = base + inc - pk;
        unsigned pgt = excl & 0xffffu, peq = excl >> 16;
#pragma unroll
        for (int q = 0; q < 4; ++q) { const int i = 4 * F.tid + q; const bool g = bits[q] > T, eq = bits[q] == T; const bool keep = g || (eq && peq < kk);
            const unsigned slot = pgt + (peq < kk ? peq : kk);
            if (keep) { idxg[(size_t)(e * NB + b) * CAP + slot] = (int)((unsigned)(b * SEQ + i) | ((unsigned)__builtin_bit_cast(unsigned short, (_Float16)rs4[q]) << 16)); gatev[(size_t)(e * NB + b) * CAP + slot] = __uint_as_float(bits[q]); }
            sel[((size_t)b * SEQ + i) * NE + e] = keep ? (int)slot : -1;
            pgt += g ? 1u : 0u; peq += eq ? 1u : 0u; }
        __syncthreads();
    }
}


constexpr int ATT_KPITCH = 144, ATT_VT_OFF = 512 * ATT_KPITCH, ATT_VPITCH = 1040, ATT_SINK_OFF = MISC_OFF + 1024;
static_assert(ATT_VT_OFF + 64 * ATT_VPITCH <= MISC_OFF, "attention LDS");
#ifndef ATT_JT_UNROLL
#define ATT_JT_UNROLL 1
#endif
struct ChunkP { const bf16* K; const bf16* V; int ldkv, tok0, cstep, r, L, nseg, qs, i0; };
template <int W>
__device__ __forceinline__ void attn_issue(const ChunkP& p, int tid, v4u (&kreg)[8], v4u (&vreg)[2][4]) {
    asm volatile("" : "+v"(tid));
    const int KS = p.qs + 2 * W, nrows = p.nseg * KS, Lm1 = p.L - 1;
    constexpr int NKP = 8;
#pragma unroll
    for (int it = 0; it < NKP; ++it) { const int pc = tid + it * NWAVES * 64, row0 = pc >> 3, ch = pc & 7, row = row0 < nrows ? row0 : nrows - 1, s = row >= KS ? 1 : 0, rho = row - s * KS;
        int j = p.i0 - W + rho; j = j < 0 ? 0 : j; j = j > Lm1 ? Lm1 : j;
        kreg[it] = *(const v4u*)(p.K + (size_t)(p.tok0 + s * p.cstep + p.r * j) * p.ldkv + ch * 8); }
#pragma unroll
    for (int it = 0; it < 2; ++it) { const int t = tid + it * NWAVES * 64, r4 = t >> 3, ch = t & 7, rowa = 4 * r4, row0 = rowa < nrows ? rowa : nrows - 4, s = row0 >= KS ? 1 : 0, rho = row0 - s * KS, j0 = p.i0 - W + rho;
#pragma unroll
        for (int q = 0; q < 4; ++q) { int j = j0 + q; j = j < 0 ? 0 : j; j = j > Lm1 ? Lm1 : j;
            vreg[it][q] = *(const v4u*)(p.V + (size_t)(p.tok0 + s * p.cstep + p.r * j) * p.ldkv + ch * 8); } }
}
__device__ __forceinline__ void attn_loadq(const Frame& F, const ChunkP& p, const bf16* Q, int ldq, bf16x8 (&qf)[4]) {
    int lane_ = F.lane; asm volatile("" : "+v"(lane_));
    const int wq = F.wave * 32, sidx = (wq >= p.qs) ? 1 : 0, qo = wq - sidx * p.qs, ql = lane_ & 31, hh = lane_ >> 5, qi = p.i0 + qo + ql;
    const bf16* q0 = Q + (size_t)(p.tok0 + sidx * p.cstep + p.r * qi) * ldq;
#pragma unroll
    for (int ks = 0; ks < 4; ++ks) qf[ks] = *(const bf16x8*)(q0 + 16 * ks + 8 * hh);
}
template <int W>
__device__ __forceinline__ void attn_commit(Frame& F, const ChunkP& p, const v4u (&kreg)[8], const v4u (&vreg)[2][4]) {
    int tid = F.tid; asm volatile("" : "+v"(tid));
    const int KS = p.qs + 2 * W, nrows = p.nseg * KS;
    LAS unsigned char* ldsK = F.lds; LAS unsigned char* ldsV = F.lds + ATT_VT_OFF;
    constexpr int NKP = 8;
#pragma unroll
    for (int it = 0; it < NKP; ++it) { const int pc = tid + it * NWAVES * 64, row = pc >> 3, ch = pc & 7;
        if (pc < nrows * 8) *(LAS v4u*)(ldsK + row * ATT_KPITCH + ch * 16) = kreg[it]; }
#pragma unroll
    for (int it = 0; it < 2; ++it) { const int t = tid + it * NWAVES * 64, r4 = t >> 3, ch = t & 7, row0 = 4 * r4;
        if (t < nrows * 2) {
            const int kap = row0 & 31, slot = (kap >> 4) * 16 + ((kap >> 2) & 1) * 8 + ((kap >> 3) & 1) * 4, pos = (row0 & ~31) + slot;
#pragma unroll
            for (int w = 0; w < 4; ++w) {
                v2u lo, hi;
                lo.x = (vreg[it][0][w] & 0xffffu) | (vreg[it][1][w] << 16); lo.y = (vreg[it][2][w] & 0xffffu) | (vreg[it][3][w] << 16);
                hi.x = (vreg[it][0][w] >> 16) | (vreg[it][1][w] & 0xffff0000u); hi.y = (vreg[it][2][w] >> 16) | (vreg[it][3][w] & 0xffff0000u);
                *(LAS v2u*)(ldsV + (ch * 8 + 2 * w) * ATT_VPITCH + pos * 2) = lo;
                *(LAS v2u*)(ldsV + (ch * 8 + 2 * w + 1) * ATT_VPITCH + pos * 2) = hi;
            } } }
}
#ifndef ATT_THR
#define ATT_THR 8.0f
#endif
template <int W, int NH, bool SINK, bool WRITE_LSE>
__device__ __forceinline__ void attn_compute(Frame& F, const ChunkP& p, bf16* Q, int ldq, long odelta, float* lse, float slope1, const float* sinkp, int hbase, bf16x8 (&qf)[4]) {
    constexpr int NJT = 2 * W / 32 + 1, JC = W / 32;
    const int KS = p.qs + 2 * W, L = p.L, i0 = p.i0;
    LAS unsigned char* ldsK = F.lds; LAS unsigned char* ldsV = F.lds + ATT_VT_OFF;
    const int wq = F.wave * 32, sidx = (wq >= p.qs) ? 1 : 0, qo = wq - sidx * p.qs, segbase = sidx * KS;
    int lane_ = F.lane; asm volatile("" : "+v"(lane_));
    const int ql = lane_ & 31, hh = lane_ >> 5;
    const int qi = i0 + qo + ql;
    const size_t qtok = (size_t)(p.tok0 + sidx * p.cstep + p.r * qi);
    const float flo = (float)((-qi > -W) ? -qi : -W), fhi = (float)((L - 1 - qi < W) ? (L - 1 - qi) : W);
#pragma unroll 1
    for (int g = 0; g < NH; ++g) {
        bf16* qptr = Q + qtok * ldq + g * 64;
        f32x16 O0, O1;
        float m, l;
#ifdef PRB_REP
        constexpr int nrep = (NH == PRB_NH) ? PRB_REP : 1;
#pragma unroll 1
        for (int rep = 0; rep < nrep; ++rep) {
        asm volatile("" ::: "memory");
#endif
#pragma unroll
        for (int i = 0; i < 16; ++i) { O0[i] = 0.f; O1[i] = 0.f; }
        const float sl = (NH == 1) ? slope1 : __builtin_amdgcn_exp2f(-0.5f * (float)(hbase + g + 1)) * LOG2E;
        const float sk2 = SINK ? *(const LAS float*)(F.lds + ATT_SINK_OFF + 4 * (hbase + g)) : 0.f;
        {
            const int jbase = i0 + qo - W + 32 * JC, krow = segbase + qo + 32 * JC;
            const bool need_mask = (jbase < 0) || (jbase + 31 >= L);
            f32x16 S;
#pragma unroll
            for (int i = 0; i < 16; ++i) S[i] = 0.f;
#pragma unroll
            for (int ks = 0; ks < 4; ++ks) { const bf16x8 kf = *(const LAS bf16x8*)(ldsK + (krow + ql) * ATT_KPITCH + (16 * ks + 8 * hh) * 2); S = __builtin_amdgcn_mfma_f32_32x32x16_bf16(kf, qf[ks], S, 0, 0, 0); }
            const float fd0 = (float)(jbase + 4 * hh - qi);
#pragma unroll
            for (int i = 0; i < 16; ++i) { const float fd = fd0 + (float)((i & 3) + 8 * (i >> 2)); S[i] = S[i] - sl * fabsf(fd); }
            if (need_mask) {
#pragma unroll
                for (int i = 0; i < 16; ++i) { const float fd = fd0 + (float)((i & 3) + 8 * (i >> 2)); S[i] = (fd >= flo && fd <= fhi) ? S[i] : -INFINITY; } }
            float mloc = S[0];
#pragma unroll
            for (int i = 1; i < 16; ++i) mloc = fmaxf(mloc, S[i]);
            m = fmaxf(mloc, shx(mloc, 32, lane_));
            float ps = 0.f;
#pragma unroll
            for (int i = 0; i < 16; ++i) { const float pv = __builtin_amdgcn_exp2f(S[i] - m); S[i] = pv; ps += pv; }
            l = ps;
#pragma unroll
            for (int s2 = 0; s2 < 2; ++s2) {
                f32x8_t pp;
#pragma unroll
                for (int i = 0; i < 8; ++i) pp[i] = S[8 * s2 + i];
                const bf16x8 pf = __builtin_bit_cast(bf16x8, __builtin_convertvector(pp, nbf16x8));
                const bf16x8 v0 = *(const LAS bf16x8*)(ldsV + ql * ATT_VPITCH + (krow + 16 * s2 + 8 * hh) * 2);
                const bf16x8 v1 = *(const LAS bf16x8*)(ldsV + (ql + 32) * ATT_VPITCH + (krow + 16 * s2 + 8 * hh) * 2);
                O0 = __builtin_amdgcn_mfma_f32_32x32x16_bf16(v0, pf, O0, 0, 0, 0);
                O1 = __builtin_amdgcn_mfma_f32_32x32x16_bf16(v1, pf, O1, 0, 0, 0);
            }
        }
#pragma unroll 1
        for (int jt = 0; jt < NJT; ++jt) {
            if (jt == JC) continue;
            const int jbase = i0 + qo - W + 32 * jt;
            if (jbase + 31 < 0 || jbase >= L) continue;
            const bool need_mask = (jt == 0) || (jt == NJT - 1) || (jbase < 0) || (jbase + 31 >= L);
            const int krow = segbase + qo + 32 * jt;
            const float fd0 = (float)(jbase + 4 * hh - qi);
            bf16x8 kf[4];
#pragma unroll
            for (int ks = 0; ks < 4; ++ks) kf[ks] = *(const LAS bf16x8*)(ldsK + (krow + ql) * ATT_KPITCH + (16 * ks + 8 * hh) * 2);
            const bf16x8 vf00 = *(const LAS bf16x8*)(ldsV + ql * ATT_VPITCH + (krow + 8 * hh) * 2), vf10 = *(const LAS bf16x8*)(ldsV + (ql + 32) * ATT_VPITCH + (krow + 8 * hh) * 2);
            f32x16 S;
            if (jt < JC) { const float k1 = sl * fd0 - m;
#pragma unroll
                for (int i = 0; i < 16; ++i) S[i] = fmaf(sl, (float)((i & 3) + 8 * (i >> 2)), k1); }
            else { const float k1 = -sl * fd0 - m;
#pragma unroll
                for (int i = 0; i < 16; ++i) S[i] = fmaf(-sl, (float)((i & 3) + 8 * (i >> 2)), k1); }
            if (need_mask) {
#pragma unroll
                for (int i = 0; i < 16; ++i) { const float fd = fd0 + (float)((i & 3) + 8 * (i >> 2)); S[i] = (fd >= flo && fd <= fhi) ? S[i] : -INFINITY; } }
#pragma unroll
            for (int ks = 0; ks < 4; ++ks) S = __builtin_amdgcn_mfma_f32_32x32x16_bf16(kf[ks], qf[ks], S, 0, 0, 0);
            const bf16x8 vf01 = *(const LAS bf16x8*)(ldsV + ql * ATT_VPITCH + (krow + 16 + 8 * hh) * 2), vf11 = *(const LAS bf16x8*)(ldsV + (ql + 32) * ATT_VPITCH + (krow + 16 + 8 * hh) * 2);
            float tmax = S[0];
#pragma unroll
            for (int i = 1; i < 16; ++i) tmax = fmaxf(tmax, S[i]);
            if (__builtin_amdgcn_ballot_w64(tmax > ATT_THR) != 0ull) {
                float d = fmaxf(tmax, 0.f); d = fmaxf(d, shx(d, 32, lane_));
                const float sc = __builtin_amdgcn_exp2f(-d);
#pragma unroll
                for (int i = 0; i < 16; ++i) { S[i] -= d; O0[i] *= sc; O1[i] *= sc; }
                l *= sc; m += d;
            }
            float ps = 0.f;
#pragma unroll
            for (int i = 0; i < 16; ++i) { const float pv = __builtin_amdgcn_exp2f(S[i]); S[i] = pv; ps += pv; }
            l += ps;
            { f32x8_t pp;
#pragma unroll
              for (int i = 0; i < 8; ++i) pp[i] = S[i];
              const bf16x8 pf = __builtin_bit_cast(bf16x8, __builtin_convertvector(pp, nbf16x8));
              O0 = __builtin_amdgcn_mfma_f32_32x32x16_bf16(vf00, pf, O0, 0, 0, 0); O1 = __builtin_amdgcn_mfma_f32_32x32x16_bf16(vf10, pf, O1, 0, 0, 0); }
            { f32x8_t pp;
#pragma unroll
              for (int i = 0; i < 8; ++i) pp[i] = S[8 + i];
              const bf16x8 pf = __builtin_bit_cast(bf16x8, __builtin_convertvector(pp, nbf16x8));
              O0 = __builtin_amdgcn_mfma_f32_32x32x16_bf16(vf01, pf, O0, 0, 0, 0); O1 = __builtin_amdgcn_mfma_f32_32x32x16_bf16(vf11, pf, O1, 0, 0, 0); }
        }
#ifdef PRB_REP
        }
        const float sk2 = SINK ? *(const LAS float*)(F.lds + ATT_SINK_OFF + 4 * (hbase + g)) : 0.f;
#endif
        float lt = l + shx(l, 32, lane_);
        float osc = 1.0f;
        if (SINK) { const float mf = fmaxf(m, sk2); osc = __builtin_amdgcn_exp2f(m - mf); lt = lt * osc + __builtin_amdgcn_exp2f(sk2 - mf); }
        if (WRITE_LSE) { if (hh == 0) lse[qtok * 4] = m + __builtin_amdgcn_logf(lt); }
        const float inv = osc / lt;
        if (NH > 1 && g + 1 < NH) {
#pragma unroll
            for (int ks = 0; ks < 4; ++ks) qf[ks] = *(const bf16x8*)(qptr + 64 + 16 * ks + 8 * hh); }
        v2u WW[8];
#pragma unroll
        for (int g4 = 0; g4 < 4; ++g4) {
            WW[g4].x = pk2bf(O0[4 * g4] * inv, O0[4 * g4 + 1] * inv); WW[g4].y = pk2bf(O0[4 * g4 + 2] * inv, O0[4 * g4 + 3] * inv);
            WW[4 + g4].x = pk2bf(O1[4 * g4] * inv, O1[4 * g4 + 1] * inv); WW[4 + g4].y = pk2bf(O1[4 * g4 + 2] * inv, O1[4 * g4 + 3] * inv); }
#pragma unroll
        for (int s4 = 0; s4 < 4; ++s4) {
            v2u a = WW[2 * s4], b = WW[2 * s4 + 1];
            { const auto r = __builtin_amdgcn_permlane32_swap(a.x, b.x, false, false); a.x = r[0]; b.x = r[1]; }
            { const auto r = __builtin_amdgcn_permlane32_swap(a.y, b.y, false, false); a.y = r[0]; b.y = r[1]; }
            *(v4u*)(qptr + odelta + 16 * s4 + 8 * hh) = (v4u){a.x, a.y, b.x, b.y};
#ifdef PRB_ST2
            asm volatile("" ::: "memory");
            *(v4u*)(qptr + odelta + 16 * s4 + 8 * hh) = (v4u){a.x, a.y, b.x, b.y};
            asm volatile("" ::: "memory");
#endif
        }
    }
}
__device__ __forceinline__ ChunkP dil_chunk(const bf16* KA, const bf16* VA, int b, int hs, int sc) {
    const int grp = sc >> 3, ix = sc & 7, col = grp * 256 + hs * 64; ChunkP p; p.K = KA + col; p.V = VA + col; p.ldkv = 768;
    if (grp == 0) { p.tok0 = b * SEQ; p.cstep = 0; p.r = 1; p.L = 2048; p.nseg = 1; p.qs = 256; p.i0 = 256 * ix; }
    else if (grp == 1) { p.tok0 = b * SEQ + (ix >> 1); p.cstep = 0; p.r = 4; p.L = 512; p.nseg = 1; p.qs = 256; p.i0 = 256 * (ix & 1); }
    else { p.tok0 = b * SEQ + 2 * ix; p.cstep = 1; p.r = 16; p.L = 128; p.nseg = 2; p.qs = 128; p.i0 = 0; }
    return p;
}
__device__ __forceinline__ ChunkP win_chunk(const bf16* KW, const bf16* VW, int wc) {
    const int b = wc >> 5, kvh = (wc >> 3) & 3, ch = wc & 7; ChunkP p; p.K = KW + kvh * 64; p.V = VW + kvh * 64; p.ldkv = 256;
    p.tok0 = b * SEQ; p.cstep = 0; p.r = 1; p.L = SEQ; p.nseg = 1; p.qs = 256; p.i0 = 256 * ch; return p;
}
__device__ __forceinline__ void attention_phase(Frame& F, int l, long odA, long odW, int which = 3) {
    unsigned char* ws = P_WS;
    bf16* big = (bf16*)(ws + WS_BIG);
    bf16* QA = big + B_QA / 2; bf16* KA = big + B_KA / 2; bf16* VA = big + B_VA / 2; bf16* QW = big + B_QW / 2; bf16* KW = big + B_KW / 2; bf16* VW = big + B_VW / 2; bf16* OA = big + B_OA / 2;
    float* LSE = (float*)(ws + WS_LSE);
    const int c = blockIdx.x;
    int w_lo, w_hi;
    v4u kreg[8], vreg[2][4];
    bf16x8 qf[4];
#ifndef ATT_N1
#define ATT_N1 0
#endif
    static_assert(ATT_N1 == 0, "the dilated workgroups take no window chunks");
    if (c < 128) { w_lo = ATT_N1 * c; w_hi = w_lo + ATT_N1; } else { w_lo = 128 * ATT_N1 + (c - 128) * (8 - ATT_N1); w_hi = w_lo + (8 - ATT_N1); }
    if (c < 128) { if (which & 1) {
        const int b = c >> 2, hs = c & 3;
        { const ChunkP p0 = dil_chunk(KA, VA, b, hs, 0); attn_issue<64>(p0, F.tid, kreg, vreg); attn_loadq(F, p0, QA + hs * 64, 768, qf); attn_commit<64>(F, p0, kreg, vreg); }
        __syncthreads();
#pragma unroll 1
        for (int sc = 0; sc < 24; ++sc) {
            const ChunkP p = dil_chunk(KA, VA, b, hs, sc); const int grp = sc >> 3;
            const int scn = sc + 1 < 24 ? sc + 1 : sc;
            const ChunkP pn = dil_chunk(KA, VA, b, hs, scn);
            bf16x8 qn[4];
            attn_issue<64>(pn, F.tid, kreg, vreg); attn_loadq(F, pn, QA + (scn >> 3) * 256 + hs * 64, 768, qn);
            const float slope1 = __builtin_amdgcn_exp2f(-8.0f * (float)(grp * 4 + hs + 1) / 12.0f) * (float)p.r * LOG2E;
            attn_compute<64, 1, false, true>(F, p, QA + grp * 256 + hs * 64, 768, odA, LSE + (size_t)grp * MTOK * 4 + hs, slope1, nullptr, 0, qf);
            __syncthreads();
            if (sc + 1 < 24) attn_commit<64>(F, pn, kreg, vreg);
            __syncthreads();
#pragma unroll
            for (int ks = 0; ks < 4; ++ks) qf[ks] = qn[ks];
        }
        VM_WAIT(); __syncthreads(); __builtin_amdgcn_fence(__ATOMIC_ACQUIRE, "agent"); VM_WAIT();
        constexpr int CB = 8;
#pragma unroll 1
        for (int t0 = F.tid; t0 < SEQ * 8; t0 += NWAVES * 64 * CB) {
            float lv[CB][3]; v4u av[CB][3];
#pragma unroll
            for (int k = 0; k < CB; ++k) { const int t = t0 + k * NWAVES * 64, tok = t >> 3, ch = t & 7; const size_t row = (size_t)b * SEQ + tok;
                lv[k][0] = LSE[row * 4 + hs]; lv[k][1] = LSE[(size_t)MTOK * 4 + row * 4 + hs]; lv[k][2] = LSE[(size_t)2 * MTOK * 4 + row * 4 + hs];
                const bf16* og = QA + odA + row * 768 + hs * 64 + ch * 8; av[k][0] = *(const v4u*)(og); av[k][1] = *(const v4u*)(og + 256); av[k][2] = *(const v4u*)(og + 512); }
            asm volatile("" ::: "memory");
#pragma unroll
            for (int k = 0; k < CB; ++k) { const int t = t0 + k * NWAVES * 64, tok = t >> 3, ch = t & 7; const size_t row = (size_t)b * SEQ + tok;
                const float mx = fmaxf(lv[k][0], fmaxf(lv[k][1], lv[k][2]));
                float w0 = __builtin_amdgcn_exp2f(lv[k][0] - mx), w1 = __builtin_amdgcn_exp2f(lv[k][1] - mx), w2 = __builtin_amdgcn_exp2f(lv[k][2] - mx);
                const float inv = 1.0f / (w0 + w1 + w2); w0 *= inv; w1 *= inv; w2 *= inv;
                v4u o;
#pragma unroll
                for (int w = 0; w < 4; ++w) o[w] = pk2bf(w0 * bflo(av[k][0][w]) + w1 * bflo(av[k][1][w]) + w2 * bflo(av[k][2][w]), w0 * bfhi(av[k][0][w]) + w1 * bfhi(av[k][1][w]) + w2 * bfhi(av[k][2][w]));
                *(v4u*)(OA + row * 256 + hs * 64 + ch * 8) = o; }
        }
    } } else if (which & 2) {
        if (F.tid < 16) *(LAS float*)(F.lds + ATT_SINK_OFF + 4 * F.tid) = P_IN(6)[l * 16 + F.tid] * LOG2E;
        const ChunkP p0 = win_chunk(KW, VW, w_lo); attn_issue<128>(p0, F.tid, kreg, vreg); attn_loadq(F, p0, QW + ((w_lo >> 3) & 3) * 256, 1024, qf); attn_commit<128>(F, p0, kreg, vreg);
        __syncthreads();
    }
#pragma unroll 1
    for (int wc = w_lo; wc < ((which & 2) ? w_hi : w_lo); ++wc) {
        const ChunkP p = win_chunk(KW, VW, wc); const int kvh = (wc >> 3) & 3;
        const int wn = wc + 1 < w_hi ? wc + 1 : wc;
        const ChunkP pn = win_chunk(KW, VW, wn);
        bf16x8 qn[4];
        attn_issue<128>(pn, F.tid, kreg, vreg); attn_loadq(F, pn, QW + ((wn >> 3) & 3) * 256, 1024, qn);
        attn_compute<128, 4, true, false>(F, p, QW + kvh * 256, 1024, odW, nullptr, 0.f, nullptr, kvh * 4, qf);
        __syncthreads();
        if (wc + 1 < w_hi) attn_commit<128>(F, pn, kreg, vreg);
        __syncthreads();
#pragma unroll
        for (int ks = 0; ks < 4; ++ks) qf[ks] = qn[ks];
    }
}
#ifndef PH_A
#define PH_A 1
#endif
#ifndef PH_B
#define PH_B 1
#endif
#ifndef PH_C
#define PH_C 1
#endif
#ifndef PH_D
#define PH_D 1
#endif
#ifndef PH_E
#define PH_E 1
#endif
#ifndef PH_F
#define PH_F 1
#endif
#ifndef PH_G
#define PH_G 1
#endif
#ifndef PH_H
#define PH_H 1
#endif
#ifndef PH_I
#define PH_I 1
#endif
#ifndef PH_J
#define PH_J 1
#endif
#ifndef PH_Z
#define PH_Z 1
#endif

struct Args { const float* in[14]; float* out; unsigned char* ws; };
__global__ void __launch_bounds__(NWAVES * 64, 2) mk_fwd(Args args) {
    extern __shared__ __attribute__((aligned(16))) unsigned char lds_raw[];
    LAS unsigned char* const lds = (LAS unsigned char*)lds_raw;
    int wave_s = __builtin_amdgcn_readfirstlane((int)(threadIdx.x >> 6)); asm volatile("" : "+s"(wave_s));
    {
        const int t0 = wave_s * 64 + xb_lane();
        volatile LAS unsigned* MISC = (volatile LAS unsigned*)(lds + MISC_OFF);
        if (t0 < 32) MISC[t0] = 0u;
        if (t0 == 0) { volatile LAS unsigned long long* pt = (volatile LAS unsigned long long*)(lds + PTAB_OFF);
            pt[0] = (unsigned long long)args.in[0]; pt[1] = (unsigned long long)args.in[1]; pt[2] = (unsigned long long)args.in[2]; pt[3] = (unsigned long long)args.in[3];
            pt[4] = (unsigned long long)args.in[4]; pt[5] = (unsigned long long)args.in[5]; pt[6] = (unsigned long long)args.in[6]; pt[7] = (unsigned long long)args.in[7];
            pt[8] = (unsigned long long)args.in[8]; pt[9] = (unsigned long long)args.in[9]; pt[10] = (unsigned long long)args.in[10]; pt[11] = (unsigned long long)args.in[11];
            pt[12] = (unsigned long long)args.in[12]; pt[13] = (unsigned long long)args.in[13]; pt[14] = (unsigned long long)args.out; pt[15] = (unsigned long long)args.ws; }
        __syncthreads();
    }
    XcdBarrier bar = xcd_barrier_post((unsigned*)(args.ws + WS_CTL) + CW_BAR, (volatile LAS unsigned*)(lds + MISC_OFF) + 8, wave_s);
    const int G = 256;

#pragma unroll 1
    for (int l = 0; l < DEPTH; ++l) {
        int c = blockIdx.x; asm volatile("" : "+s"(c));
#if PH_A
        { Frame F = make_frame(lds, wave_s); convert_weights(F, l);
          unsigned char* ws = P_WS;
          if (l == 0) norm_rows<true, false, false>(F, P_IN(0), (bf16*)(ws + WS_HB), P_IN(1) + l * DM, (float*)(ws + WS_LSE), nullptr);
          else norm_rows<false, true, false>(F, nullptr, (bf16*)(ws + WS_HB), P_IN(1) + l * DM, (float*)(ws + WS_LSE), nullptr);
          }
#endif
        xcd_barrier(bar);
#if PH_B
        { Frame F = make_frame(lds, wave_s); unsigned char* ws = P_WS; bf16* big = (bf16*)(ws + WS_BIG);
          pg8::Gemm g{(const bf16*)(ws + WS_HB), (const bf16*)(ws + WS_WIN), MTOK, INC, DM}; pg8::StaticOrder S; S.init(MTOK, INC, G, c);
          pg8::EpiInProj E{big + B_QA / 2, big + B_KA / 2, big + B_VA / 2, big + B_QW / 2, big + B_KW / 2, big + B_VW / 2, big + B_G / 2, big + B_G / 2 + (size_t)MTOK * DM, P_IN(5) + l * 2048, QSCALE, (const float*)(ws + WS_LSE), 0.f, 0.f};
          pg8::gemm_phase<pg8::EpiInProj, pg8::StaticOrder, true, true>(F.tid, lds, g, S, E); }
#endif
        xcd_barrier(bar);
#ifdef DUP_C
        { Frame F = make_frame(lds, wave_s); attention_phase(F, l, ((long)WS_HN - (long)(WS_BIG + B_QA)) / 2, ((long)WS_HN - (long)(WS_BIG + B_QW)) / 2, DUP_C); }
        xcd_barrier(bar);
#endif
#if PH_C
        { Frame F = make_frame(lds, wave_s); attention_phase(F, l, 0, 0); }
#endif
        xcd_barrier(bar);
#if PH_E
        { Frame F = make_frame(lds, wave_s); unsigned char* ws = P_WS; bf16* big = (bf16*)(ws + WS_BIG);
          pg8::Gemm g0{big + B_OA / 2, (const bf16*)(ws + WS_WA), MTOK, DM, 256}; pg8::Gemm g1{big + B_QW / 2, (const bf16*)(ws + WS_WB), MTOK, DM, DM}; pg8::StaticOrder S; S.init(MTOK, DM, G, c);
          pg8::EpiMergeDual E{big + B_MERGED / 2, big + B_G / 2, big + B_G / 2 + (size_t)MTOK * DM};
          pg8::gemm_phase_dual<pg8::EpiMergeDual, pg8::StaticOrder>(F.tid, lds, g0, g1, S, E); }
#endif
        xcd_barrier(bar);
#if PH_F
        { Frame F = make_frame(lds, wave_s); unsigned char* ws = P_WS; bf16* big = (bf16*)(ws + WS_BIG); bf16* hb = (bf16*)(ws + WS_HB);
          pg8::Gemm g{big + B_MERGED / 2, (const bf16*)(ws + WS_WO), MTOK, DM, DM}; pg8::StaticOrder S; S.init(MTOK, DM, G, c);
          pg8::EpiResid E{hb, hb};
          pg8::gemm_phase<pg8::EpiResid, pg8::StaticOrder, true, true>(F.tid, lds, g, S, E); }
#endif
        xcd_barrier(bar);
#if PH_G
        { Frame F = make_frame(lds, wave_s); unsigned char* ws = P_WS;
          norm_router(F, (const bf16*)(ws + WS_HB), P_IN(8) + l * DM, P_IN(9) + (size_t)l * DM * NE, (float*)(ws + WS_LSE), (float*)(ws + WS_AFF)); }
#endif
        xcd_barrier(bar);
#if PH_H
        { Frame F = make_frame(lds, wave_s); unsigned char* ws = P_WS;
          topk_gather(F, (const float*)(ws + WS_AFF), (const float*)(ws + WS_LSE), (int*)(ws + WS_SEL), (float*)(ws + WS_GATE), (int*)(ws + WS_IDX)); }
#endif
        xcd_barrier(bar);
#if PH_I
        { Frame F = make_frame(lds, wave_s); unsigned char* ws = P_WS; bf16* big = (bf16*)(ws + WS_BIG);
          pg8::Gemm g{(const bf16*)(ws + WS_HB), (const bf16*)(ws + WS_WGU), MEXP, NE * 2048, DM}; pg8::GroupedOrder S; S.init(NE, NB, 8, G, c);
          pg8::EpiSwiGLU E{(unsigned char*)(big + B_ACT / 2), (const LAS int*)(lds + AROW_OFF), 0};
          { const int* idxg = (const int*)(ws + WS_IDX); LAS int* arow = (LAS int*)(lds + AROW_OFF);
            int rv[NE]; const int r = F.tid & 255;
#pragma unroll
            for (int i = 0; i < NE; ++i) { pg8::Unit u; u.pm = 0; u.pn = 0; S.next(i, u); rv[i] = u.pm; }
            asm volatile("" ::: "memory");
#pragma unroll
            for (int i = 0; i < NE; ++i) rv[i] = idxg[(size_t)rv[i] * 256 + r];
#pragma unroll
            for (int i = 0; i < NE; ++i) if (F.tid < 256) arow[i * 256 + r] = rv[i];
            __syncthreads(); }
          pg8::gemm_phase<pg8::EpiSwiGLU, pg8::GroupedOrder, true, true, true>(F.tid, lds, g, S, E, (const LAS int*)(lds + AROW_OFF)); }
#endif
        xcd_barrier(bar);
#if PH_J
        { Frame F = make_frame(lds, wave_s); unsigned char* ws = P_WS; bf16* big = (bf16*)(ws + WS_BIG);
          pg8::Gemm g{big + B_ACT / 2, (const bf16*)(ws + WS_WD), MEXP, NE * 1024, DEX / 2}; pg8::GroupedOrder S; S.init(NE, NB, 4, G, c);
          pg8::EpiDown E{big + B_Y / 2, (const LAS float*)(lds + AROW_OFF), 0};
          { const float* gatev = (const float*)(ws + WS_GATE); LAS float* gl = (LAS float*)(lds + AROW_OFF);
            float gv[8]; int pmv[8]; const int r = F.tid & 255;
#pragma unroll
            for (int i = 0; i < 8; ++i) { pg8::Unit u; u.pm = 0; u.pn = 0; S.next(i, u); pmv[i] = u.pm; }
            asm volatile("" ::: "memory");
#pragma unroll
            for (int i = 0; i < 8; ++i) gv[i] = gatev[(size_t)pmv[i] * 256 + r];
#pragma unroll
            for (int i = 0; i < 8; ++i) if (F.tid < 256) gl[i * 256 + r] = gv[i];
            __syncthreads(); }
          pg8::gemm_phase<pg8::EpiDown, pg8::GroupedOrder, true, true, false, true>(F.tid, lds, g, S, E); }
#endif
        xcd_barrier(bar);
    }
#if PH_Z
    { Frame F = make_frame(lds, wave_s); unsigned char* ws = P_WS; norm_rows<false, true, true>(F, nullptr, (bf16*)(ws + WS_HB), P_IN(13), nullptr, P_OUT); }
#endif
}

extern "C" void kernel_launch(void* const* d_in, const int* in_sizes, int n_in, void* d_out, int out_size, void* d_ws, size_t ws_size, hipStream_t stream) {
    static int grid = 0;
    if (grid == 0) {
        if (n_in != 14 || out_size != MTOK * DM || ws_size < WS_END) { fprintf(stderr, "kernel_launch: unexpected shapes (n_in %d, out %d, ws %zu < %zu); nothing launched\n", n_in, out_size, ws_size, (size_t)WS_END); grid = -1; return; }
        int dev = 0, cus = 0, per_cu = 0;
        if (hipGetDevice(&dev) != hipSuccess || hipDeviceGetAttribute(&cus, hipDeviceAttributeMultiprocessorCount, dev) != hipSuccess) { grid = -1; return; }
        if (hipFuncSetAttribute((const void*)mk_fwd, hipFuncAttributeMaxDynamicSharedMemorySize, LDS_BYTES) != hipSuccess) { fprintf(stderr, "kernel_launch: hipFuncSetAttribute failed\n"); grid = -1; return; }
        if (hipOccupancyMaxActiveBlocksPerMultiprocessor(&per_cu, (const void*)mk_fwd, NWAVES * 64, LDS_BYTES) != hipSuccess || per_cu < 1) fprintf(stderr, "kernel_launch: occupancy query reports %d\n", per_cu);
        (void)hipGetLastError();
        grid = 256;
        if (cus != 256) fprintf(stderr, "kernel_launch: device has %d CUs, built for 256\n", cus);
    }
    if (grid < 0) return;
    (void)in_sizes;
    hipMemsetAsync((char*)d_ws + WS_CTL, 0, CTL_ZERO_BYTES, stream);
    Args a{};
    for (int i = 0; i < 14; ++i) a.in[i] = (const float*)d_in[i];
    a.out = (float*)d_out; a.ws = (unsigned char*)d_ws;
    hipLaunchKernelGGL(mk_fwd, dim3(grid), dim3(NWAVES * 64), LDS_BYTES, stream, a);
}
```

```cpp
#include <hip/hip_runtime.h>
#include <cstdio>
#include <cstdint>
typedef __bf16 nbf16x2 __attribute__((ext_vector_type(2)));
typedef __bf16 nbf16x4 __attribute__((ext_vector_type(4)));
typedef __bf16 nbf16x8 __attribute__((ext_vector_type(8)));
typedef float f32x2_t __attribute__((ext_vector_type(2)));
typedef float f32x8_t __attribute__((ext_vector_type(8)));
__device__ __forceinline__ unsigned pk2bf(float lo, float hi) { f32x2_t v = {lo, hi}; return __builtin_bit_cast(unsigned, __builtin_convertvector(v, nbf16x2)); }
__device__ __forceinline__ float bflo(unsigned w) { return __builtin_bit_cast(float, w << 16); }
__device__ __forceinline__ float bfhi(unsigned w) { return __builtin_bit_cast(float, w & 0xffff0000u); }
namespace pg8 {
#define PG8_LAS __attribute__((address_space(3)))
typedef unsigned short bf16_t;
typedef short bf16x8 __attribute__((ext_vector_type(8)));
typedef float f32x4 __attribute__((ext_vector_type(4)));
typedef unsigned u32x4 __attribute__((ext_vector_type(4)));
typedef int i32x4_t __attribute__((ext_vector_type(4)));
constexpr int BM = 256, BK = 64, HALF = 128, HTB = HALF * BK * 2  , STAGE_BYTES = 8 * HTB, NXCD = 8;
#ifndef PG8_WGM
#define PG8_WGM 8
#endif
#ifndef PG8_WGM_G
#define PG8_WGM_G 8
#endif
constexpr int WGM = PG8_WGM, WGM_G = PG8_WGM_G;

__host__ __device__ __forceinline__ int lds_byte(int r, int c) { const int st = (r >> 4) * 2 + (c >> 5), rr = r & 15, cc = c & 31, ob = rr * 64 + cc * 2; return st * 1024 + (ob ^ (((ob >> 9) & 1) << 5)); }
__host__ __device__ __forceinline__ void stage_rc(int b, int& R, int& C) { const int st = b / 1024, sb = b % 1024, swz = sb ^ (((sb >> 9) & 1) << 5); R = (st >> 1) * 16 + swz / 64; C = (st & 1) * 32 + (swz % 64) / 2; }
__host__ __device__ __forceinline__ int perm32(int rho) { const int n = rho >> 4, i = rho & 15; return 8 * (i >> 2) + 4 * n + (i & 3); }

struct Unit { int pm, pn; };
struct Gemm { const bf16_t* A; const bf16_t* Bt; int M, N, K; };

struct StaticOrder {
    int nM, nN, nwg, G, c;
    __host__ __device__ void init(int M, int N, int G_, int c_) { nM = M / BM; nN = N / BM; nwg = nM * nN; G = G_; c = c_; }
    __host__ __device__ bool next(int i, Unit& u) const {
        const long L = (long)i * G + c; if (L >= nwg) return false;
        int wgid = (int)L; { const int q = nwg / NXCD, r = nwg % NXCD, xcd = wgid % NXCD, off = wgid / NXCD; wgid = (xcd < r ? xcd * (q + 1) : r * (q + 1) + (xcd - r) * q) + off; }
        const int nig = WGM * nN, gid = wgid / nig, fm = gid * WGM, gsz = (nM - fm) < WGM ? (nM - fm) : WGM;
        u.pm = fm + ((wgid % nig) % gsz); u.pn = (wgid % nig) / gsz; return true;
    }
    __device__ __forceinline__ void a_ready(const Unit&) const {}
    __device__ __forceinline__ void done(const Unit&) const {}
};

struct GroupedOrder {
    int nMg, nNg, upg, ntot, G, c;
    __host__ __device__ void init(int ngrp, int nMg_, int nNg_, int G_, int c_) { nMg = nMg_; nNg = nNg_; upg = nMg * nNg; ntot = ngrp * upg; G = G_; c = c_; }
    __host__ __device__ bool next(int i, Unit& u) const {
        const long L = (long)i * G + c; if (L >= ntot) return false;
        const int e = (int)(L / upg); int wgid = (int)(L % upg);
        { const int q = upg / NXCD, r = upg % NXCD, xcd = wgid % NXCD, off = wgid / NXCD; wgid = (xcd < r ? xcd * (q + 1) : r * (q + 1) + (xcd - r) * q) + off; }
        const int nig = WGM_G * nNg, gid = wgid / nig, fm = gid * WGM_G, gsz = (nMg - fm) < WGM_G ? (nMg - fm) : WGM_G;
        u.pm = e * nMg + fm + ((wgid % nig) % gsz); u.pn = e * nNg + (wgid % nig) / gsz; return true;
    }
    __device__ __forceinline__ void a_ready(const Unit&) const {}
    __device__ __forceinline__ void done(const Unit&) const {}
};

#ifndef EPI_NT
#define EPI_NT 0
#endif
#if EPI_NT
#define EPI_ST(ptr, val) __builtin_nontemporal_store((val), (ptr))
#else
#define EPI_ST(ptr, val) (*(ptr) = (val))
#endif
#ifndef EPI_NT_B
#define EPI_NT_B 0
#endif
#if EPI_NT_B
#define EPI_ST_B(ptr, val) __builtin_nontemporal_store((val), (ptr))
#else
#define EPI_ST_B(ptr, val) (*(ptr) = (val))
#endif
__device__ __forceinline__ u32x4 pack8(const f32x4 a, const f32x4 b) { u32x4 w; w.x = pk2bf(a[0], a[1]); w.y = pk2bf(a[2], a[3]); w.z = pk2bf(b[0], b[1]); w.w = pk2bf(b[2], b[3]); return w; }
__device__ __forceinline__ void unpack8(const u32x4 w, f32x4& a, f32x4& b) { a = (f32x4){bflo(w.x), bfhi(w.x), bflo(w.y), bfhi(w.y)}; b = (f32x4){bflo(w.z), bfhi(w.z), bflo(w.w), bfhi(w.w)}; }
typedef unsigned u32x2 __attribute__((ext_vector_type(2)));
__device__ __forceinline__ unsigned pk4f8u(const f32x4 v) { int w = __builtin_amdgcn_cvt_pk_fp8_f32(v[0], v[1], 0, false); w = __builtin_amdgcn_cvt_pk_fp8_f32(v[2], v[3], w, true); return (unsigned)w; }
__device__ __forceinline__ float sigmoidf_fast(float x) { return __builtin_amdgcn_rcpf(1.0f + __builtin_amdgcn_exp2f(-1.4426950408889634f * x)); }

__device__ __forceinline__ size_t gate_blk(int pm, int pn, int wave, int ai, int m, int bj, int lane) { return ((size_t)(((pm * 4 + pn) * 8 + wave) * 16 + (ai * 8 + m * 2 + bj)) * 64 + lane) * 8; }
__device__ __forceinline__ u32x4 xchg_pair(const u32x4 v) { u32x4 r;
#pragma unroll
    for (int w = 0; w < 4; ++w) r[w] = (unsigned)__builtin_amdgcn_mov_dpp((int)v[w], 0xB1, 0xF, 0xF, true);
    return r; }
__device__ __forceinline__ void wide_pair(const u32x4 p0, const u32x4 p1, bool odd, u32x4& a, u32x4& b) {
    const u32x4 recv = xchg_pair(odd ? p0 : p1); a = odd ? recv : p0; b = odd ? p1 : recv; }
struct EpiInProj {
    static constexpr bool PERM = true, AFTER_DRAIN = false, WIDE = true, ROWSCALE = true; static constexpr int F8_SW = 0, F8_SA = 0;
    bf16_t *qa, *ka, *va, *qw, *kw, *vw, *gr, *g1; const float* bgate; float qscale;
    const float* rsv; mutable float rs0, rs1;
    __device__ __forceinline__ float row_rs(int ai, int m, int fr) const { return __builtin_bit_cast(float, __builtin_amdgcn_ds_bpermute((fr + 16 * m) << 2, __builtin_bit_cast(int, ai ? rs1 : rs0))); }
    __device__ __forceinline__ void operator()(const f32x4 (&acc)[2][2][4][2], const Unit& u, int wr, int wc, int fr, int fq) const {
        const int pn = u.pn; const int row0 = u.pm * BM + wr * 64 + fr;
        if (pn >= 15) {
            const int cc0 = (pn - 15) * HALF + wc * 32 + 8 * fq;
            f32x4 b0[2], b1[2];
#pragma unroll
            for (int n = 0; n < 2; ++n) { b0[n] = *(const f32x4*)(bgate + cc0 + 4 * n); b1[n] = *(const f32x4*)(bgate + 1024 + cc0 + 4 * n); }
#pragma unroll
            for (int ai = 0; ai < 2; ++ai)
#pragma unroll
                for (int m = 0; m < 4; ++m) { const size_t off = gate_blk(u.pm, (pn - 15) >> 1, wr * 4 + wc, ai, m, (pn - 15) & 1, fq * 16 + fr); f32x4 rr[2], gg[2]; const float rs = row_rs(ai, m, fr);
#pragma unroll
                    for (int n = 0; n < 2; ++n)
#pragma unroll
                        for (int j = 0; j < 4; ++j) { float a0 = acc[ai][0][m][n][j] * rs + b0[n][j], a1 = acc[ai][1][m][n][j] * rs + b1[n][j];
                            a0 = fminf(fmaxf(a0, -30.f), 30.f); a1 = fminf(fmaxf(a1, -30.f), 30.f);
                            const float e0 = __builtin_amdgcn_exp2f(-1.4426950408889634f * a0), e1 = __builtin_amdgcn_exp2f(-1.4426950408889634f * a1);
                            gg[n][j] = __builtin_amdgcn_rcpf(1.0f + e1); rr[n][j] = (1.0f + e1) * __builtin_amdgcn_rcpf(1.0f + e0); }
                    EPI_ST_B((u32x4*)(gr + off), pack8(rr[0], rr[1])); EPI_ST_B((u32x4*)(g1 + off), pack8(gg[0], gg[1])); }
            return;
        }
        bf16_t* base; int ldc, ct; float sc = 1.0f;
        if (pn < 3) { base = qa; ldc = 768; ct = pn; sc = qscale; }
        else if (pn < 6) { base = ka; ldc = 768; ct = pn - 3; }
        else if (pn < 9) { base = va; ldc = 768; ct = pn - 6; }
        else if (pn < 13) { base = qw; ldc = 1024; ct = pn - 9; sc = qscale; }
        else if (pn == 13) { base = kw; ldc = 256; ct = 0; }
        else { base = vw; ldc = 256; ct = 0; }
        const bool odd = (fr & 1) != 0;
        const int col0 = ct * BM + wc * 64 + 8 * fq + (odd ? 32 : 0);
#pragma unroll
        for (int ai = 0; ai < 2; ++ai)
#pragma unroll
            for (int m = 0; m < 4; ++m) { bf16_t* rowp = base + (size_t)(row0 - (odd ? 1 : 0) + ai * HALF + m * 16) * ldc + col0;
                const float s2 = sc * row_rs(ai, m, fr);
                u32x4 a, b; wide_pair(pack8(acc[ai][0][m][0] * s2, acc[ai][0][m][1] * s2), pack8(acc[ai][1][m][0] * s2, acc[ai][1][m][1] * s2), odd, a, b);
                EPI_ST_B((u32x4*)rowp, a); EPI_ST_B((u32x4*)(rowp + ldc), b); }
    }
};
struct EpiMergeDual {
    static constexpr bool PERM = true, AFTER_DRAIN = false, WIDE = true, ROWSCALE = false; static constexpr int F8_SW = 0, F8_SA = 0;
    bf16_t* merged; const bf16_t* gr; const bf16_t* g1;
    __device__ __forceinline__ size_t gblk(const Unit& u, int wr, int wc, int ai, int m, int bj, int fr, int fq) const { return gate_blk(u.pm, u.pn, wr * 4 + 2 * (wc & 1) + bj, ai, m, wc >> 1, fq * 16 + fr); }
    __device__ __forceinline__ void mid(f32x4 (&acc)[2][2][4][2], const Unit& u, int wr, int wc, int fr, int fq) const {
        u32x4 w[2][4][2];
#pragma unroll
        for (int ai = 0; ai < 2; ++ai)
#pragma unroll
            for (int m = 0; m < 4; ++m) {
#pragma unroll
                for (int bj = 0; bj < 2; ++bj) w[ai][m][bj] = *(const u32x4*)(gr + gblk(u, wr, wc, ai, m, bj, fr, fq)); }
        asm volatile("" ::: "memory");
#pragma unroll
        for (int ai = 0; ai < 2; ++ai)
#pragma unroll
            for (int m = 0; m < 4; ++m) {
#pragma unroll
                for (int bj = 0; bj < 2; ++bj) { f32x4 r0, r1; unpack8(w[ai][m][bj], r0, r1); acc[ai][bj][m][0] *= r0; acc[ai][bj][m][1] *= r1; } }
    }
    __device__ __forceinline__ void operator()(const f32x4 (&acc)[2][2][4][2], const Unit& u, int wr, int wc, int fr, int fq) const {
        const bool odd = (fr & 1) != 0;
        const int rowe = u.pm * BM + wr * 64 + (fr & ~1), col = u.pn * BM + wc * 64 + 8 * fq + (odd ? 32 : 0);
        u32x4 w[2][4][2];
#pragma unroll
        for (int ai = 0; ai < 2; ++ai)
#pragma unroll
            for (int m = 0; m < 4; ++m) {
#pragma unroll
                for (int bj = 0; bj < 2; ++bj) w[ai][m][bj] = *(const u32x4*)(g1 + gblk(u, wr, wc, ai, m, bj, fr, fq)); }
        asm volatile("" ::: "memory");
#pragma unroll
        for (int ai = 0; ai < 2; ++ai)
#pragma unroll
            for (int m = 0; m < 4; ++m) { f32x4 a0, a1, c0, c1; unpack8(w[ai][m][0], a0, a1); unpack8(w[ai][m][1], c0, c1);
                u32x4 a, b; wide_pair(pack8(acc[ai][0][m][0] * a0, acc[ai][0][m][1] * a1), pack8(acc[ai][1][m][0] * c0, acc[ai][1][m][1] * c1), odd, a, b);
                bf16_t* p = merged + (size_t)(rowe + ai * HALF + m * 16) * 1024 + col;
                EPI_ST((u32x4*)p, a); EPI_ST((u32x4*)(p + 1024), b); }
    }
};
struct EpiResid {
    static constexpr bool PERM = true, AFTER_DRAIN = false, WIDE = true, ROWSCALE = false; static constexpr int F8_SW = 0, F8_SA = 0;
    const bf16_t* base; bf16_t* out;
    __device__ __forceinline__ void operator()(const f32x4 (&acc)[2][2][4][2], const Unit& u, int wr, int wc, int fr, int fq) const {
        const bool odd = (fr & 1) != 0;
        const int rowe = u.pm * BM + wr * 64 + (fr & ~1), col = u.pn * BM + wc * 64 + 8 * fq + (odd ? 32 : 0);
        u32x4 la[2][4], lb[2][4];
#pragma unroll
        for (int ai = 0; ai < 2; ++ai)
#pragma unroll
            for (int m = 0; m < 4; ++m) { const bf16_t* p = base + (size_t)(rowe + ai * HALF + m * 16) * 1024 + col; la[ai][m] = *(const u32x4*)p; lb[ai][m] = *(const u32x4*)(p + 1024); }
        asm volatile("" ::: "memory");
#pragma unroll
        for (int ai = 0; ai < 2; ++ai)
#pragma unroll
            for (int m = 0; m < 4; ++m) {
                const u32x4 recv = xchg_pair(odd ? la[ai][m] : lb[ai][m]); const u32x4 r0 = odd ? recv : la[ai][m], r1 = odd ? lb[ai][m] : recv;
                f32x4 b0, b1, c0, c1; unpack8(r0, b0, b1); unpack8(r1, c0, c1);
                u32x4 a, b; wide_pair(pack8(b0 + acc[ai][0][m][0], b1 + acc[ai][0][m][1]), pack8(c0 + acc[ai][1][m][0], c1 + acc[ai][1][m][1]), odd, a, b);
                bf16_t* p = out + (size_t)(rowe + ai * HALF + m * 16) * 1024 + col;
                EPI_ST((u32x4*)p, a); EPI_ST((u32x4*)(p + 1024), b); }
    }
};
struct EpiSwiGLU {
    static constexpr bool PERM = true, AFTER_DRAIN = false, WIDE = false, ROWSCALE = false; static constexpr int F8_SW = 0, F8_SA = 0;
    unsigned char* act; const PG8_LAS int* arow; mutable int ui;
    __device__ __forceinline__ void operator()(const f32x4 (&acc)[2][2][4][2], const Unit& u, int wr, int wc, int fr, int fq) const {
        const int row0 = u.pm * BM + wr * 64 + fr, col0 = (u.pn & 7) * HALF + wc * 32 + 8 * fq;
#pragma unroll
        for (int ai = 0; ai < 2; ++ai)
#pragma unroll
            for (int m = 0; m < 4; ++m) { f32x4 o[2];
                const float rs = 1.0f / 1024.0f;
#pragma unroll
                for (int n = 0; n < 2; ++n)
#pragma unroll
                    for (int j = 0; j < 4; ++j) { const float a = acc[ai][0][m][n][j] * rs, up = acc[ai][1][m][n][j] * rs; o[n][j] = fminf(fmaxf(8.0f * a * sigmoidf_fast(a) * up, -440.f), 440.f); }
                u32x2 w8; w8.x = pk4f8u(o[0]); w8.y = pk4f8u(o[1]);
                *(u32x2*)(act + (size_t)(row0 + ai * HALF + m * 16) * 1024 + col0) = w8; }
        ++ui;
    }
};
struct EpiDown {
    static constexpr bool PERM = true, AFTER_DRAIN = false, WIDE = true, ROWSCALE = false; static constexpr int F8_SW = 0, F8_SA = 0;
    bf16_t* y; const PG8_LAS float* glds; mutable int ui;
    __device__ __forceinline__ void operator()(const f32x4 (&acc)[2][2][4][2], const Unit& u, int wr, int wc, int fr, int fq) const {
        const bool odd = (fr & 1) != 0;
        const int rowe = u.pm * BM + wr * 64 + (fr & ~1), col = (u.pn & 3) * BM + wc * 64 + 8 * fq + (odd ? 32 : 0);
#pragma unroll
        for (int ai = 0; ai < 2; ++ai)
#pragma unroll
            for (int m = 0; m < 4; ++m) { const float gv = glds[ui * 256 + wr * 64 + fr + ai * HALF + m * 16] * (1.0f / 512.0f);
                u32x4 a, b; wide_pair(pack8(acc[ai][0][m][0] * gv, acc[ai][0][m][1] * gv), pack8(acc[ai][1][m][0] * gv, acc[ai][1][m][1] * gv), odd, a, b);
                bf16_t* p = y + (size_t)(rowe + ai * HALF + m * 16) * 1024 + col;
                EPI_ST((u32x4*)p, a); EPI_ST((u32x4*)(p + 1024), b); }
        ++ui;
    }
};

template <class Epi, class Sched, bool ALIGN_EPI = false, bool SP2 = false, bool GATHER = false, bool FP8 = false>
__device__ __forceinline__ void gemm_phase(int tid_, PG8_LAS unsigned char* lds, const Gemm g, const Sched& S, const Epi& E, const PG8_LAS int* arow = nullptr) {
    static_assert(!GATHER || SP2, "GATHER is written for the SP2 loop");
    asm volatile("" : "+v"(tid_));
    const int tid = tid_, wid = __builtin_amdgcn_readfirstlane(tid >> 6), lane = tid & 63, wr = wid >> 2, wc = wid & 3, fr = lane & 15, fq = lane >> 4;
    const int K = g.K, nt = K / BK;
    unsigned voffA[2], voffB[2];
#pragma unroll
    for (int i = 0; i < 2; ++i) { int R, C; stage_rc(tid * 16 + i * 8192, R, C); const int Rb = Epi::WIDE ? ((R >> 5) * 64 + perm32(R & 31)) : (Epi::PERM ? ((R & ~31) + perm32(R & 31)) : R);
        voffA[i] = (unsigned)(R * K + C) * 2u; voffB[i] = (unsigned)(Rb * K + C) * 2u; }
    unsigned vA0[2] = {voffA[0], voffA[1]}, vA1[2] = {voffA[0], voffA[1]}, nA0[2] = {voffA[0], voffA[1]}, nA1[2] = {voffA[0], voffA[1]};
    int gR[2], gC[2];
#pragma unroll
    for (int i = 0; i < 2; ++i) { stage_rc(tid * 16 + i * 8192, gR[i], gC[i]); }
#define PG8_GOFF(dst0, dst1, u_) do { _Pragma("unroll") for (int _i = 0; _i < 2; ++_i) { \
        dst0[_i] = (((unsigned)arow[(u_) * 256 + gR[_i]] & 0xffffu) * (unsigned)K + (unsigned)gC[_i]) * 2u; dst1[_i] = (((unsigned)arow[(u_) * 256 + HALF + gR[_i]] & 0xffffu) * (unsigned)K + (unsigned)gC[_i]) * 2u; } } while (0)
    const size_t kstep = (size_t)(BK * 2);
    const size_t hstep = (size_t)HALF * K * 2;
    const size_t tstep = 2 * hstep;
    const size_t bhs = Epi::WIDE ? (size_t)32 * K * 2 : hstep;
    const size_t ahs = GATHER ? (size_t)0 : hstep, atstep = GATHER ? (size_t)0 : tstep;
    const unsigned ldsw = (unsigned)wid * 1024u;
    const int aoff = lds_byte(wr * 64 + fr, fq * 8), boff = lds_byte(wc * 32 + fr, fq * 8);
#define PG8_SA(b, h) (((b) * 2 + (h)) * HTB)
#define PG8_SB(b, h) ((4 + (b) * 2 + (h)) * HTB)
#define PG8_STAGE(bufoff, gbase, voff) do { _Pragma("unroll") for (int _i = 0; _i < 2; ++_i) \
        __builtin_amdgcn_global_load_lds((const unsigned*)((const char*)(gbase) + (voff)[_i]), (PG8_LAS unsigned*)(lds + (bufoff) + ldsw + _i * 8192), 16, 0, 0); } while (0)
#define PG8_LDA(dst, b, h) do { _Pragma("unroll") for (int m = 0; m < 4; ++m) _Pragma("unroll") for (int k = 0; k < 2; ++k) dst[m][k] = *(const PG8_LAS bf16x8*)(lds + PG8_SA(b, h) + aoff + m * 2048 + k * 1024); } while (0)
#define PG8_LDB(dst, b, h) do { _Pragma("unroll") for (int n = 0; n < 2; ++n) _Pragma("unroll") for (int k = 0; k < 2; ++k) dst[n][k] = *(const PG8_LAS bf16x8*)(lds + PG8_SB(b, h) + boff + n * 2048 + k * 1024); } while (0)
#define PG8_CAT8(x0, x1) __builtin_shufflevector(__builtin_bit_cast(i32x4_t, (x0)), __builtin_bit_cast(i32x4_t, (x1)), 0, 1, 2, 3, 4, 5, 6, 7)
#define PG8_MMA(ai, bj, At, Bt) do { __builtin_amdgcn_s_setprio(1); \
        if constexpr (FP8) { _Pragma("unroll") for (int m = 0; m < 4; ++m) _Pragma("unroll") for (int n = 0; n < 2; ++n) \
            asm volatile("v_mfma_f32_16x16x128_f8f6f4 %0, %1, %2, %0" : "+v"(acc[ai][bj][m][n]) : "v"(PG8_CAT8(Bt[n][0], Bt[n][1])), "v"(PG8_CAT8(At[m][0], At[m][1]))); } \
        else { _Pragma("unroll") for (int m = 0; m < 4; ++m) _Pragma("unroll") for (int n = 0; n < 2; ++n) _Pragma("unroll") for (int k = 0; k < 2; ++k) \
            acc[ai][bj][m][n] = __builtin_amdgcn_mfma_f32_16x16x32_bf16(Bt[n][k], At[m][k], acc[ai][bj][m][n], 0, 0, 0); } \
        __builtin_amdgcn_s_setprio(0); } while (0)
#define PG8_WAIT_V(n) asm volatile("s_waitcnt vmcnt(" #n ")" ::: "memory")
#define PG8_WAIT_L(n) asm volatile("s_waitcnt lgkmcnt(" #n ")" ::: "memory")
#define PG8_BAR __builtin_amdgcn_s_barrier()
#define PG8_SCHED __builtin_amdgcn_sched_barrier(0)
    Unit cur, nxt; int ui = 0;
    if (!S.next(0, cur)) return;
    f32x4 acc[2][2][4][2];
#pragma unroll
    for (int a = 0; a < 2; ++a)
#pragma unroll
        for (int b = 0; b < 2; ++b)
#pragma unroll
            for (int m = 0; m < 4; ++m)
#pragma unroll
                for (int n = 0; n < 2; ++n) acc[a][b][m][n] = (f32x4){0.f, 0.f, 0.f, 0.f};
    bf16x8 At[4][2], B0[2][2], B1[2][2];
    const char* cA = (const char*)g.A + (size_t)cur.pm * atstep; const char* cB = (const char*)g.Bt + (size_t)cur.pn * tstep;
    if constexpr (GATHER) { PG8_GOFF(vA0, vA1, 0); }
    S.a_ready(cur);
    if constexpr (SP2) {
        PG8_STAGE(PG8_SB(0, 0), cB, voffB); PG8_STAGE(PG8_SB(0, 1), cB + bhs, voffB); PG8_STAGE(PG8_SA(0, 0), cA, vA0); PG8_STAGE(PG8_SA(0, 1), cA + ahs, vA1);
        if (wr == 1) PG8_BAR;
        PG8_WAIT_V(2); PG8_BAR;
        PG8_STAGE(PG8_SB(1, 0), cB + kstep, voffB); PG8_STAGE(PG8_SA(1, 0), cA + kstep, vA0); PG8_STAGE(PG8_SB(1, 1), cB + bhs + kstep, voffB);
        PG8_WAIT_V(6); PG8_BAR;
    } else {
        PG8_STAGE(PG8_SB(0, 0), cB, voffB); PG8_STAGE(PG8_SA(0, 0), cA, voffA); PG8_STAGE(PG8_SB(0, 1), cB + bhs, voffB); PG8_STAGE(PG8_SA(0, 1), cA + hstep, voffA);
        if (wr == 1) PG8_BAR;
        PG8_WAIT_V(4); PG8_BAR;
        PG8_STAGE(PG8_SB(1, 0), cB + kstep, voffB); PG8_STAGE(PG8_SA(1, 0), cA + kstep, voffA); PG8_STAGE(PG8_SB(1, 1), cB + bhs + kstep, voffB);
        PG8_WAIT_V(6); PG8_BAR;
    }
    for (;;) {
        const bool has_next = S.next(ui + 1, nxt);
        const char* nA = has_next ? (const char*)g.A + (size_t)nxt.pm * atstep : cA; const char* nB = has_next ? (const char*)g.Bt + (size_t)nxt.pn * tstep : cB;
#pragma unroll 1
        for (int t = 0; t < nt; t += 2) {
            const bool last = (t == nt - 2);
            const char* a1 = cA + (size_t)(t + 1) * kstep;
            const char* a2 = last ? nA : cA + (size_t)(t + 2) * kstep; const char* b2 = last ? nB : cB + (size_t)(t + 2) * kstep;
            const char* a3 = a2 + kstep; const char* b3 = b2 + kstep;
            if (last && has_next) S.a_ready(nxt);
            if constexpr (Epi::ROWSCALE) { if (last) { E.rs0 = E.rsv[cur.pm * BM + wr * 64 + lane]; E.rs1 = E.rsv[cur.pm * BM + HALF + wr * 64 + lane]; } }
            unsigned s0[2] = {vA0[0], vA0[1]}, s1[2] = {vA1[0], vA1[1]};
            if constexpr (GATHER) { if (last && has_next) { PG8_GOFF(nA0, nA1, ui + 1); s0[0] = nA0[0]; s0[1] = nA0[1]; s1[0] = nA1[0]; s1[1] = nA1[1]; } }
            if constexpr (SP2) {
            PG8_LDB(B0, 0, 0); PG8_LDB(B1, 0, 1); PG8_SCHED; PG8_LDA(At, 0, 0); PG8_STAGE(PG8_SA(1, 1), a1 + ahs, vA1);
            PG8_WAIT_V(8); PG8_WAIT_L(0); PG8_BAR; PG8_MMA(0, 0, At, B0); PG8_MMA(0, 1, At, B1); PG8_BAR; PG8_SCHED;
            PG8_LDA(At, 0, 1); PG8_STAGE(PG8_SB(0, 0), b2, voffB); PG8_STAGE(PG8_SB(0, 1), b2 + bhs, voffB); PG8_STAGE(PG8_SA(0, 0), a2, s0);
            PG8_WAIT_V(8); PG8_WAIT_L(0); PG8_BAR; PG8_MMA(1, 0, At, B0); PG8_MMA(1, 1, At, B1); PG8_BAR; PG8_SCHED;
            PG8_LDB(B0, 1, 0); PG8_LDB(B1, 1, 1); PG8_SCHED; PG8_LDA(At, 1, 0); PG8_STAGE(PG8_SA(0, 1), a2 + ahs, s1);
            PG8_WAIT_V(8); PG8_WAIT_L(0); PG8_BAR; PG8_MMA(0, 0, At, B0); PG8_MMA(0, 1, At, B1); PG8_BAR; PG8_SCHED;
            PG8_LDA(At, 1, 1); PG8_STAGE(PG8_SB(1, 0), b3, voffB); PG8_STAGE(PG8_SB(1, 1), b3 + bhs, voffB); PG8_STAGE(PG8_SA(1, 0), a3, s0);
            PG8_WAIT_V(8); PG8_WAIT_L(0); PG8_BAR; PG8_MMA(1, 0, At, B0); PG8_MMA(1, 1, At, B1); PG8_BAR; PG8_SCHED;
            } else {
            PG8_LDB(B0, 0, 0); PG8_SCHED; PG8_LDA(At, 0, 0); PG8_STAGE(PG8_SA(1, 1), a1 + hstep, voffA);
            PG8_WAIT_L(8); PG8_BAR; PG8_WAIT_L(0); PG8_MMA(0, 0, At, B0); PG8_BAR; PG8_SCHED;
            PG8_LDB(B1, 0, 1); PG8_STAGE(PG8_SB(0, 0), b2, voffB);
            PG8_BAR; PG8_WAIT_L(0); PG8_MMA(0, 1, At, B1); PG8_BAR;
            PG8_LDA(At, 0, 1); PG8_STAGE(PG8_SA(0, 0), a2, voffA);
            PG8_BAR; PG8_WAIT_L(0); PG8_MMA(1, 0, At, B0); PG8_BAR; PG8_SCHED;
            PG8_STAGE(PG8_SB(0, 1), b2 + bhs, voffB);
            PG8_WAIT_V(6); PG8_BAR; PG8_MMA(1, 1, At, B1); PG8_BAR;
            PG8_LDB(B0, 1, 0); PG8_SCHED; PG8_LDA(At, 1, 0); PG8_STAGE(PG8_SA(0, 1), a2 + hstep, voffA);
            PG8_WAIT_L(8); PG8_BAR; PG8_WAIT_L(0); PG8_MMA(0, 0, At, B0); PG8_BAR; PG8_SCHED;
            PG8_LDB(B1, 1, 1); PG8_STAGE(PG8_SB(1, 0), b3, voffB);
            PG8_BAR; PG8_WAIT_L(0); PG8_MMA(0, 1, At, B1); PG8_BAR;
            PG8_LDA(At, 1, 1); PG8_STAGE(PG8_SA(1, 0), a3, voffA);
            PG8_BAR; PG8_WAIT_L(0); PG8_MMA(1, 0, At, B0); PG8_BAR; PG8_SCHED;
            PG8_STAGE(PG8_SB(1, 1), b3 + bhs, voffB);
            PG8_WAIT_V(6); PG8_BAR; PG8_MMA(1, 1, At, B1); PG8_BAR;
            }
        }
        if constexpr (ALIGN_EPI) { if (wr == 0) PG8_BAR; }
        if constexpr (FP8) asm volatile("s_nop 15\n\ts_nop 15" ::: "memory");
        if constexpr (!Epi::AFTER_DRAIN) { E(acc, cur, wr, wc, fr, fq); S.done(cur); }
        if (!has_next) break;
#pragma unroll
        for (int a = 0; a < 2; ++a)
#pragma unroll
            for (int b = 0; b < 2; ++b)
#pragma unroll
                for (int m = 0; m < 4; ++m)
#pragma unroll
                    for (int n = 0; n < 2; ++n) acc[a][b][m][n] = (f32x4){0.f, 0.f, 0.f, 0.f};
        cur = nxt; cA = nA; cB = nB; ++ui;
        if constexpr (GATHER) { vA0[0] = nA0[0]; vA0[1] = nA0[1]; vA1[0] = nA1[0]; vA1[1] = nA1[1]; }
        if constexpr (ALIGN_EPI) { if (wr == 1) PG8_BAR; }
    }
    PG8_WAIT_V(0);
    if constexpr (!ALIGN_EPI) { if (wr == 0) PG8_BAR; }
    PG8_BAR;
    if constexpr (Epi::AFTER_DRAIN) { E.fused(acc, cur, wr, wc, fr, fq, lds, wid, lane); S.done(cur); }
#undef PG8_SA
#undef PG8_SB
#undef PG8_STAGE
#undef PG8_LDA
#undef PG8_LDB
#undef PG8_MMA
#undef PG8_CAT8
#undef PG8_WAIT_V
#undef PG8_WAIT_L
#undef PG8_BAR
#undef PG8_SCHED
#undef PG8_GOFF
}

template <class Epi, class Sched>
__device__ __forceinline__ void gemm_phase_dual(int tid_, PG8_LAS unsigned char* lds, const Gemm g0, const Gemm g1, const Sched& S, const Epi& E) {
    asm volatile("" : "+v"(tid_));
    const int tid = tid_, wid = __builtin_amdgcn_readfirstlane(tid >> 6), lane = tid & 63, wr = wid >> 2, wc = wid & 3, fr = lane & 15, fq = lane >> 4;
    unsigned vA_0[2], vB_0[2], vA_1[2], vB_1[2];
#pragma unroll
    for (int i = 0; i < 2; ++i) { int R, C; stage_rc(tid * 16 + i * 8192, R, C); const int Rb = Epi::WIDE ? ((R >> 5) * 64 + perm32(R & 31)) : (Epi::PERM ? ((R & ~31) + perm32(R & 31)) : R);
        vA_0[i] = (unsigned)(R * g0.K + C) * 2u; vB_0[i] = (unsigned)(Rb * g0.K + C) * 2u; vA_1[i] = (unsigned)(R * g1.K + C) * 2u; vB_1[i] = (unsigned)(Rb * g1.K + C) * 2u; }
    const size_t kstep = (size_t)(BK * 2);
    const size_t hs_0 = (size_t)HALF * g0.K * 2, hs_1 = (size_t)HALF * g1.K * 2;
#define PG8_BH(x) (Epi::WIDE ? (x) / 4 : (x))
    const int nt_0 = g0.K / BK, nt_1 = g1.K / BK;
    const unsigned ldsw = (unsigned)wid * 1024u;
    const int aoff = lds_byte(wr * 64 + fr, fq * 8), boff = lds_byte(wc * 32 + fr, fq * 8);
#define PG8_SA(b, h) (((b) * 2 + (h)) * HTB)
#define PG8_SB(b, h) ((4 + (b) * 2 + (h)) * HTB)
#define PG8_STAGE(bufoff, gbase, voff) do { _Pragma("unroll") for (int _i = 0; _i < 2; ++_i) \
        __builtin_amdgcn_global_load_lds((const unsigned*)((const char*)(gbase) + (voff)[_i]), (PG8_LAS unsigned*)(lds + (bufoff) + ldsw + _i * 8192), 16, 0, 0); } while (0)
#define PG8_LDA(dst, b, h) do { _Pragma("unroll") for (int m = 0; m < 4; ++m) _Pragma("unroll") for (int k = 0; k < 2; ++k) dst[m][k] = *(const PG8_LAS bf16x8*)(lds + PG8_SA(b, h) + aoff + m * 2048 + k * 1024); } while (0)
#define PG8_LDB(dst, b, h) do { _Pragma("unroll") for (int n = 0; n < 2; ++n) _Pragma("unroll") for (int k = 0; k < 2; ++k) dst[n][k] = *(const PG8_LAS bf16x8*)(lds + PG8_SB(b, h) + boff + n * 2048 + k * 1024); } while (0)
#define PG8_MMA(ai, bj, At, Bt) do { __builtin_amdgcn_s_setprio(1); _Pragma("unroll") for (int m = 0; m < 4; ++m) _Pragma("unroll") for (int n = 0; n < 2; ++n) _Pragma("unroll") for (int k = 0; k < 2; ++k) \
        acc[ai][bj][m][n] = __builtin_amdgcn_mfma_f32_16x16x32_bf16(Bt[n][k], At[m][k], acc[ai][bj][m][n], 0, 0, 0); __builtin_amdgcn_s_setprio(0); } while (0)
#define PG8_WAIT_V(n) asm volatile("s_waitcnt vmcnt(" #n ")" ::: "memory")
#define PG8_WAIT_L(n) asm volatile("s_waitcnt lgkmcnt(" #n ")" ::: "memory")
#define PG8_BAR __builtin_amdgcn_s_barrier()
#define PG8_SCHED __builtin_amdgcn_sched_barrier(0)
    Unit cur, nxt; int ui = 0, s = 0;
    if (!S.next(0, cur)) return;
    f32x4 acc[2][2][4][2];
#pragma unroll
    for (int a = 0; a < 2; ++a)
#pragma unroll
        for (int b = 0; b < 2; ++b)
#pragma unroll
            for (int m = 0; m < 4; ++m)
#pragma unroll
                for (int n = 0; n < 2; ++n) acc[a][b][m][n] = (f32x4){0.f, 0.f, 0.f, 0.f};
    bf16x8 At[4][2], B0[2][2], B1[2][2];
    const char* cA = (const char*)g0.A + (size_t)cur.pm * 2 * hs_0; const char* cB = (const char*)g0.Bt + (size_t)cur.pn * 2 * hs_0;
    size_t hsC = hs_0; unsigned vAc[2] = {vA_0[0], vA_0[1]}, vBc[2] = {vB_0[0], vB_0[1]};
    PG8_STAGE(PG8_SB(0, 0), cB, vBc); PG8_STAGE(PG8_SB(0, 1), cB + PG8_BH(hsC), vBc); PG8_STAGE(PG8_SA(0, 0), cA, vAc); PG8_STAGE(PG8_SA(0, 1), cA + hsC, vAc);
    if (wr == 1) PG8_BAR;
    PG8_WAIT_V(2); PG8_BAR;
    PG8_STAGE(PG8_SB(1, 0), cB + kstep, vBc); PG8_STAGE(PG8_SA(1, 0), cA + kstep, vAc); PG8_STAGE(PG8_SB(1, 1), cB + PG8_BH(hsC) + kstep, vBc);
    PG8_WAIT_V(6); PG8_BAR;
    for (;;) {
        bool has_next = true; if (s == 1) has_next = S.next(ui + 1, nxt);
        const int npm = (s == 0) ? cur.pm : nxt.pm, npn = (s == 0) ? cur.pn : nxt.pn;
        const size_t hsN = has_next ? (s == 0 ? hs_1 : hs_0) : hsC;
        const char* nA = has_next ? (s == 0 ? (const char*)g1.A : (const char*)g0.A) + (size_t)npm * 2 * hsN : cA;
        const char* nB = has_next ? (s == 0 ? (const char*)g1.Bt : (const char*)g0.Bt) + (size_t)npn * 2 * hsN : cB;
        unsigned vAn[2], vBn[2];
#pragma unroll
        for (int i = 0; i < 2; ++i) { vAn[i] = has_next ? (s == 0 ? vA_1[i] : vA_0[i]) : vAc[i]; vBn[i] = has_next ? (s == 0 ? vB_1[i] : vB_0[i]) : vBc[i]; }
        const int nt = (s == 0) ? nt_0 : nt_1;
#pragma unroll 1
        for (int t = 0; t < nt; t += 2) {
            const bool last = (t == nt - 2);
            const char* a1 = cA + (size_t)(t + 1) * kstep;
            const char* a2 = last ? nA : cA + (size_t)(t + 2) * kstep; const char* b2 = last ? nB : cB + (size_t)(t + 2) * kstep;
            const char* a3 = a2 + kstep; const char* b3 = b2 + kstep;
            const size_t hs2 = last ? hsN : hsC;
            unsigned vA2[2], vB2[2];
#pragma unroll
            for (int i = 0; i < 2; ++i) { vA2[i] = last ? vAn[i] : vAc[i]; vB2[i] = last ? vBn[i] : vBc[i]; }
            PG8_LDB(B0, 0, 0); PG8_LDB(B1, 0, 1); PG8_SCHED; PG8_LDA(At, 0, 0); PG8_STAGE(PG8_SA(1, 1), a1 + hsC, vAc);
            PG8_WAIT_V(8); PG8_WAIT_L(0); PG8_BAR; PG8_MMA(0, 0, At, B0); PG8_MMA(0, 1, At, B1); PG8_BAR; PG8_SCHED;
            PG8_LDA(At, 0, 1); PG8_STAGE(PG8_SB(0, 0), b2, vB2); PG8_STAGE(PG8_SB(0, 1), b2 + PG8_BH(hs2), vB2); PG8_STAGE(PG8_SA(0, 0), a2, vA2);
            PG8_WAIT_V(8); PG8_WAIT_L(0); PG8_BAR; PG8_MMA(1, 0, At, B0); PG8_MMA(1, 1, At, B1); PG8_BAR; PG8_SCHED;
            PG8_LDB(B0, 1, 0); PG8_LDB(B1, 1, 1); PG8_SCHED; PG8_LDA(At, 1, 0); PG8_STAGE(PG8_SA(0, 1), a2 + hs2, vA2);
            PG8_WAIT_V(8); PG8_WAIT_L(0); PG8_BAR; PG8_MMA(0, 0, At, B0); PG8_MMA(0, 1, At, B1); PG8_BAR; PG8_SCHED;
            PG8_LDA(At, 1, 1); PG8_STAGE(PG8_SB(1, 0), b3, vB2); PG8_STAGE(PG8_SB(1, 1), b3 + PG8_BH(hs2), vB2); PG8_STAGE(PG8_SA(1, 0), a3, vA2);
            PG8_WAIT_V(8); PG8_WAIT_L(0); PG8_BAR; PG8_MMA(1, 0, At, B0); PG8_MMA(1, 1, At, B1); PG8_BAR; PG8_SCHED;
        }
        if (wr == 0) PG8_BAR;
        if (s == 0) E.mid(acc, cur, wr, wc, fr, fq); else E(acc, cur, wr, wc, fr, fq);
        if (!has_next) break;
        if (s == 1) {
#pragma unroll
            for (int a = 0; a < 2; ++a)
#pragma unroll
                for (int b = 0; b < 2; ++b)
#pragma unroll
                    for (int m = 0; m < 4; ++m)
#pragma unroll
                        for (int n = 0; n < 2; ++n) acc[a][b][m][n] = (f32x4){0.f, 0.f, 0.f, 0.f};
            cur = nxt; ++ui; }
        s ^= 1; cA = nA; cB = nB; hsC = hsN;
#pragma unroll
        for (int i = 0; i < 2; ++i) { vAc[i] = vAn[i]; vBc[i] = vBn[i]; }
        if (wr == 1) PG8_BAR;
    }
    PG8_WAIT_V(0);
    PG8_BAR;
#undef PG8_SA
#undef PG8_SB
#undef PG8_STAGE
#undef PG8_LDA
#undef PG8_LDB
#undef PG8_MMA
#undef PG8_WAIT_V
#undef PG8_WAIT_L
#undef PG8_BAR
#undef PG8_SCHED
#undef PG8_BH
}
}

constexpr int NWAVES = 8;
constexpr int NB = 32, SEQ = 2048, DM = 1024, MTOK = NB * SEQ, DEPTH = 4;
constexpr int INC = 5888, NE = 16, CAP = 256, DEX = 1024, MEXP = NE * NB * CAP;
constexpr float RMS_EPS = 1e-6f, LOG2E = 1.4426950408889634f;
constexpr float QSCALE = 0.125f * LOG2E;

constexpr size_t MiB = 1u << 20;
constexpr size_t WS_CTL = 0, CTL_ZERO_BYTES = 32768;
constexpr size_t WS_WIN = 1 * MiB;
constexpr size_t WS_WA = WS_WIN + (size_t)INC * DM * 2;
constexpr size_t WS_WB = WS_WA + (size_t)DM * 256 * 2;
constexpr size_t WS_WO = WS_WB + (size_t)DM * DM * 2;
constexpr size_t WS_WGU = WS_WO + (size_t)DM * DM * 2;
constexpr size_t WS_WD = WS_WGU + (size_t)NE * 2048 * DM * 2;
constexpr size_t WS_HN = WS_WD + (size_t)NE * DM * DEX * 2;
constexpr size_t WS_BIG = WS_HN + (size_t)MTOK * DM * 2;
constexpr size_t B_QA = 0, B_KA = 96 * MiB, B_VA = 192 * MiB, B_QW = 288 * MiB, B_KW = 416 * MiB, B_VW = 448 * MiB, B_G = 480 * MiB, B_OA = 736 * MiB, B_END = 768 * MiB;
constexpr size_t B_MERGED = 0;
constexpr size_t B_XE = 0, B_ACT = 256 * MiB, B_Y = 512 * MiB;
constexpr size_t WS_AFF = WS_BIG + B_END;
constexpr size_t WS_SEL = WS_AFF + (size_t)MTOK * NE * 4;
constexpr size_t WS_GATE = WS_SEL + (size_t)MTOK * NE * 4;
constexpr size_t WS_LSE = WS_GATE + (size_t)MEXP * 4;
constexpr size_t WS_IDX = WS_LSE + (size_t)3 * MTOK * 4 * 4;
constexpr size_t WS_HB = WS_IDX + (size_t)MEXP * 4;
constexpr size_t WS_END = WS_HB + (size_t)MTOK * DM * 2;
static_assert(WS_WIN % 256 == 0 && WS_WA % 256 == 0 && WS_WGU % 256 == 0 && WS_HN % 256 == 0 && WS_BIG % 256 == 0 && WS_AFF % 256 == 0, "alignment");
constexpr int CW_BAR = 4096;
constexpr int AROW_OFF = 131072;
constexpr int MISC_OFF = 147456, LDS_BYTES = 151552;

#define GAS __attribute__((address_space(1)))
#define LAS __attribute__((address_space(3)))
typedef unsigned short bf16;
typedef unsigned v4u __attribute__((ext_vector_type(4)));
typedef unsigned v2u __attribute__((ext_vector_type(2)));
typedef float f32x4 __attribute__((ext_vector_type(4)));
typedef float f32x16 __attribute__((ext_vector_type(16)));
typedef short bf16x8 __attribute__((ext_vector_type(8)));
#define LDS_WAIT() asm volatile("s_waitcnt lgkmcnt(0)" ::: "memory")
#define VM_WAIT() asm volatile("s_waitcnt vmcnt(0)" ::: "memory")

#define XB_TMO      128
#define XB_XCNT(j)  (256  + 64 * (j))
#define XB_XSUB(j)  (1280 + 64 * (j))
#define XB_XGEN(j)  (2304 + 64 * (j))
#define XB_TOP      3328
#define XB_TOPGEN   3392
#define XCD_BAR_WORDS 3456
#define XB_SPIN_CAP (1u << 18)

__device__ __forceinline__ unsigned xb_ld(unsigned* p)              { return __hip_atomic_load(p, __ATOMIC_RELAXED, __HIP_MEMORY_SCOPE_AGENT); }
__device__ __forceinline__ unsigned xb_add(unsigned* p, unsigned v) { return __hip_atomic_fetch_add(p, v, __ATOMIC_RELAXED, __HIP_MEMORY_SCOPE_AGENT); }
__device__ __forceinline__ unsigned xb_xcc_id() { return (unsigned)__builtin_amdgcn_s_getreg((3 << 11) | 20) & 0xFu; }
#define XB_SPIN(cond, bar) do { unsigned _sp = 0; while (cond) { __builtin_amdgcn_s_sleep(1); \
    if ((++_sp & 255u) == 0u) { if (xb_ld(&(bar)[XB_TMO])) break; if (_sp > XB_SPIN_CAP) { atomicAdd(&(bar)[XB_TMO], 1u); break; } } } } while (0)

__device__ __forceinline__ int xb_lane() { unsigned z = 0u; asm volatile("" : "+v"(z)); return (int)__builtin_amdgcn_mbcnt_hi(~0u, __builtin_amdgcn_mbcnt_lo(~0u, z)); }
struct XcdBarrier {
    int w;
    unsigned* bar; unsigned x;
    volatile LAS unsigned* st;
};

__device__ __forceinline__ XcdBarrier xcd_barrier_post(unsigned* bar, volatile LAS unsigned* st, int wave) {
    XcdBarrier b; b.w = wave; b.bar = bar; b.x = xb_xcc_id(); b.st = st;
    if (wave == 0 && xb_lane() == 0) (void)xb_add(&bar[XB_XCNT(b.x)], 1u);
    return b;
}
__device__ __forceinline__ void xcd_barrier_complete(unsigned* bar, unsigned x, unsigned& nloc, unsigned& nx) {
    const unsigned G = gridDim.x * gridDim.y * gridDim.z;
    unsigned sum, cnt, mine, sp = 0u;
    for (;;) {
        sum = 0u; cnt = 0u; mine = 0u;
#pragma unroll
        for (unsigned j = 0; j < 16; ++j) { const unsigned c = xb_ld(&bar[XB_XCNT(j)]); sum += c; cnt += (c > 0u) ? 1u : 0u; mine = (j == x) ? c : mine; }
        if (sum == G) break;
        __builtin_amdgcn_s_sleep(1);
        if ((++sp & 255u) == 0u) { if (xb_ld(&bar[XB_TMO])) break; if (sp > XB_SPIN_CAP) { atomicAdd(&bar[XB_TMO], 1u); break; } }
    }
    nloc = mine > 0u ? mine : 1u; nx = cnt > 0u ? cnt : 1u;
}

__device__ __forceinline__ void xcd_barrier(const XcdBarrier& b) {
    asm volatile("s_waitcnt vmcnt(0)" ::: "memory");
    __syncthreads();
    if (b.w == 0 && xb_lane() == 0) {
        unsigned* bar = b.bar;
        __builtin_amdgcn_s_waitcnt(0);
        unsigned nloc = b.st[0], nx = b.st[1];
        if (nloc == 0u) { xcd_barrier_complete(bar, b.x, nloc, nx); b.st[0] = nloc; b.st[1] = nx; }
        const unsigned old = xb_add(&bar[XB_XSUB(b.x)], 1u);
        const unsigned gen = old / nloc;
        if (old + 1u == (gen + 1u) * nloc) {
            __builtin_amdgcn_fence(__ATOMIC_RELEASE, "agent");
            asm volatile("s_waitcnt vmcnt(0)" ::: "memory");
            const unsigned og = xb_add(&bar[XB_TOP], 1u);
            const unsigned tg = og / nx;
            if (og + 1u == (tg + 1u) * nx) xb_add(&bar[XB_TOPGEN], 1u);
            else XB_SPIN(xb_ld(&bar[XB_TOPGEN]) == tg, bar);
            __builtin_amdgcn_fence(__ATOMIC_ACQUIRE, "agent");
            xb_add(&bar[XB_XGEN(b.x)], 1u);
            asm volatile("s_waitcnt vmcnt(0)" ::: "memory");
        } else {
            XB_SPIN(xb_ld(&bar[XB_XGEN(b.x)]) == gen, bar);
            __builtin_amdgcn_fence(__ATOMIC_ACQUIRE, "agent");
            asm volatile("s_waitcnt vmcnt(0)" ::: "memory");
        }
    }
    __syncthreads();
}

struct Frame {
    LAS unsigned char* lds;
    int tid, lane, wave, gw;
};
constexpr int PTAB_OFF = MISC_OFF + 256;
__device__ __forceinline__ unsigned long long ptab_get(LAS unsigned char* lds, int i) {
    LAS unsigned char* base = lds + PTAB_OFF; asm volatile("" : "+v"(base));
    const unsigned long long v = ((const volatile LAS unsigned long long*)base)[i];
    const unsigned lo = __builtin_amdgcn_readfirstlane((unsigned)v), hi = __builtin_amdgcn_readfirstlane((unsigned)(v >> 32));
    return ((unsigned long long)hi << 32) | lo;
}
#define P_IN(i) ((const float*)(const GAS float*)ptab_get(F.lds, (i)))
#define P_OUT ((float*)(GAS float*)ptab_get(F.lds, 14))
#define P_WS ((unsigned char*)(GAS unsigned char*)ptab_get(F.lds, 15))
__device__ __forceinline__ Frame make_frame(LAS unsigned char* lds, int wave_s) { Frame F; F.lds = lds; int bx = blockIdx.x; asm volatile("" : "+s"(bx));
    int ln = xb_lane(); asm volatile("" : "+v"(ln));
    F.lane = ln; F.wave = wave_s; F.tid = wave_s * 64 + ln; F.gw = bx * NWAVES + F.wave; return F; }
__device__ __forceinline__ float shx(float v, int o, int lane) { return __builtin_bit_cast(float, __builtin_amdgcn_ds_bpermute((lane ^ o) << 2, __builtin_bit_cast(int, v))); }
__device__ __forceinline__ unsigned shrel(unsigned v, int d, int lane) { return (unsigned)__builtin_amdgcn_ds_bpermute(((lane + d) & 63) << 2, (int)v); }
__device__ __forceinline__ float wave_sum(float v, int lane) {
#pragma unroll
    for (int o = 1; o < 64; o <<= 1) v += shx(v, o, lane);
    return v;
}
template <bool SCALE = false>
__device__ __forceinline__ void transpose_item(const float* W, int K, int N, bf16* dst, LAS float* scr, int k0, int n0, int lane, const float* gk = nullptr) {
    float tv[32];
#pragma unroll
    for (int i = 0; i < 32; ++i) { const int kk = 2 * i + (lane >> 5); tv[i] = W[(size_t)(k0 + kk) * N + n0 + (lane & 31)]; }
#pragma unroll
    for (int i = 0; i < 32; ++i) { const int kk = 2 * i + (lane >> 5); scr[kk * 33 + (lane & 31)] = tv[i]; }
    LDS_WAIT(); asm volatile("" ::: "memory");
    const int c = lane & 7;
    f32x4 ga = {1.f, 1.f, 1.f, 1.f}, gb = {1.f, 1.f, 1.f, 1.f};
    if (SCALE) { ga = *(const f32x4*)(gk + k0 + 8 * c); gb = *(const f32x4*)(gk + k0 + 8 * c + 4); }
#pragma unroll
    for (int j = 0; j < 4; ++j) { const int n = (lane >> 3) + 8 * j; const LAS float* s = scr + (8 * c) * 33 + n;
        v4u o; o.x = pk2bf(s[0 * 33] * ga.x, s[1 * 33] * ga.y); o.y = pk2bf(s[2 * 33] * ga.z, s[3 * 33] * ga.w); o.z = pk2bf(s[4 * 33] * gb.x, s[5 * 33] * gb.y); o.w = pk2bf(s[6 * 33] * gb.z, s[7 * 33] * gb.w);
        *(GAS v4u*)(dst + (size_t)n * K + k0 + 8 * c) = o; }
    LDS_WAIT(); asm volatile("" ::: "memory");
}
__device__ __forceinline__ float f8clamp(float x) { return fminf(fmaxf(x, -440.f), 440.f); }
__device__ __forceinline__ unsigned pk4f8(float a, float b, float c, float d) {
    int w = __builtin_amdgcn_cvt_pk_fp8_f32(f8clamp(a), f8clamp(b), 0, false); w = __builtin_amdgcn_cvt_pk_fp8_f32(f8clamp(c), f8clamp(d), w, true); return (unsigned)w; }
template <bool SCALE = false>
__device__ __forceinline__ void transpose_item8(const float* W, int K, int N, unsigned char* dst8, LAS float* scr, int k0, int n0, int lane, float mul, const float* gk = nullptr) {
    float tv[32];
#pragma unroll
    for (int i = 0; i < 32; ++i) { const int kk = 2 * i + (lane >> 5); tv[i] = W[(size_t)(k0 + kk) * N + n0 + (lane & 31)]; }
#pragma unroll
    for (int i = 0; i < 32; ++i) { const int kk = 2 * i + (lane >> 5); scr[kk * 33 + (lane & 31)] = tv[i]; }
    LDS_WAIT(); asm volatile("" ::: "memory");
    const int c = lane & 7;
    f32x4 ga = {mul, mul, mul, mul}, gb = {mul, mul, mul, mul};
    if (SCALE) { ga = *(const f32x4*)(gk + k0 + 8 * c) * mul; gb = *(const f32x4*)(gk + k0 + 8 * c + 4) * mul; }
#pragma unroll
    for (int j = 0; j < 4; ++j) { const int n = (lane >> 3) + 8 * j; const LAS float* s = scr + (8 * c) * 33 + n;
        v2u o; o.x = pk4f8(s[0 * 33] * ga.x, s[1 * 33] * ga.y, s[2 * 33] * ga.z, s[3 * 33] * ga.w); o.y = pk4f8(s[4 * 33] * gb.x, s[5 * 33] * gb.y, s[6 * 33] * gb.z, s[7 * 33] * gb.w);
        *(GAS v2u*)(dst8 + (size_t)n * K + k0 + 8 * c) = o; }
    LDS_WAIT(); asm volatile("" ::: "memory");
}
__device__ __forceinline__ void convert_weights(Frame& F, int l) {
    LAS float* scr = (LAS float*)(F.lds + F.wave * 8448);
    const int NGW = 256 * NWAVES;
    unsigned char* ws = P_WS;
    bf16* WinT = (bf16*)(ws + WS_WIN); bf16* WaT = (bf16*)(ws + WS_WA); bf16* WbT = (bf16*)(ws + WS_WB); bf16* WoT = (bf16*)(ws + WS_WO);
    bf16* WguT = (bf16*)(ws + WS_WGU); bf16* WdT = (bf16*)(ws + WS_WD);
    const float* w_in = P_IN(2) + (size_t)l * DM * INC; const float* w_a = P_IN(3) + (size_t)l * 256 * DM; const float* w_b = P_IN(4) + (size_t)l * DM * DM;
    const float* w_o = P_IN(7) + (size_t)l * DM * DM; const float* g2 = P_IN(8) + (size_t)l * DM; const float* g1n = P_IN(1) + (size_t)l * DM;
    const float* w_g = P_IN(10) + (size_t)l * NE * DM * DEX; const float* w_u = P_IN(11) + (size_t)l * NE * DM * DEX; const float* w_d = P_IN(12) + (size_t)l * NE * DEX * DM;
    constexpr int I_IN = 16 * (INC / 32), I_A = 4 * 32, I_B = 16 * 32, I_O = 16 * 32, I_E = NE * 16 * 32;
    constexpr int NITEMS = I_IN + I_A + I_B + I_O + 3 * I_E;
    for (int it = F.gw; it < NITEMS; it += NGW) {
        int r = it;
        if (r < I_IN) { const int nb = r % (INC / 32), kb = r / (INC / 32), n0 = 32 * nb; int drow = n0;
            if (n0 >= 3840) { const int gc = n0 - 3840, br = gc >> 10, cc = gc & 1023; drow = 3840 + (cc >> 7) * 256 + ((cc & 127) >> 5) * 64 + br * 32; }
            transpose_item<true>(w_in, DM, INC, WinT + (size_t)drow * DM, scr, 64 * kb, n0, F.lane, g1n); continue; } r -= I_IN;
        if (r < I_A) { const int nb = r % 32, kb = r / 32; transpose_item(w_a, 256, DM, WaT + (size_t)(32 * nb) * 256, scr, 64 * kb, 32 * nb, F.lane); continue; } r -= I_A;
        if (r < I_B) { const int nb = r % 32, kb = r / 32; transpose_item(w_b, DM, DM, WbT + (size_t)(32 * nb) * DM, scr, 64 * kb, 32 * nb, F.lane); continue; } r -= I_B;
        if (r < I_O) { const int nb = r % 32, kb = r / 32; transpose_item(w_o, DM, DM, WoT + (size_t)(32 * nb) * DM, scr, 64 * kb, 32 * nb, F.lane); continue; } r -= I_O;
        if (r < 2 * I_E) { const int up = r >= I_E; if (up) r -= I_E; const int e = r / 512, loc = r % 512, nb = loc % 32, kb = loc / 32, f0 = 32 * nb;
            const float* W = (up ? w_u : w_g) + (size_t)e * DM * DEX;
            transpose_item8<true>(W, DM, DEX, (unsigned char*)WguT + ((size_t)e * 2048 + (f0 >> 7) * 256 + (up ? 128 : 0) + (f0 & 127)) * DM, scr, 64 * kb, f0, F.lane, 64.0f, g2); continue; } r -= 2 * I_E;
        { const int e = r / 512, loc = r % 512, nb = loc % 32, kb = loc / 32;
            transpose_item8(w_d + (size_t)e * DEX * DM, DEX, DM, (unsigned char*)WdT + ((size_t)e * 1024 + 32 * nb) * DEX, scr, 64 * kb, 32 * nb, F.lane, 64.0f); }
    }
}
__device__ __forceinline__ void unpk8(const v4u w, float (&v)[8]) { v[0] = bflo(w.x); v[1] = bfhi(w.x); v[2] = bflo(w.y); v[3] = bfhi(w.y); v[4] = bflo(w.z); v[5] = bfhi(w.z); v[6] = bflo(w.w); v[7] = bfhi(w.w); }
__device__ __forceinline__ v4u pk8(const float (&v)[8]) { v4u w; w.x = pk2bf(v[0], v[1]); w.y = pk2bf(v[2], v[3]); w.z = pk2bf(v[4], v[5]); w.w = pk2bf(v[6], v[7]); return w; }
template <bool XIN, bool COMBINE, bool FINAL>
__device__ __forceinline__ void norm_rows(Frame& F, const float* xin, bf16* hb, const float* gain, float* rsv, float* out) {
    const int NGW = 256 * NWAVES;
    unsigned char* ws = P_WS;
    const int* sel = (const int*)(ws + WS_SEL); const bf16* Y = (const bf16*)(ws + WS_BIG + B_Y);
    float gv[2][8];
#pragma unroll
    for (int j = 0; j < 2; ++j) { const f32x4 a = *(const f32x4*)(gain + (64 * j + F.lane) * 8), b = *(const f32x4*)(gain + (64 * j + F.lane) * 8 + 4);
        gv[j][0] = a.x; gv[j][1] = a.y; gv[j][2] = a.z; gv[j][3] = a.w; gv[j][4] = b.x; gv[j][5] = b.y; gv[j][6] = b.z; gv[j][7] = b.w; }
    constexpr int NR = 4;
    for (int m0 = F.gw; m0 < MTOK; m0 += NR * NGW) {
        float v[NR][2][8]; int sv[NR];
#pragma unroll
        for (int rr = 0; rr < NR; ++rr) { const int m = m0 + rr * NGW;
            if (COMBINE) sv[rr] = sel[(size_t)m * NE + (F.lane & 15)];
            if (XIN) {
#pragma unroll
                for (int j = 0; j < 2; ++j) { const f32x4 a = *(const f32x4*)(xin + (size_t)m * DM + (64 * j + F.lane) * 8), b = *(const f32x4*)(xin + (size_t)m * DM + (64 * j + F.lane) * 8 + 4);
                    v[rr][j][0] = a.x; v[rr][j][1] = a.y; v[rr][j][2] = a.z; v[rr][j][3] = a.w; v[rr][j][4] = b.x; v[rr][j][5] = b.y; v[rr][j][6] = b.z; v[rr][j][7] = b.w; }
            } else {
#pragma unroll
                for (int j = 0; j < 2; ++j) unpk8(*(const v4u*)(hb + (size_t)m * DM + (64 * j + F.lane) * 8), v[rr][j]);
            } }
        if (COMBINE) {
            unsigned msk[NR];
#pragma unroll
            for (int rr = 0; rr < NR; ++rr) msk[rr] = (unsigned)(__builtin_amdgcn_ballot_w64(sv[rr] >= 0) & 0xffffull);
            unsigned any = 0u;
#pragma unroll
            for (int rr = 0; rr < NR; ++rr) any |= msk[rr];
            while (any != 0u) {
                v4u yv[NR][2]; float wgt[NR];
#pragma unroll
                for (int rr = 0; rr < NR; ++rr) { const int m = m0 + rr * NGW, b = m >> 11; const bool has = msk[rr] != 0u;
                    const int e = has ? __builtin_ctz(msk[rr]) : 0; const int r = has ? __builtin_amdgcn_readlane(sv[rr], e) : 0;
                    const bf16* yr = Y + ((size_t)(e * NB + b) * CAP + r) * DM; wgt[rr] = has ? 1.0f : 0.0f; msk[rr] &= msk[rr] - 1u;
#pragma unroll
                    for (int j = 0; j < 2; ++j) yv[rr][j] = *(const v4u*)(yr + (64 * j + F.lane) * 8); }
                any = 0u;
#pragma unroll
                for (int rr = 0; rr < NR; ++rr) { any |= msk[rr];
#pragma unroll
                    for (int j = 0; j < 2; ++j) { float y[8]; unpk8(yv[rr][j], y);
#pragma unroll
                        for (int i = 0; i < 8; ++i) v[rr][j][i] += wgt[rr] * y[i]; } }
            }
        }
#pragma unroll
        for (int rr = 0; rr < NR; ++rr) { const int m = m0 + rr * NGW;
            if ((XIN || COMBINE) && !FINAL) {
#pragma unroll
                for (int j = 0; j < 2; ++j) *(v4u*)(hb + (size_t)m * DM + (64 * j + F.lane) * 8) = pk8(v[rr][j]);
            }
            float ss = 0.f;
#pragma unroll
            for (int j = 0; j < 2; ++j)
#pragma unroll
                for (int i = 0; i < 8; ++i) ss += v[rr][j][i] * v[rr][j][i];
            const float rs = 1.0f / sqrtf(wave_sum(ss, F.lane) * (1.0f / DM) + RMS_EPS);
            if (FINAL) {
#pragma unroll
                for (int j = 0; j < 2; ++j) { float o[8];
#pragma unroll
                    for (int i = 0; i < 8; ++i) o[i] = v[rr][j][i] * rs * gv[j][i];
                    float* op = out + (size_t)m * DM + (64 * j + F.lane) * 8; *(f32x4*)op = (f32x4){o[0], o[1], o[2], o[3]}; *(f32x4*)(op + 4) = (f32x4){o[4], o[5], o[6], o[7]}; }
            } else if (F.lane == 0) rsv[m] = rs; }
    }
}
constexpr int RT_PITCH = 2048 + 16;
__device__ __forceinline__ void norm_router(Frame& F, const bf16* hb, const float* gain, const float* wr, float* rsv, float* aff, unsigned char* hn8) {
    LAS unsigned char* whi = F.lds; LAS unsigned char* wlo = F.lds + 16 * RT_PITCH; LAS float* gl = (LAS float*)(F.lds + 32 * RT_PITCH);
    { const float g0 = gain[F.tid], g1 = gain[F.tid + NWAVES * 64]; gl[F.tid] = g0; gl[F.tid + NWAVES * 64] = g1; }
    __syncthreads();
    { f32x4 wv[8];
#pragma unroll
      for (int j = 0; j < 8; ++j) wv[j] = *(const f32x4*)(wr + 4 * (F.tid + j * NWAVES * 64));
      asm volatile("" ::: "memory");
#pragma unroll
      for (int j = 0; j < 8; ++j) { const int i0 = 4 * (F.tid + j * NWAVES * 64), k = i0 >> 4, e0 = i0 & 15; const float g = gl[k];
#pragma unroll
          for (int t = 0; t < 4; ++t) { const float w = wv[j][t] * g; const unsigned hi = pk2bf(w, 0.f) & 0xffffu; const float rem = w - bflo(hi);
              *(LAS unsigned short*)(whi + (e0 + t) * RT_PITCH + k * 2) = (unsigned short)hi; *(LAS unsigned short*)(wlo + (e0 + t) * RT_PITCH + k * 2) = (unsigned short)(pk2bf(rem, 0.f) & 0xffffu); } } }
    __syncthreads();
    const int NGW = 256 * NWAVES, r16 = F.lane & 15, q = F.lane >> 4;
    for (int grp = F.gw; grp < MTOK / 16; grp += NGW) {
        const size_t row = (size_t)grp * 16 + r16;
        v4u xs[32];
#pragma unroll
        for (int s = 0; s < 16; ++s) { const v4u* p = (const v4u*)(hb + row * DM + 64 * s + 16 * q); xs[2 * s] = p[0]; xs[2 * s + 1] = p[1]; }
        f32x4 acc = {0.f, 0.f, 0.f, 0.f}; float ss = 0.f;
#pragma unroll
        for (int s = 0; s < 16; ++s) {
#pragma unroll
            for (int h2 = 0; h2 < 2; ++h2) { const bf16x8 a = __builtin_bit_cast(bf16x8, xs[2 * s + h2]);
                const bf16x8 bh = *(const LAS bf16x8*)(whi + r16 * RT_PITCH + (64 * s + 16 * q + 8 * h2) * 2), bl = *(const LAS bf16x8*)(wlo + r16 * RT_PITCH + (64 * s + 16 * q + 8 * h2) * 2);
                acc = __builtin_amdgcn_mfma_f32_16x16x32_bf16(a, bh, acc, 0, 0, 0); acc = __builtin_amdgcn_mfma_f32_16x16x32_bf16(a, bl, acc, 0, 0, 0);
                float x[8]; unpk8(xs[2 * s + h2], x);
#pragma unroll
                for (int i = 0; i < 8; ++i) ss += x[i] * x[i]; }
            asm volatile("" ::: "memory"); }
        ss += shx(ss, 16, F.lane); ss += shx(ss, 32, F.lane);
        const float rs = 1.0f / sqrtf(ss * (1.0f / DM) + RMS_EPS);
        float lg[4];
#pragma unroll
        for (int r = 0; r < 4; ++r) { const float rr = __builtin_bit_cast(float, __builtin_amdgcn_ds_bpermute((4 * q + r) << 2, __builtin_bit_cast(int, rs))); lg[r] = acc[r] * rr; }
#pragma unroll
        for (int r = 0; r < 4; ++r) { float mx = lg[r];
#pragma unroll
            for (int o = 1; o < 16; o <<= 1) mx = fmaxf(mx, shx(mx, o, F.lane));
            const float ex = __expf(lg[r] - mx); float sm = ex;
#pragma unroll
            for (int o = 1; o < 16; o <<= 1) sm += shx(sm, o, F.lane);
            aff[((size_t)grp * 16 + 4 * q + r) * NE + r16] = ex / sm; }
        if (q == 0) rsv[row] = rs;
        { const float rs16 = rs * 16.0f;
#pragma unroll
          for (int s = 0; s < 16; ++s) { v4u o;
#pragma unroll
              for (int h2 = 0; h2 < 2; ++h2) { v4u t = xs[2 * s + h2]; asm volatile("" : "+v"(t));
                  float x[8]; unpk8(t, x);
                  o[2 * h2] = pk4f8(x[0] * rs16, x[1] * rs16, x[2] * rs16, x[3] * rs16); o[2 * h2 + 1] = pk4f8(x[4] * rs16, x[5] * rs16, x[6] * rs16, x[7] * rs16); }
              *(v4u*)(hn8 + row * DM + 64 * s + 16 * q) = o;
              asm volatile("" ::: "memory"); } }
    }
}
__device__ __forceinline__ void topk_gather(Frame& F, const float* aff, const float* rsv, int* sel, float* gatev, int* idxg) {
    LAS unsigned* hist = (LAS unsigned*)F.lds;
    volatile LAS unsigned* st = (volatile LAS unsigned*)(F.lds + 1024);
    for (int u = blockIdx.x; u < NB * NE; u += 256) {
        const int b = u >> 4, e = u & 15;
        unsigned bits[4];
#pragma unroll
        for (int q = 0; q < 4; ++q) bits[q] = __float_as_uint(aff[((size_t)b * SEQ + 4 * F.tid + q) * NE + e]);
        const f32x4 rs4 = *(const f32x4*)(rsv + (size_t)b * SEQ + 4 * F.tid);
        unsigned prefix = 0u, kk = CAP;
#pragma unroll 1
        for (int pass = 0; pass < 4; ++pass) {
            const int shift = 24 - 8 * pass;
            if (F.tid < 256) hist[F.tid] = 0u;
            __syncthreads();
#pragma unroll
            for (int q = 0; q < 4; ++q) { const bool in = (pass == 0) || ((bits[q] >> (shift + 8)) == prefix); if (in) atomicAdd((unsigned*)&hist[(bits[q] >> shift) & 255u], 1u); }
            __syncthreads();
            if (F.wave == 0) {
                const unsigned c0 = hist[4 * F.lane], c1 = hist[4 * F.lane + 1], c2 = hist[4 * F.lane + 2], c3 = hist[4 * F.lane + 3];
                unsigned incl = c0 + c1 + c2 + c3;
#pragma unroll
                for (int o = 1; o < 64; o <<= 1) { const unsigned v = shrel(incl, o, F.lane); if (F.lane + o < 64) incl += v; }
                unsigned cum = incl - (c0 + c1 + c2 + c3);
                int found = -1; unsigned above = 0u;
                if (cum < kk && cum + c3 >= kk) { found = 3; above = cum; } cum += c3;
                if (cum < kk && cum + c2 >= kk) { found = 2; above = cum; } cum += c2;
                if (cum < kk && cum + c1 >= kk) { found = 1; above = cum; } cum += c1;
                if (cum < kk && cum + c0 >= kk) { found = 0; above = cum; }
                if (found >= 0) { st[0] = (prefix << 8) | (unsigned)(4 * F.lane + found); st[1] = kk - above; }
            }
            __syncthreads();
            prefix = st[0]; kk = st[1];
        }
        const unsigned T = prefix;
        unsigned ngt = 0u, neq = 0u;
#pragma unroll
        for (int q = 0; q < 4; ++q) { ngt += bits[q] > T ? 1u : 0u; neq += bits[q] == T ? 1u : 0u; }
        unsigned pk = ngt | (neq << 16), inc = pk;
#pragma unroll
        for (int o = 1; o < 64; o <<= 1) { const unsigned v = shrel(inc, -o, F.lane); if (F.lane >= o) inc += v; }
        if (F.lane == 63) st[8 + F.wave] = inc;
        __syncthreads();
        unsigned base = 0u;
#pragma unroll
        for (int w = 0; w < NWAVES; ++w) base += (w < F.wave) ? st[8 + w] : 0u;
        const unsigned excl = base + inc - pk;
        unsigned pgt = excl & 0xffffu, peq = excl >> 16;
#pragma unroll
        for (int q = 0; q < 4; ++q) { const int i = 4 * F.tid + q; const bool g = bits[q] > T, eq = bits[q] == T; const bool keep = g || (eq && peq < kk);
            const unsigned slot = pgt + (peq < kk ? peq : kk);
            if (keep) { idxg[(size_t)(e * NB + b) * CAP + slot] = (int)((unsigned)(b * SEQ + i) | ((unsigned)__builtin_bit_cast(unsigned short, (_Float16)rs4[q]) << 16)); gatev[(size_t)(e * NB + b) * CAP + slot] = __uint_as_float(bits[q]); }
            sel[((size_t)b * SEQ + i) * NE + e] = keep ? (int)slot : -1;
            pgt += g ? 1u : 0u; peq += eq ? 1u : 0u; }
        __syncthreads();
    }
}


constexpr int ATT_KPITCH = 144, ATT_VT_OFF = 512 * ATT_KPITCH, ATT_VPITCH = 1040, ATT_SINK_OFF = MISC_OFF + 1024;
static_assert(ATT_VT_OFF + 64 * ATT_VPITCH <= MISC_OFF, "attention LDS");
#ifndef ATT_JT_UNROLL
#define ATT_JT_UNROLL 1
#endif
struct ChunkP { const bf16* K; const bf16* V; int ldkv, tok0, cstep, r, L, nseg, qs, i0; };
template <int W>
__device__ __forceinline__ void attn_issue(const ChunkP& p, int tid, v4u (&kreg)[8], v4u (&vreg)[2][4]) {
    asm volatile("" : "+v"(tid));
    const int KS = p.qs + 2 * W, nrows = p.nseg * KS, Lm1 = p.L - 1;
    constexpr int NKP = 8;
#pragma unroll
    for (int it = 0; it < NKP; ++it) { const int pc = tid + it * NWAVES * 64, row0 = pc >> 3, ch = pc & 7, row = row0 < nrows ? row0 : nrows - 1, s = row >= KS ? 1 : 0, rho = row - s * KS;
        int j = p.i0 - W + rho; j = j < 0 ? 0 : j; j = j > Lm1 ? Lm1 : j;
        kreg[it] = *(const v4u*)(p.K + (size_t)(p.tok0 + s * p.cstep + p.r * j) * p.ldkv + ch * 8); }
#pragma unroll
    for (int it = 0; it < 2; ++it) { const int t = tid + it * NWAVES * 64, r4 = t >> 3, ch = t & 7, rowa = 4 * r4, row0 = rowa < nrows ? rowa : nrows - 4, s = row0 >= KS ? 1 : 0, rho = row0 - s * KS, j0 = p.i0 - W + rho;
#pragma unroll
        for (int q = 0; q < 4; ++q) { int j = j0 + q; j = j < 0 ? 0 : j; j = j > Lm1 ? Lm1 : j;
            vreg[it][q] = *(const v4u*)(p.V + (size_t)(p.tok0 + s * p.cstep + p.r * j) * p.ldkv + ch * 8); } }
}
__device__ __forceinline__ void attn_loadq(const Frame& F, const ChunkP& p, const bf16* Q, int ldq, bf16x8 (&qf)[4]) {
    int lane_ = F.lane; asm volatile("" : "+v"(lane_));
    const int wq = F.wave * 32, sidx = (wq >= p.qs) ? 1 : 0, qo = wq - sidx * p.qs, ql = lane_ & 31, hh = lane_ >> 5, qi = p.i0 + qo + ql;
    const bf16* q0 = Q + (size_t)(p.tok0 + sidx * p.cstep + p.r * qi) * ldq;
#pragma unroll
    for (int ks = 0; ks < 4; ++ks) qf[ks] = *(const bf16x8*)(q0 + 16 * ks + 8 * hh);
}
template <int W>
__device__ __forceinline__ void attn_commit(Frame& F, const ChunkP& p, const v4u (&kreg)[8], const v4u (&vreg)[2][4]) {
    int tid = F.tid; asm volatile("" : "+v"(tid));
    const int KS = p.qs + 2 * W, nrows = p.nseg * KS;
    LAS unsigned char* ldsK = F.lds; LAS unsigned char* ldsV = F.lds + ATT_VT_OFF;
    constexpr int NKP = 8;
#pragma unroll
    for (int it = 0; it < NKP; ++it) { const int pc = tid + it * NWAVES * 64, row = pc >> 3, ch = pc & 7;
        if (pc < nrows * 8) *(LAS v4u*)(ldsK + row * ATT_KPITCH + ch * 16) = kreg[it]; }
#pragma unroll
    for (int it = 0; it < 2; ++it) { const int t = tid + it * NWAVES * 64, r4 = t >> 3, ch = t & 7, row0 = 4 * r4;
        if (t < nrows * 2) {
            const int kap = row0 & 31, slot = (kap >> 4) * 16 + ((kap >> 2) & 1) * 8 + ((kap >> 3) & 1) * 4, pos = (row0 & ~31) + slot;
#pragma unroll
            for (int w = 0; w < 4; ++w) {
                v2u lo, hi;
                lo.x = (vreg[it][0][w] & 0xffffu) | (vreg[it][1][w] << 16); lo.y = (vreg[it][2][w] & 0xffffu) | (vreg[it][3][w] << 16);
                hi.x = (vreg[it][0][w] >> 16) | (vreg[it][1][w] & 0xffff0000u); hi.y = (vreg[it][2][w] >> 16) | (vreg[it][3][w] & 0xffff0000u);
                *(LAS v2u*)(ldsV + (ch * 8 + 2 * w) * ATT_VPITCH + pos * 2) = lo;
                *(LAS v2u*)(ldsV + (ch * 8 + 2 * w + 1) * ATT_VPITCH + pos * 2) = hi;
            } } }
}
#ifndef ATT_THR
#define ATT_THR 8.0f
#endif
template <int W, int NH, bool SINK, bool WRITE_LSE>
__device__ __forceinline__ void attn_compute(Frame& F, const ChunkP& p, bf16* Q, int ldq, long odelta, float* lse, float slope1, const float* sinkp, int hbase, bf16x8 (&qf)[4]) {
    constexpr int NJT = 2 * W / 32 + 1, JC = W / 32;
    const int KS = p.qs + 2 * W, L = p.L, i0 = p.i0;
    LAS unsigned char* ldsK = F.lds; LAS unsigned char* ldsV = F.lds + ATT_VT_OFF;
    const int wq = F.wave * 32, sidx = (wq >= p.qs) ? 1 : 0, qo = wq - sidx * p.qs, segbase = sidx * KS;
    int lane_ = F.lane; asm volatile("" : "+v"(lane_));
    const int ql = lane_ & 31, hh = lane_ >> 5;
    const int qi = i0 + qo + ql;
    const size_t qtok = (size_t)(p.tok0 + sidx * p.cstep + p.r * qi);
    const float flo = (float)((-qi > -W) ? -qi : -W), fhi = (float)((L - 1 - qi < W) ? (L - 1 - qi) : W);
#pragma unroll 1
    for (int g = 0; g < NH; ++g) {
        bf16* qptr = Q + qtok * ldq + g * 64;
        f32x16 O0, O1;
        float m, l;
#ifdef PRB_REP
        constexpr int nrep = (NH == PRB_NH) ? PRB_REP : 1;
#pragma unroll 1
        for (int rep = 0; rep < nrep; ++rep) {
        asm volatile("" ::: "memory");
#endif
#pragma unroll
        for (int i = 0; i < 16; ++i) { O0[i] = 0.f; O1[i] = 0.f; }
        const float sl = (NH == 1) ? slope1 : __builtin_amdgcn_exp2f(-0.5f * (float)(hbase + g + 1)) * LOG2E;
        const float sk2 = SINK ? *(const LAS float*)(F.lds + ATT_SINK_OFF + 4 * (hbase + g)) : 0.f;
        {
            const int jbase = i0 + qo - W + 32 * JC, krow = segbase + qo + 32 * JC;
            const bool need_mask = (jbase < 0) || (jbase + 31 >= L);
            f32x16 S;
#pragma unroll
            for (int i = 0; i < 16; ++i) S[i] = 0.f;
#pragma unroll
            for (int ks = 0; ks < 4; ++ks) { const bf16x8 kf = *(const LAS bf16x8*)(ldsK + (krow + ql) * ATT_KPITCH + (16 * ks + 8 * hh) * 2); S = __builtin_amdgcn_mfma_f32_32x32x16_bf16(kf, qf[ks], S, 0, 0, 0); }
            const float fd0 = (float)(jbase + 4 * hh - qi);
#pragma unroll
            for (int i = 0; i < 16; ++i) { const float fd = fd0 + (float)((i & 3) + 8 * (i >> 2)); S[i] = S[i] - sl * fabsf(fd); }
            if (need_mask) {
#pragma unroll
                for (int i = 0; i < 16; ++i) { const float fd = fd0 + (float)((i & 3) + 8 * (i >> 2)); S[i] = (fd >= flo && fd <= fhi) ? S[i] : -INFINITY; } }
            float mloc = S[0];
#pragma unroll
            for (int i = 1; i < 16; ++i) mloc = fmaxf(mloc, S[i]);
            m = fmaxf(mloc, shx(mloc, 32, lane_));
            float ps = 0.f;
#pragma unroll
            for (int i = 0; i < 16; ++i) { const float pv = __builtin_amdgcn_exp2f(S[i] - m); S[i] = pv; ps += pv; }
            l = ps;
#pragma unroll
            for (int s2 = 0; s2 < 2; ++s2) {
                f32x8_t pp;
#pragma unroll
                for (int i = 0; i < 8; ++i) pp[i] = S[8 * s2 + i];
                const bf16x8 pf = __builtin_bit_cast(bf16x8, __builtin_convertvector(pp, nbf16x8));
                const bf16x8 v0 = *(const LAS bf16x8*)(ldsV + ql * ATT_VPITCH + (krow + 16 * s2 + 8 * hh) * 2);
                const bf16x8 v1 = *(const LAS bf16x8*)(ldsV + (ql + 32) * ATT_VPITCH + (krow + 16 * s2 + 8 * hh) * 2);
                O0 = __builtin_amdgcn_mfma_f32_32x32x16_bf16(v0, pf, O0, 0, 0, 0);
                O1 = __builtin_amdgcn_mfma_f32_32x32x16_bf16(v1, pf, O1, 0, 0, 0);
            }
        }
#pragma unroll 1
        for (int jt = 0; jt < NJT; ++jt) {
            if (jt == JC) continue;
            const int jbase = i0 + qo - W + 32 * jt;
            if (jbase + 31 < 0 || jbase >= L) continue;
            const bool need_mask = (jt == 0) || (jt == NJT - 1) || (jbase < 0) || (jbase + 31 >= L);
            const int krow = segbase + qo + 32 * jt;
            const float fd0 = (float)(jbase + 4 * hh - qi);
            bf16x8 kf[4];
#pragma unroll
            for (int ks = 0; ks < 4; ++ks) kf[ks] = *(const LAS bf16x8*)(ldsK + (krow + ql) * ATT_KPITCH + (16 * ks + 8 * hh) * 2);
            const bf16x8 vf00 = *(const LAS bf16x8*)(ldsV + ql * ATT_VPITCH + (krow + 8 * hh) * 2), vf10 = *(const LAS bf16x8*)(ldsV + (ql + 32) * ATT_VPITCH + (krow + 8 * hh) * 2);
            f32x16 S;
            if (jt < JC) { const float k1 = sl * fd0 - m;
#pragma unroll
                for (int i = 0; i < 16; ++i) S[i] = fmaf(sl, (float)((i & 3) + 8 * (i >> 2)), k1); }
            else { const float k1 = -sl * fd0 - m;
#pragma unroll
                for (int i = 0; i < 16; ++i) S[i] = fmaf(-sl, (float)((i & 3) + 8 * (i >> 2)), k1); }
            if (need_mask) {
#pragma unroll
                for (int i = 0; i < 16; ++i) { const float fd = fd0 + (float)((i & 3) + 8 * (i >> 2)); S[i] = (fd >= flo && fd <= fhi) ? S[i] : -INFINITY; } }
#pragma unroll
            for (int ks = 0; ks < 4; ++ks) S = __builtin_amdgcn_mfma_f32_32x32x16_bf16(kf[ks], qf[ks], S, 0, 0, 0);
            const bf16x8 vf01 = *(const LAS bf16x8*)(ldsV + ql * ATT_VPITCH + (krow + 16 + 8 * hh) * 2), vf11 = *(const LAS bf16x8*)(ldsV + (ql + 32) * ATT_VPITCH + (krow + 16 + 8 * hh) * 2);
            float tmax = S[0];
#pragma unroll
            for (int i = 1; i < 16; ++i) tmax = fmaxf(tmax, S[i]);
            if (__builtin_amdgcn_ballot_w64(tmax > ATT_THR) != 0ull) {
                float d = fmaxf(tmax, 0.f); d = fmaxf(d, shx(d, 32, lane_));
                const float sc = __builtin_amdgcn_exp2f(-d);
#pragma unroll
                for (int i = 0; i < 16; ++i) { S[i] -= d; O0[i] *= sc; O1[i] *= sc; }
                l *= sc; m += d;
            }
            float ps = 0.f;
#pragma unroll
            for (int i = 0; i < 16; ++i) { const float pv = __builtin_amdgcn_exp2f(S[i]); S[i] = pv; ps += pv; }
            l += ps;
            { f32x8_t pp;
#pragma unroll
              for (int i = 0; i < 8; ++i) pp[i] = S[i];
              const bf16x8 pf = __builtin_bit_cast(bf16x8, __builtin_convertvector(pp, nbf16x8));
              O0 = __builtin_amdgcn_mfma_f32_32x32x16_bf16(vf00, pf, O0, 0, 0, 0); O1 = __builtin_amdgcn_mfma_f32_32x32x16_bf16(vf10, pf, O1, 0, 0, 0); }
            { f32x8_t pp;
#pragma unroll
              for (int i = 0; i < 8; ++i) pp[i] = S[8 + i];
              const bf16x8 pf = __builtin_bit_cast(bf16x8, __builtin_convertvector(pp, nbf16x8));
              O0 = __builtin_amdgcn_mfma_f32_32x32x16_bf16(vf01, pf, O0, 0, 0, 0); O1 = __builtin_amdgcn_mfma_f32_32x32x16_bf16(vf11, pf, O1, 0, 0, 0); }
        }
#ifdef PRB_REP
        }
        const float sk2 = SINK ? *(const LAS float*)(F.lds + ATT_SINK_OFF + 4 * (hbase + g)) : 0.f;
#endif
        float lt = l + shx(l, 32, lane_);
        float osc = 1.0f;
        if (SINK) { const float mf = fmaxf(m, sk2); osc = __builtin_amdgcn_exp2f(m - mf); lt = lt * osc + __builtin_amdgcn_exp2f(sk2 - mf); }
        if (WRITE_LSE) { if (hh == 0) lse[qtok * 4] = m + __builtin_amdgcn_logf(lt); }
        const float inv = osc / lt;
        if (NH > 1 && g + 1 < NH) {
#pragma unroll
            for (int ks = 0; ks < 4; ++ks) qf[ks] = *(const bf16x8*)(qptr + 64 + 16 * ks + 8 * hh); }
        v2u WW[8];
#pragma unroll
        for (int g4 = 0; g4 < 4; ++g4) {
            WW[g4].x = pk2bf(O0[4 * g4] * inv, O0[4 * g4 + 1] * inv); WW[g4].y = pk2bf(O0[4 * g4 + 2] * inv, O0[4 * g4 + 3] * inv);
            WW[4 + g4].x = pk2bf(O1[4 * g4] * inv, O1[4 * g4 + 1] * inv); WW[4 + g4].y = pk2bf(O1[4 * g4 + 2] * inv, O1[4 * g4 + 3] * inv); }
#pragma unroll
        for (int s4 = 0; s4 < 4; ++s4) {
            v2u a = WW[2 * s4], b = WW[2 * s4 + 1];
            { const auto r = __builtin_amdgcn_permlane32_swap(a.x, b.x, false, false); a.x = r[0]; b.x = r[1]; }
            { const auto r = __builtin_amdgcn_permlane32_swap(a.y, b.y, false, false); a.y = r[0]; b.y = r[1]; }
            *(v4u*)(qptr + odelta + 16 * s4 + 8 * hh) = (v4u){a.x, a.y, b.x, b.y};
#ifdef PRB_ST2
            asm volatile("" ::: "memory");
            *(v4u*)(qptr + odelta + 16 * s4 + 8 * hh) = (v4u){a.x, a.y, b.x, b.y};
            asm volatile("" ::: "memory");
#endif
        }
    }
}
__device__ __forceinline__ ChunkP dil_chunk(const bf16* KA, const bf16* VA, int b, int hs, int sc) {
    const int grp = sc >> 3, ix = sc & 7, col = grp * 256 + hs * 64; ChunkP p; p.K = KA + col; p.V = VA + col; p.ldkv = 768;
    if (grp == 0) { p.tok0 = b * SEQ; p.cstep = 0; p.r = 1; p.L = 2048; p.nseg = 1; p.qs = 256; p.i0 = 256 * ix; }
    else if (grp == 1) { p.tok0 = b * SEQ + (ix >> 1); p.cstep = 0; p.r = 4; p.L = 512; p.nseg = 1; p.qs = 256; p.i0 = 256 * (ix & 1); }
    else { p.tok0 = b * SEQ + 2 * ix; p.cstep = 1; p.r = 16; p.L = 128; p.nseg = 2; p.qs = 128; p.i0 = 0; }
    return p;
}
__device__ __forceinline__ ChunkP win_chunk(const bf16* KW, const bf16* VW, int wc) {
    const int b = wc >> 5, kvh = (wc >> 3) & 3, ch = wc & 7; ChunkP p; p.K = KW + kvh * 64; p.V = VW + kvh * 64; p.ldkv = 256;
    p.tok0 = b * SEQ; p.cstep = 0; p.r = 1; p.L = SEQ; p.nseg = 1; p.qs = 256; p.i0 = 256 * ch; return p;
}
__device__ __forceinline__ void attention_phase(Frame& F, int l, long odA, long odW, int which = 3) {
    unsigned char* ws = P_WS;
    bf16* big = (bf16*)(ws + WS_BIG);
    bf16* QA = big + B_QA / 2; bf16* KA = big + B_KA / 2; bf16* VA = big + B_VA / 2; bf16* QW = big + B_QW / 2; bf16* KW = big + B_KW / 2; bf16* VW = big + B_VW / 2; bf16* OA = big + B_OA / 2;
    float* LSE = (float*)(ws + WS_LSE);
    const int c = blockIdx.x;
    int w_lo, w_hi;
    v4u kreg[8], vreg[2][4];
    bf16x8 qf[4];
#ifndef ATT_N1
#define ATT_N1 0
#endif
    static_assert(ATT_N1 == 0, "the dilated workgroups take no window chunks");
    if (c < 128) { w_lo = ATT_N1 * c; w_hi = w_lo + ATT_N1; } else { w_lo = 128 * ATT_N1 + (c - 128) * (8 - ATT_N1); w_hi = w_lo + (8 - ATT_N1); }
    if (c < 128) { if (which & 1) {
        const int b = c >> 2, hs = c & 3;
        { const ChunkP p0 = dil_chunk(KA, VA, b, hs, 0); attn_issue<64>(p0, F.tid, kreg, vreg); attn_loadq(F, p0, QA + hs * 64, 768, qf); attn_commit<64>(F, p0, kreg, vreg); }
        __syncthreads();
#pragma unroll 1
        for (int sc = 0; sc < 24; ++sc) {
            const ChunkP p = dil_chunk(KA, VA, b, hs, sc); const int grp = sc >> 3;
            const int scn = sc + 1 < 24 ? sc + 1 : sc;
            const ChunkP pn = dil_chunk(KA, VA, b, hs, scn);
            bf16x8 qn[4];
            attn_issue<64>(pn, F.tid, kreg, vreg); attn_loadq(F, pn, QA + (scn >> 3) * 256 + hs * 64, 768, qn);
            const float slope1 = __builtin_amdgcn_exp2f(-8.0f * (float)(grp * 4 + hs + 1) / 12.0f) * (float)p.r * LOG2E;
            attn_compute<64, 1, false, true>(F, p, QA + grp * 256 + hs * 64, 768, odA, LSE + (size_t)grp * MTOK * 4 + hs, slope1, nullptr, 0, qf);
            __syncthreads();
            if (sc + 1 < 24) attn_commit<64>(F, pn, kreg, vreg);
            __syncthreads();
#pragma unroll
            for (int ks = 0; ks < 4; ++ks) qf[ks] = qn[ks];
        }
        VM_WAIT(); __syncthreads(); __builtin_amdgcn_fence(__ATOMIC_ACQUIRE, "agent"); VM_WAIT();
        constexpr int CB = 8;
#pragma unroll 1
        for (int t0 = F.tid; t0 < SEQ * 8; t0 += NWAVES * 64 * CB) {
            float lv[CB][3]; v4u av[CB][3];
#pragma unroll
            for (int k = 0; k < CB; ++k) { const int t = t0 + k * NWAVES * 64, tok = t >> 3, ch = t & 7; const size_t row = (size_t)b * SEQ + tok;
                lv[k][0] = LSE[row * 4 + hs]; lv[k][1] = LSE[(size_t)MTOK * 4 + row * 4 + hs]; lv[k][2] = LSE[(size_t)2 * MTOK * 4 + row * 4 + hs];
                const bf16* og = QA + odA + row * 768 + hs * 64 + ch * 8; av[k][0] = *(const v4u*)(og); av[k][1] = *(const v4u*)(og + 256); av[k][2] = *(const v4u*)(og + 512); }
            asm volatile("" ::: "memory");
#pragma unroll
            for (int k = 0; k < CB; ++k) { const int t = t0 + k * NWAVES * 64, tok = t >> 3, ch = t & 7; const size_t row = (size_t)b * SEQ + tok;
                const float mx = fmaxf(lv[k][0], fmaxf(lv[k][1], lv[k][2]));
                float w0 = __builtin_amdgcn_exp2f(lv[k][0] - mx), w1 = __builtin_amdgcn_exp2f(lv[k][1] - mx), w2 = __builtin_amdgcn_exp2f(lv[k][2] - mx);
                const float inv = 1.0f / (w0 + w1 + w2); w0 *= inv; w1 *= inv; w2 *= inv;
                v4u o;
#pragma unroll
                for (int w = 0; w < 4; ++w) o[w] = pk2bf(w0 * bflo(av[k][0][w]) + w1 * bflo(av[k][1][w]) + w2 * bflo(av[k][2][w]), w0 * bfhi(av[k][0][w]) + w1 * bfhi(av[k][1][w]) + w2 * bfhi(av[k][2][w]));
                *(v4u*)(OA + row * 256 + hs * 64 + ch * 8) = o; }
        }
    } } else if (which & 2) {
        if (F.tid < 16) *(LAS float*)(F.lds + ATT_SINK_OFF + 4 * F.tid) = P_IN(6)[l * 16 + F.tid] * LOG2E;
        const ChunkP p0 = win_chunk(KW, VW, w_lo); attn_issue<128>(p0, F.tid, kreg, vreg); attn_loadq(F, p0, QW + ((w_lo >> 3) & 3) * 256, 1024, qf); attn_commit<128>(F, p0, kreg, vreg);
        __syncthreads();
    }
#pragma unroll 1
    for (int wc = w_lo; wc < ((which & 2) ? w_hi : w_lo); ++wc) {
        const ChunkP p = win_chunk(KW, VW, wc); const int kvh = (wc >> 3) & 3;
        const int wn = wc + 1 < w_hi ? wc + 1 : wc;
        const ChunkP pn = win_chunk(KW, VW, wn);
        bf16x8 qn[4];
        attn_issue<128>(pn, F.tid, kreg, vreg); attn_loadq(F, pn, QW + ((wn >> 3) & 3) * 256, 1024, qn);
        attn_compute<128, 4, true, false>(F, p, QW + kvh * 256, 1024, odW, nullptr, 0.f, nullptr, kvh * 4, qf);
        __syncthreads();
        if (wc + 1 < w_hi) attn_commit<128>(F, pn, kreg, vreg);
        __syncthreads();
#pragma unroll
        for (int ks = 0; ks < 4; ++ks) qf[ks] = qn[ks];
    }
}
#ifndef PH_A
#define PH_A 1
#endif
#ifndef PH_B
#define PH_B 1
#endif
#ifndef PH_C
#define PH_C 1
#endif
#ifndef PH_D
#define PH_D 1
#endif
#ifndef PH_E
#define PH_E 1
#endif
#ifndef PH_F
#define PH_F 1
#endif
#ifndef PH_G
#define PH_G 1
#endif
#ifndef PH_H
#define PH_H 1
#endif
#ifndef PH_I
#define PH_I 1
#endif
#ifndef PH_J
#define PH_J 1
#endif
#ifndef PH_Z
#define PH_Z 1
#endif

struct Args { const float* in[14]; float* out; unsigned char* ws; };
__global__ void __launch_bounds__(NWAVES * 64, 2) mk_fwd(Args args) {
    extern __shared__ __attribute__((aligned(16))) unsigned char lds_raw[];
    LAS unsigned char* const lds = (LAS unsigned char*)lds_raw;
    int wave_s = __builtin_amdgcn_readfirstlane((int)(threadIdx.x >> 6)); asm volatile("" : "+s"(wave_s));
    {
        const int t0 = wave_s * 64 + xb_lane();
        volatile LAS unsigned* MISC = (volatile LAS unsigned*)(lds + MISC_OFF);
        if (t0 < 32) MISC[t0] = 0u;
        if (t0 == 0) { volatile LAS unsigned long long* pt = (volatile LAS unsigned long long*)(lds + PTAB_OFF);
            pt[0] = (unsigned long long)args.in[0]; pt[1] = (unsigned long long)args.in[1]; pt[2] = (unsigned long long)args.in[2]; pt[3] = (unsigned long long)args.in[3];
            pt[4] = (unsigned long long)args.in[4]; pt[5] = (unsigned long long)args.in[5]; pt[6] = (unsigned long long)args.in[6]; pt[7] = (unsigned long long)args.in[7];
            pt[8] = (unsigned long long)args.in[8]; pt[9] = (unsigned long long)args.in[9]; pt[10] = (unsigned long long)args.in[10]; pt[11] = (unsigned long long)args.in[11];
            pt[12] = (unsigned long long)args.in[12]; pt[13] = (unsigned long long)args.in[13]; pt[14] = (unsigned long long)args.out; pt[15] = (unsigned long long)args.ws; }
        __syncthreads();
    }
    XcdBarrier bar = xcd_barrier_post((unsigned*)(args.ws + WS_CTL) + CW_BAR, (volatile LAS unsigned*)(lds + MISC_OFF) + 8, wave_s);
    const int G = 256;

#pragma unroll 1
    for (int l = 0; l < DEPTH; ++l) {
        int c = blockIdx.x; asm volatile("" : "+s"(c));
#if PH_A
        { Frame F = make_frame(lds, wave_s); convert_weights(F, l);
          unsigned char* ws = P_WS;
          if (l == 0) norm_rows<true, false, false>(F, P_IN(0), (bf16*)(ws + WS_HB), P_IN(1) + l * DM, (float*)(ws + WS_LSE), nullptr);
          else norm_rows<false, true, false>(F, nullptr, (bf16*)(ws + WS_HB), P_IN(1) + l * DM, (float*)(ws + WS_LSE), nullptr);
          }
#endif
        xcd_barrier(bar);
#if PH_B
        { Frame F = make_frame(lds, wave_s); unsigned char* ws = P_WS; bf16* big = (bf16*)(ws + WS_BIG);
          pg8::Gemm g{(const bf16*)(ws + WS_HB), (const bf16*)(ws + WS_WIN), MTOK, INC, DM}; pg8::StaticOrder S; S.init(MTOK, INC, G, c);
          pg8::EpiInProj E{big + B_QA / 2, big + B_KA / 2, big + B_VA / 2, big + B_QW / 2, big + B_KW / 2, big + B_VW / 2, big + B_G / 2, big + B_G / 2 + (size_t)MTOK * DM, P_IN(5) + l * 2048, QSCALE, (const float*)(ws + WS_LSE), 0.f, 0.f};
          pg8::gemm_phase<pg8::EpiInProj, pg8::StaticOrder, true, true>(F.tid, lds, g, S, E); }
#endif
        xcd_barrier(bar);
#ifdef DUP_C
        { Frame F = make_frame(lds, wave_s); attention_phase(F, l, ((long)WS_HN - (long)(WS_BIG + B_QA)) / 2, ((long)WS_HN - (long)(WS_BIG + B_QW)) / 2, DUP_C); }
        xcd_barrier(bar);
#endif
#if PH_C
        { Frame F = make_frame(lds, wave_s); attention_phase(F, l, 0, 0); }
#endif
        xcd_barrier(bar);
#if PH_E
        { Frame F = make_frame(lds, wave_s); unsigned char* ws = P_WS; bf16* big = (bf16*)(ws + WS_BIG);
          pg8::Gemm g0{big + B_OA / 2, (const bf16*)(ws + WS_WA), MTOK, DM, 256}; pg8::Gemm g1{big + B_QW / 2, (const bf16*)(ws + WS_WB), MTOK, DM, DM}; pg8::StaticOrder S; S.init(MTOK, DM, G, c);
          pg8::EpiMergeDual E{big + B_MERGED / 2, big + B_G / 2, big + B_G / 2 + (size_t)MTOK * DM};
          pg8::gemm_phase_dual<pg8::EpiMergeDual, pg8::StaticOrder>(F.tid, lds, g0, g1, S, E); }
#endif
        xcd_barrier(bar);
#if PH_F
        { Frame F = make_frame(lds, wave_s); unsigned char* ws = P_WS; bf16* big = (bf16*)(ws + WS_BIG); bf16* hb = (bf16*)(ws + WS_HB);
          pg8::Gemm g{big + B_MERGED / 2, (const bf16*)(ws + WS_WO), MTOK, DM, DM}; pg8::StaticOrder S; S.init(MTOK, DM, G, c);
          pg8::EpiResid E{hb, hb};
          pg8::gemm_phase<pg8::EpiResid, pg8::StaticOrder, true, true>(F.tid, lds, g, S, E); }
#endif
        xcd_barrier(bar);
#if PH_G
        { Frame F = make_frame(lds, wave_s); unsigned char* ws = P_WS;
          norm_router(F, (const bf16*)(ws + WS_HB), P_IN(8) + l * DM, P_IN(9) + (size_t)l * DM * NE, (float*)(ws + WS_LSE), (float*)(ws + WS_AFF), ws + WS_HN); }
#endif
        xcd_barrier(bar);
#if PH_H
        { Frame F = make_frame(lds, wave_s); unsigned char* ws = P_WS;
          topk_gather(F, (const float*)(ws + WS_AFF), (const float*)(ws + WS_LSE), (int*)(ws + WS_SEL), (float*)(ws + WS_GATE), (int*)(ws + WS_IDX)); }
#endif
        xcd_barrier(bar);
#if PH_I
        { Frame F = make_frame(lds, wave_s); unsigned char* ws = P_WS; bf16* big = (bf16*)(ws + WS_BIG);
          pg8::Gemm g{(const bf16*)(ws + WS_HN), (const bf16*)(ws + WS_WGU), MEXP, NE * 2048, DM / 2}; pg8::GroupedOrder S; S.init(NE, NB, 8, G, c);
          pg8::EpiSwiGLU E{(unsigned char*)(big + B_ACT / 2), (const LAS int*)(lds + AROW_OFF), 0};
          { const int* idxg = (const int*)(ws + WS_IDX); LAS int* arow = (LAS int*)(lds + AROW_OFF);
            int rv[NE]; const int r = F.tid & 255;
#pragma unroll
            for (int i = 0; i < NE; ++i) { pg8::Unit u; u.pm = 0; u.pn = 0; S.next(i, u); rv[i] = u.pm; }
            asm volatile("" ::: "memory");
#pragma unroll
            for (int i = 0; i < NE; ++i) rv[i] = idxg[(size_t)rv[i] * 256 + r];
#pragma unroll
            for (int i = 0; i < NE; ++i) if (F.tid < 256) arow[i * 256 + r] = rv[i];
            __syncthreads(); }
          pg8::gemm_phase<pg8::EpiSwiGLU, pg8::GroupedOrder, true, true, true, true>(F.tid, lds, g, S, E, (const LAS int*)(lds + AROW_OFF)); }
#endif
        xcd_barrier(bar);
#if PH_J
        { Frame F = make_frame(lds, wave_s); unsigned char* ws = P_WS; bf16* big = (bf16*)(ws + WS_BIG);
          pg8::Gemm g{big + B_ACT / 2, (const bf16*)(ws + WS_WD), MEXP, NE * 1024, DEX / 2}; pg8::GroupedOrder S; S.init(NE, NB, 4, G, c);
          pg8::EpiDown E{big + B_Y / 2, (const LAS float*)(lds + AROW_OFF), 0};
          { const float* gatev = (const float*)(ws + WS_GATE); LAS float* gl = (LAS float*)(lds + AROW_OFF);
            float gv[8]; int pmv[8]; const int r = F.tid & 255;
#pragma unroll
            for (int i = 0; i < 8; ++i) { pg8::Unit u; u.pm = 0; u.pn = 0; S.next(i, u); pmv[i] = u.pm; }
            asm volatile("" ::: "memory");
#pragma unroll
            for (int i = 0; i < 8; ++i) gv[i] = gatev[(size_t)pmv[i] * 256 + r];
#pragma unroll
            for (int i = 0; i < 8; ++i) if (F.tid < 256) gl[i * 256 + r] = gv[i];
            __syncthreads(); }
          pg8::gemm_phase<pg8::EpiDown, pg8::GroupedOrder, true, true, false, true>(F.tid, lds, g, S, E); }
#endif
        xcd_barrier(bar);
    }
#if PH_Z
    { Frame F = make_frame(lds, wave_s); unsigned char* ws = P_WS; norm_rows<false, true, true>(F, nullptr, (bf16*)(ws + WS_HB), P_IN(13), nullptr, P_OUT); }
#endif
}

extern "C" void kernel_launch(void* const* d_in, const int* in_sizes, int n_in, void* d_out, int out_size, void* d_ws, size_t ws_size, hipStream_t stream) {
    static int grid = 0;
    if (grid == 0) {
        if (n_in != 14 || out_size != MTOK * DM || ws_size < WS_END) { fprintf(stderr, "kernel_launch: unexpected shapes (n_in %d, out %d, ws %zu < %zu); nothing launched\n", n_in, out_size, ws_size, (size_t)WS_END); grid = -1; return; }
        int dev = 0, cus = 0, per_cu = 0;
        if (hipGetDevice(&dev) != hipSuccess || hipDeviceGetAttribute(&cus, hipDeviceAttributeMultiprocessorCount, dev) != hipSuccess) { grid = -1; return; }
        if (hipFuncSetAttribute((const void*)mk_fwd, hipFuncAttributeMaxDynamicSharedMemorySize, LDS_BYTES) != hipSuccess) { fprintf(stderr, "kernel_launch: hipFuncSetAttribute failed\n"); grid = -1; return; }
        if (hipOccupancyMaxActiveBlocksPerMultiprocessor(&per_cu, (const void*)mk_fwd, NWAVES * 64, LDS_BYTES) != hipSuccess || per_cu < 1) fprintf(stderr, "kernel_launch: occupancy query reports %d\n", per_cu);
        (void)hipGetLastError();
        grid = 256;
        if (cus != 256) fprintf(stderr, "kernel_launch: device has %d CUs, built for 256\n", cus);
    }
    if (grid < 0) return;
    (void)in_sizes;
    hipMemsetAsync((char*)d_ws + WS_CTL, 0, CTL_ZERO_BYTES, stream);
    Args a{};
    for (int i = 0; i < 14; ++i) a.in[i] = (const float*)d_in[i];
    a.out = (float*)d_out; a.ws = (unsigned char*)d_ws;
    hipLaunchKernelGGL(mk_fwd, dim3(grid), dim3(NWAVES * 64), LDS_BYTES, stream, a);
}
```

```cpp
#include <hip/hip_runtime.h>
#include <cstdio>
#include <cstdint>
typedef __bf16 nbf16x2 __attribute__((ext_vector_type(2)));
typedef __bf16 nbf16x4 __attribute__((ext_vector_type(4)));
typedef __bf16 nbf16x8 __attribute__((ext_vector_type(8)));
typedef float f32x2_t __attribute__((ext_vector_type(2)));
typedef float f32x8_t __attribute__((ext_vector_type(8)));
__device__ __forceinline__ unsigned pk2bf(float lo, float hi) { f32x2_t v = {lo, hi}; return __builtin_bit_cast(unsigned, __builtin_convertvector(v, nbf16x2)); }
__device__ __forceinline__ float bflo(unsigned w) { return __builtin_bit_cast(float, w << 16); }
__device__ __forceinline__ float bfhi(unsigned w) { return __builtin_bit_cast(float, w & 0xffff0000u); }
namespace pg8 {
#define PG8_LAS __attribute__((address_space(3)))
typedef unsigned short bf16_t;
typedef short bf16x8 __attribute__((ext_vector_type(8)));
typedef float f32x4 __attribute__((ext_vector_type(4)));
typedef unsigned u32x4 __attribute__((ext_vector_type(4)));
typedef int i32x4_t __attribute__((ext_vector_type(4)));
constexpr int BM = 256, BK = 64, HALF = 128, HTB = HALF * BK * 2  , STAGE_BYTES = 8 * HTB, NXCD = 8;
#ifndef PG8_WGM
#define PG8_WGM 8
#endif
#ifndef PG8_WGM_G
#define PG8_WGM_G 8
#endif
constexpr int WGM = PG8_WGM, WGM_G = PG8_WGM_G;

__host__ __device__ __forceinline__ int lds_byte(int r, int c) { const int st = (r >> 4) * 2 + (c >> 5), rr = r & 15, cc = c & 31, ob = rr * 64 + cc * 2; return st * 1024 + (ob ^ (((ob >> 9) & 1) << 5)); }
__host__ __device__ __forceinline__ void stage_rc(int b, int& R, int& C) { const int st = b / 1024, sb = b % 1024, swz = sb ^ (((sb >> 9) & 1) << 5); R = (st >> 1) * 16 + swz / 64; C = (st & 1) * 32 + (swz % 64) / 2; }
__host__ __device__ __forceinline__ int perm32(int rho) { const int n = rho >> 4, i = rho & 15; return 8 * (i >> 2) + 4 * n + (i & 3); }

struct Unit { int pm, pn; };
struct Gemm { const bf16_t* A; const bf16_t* Bt; int M, N, K; };

struct StaticOrder {
    int nM, nN, nwg, G, c;
    __host__ __device__ void init(int M, int N, int G_, int c_) { nM = M / BM; nN = N / BM; nwg = nM * nN; G = G_; c = c_; }
    __host__ __device__ bool next(int i, Unit& u) const {
        const long L = (long)i * G + c; if (L >= nwg) return false;
        int wgid = (int)L; { const int q = nwg / NXCD, r = nwg % NXCD, xcd = wgid % NXCD, off = wgid / NXCD; wgid = (xcd < r ? xcd * (q + 1) : r * (q + 1) + (xcd - r) * q) + off; }
        const int nig = WGM * nN, gid = wgid / nig, fm = gid * WGM, gsz = (nM - fm) < WGM ? (nM - fm) : WGM;
        u.pm = fm + ((wgid % nig) % gsz); u.pn = (wgid % nig) / gsz; return true;
    }
    __device__ __forceinline__ void a_ready(const Unit&) const {}
    __device__ __forceinline__ void done(const Unit&) const {}
};

struct GroupedOrder {
    int nMg, nNg, upg, ntot, G, c;
    __host__ __device__ void init(int ngrp, int nMg_, int nNg_, int G_, int c_) { nMg = nMg_; nNg = nNg_; upg = nMg * nNg; ntot = ngrp * upg; G = G_; c = c_; }
    __host__ __device__ bool next(int i, Unit& u) const {
        const long L = (long)i * G + c; if (L >= ntot) return false;
        const int e = (int)(L / upg); int wgid = (int)(L % upg);
        { const int q = upg / NXCD, r = upg % NXCD, xcd = wgid % NXCD, off = wgid / NXCD; wgid = (xcd < r ? xcd * (q + 1) : r * (q + 1) + (xcd - r) * q) + off; }
        const int nig = WGM_G * nNg, gid = wgid / nig, fm = gid * WGM_G, gsz = (nMg - fm) < WGM_G ? (nMg - fm) : WGM_G;
        u.pm = e * nMg + fm + ((wgid % nig) % gsz); u.pn = e * nNg + (wgid % nig) / gsz; return true;
    }
    __device__ __forceinline__ void a_ready(const Unit&) const {}
    __device__ __forceinline__ void done(const Unit&) const {}
};

#ifndef EPI_NT
#define EPI_NT 0
#endif
#if EPI_NT
#define EPI_ST(ptr, val) __builtin_nontemporal_store((val), (ptr))
#else
#define EPI_ST(ptr, val) (*(ptr) = (val))
#endif
#ifndef EPI_NT_B
#define EPI_NT_B 0
#endif
#if EPI_NT_B
#define EPI_ST_B(ptr, val) __builtin_nontemporal_store((val), (ptr))
#else
#define EPI_ST_B(ptr, val) (*(ptr) = (val))
#endif
__device__ __forceinline__ u32x4 pack8(const f32x4 a, const f32x4 b) { u32x4 w; w.x = pk2bf(a[0], a[1]); w.y = pk2bf(a[2], a[3]); w.z = pk2bf(b[0], b[1]); w.w = pk2bf(b[2], b[3]); return w; }
__device__ __forceinline__ void unpack8(const u32x4 w, f32x4& a, f32x4& b) { a = (f32x4){bflo(w.x), bfhi(w.x), bflo(w.y), bfhi(w.y)}; b = (f32x4){bflo(w.z), bfhi(w.z), bflo(w.w), bfhi(w.w)}; }
typedef unsigned u32x2 __attribute__((ext_vector_type(2)));
__device__ __forceinline__ unsigned pk4f8u(const f32x4 v) { int w = __builtin_amdgcn_cvt_pk_fp8_f32(v[0], v[1], 0, false); w = __builtin_amdgcn_cvt_pk_fp8_f32(v[2], v[3], w, true); return (unsigned)w; }
__device__ __forceinline__ unsigned pk4f8c(const f32x4 v) { f32x4 c; for (int i = 0; i < 4; ++i) c[i] = fminf(fmaxf(v[i], -440.f), 440.f); return pk4f8u(c); }
__device__ __forceinline__ float sigmoidf_fast(float x) { return __builtin_amdgcn_rcpf(1.0f + __builtin_amdgcn_exp2f(-1.4426950408889634f * x)); }

__device__ __forceinline__ size_t gate_blk(int pm, int pn, int wave, int ai, int m, int bj, int lane) { return ((size_t)(((pm * 4 + pn) * 8 + wave) * 16 + (ai * 8 + m * 2 + bj)) * 64 + lane) * 8; }
__device__ __forceinline__ u32x4 xchg_pair(const u32x4 v) { u32x4 r;
#pragma unroll
    for (int w = 0; w < 4; ++w) r[w] = (unsigned)__builtin_amdgcn_mov_dpp((int)v[w], 0xB1, 0xF, 0xF, true);
    return r; }
__device__ __forceinline__ void wide_pair(const u32x4 p0, const u32x4 p1, bool odd, u32x4& a, u32x4& b) {
    const u32x4 recv = xchg_pair(odd ? p0 : p1); a = odd ? recv : p0; b = odd ? p1 : recv; }
struct EpiInProj {
    static constexpr bool PERM = true, AFTER_DRAIN = false, WIDE = true, ROWSCALE = true; static constexpr int F8_SW = 0, F8_SA = 0;
    bf16_t *qa, *ka, *va, *qw, *kw, *vw, *gr, *g1; const float* bgate; float qscale;
    const float* rsv; mutable float rs0, rs1;
    __device__ __forceinline__ float row_rs(int ai, int m, int fr) const { return __builtin_bit_cast(float, __builtin_amdgcn_ds_bpermute((fr + 16 * m) << 2, __builtin_bit_cast(int, ai ? rs1 : rs0))); }
    __device__ __forceinline__ void operator()(const f32x4 (&acc)[2][2][4][2], const Unit& u, int wr, int wc, int fr, int fq) const {
        const int pn = u.pn; const int row0 = u.pm * BM + wr * 64 + fr;
        if (pn >= 15) {
            const int cc0 = (pn - 15) * HALF + wc * 32 + 8 * fq;
            f32x4 b0[2], b1[2];
#pragma unroll
            for (int n = 0; n < 2; ++n) { b0[n] = *(const f32x4*)(bgate + cc0 + 4 * n); b1[n] = *(const f32x4*)(bgate + 1024 + cc0 + 4 * n); }
#pragma unroll
            for (int ai = 0; ai < 2; ++ai)
#pragma unroll
                for (int m = 0; m < 4; ++m) { const size_t off = gate_blk(u.pm, (pn - 15) >> 1, wr * 4 + wc, ai, m, (pn - 15) & 1, fq * 16 + fr); f32x4 rr[2], gg[2]; const float rs = row_rs(ai, m, fr);
#pragma unroll
                    for (int n = 0; n < 2; ++n)
#pragma unroll
                        for (int j = 0; j < 4; ++j) { float a0 = acc[ai][0][m][n][j] * rs + b0[n][j], a1 = acc[ai][1][m][n][j] * rs + b1[n][j];
                            a0 = fminf(fmaxf(a0, -30.f), 30.f); a1 = fminf(fmaxf(a1, -30.f), 30.f);
                            const float e0 = __builtin_amdgcn_exp2f(-1.4426950408889634f * a0), e1 = __builtin_amdgcn_exp2f(-1.4426950408889634f * a1);
                            gg[n][j] = __builtin_amdgcn_rcpf(1.0f + e1); rr[n][j] = (1.0f + e1) * __builtin_amdgcn_rcpf(1.0f + e0); }
                    EPI_ST_B((u32x4*)(gr + off), pack8(rr[0], rr[1])); EPI_ST_B((u32x4*)(g1 + off), pack8(gg[0], gg[1])); }
            return;
        }
        bf16_t* base; int ldc, ct; float sc = 1.0f;
        if (pn < 3) { base = qa; ldc = 768; ct = pn; sc = qscale; }
        else if (pn < 6) { base = ka; ldc = 768; ct = pn - 3; }
        else if (pn < 9) { base = va; ldc = 768; ct = pn - 6; }
        else if (pn < 13) { base = qw; ldc = 1024; ct = pn - 9; sc = qscale; }
        else if (pn == 13) { base = kw; ldc = 256; ct = 0; }
        else { base = vw; ldc = 256; ct = 0; }
        const bool odd = (fr & 1) != 0;
        const int col0 = ct * BM + wc * 64 + 8 * fq + (odd ? 32 : 0);
#pragma unroll
        for (int ai = 0; ai < 2; ++ai)
#pragma unroll
            for (int m = 0; m < 4; ++m) { bf16_t* rowp = base + (size_t)(row0 - (odd ? 1 : 0) + ai * HALF + m * 16) * ldc + col0;
                const float s2 = sc * row_rs(ai, m, fr);
                u32x4 a, b; wide_pair(pack8(acc[ai][0][m][0] * s2, acc[ai][0][m][1] * s2), pack8(acc[ai][1][m][0] * s2, acc[ai][1][m][1] * s2), odd, a, b);
                EPI_ST_B((u32x4*)rowp, a); EPI_ST_B((u32x4*)(rowp + ldc), b); }
    }
};
struct EpiGate8 {
    static constexpr bool PERM = true, AFTER_DRAIN = false, WIDE = true, ROWSCALE = false; static constexpr int F8_SW = 0, F8_SA = 0; static constexpr int NVM = 32;
    bf16_t *gr, *g1; const float* bgate;
    __device__ __forceinline__ void operator()(const f32x4 (&acc)[2][2][4][2], const Unit& u, int wr, int wc, int fr, int fq) const {
        const int pn = u.pn;
        const int cc0 = pn * HALF + wc * 32 + 8 * fq;
        f32x4 b0[2], b1[2];
#pragma unroll
        for (int n = 0; n < 2; ++n) { b0[n] = *(const f32x4*)(bgate + cc0 + 4 * n); b1[n] = *(const f32x4*)(bgate + 1024 + cc0 + 4 * n); }
        constexpr float SC = 1.0f / 1024.0f;
#pragma unroll
        for (int ai = 0; ai < 2; ++ai)
#pragma unroll
            for (int m = 0; m < 4; ++m) { const size_t off = gate_blk(u.pm, pn >> 1, wr * 4 + wc, ai, m, pn & 1, fq * 16 + fr); f32x4 rr[2], gg[2];
#pragma unroll
                for (int n = 0; n < 2; ++n)
#pragma unroll
                    for (int j = 0; j < 4; ++j) { float a0 = acc[ai][0][m][n][j] * SC + b0[n][j], a1 = acc[ai][1][m][n][j] * SC + b1[n][j];
                        a0 = fminf(fmaxf(a0, -30.f), 30.f); a1 = fminf(fmaxf(a1, -30.f), 30.f);
                        const float e0 = __builtin_amdgcn_exp2f(-1.4426950408889634f * a0), e1 = __builtin_amdgcn_exp2f(-1.4426950408889634f * a1);
                        gg[n][j] = __builtin_amdgcn_rcpf(1.0f + e1); rr[n][j] = (1.0f + e1) * __builtin_amdgcn_rcpf(1.0f + e0); }
                EPI_ST_B((u32x4*)(gr + off), pack8(rr[0], rr[1])); EPI_ST_B((u32x4*)(g1 + off), pack8(gg[0], gg[1])); }
    }
};
struct EpiMergeDual {
    static constexpr bool PERM = true, AFTER_DRAIN = false, WIDE = true, ROWSCALE = false; static constexpr int F8_SW = 0, F8_SA = 0;
    unsigned char* merged; const bf16_t* gr; const bf16_t* g1;
    __device__ __forceinline__ size_t gblk(const Unit& u, int wr, int wc, int ai, int m, int bj, int fr, int fq) const { return gate_blk(u.pm, u.pn, wr * 4 + 2 * (wc & 1) + bj, ai, m, wc >> 1, fq * 16 + fr); }
    __device__ __forceinline__ void mid(f32x4 (&acc)[2][2][4][2], const Unit& u, int wr, int wc, int fr, int fq) const {
        u32x4 w[2][4][2];
#pragma unroll
        for (int ai = 0; ai < 2; ++ai)
#pragma unroll
            for (int m = 0; m < 4; ++m) {
#pragma unroll
                for (int bj = 0; bj < 2; ++bj) w[ai][m][bj] = *(const u32x4*)(gr + gblk(u, wr, wc, ai, m, bj, fr, fq)); }
        asm volatile("" ::: "memory");
#pragma unroll
        for (int ai = 0; ai < 2; ++ai)
#pragma unroll
            for (int m = 0; m < 4; ++m) {
#pragma unroll
                for (int bj = 0; bj < 2; ++bj) { f32x4 r0, r1; unpack8(w[ai][m][bj], r0, r1); acc[ai][bj][m][0] *= r0; acc[ai][bj][m][1] *= r1; } }
    }
    __device__ __forceinline__ void operator()(const f32x4 (&acc)[2][2][4][2], const Unit& u, int wr, int wc, int fr, int fq) const {
        u32x4 w[2][4][2];
#pragma unroll
        for (int ai = 0; ai < 2; ++ai)
#pragma unroll
            for (int m = 0; m < 4; ++m) {
#pragma unroll
                for (int bj = 0; bj < 2; ++bj) w[ai][m][bj] = *(const u32x4*)(g1 + gblk(u, wr, wc, ai, m, bj, fr, fq)); }
        asm volatile("" ::: "memory");
#pragma unroll
        for (int ai = 0; ai < 2; ++ai)
#pragma unroll
            for (int m = 0; m < 4; ++m) { f32x4 a0, a1, c0, c1; unpack8(w[ai][m][0], a0, a1); unpack8(w[ai][m][1], c0, c1);
                unsigned char* p = merged + (size_t)(u.pm * BM + wr * 64 + fr + ai * HALF + m * 16) * 1024 + u.pn * BM + wc * 64 + 8 * fq;
                u32x2 p0, p1; p0.x = pk4f8c(acc[ai][0][m][0] * a0 * 64.0f); p0.y = pk4f8c(acc[ai][0][m][1] * a1 * 64.0f); p1.x = pk4f8c(acc[ai][1][m][0] * c0 * 64.0f); p1.y = pk4f8c(acc[ai][1][m][1] * c1 * 64.0f);
                *(u32x2*)p = p0; *(u32x2*)(p + 32) = p1; }
    }
};
struct EpiResid {
    static constexpr bool PERM = true, AFTER_DRAIN = false, WIDE = true, ROWSCALE = false; static constexpr int F8_SW = 0, F8_SA = 0;
    const bf16_t* base; bf16_t* out;
    __device__ __forceinline__ void operator()(const f32x4 (&acc)[2][2][4][2], const Unit& u, int wr, int wc, int fr, int fq) const {
        const bool odd = (fr & 1) != 0;
        const int rowe = u.pm * BM + wr * 64 + (fr & ~1), col = u.pn * BM + wc * 64 + 8 * fq + (odd ? 32 : 0);
        u32x4 la[2][4], lb[2][4];
#pragma unroll
        for (int ai = 0; ai < 2; ++ai)
#pragma unroll
            for (int m = 0; m < 4; ++m) { const bf16_t* p = base + (size_t)(rowe + ai * HALF + m * 16) * 1024 + col; la[ai][m] = *(const u32x4*)p; lb[ai][m] = *(const u32x4*)(p + 1024); }
        asm volatile("" ::: "memory");
#pragma unroll
        for (int ai = 0; ai < 2; ++ai)
#pragma unroll
            for (int m = 0; m < 4; ++m) {
                const u32x4 recv = xchg_pair(odd ? la[ai][m] : lb[ai][m]); const u32x4 r0 = odd ? recv : la[ai][m], r1 = odd ? lb[ai][m] : recv;
                f32x4 b0, b1, c0, c1; unpack8(r0, b0, b1); unpack8(r1, c0, c1);
                constexpr float SC = 1.0f / 4096.0f;
                u32x4 a, b; wide_pair(pack8(b0 + acc[ai][0][m][0] * SC, b1 + acc[ai][0][m][1] * SC), pack8(c0 + acc[ai][1][m][0] * SC, c1 + acc[ai][1][m][1] * SC), odd, a, b);
                bf16_t* p = out + (size_t)(rowe + ai * HALF + m * 16) * 1024 + col;
                EPI_ST((u32x4*)p, a); EPI_ST((u32x4*)(p + 1024), b); }
    }
};
struct EpiSwiGLU {
    static constexpr bool PERM = true, AFTER_DRAIN = false, WIDE = false, ROWSCALE = false; static constexpr int F8_SW = 0, F8_SA = 0;
    unsigned char* act; const PG8_LAS int* arow; mutable int ui;
    __device__ __forceinline__ void operator()(const f32x4 (&acc)[2][2][4][2], const Unit& u, int wr, int wc, int fr, int fq) const {
        const int row0 = u.pm * BM + wr * 64 + fr, col0 = (u.pn & 7) * HALF + wc * 32 + 8 * fq;
#pragma unroll
        for (int ai = 0; ai < 2; ++ai)
#pragma unroll
            for (int m = 0; m < 4; ++m) { f32x4 o[2];
                const float rs = 1.0f / 1024.0f;
#pragma unroll
                for (int n = 0; n < 2; ++n)
#pragma unroll
                    for (int j = 0; j < 4; ++j) { const float a = acc[ai][0][m][n][j] * rs, up = acc[ai][1][m][n][j] * rs; o[n][j] = fminf(fmaxf(8.0f * a * sigmoidf_fast(a) * up, -440.f), 440.f); }
                u32x2 w8; w8.x = pk4f8u(o[0]); w8.y = pk4f8u(o[1]);
                *(u32x2*)(act + (size_t)(row0 + ai * HALF + m * 16) * 1024 + col0) = w8; }
        ++ui;
    }
};
struct EpiDown {
    static constexpr bool PERM = true, AFTER_DRAIN = false, WIDE = true, ROWSCALE = false; static constexpr int F8_SW = 0, F8_SA = 0;
    bf16_t* y; const PG8_LAS float* glds; mutable int ui;
    __device__ __forceinline__ void operator()(const f32x4 (&acc)[2][2][4][2], const Unit& u, int wr, int wc, int fr, int fq) const {
        const bool odd = (fr & 1) != 0;
        const int rowe = u.pm * BM + wr * 64 + (fr & ~1), col = (u.pn & 3) * BM + wc * 64 + 8 * fq + (odd ? 32 : 0);
#pragma unroll
        for (int ai = 0; ai < 2; ++ai)
#pragma unroll
            for (int m = 0; m < 4; ++m) { const float gv = glds[ui * 256 + wr * 64 + fr + ai * HALF + m * 16] * (1.0f / 512.0f);
                u32x4 a, b; wide_pair(pack8(acc[ai][0][m][0] * gv, acc[ai][0][m][1] * gv), pack8(acc[ai][1][m][0] * gv, acc[ai][1][m][1] * gv), odd, a, b);
                bf16_t* p = y + (size_t)(rowe + ai * HALF + m * 16) * 1024 + col;
                EPI_ST((u32x4*)p, a); EPI_ST((u32x4*)(p + 1024), b); }
        ++ui;
    }
};

template <class Epi, class Sched, bool ALIGN_EPI = false, bool SP2 = false, bool GATHER = false, bool FP8 = false>
__device__ __forceinline__ void gemm_phase(int tid_, PG8_LAS unsigned char* lds, const Gemm g, const Sched& S, const Epi& E, const PG8_LAS int* arow = nullptr) {
    static_assert(!GATHER || SP2, "GATHER is written for the SP2 loop");
    asm volatile("" : "+v"(tid_));
    const int tid = tid_, wid = __builtin_amdgcn_readfirstlane(tid >> 6), lane = tid & 63, wr = wid >> 2, wc = wid & 3, fr = lane & 15, fq = lane >> 4;
    const int K = g.K, nt = K / BK;
    unsigned voffA[2], voffB[2];
#pragma unroll
    for (int i = 0; i < 2; ++i) { int R, C; stage_rc(tid * 16 + i * 8192, R, C); const int Rb = Epi::WIDE ? ((R >> 5) * 64 + perm32(R & 31)) : (Epi::PERM ? ((R & ~31) + perm32(R & 31)) : R);
        voffA[i] = (unsigned)(R * K + C) * 2u; voffB[i] = (unsigned)(Rb * K + C) * 2u; }
    unsigned vA0[2] = {voffA[0], voffA[1]}, vA1[2] = {voffA[0], voffA[1]}, nA0[2] = {voffA[0], voffA[1]}, nA1[2] = {voffA[0], voffA[1]};
    int gR[2], gC[2];
#pragma unroll
    for (int i = 0; i < 2; ++i) { stage_rc(tid * 16 + i * 8192, gR[i], gC[i]); }
#define PG8_GOFF(dst0, dst1, u_) do { _Pragma("unroll") for (int _i = 0; _i < 2; ++_i) { \
        dst0[_i] = (((unsigned)arow[(u_) * 256 + gR[_i]] & 0xffffu) * (unsigned)K + (unsigned)gC[_i]) * 2u; dst1[_i] = (((unsigned)arow[(u_) * 256 + HALF + gR[_i]] & 0xffffu) * (unsigned)K + (unsigned)gC[_i]) * 2u; } } while (0)
    const size_t kstep = (size_t)(BK * 2);
    const size_t hstep = (size_t)HALF * K * 2;
    const size_t tstep = 2 * hstep;
    const size_t bhs = Epi::WIDE ? (size_t)32 * K * 2 : hstep;
    const size_t ahs = GATHER ? (size_t)0 : hstep, atstep = GATHER ? (size_t)0 : tstep;
    const unsigned ldsw = (unsigned)wid * 1024u;
    const int aoff = lds_byte(wr * 64 + fr, fq * 8), boff = lds_byte(wc * 32 + fr, fq * 8);
#define PG8_SA(b, h) (((b) * 2 + (h)) * HTB)
#define PG8_SB(b, h) ((4 + (b) * 2 + (h)) * HTB)
#define PG8_STAGE(bufoff, gbase, voff) do { _Pragma("unroll") for (int _i = 0; _i < 2; ++_i) \
        __builtin_amdgcn_global_load_lds((const unsigned*)((const char*)(gbase) + (voff)[_i]), (PG8_LAS unsigned*)(lds + (bufoff) + ldsw + _i * 8192), 16, 0, 0); } while (0)
#define PG8_LDA(dst, b, h) do { _Pragma("unroll") for (int m = 0; m < 4; ++m) _Pragma("unroll") for (int k = 0; k < 2; ++k) dst[m][k] = *(const PG8_LAS bf16x8*)(lds + PG8_SA(b, h) + aoff + m * 2048 + k * 1024); } while (0)
#define PG8_LDB(dst, b, h) do { _Pragma("unroll") for (int n = 0; n < 2; ++n) _Pragma("unroll") for (int k = 0; k < 2; ++k) dst[n][k] = *(const PG8_LAS bf16x8*)(lds + PG8_SB(b, h) + boff + n * 2048 + k * 1024); } while (0)
#define PG8_CAT8(x0, x1) __builtin_shufflevector(__builtin_bit_cast(i32x4_t, (x0)), __builtin_bit_cast(i32x4_t, (x1)), 0, 1, 2, 3, 4, 5, 6, 7)
#define PG8_MMA(ai, bj, At, Bt) do { __builtin_amdgcn_s_setprio(1); \
        if constexpr (FP8) { _Pragma("unroll") for (int m = 0; m < 4; ++m) _Pragma("unroll") for (int n = 0; n < 2; ++n) \
            asm volatile("v_mfma_f32_16x16x128_f8f6f4 %0, %1, %2, %0" : "+v"(acc[ai][bj][m][n]) : "v"(PG8_CAT8(Bt[n][0], Bt[n][1])), "v"(PG8_CAT8(At[m][0], At[m][1]))); } \
        else { _Pragma("unroll") for (int m = 0; m < 4; ++m) _Pragma("unroll") for (int n = 0; n < 2; ++n) _Pragma("unroll") for (int k = 0; k < 2; ++k) \
            acc[ai][bj][m][n] = __builtin_amdgcn_mfma_f32_16x16x32_bf16(Bt[n][k], At[m][k], acc[ai][bj][m][n], 0, 0, 0); } \
        __builtin_amdgcn_s_setprio(0); } while (0)
#define PG8_WAIT_V(n) asm volatile("s_waitcnt vmcnt(" #n ")" ::: "memory")
#define PG8_WAIT_L(n) asm volatile("s_waitcnt lgkmcnt(" #n ")" ::: "memory")
#define PG8_BAR __builtin_amdgcn_s_barrier()
#define PG8_SCHED __builtin_amdgcn_sched_barrier(0)
    Unit cur, nxt; int ui = 0;
    if (!S.next(0, cur)) return;
    f32x4 acc[2][2][4][2];
#pragma unroll
    for (int a = 0; a < 2; ++a)
#pragma unroll
        for (int b = 0; b < 2; ++b)
#pragma unroll
            for (int m = 0; m < 4; ++m)
#pragma unroll
                for (int n = 0; n < 2; ++n) acc[a][b][m][n] = (f32x4){0.f, 0.f, 0.f, 0.f};
    bf16x8 At[4][2], B0[2][2], B1[2][2];
    const char* cA = (const char*)g.A + (size_t)cur.pm * atstep; const char* cB = (const char*)g.Bt + (size_t)cur.pn * tstep;
    if constexpr (GATHER) { PG8_GOFF(vA0, vA1, 0); }
    S.a_ready(cur);
    if constexpr (SP2) {
        PG8_STAGE(PG8_SB(0, 0), cB, voffB); PG8_STAGE(PG8_SB(0, 1), cB + bhs, voffB); PG8_STAGE(PG8_SA(0, 0), cA, vA0); PG8_STAGE(PG8_SA(0, 1), cA + ahs, vA1);
        if (wr == 1) PG8_BAR;
        PG8_WAIT_V(2); PG8_BAR;
        PG8_STAGE(PG8_SB(1, 0), cB + kstep, voffB); PG8_STAGE(PG8_SA(1, 0), cA + kstep, vA0); PG8_STAGE(PG8_SB(1, 1), cB + bhs + kstep, voffB);
        PG8_WAIT_V(6); PG8_BAR;
    } else {
        PG8_STAGE(PG8_SB(0, 0), cB, voffB); PG8_STAGE(PG8_SA(0, 0), cA, voffA); PG8_STAGE(PG8_SB(0, 1), cB + bhs, voffB); PG8_STAGE(PG8_SA(0, 1), cA + hstep, voffA);
        if (wr == 1) PG8_BAR;
        PG8_WAIT_V(4); PG8_BAR;
        PG8_STAGE(PG8_SB(1, 0), cB + kstep, voffB); PG8_STAGE(PG8_SA(1, 0), cA + kstep, voffA); PG8_STAGE(PG8_SB(1, 1), cB + bhs + kstep, voffB);
        PG8_WAIT_V(6); PG8_BAR;
    }
    for (;;) {
        const bool has_next = S.next(ui + 1, nxt);
        const char* nA = has_next ? (const char*)g.A + (size_t)nxt.pm * atstep : cA; const char* nB = has_next ? (const char*)g.Bt + (size_t)nxt.pn * tstep : cB;
#pragma unroll 1
        for (int t = 0; t < nt; t += 2) {
            const bool last = (t == nt - 2);
            const char* a1 = cA + (size_t)(t + 1) * kstep;
            const char* a2 = last ? nA : cA + (size_t)(t + 2) * kstep; const char* b2 = last ? nB : cB + (size_t)(t + 2) * kstep;
            const char* a3 = a2 + kstep; const char* b3 = b2 + kstep;
            if (last && has_next) S.a_ready(nxt);
            if constexpr (Epi::ROWSCALE) { if (last) { E.rs0 = E.rsv[cur.pm * BM + wr * 64 + lane]; E.rs1 = E.rsv[cur.pm * BM + HALF + wr * 64 + lane]; } }
            unsigned s0[2] = {vA0[0], vA0[1]}, s1[2] = {vA1[0], vA1[1]};
            if constexpr (GATHER) { if (last && has_next) { PG8_GOFF(nA0, nA1, ui + 1); s0[0] = nA0[0]; s0[1] = nA0[1]; s1[0] = nA1[0]; s1[1] = nA1[1]; } }
            if constexpr (SP2) {
            PG8_LDB(B0, 0, 0); PG8_LDB(B1, 0, 1); PG8_SCHED; PG8_LDA(At, 0, 0); PG8_STAGE(PG8_SA(1, 1), a1 + ahs, vA1);
            PG8_WAIT_V(8); PG8_WAIT_L(0); PG8_BAR; PG8_MMA(0, 0, At, B0); PG8_MMA(0, 1, At, B1); PG8_BAR; PG8_SCHED;
            PG8_LDA(At, 0, 1); PG8_STAGE(PG8_SB(0, 0), b2, voffB); PG8_STAGE(PG8_SB(0, 1), b2 + bhs, voffB); PG8_STAGE(PG8_SA(0, 0), a2, s0);
            PG8_WAIT_V(8); PG8_WAIT_L(0); PG8_BAR; PG8_MMA(1, 0, At, B0); PG8_MMA(1, 1, At, B1); PG8_BAR; PG8_SCHED;
            PG8_LDB(B0, 1, 0); PG8_LDB(B1, 1, 1); PG8_SCHED; PG8_LDA(At, 1, 0); PG8_STAGE(PG8_SA(0, 1), a2 + ahs, s1);
            PG8_WAIT_V(8); PG8_WAIT_L(0); PG8_BAR; PG8_MMA(0, 0, At, B0); PG8_MMA(0, 1, At, B1); PG8_BAR; PG8_SCHED;
            PG8_LDA(At, 1, 1); PG8_STAGE(PG8_SB(1, 0), b3, voffB); PG8_STAGE(PG8_SB(1, 1), b3 + bhs, voffB); PG8_STAGE(PG8_SA(1, 0), a3, s0);
            PG8_WAIT_V(8); PG8_WAIT_L(0); PG8_BAR; PG8_MMA(1, 0, At, B0); PG8_MMA(1, 1, At, B1); PG8_BAR; PG8_SCHED;
            } else {
            PG8_LDB(B0, 0, 0); PG8_SCHED; PG8_LDA(At, 0, 0); PG8_STAGE(PG8_SA(1, 1), a1 + hstep, voffA);
            PG8_WAIT_L(8); PG8_BAR; PG8_WAIT_L(0); PG8_MMA(0, 0, At, B0); PG8_BAR; PG8_SCHED;
            PG8_LDB(B1, 0, 1); PG8_STAGE(PG8_SB(0, 0), b2, voffB);
            PG8_BAR; PG8_WAIT_L(0); PG8_MMA(0, 1, At, B1); PG8_BAR;
            PG8_LDA(At, 0, 1); PG8_STAGE(PG8_SA(0, 0), a2, voffA);
            PG8_BAR; PG8_WAIT_L(0); PG8_MMA(1, 0, At, B0); PG8_BAR; PG8_SCHED;
            PG8_STAGE(PG8_SB(0, 1), b2 + bhs, voffB);
            PG8_WAIT_V(6); PG8_BAR; PG8_MMA(1, 1, At, B1); PG8_BAR;
            PG8_LDB(B0, 1, 0); PG8_SCHED; PG8_LDA(At, 1, 0); PG8_STAGE(PG8_SA(0, 1), a2 + hstep, voffA);
            PG8_WAIT_L(8); PG8_BAR; PG8_WAIT_L(0); PG8_MMA(0, 0, At, B0); PG8_BAR; PG8_SCHED;
            PG8_LDB(B1, 1, 1); PG8_STAGE(PG8_SB(1, 0), b3, voffB);
            PG8_BAR; PG8_WAIT_L(0); PG8_MMA(0, 1, At, B1); PG8_BAR;
            PG8_LDA(At, 1, 1); PG8_STAGE(PG8_SA(1, 0), a3, voffA);
            PG8_BAR; PG8_WAIT_L(0); PG8_MMA(1, 0, At, B0); PG8_BAR; PG8_SCHED;
            PG8_STAGE(PG8_SB(1, 1), b3 + bhs, voffB);
            PG8_WAIT_V(6); PG8_BAR; PG8_MMA(1, 1, At, B1); PG8_BAR;
            }
        }
        if constexpr (ALIGN_EPI) { if (wr == 0) PG8_BAR; }
        if constexpr (FP8) asm volatile("s_nop 15\n\ts_nop 15" ::: "memory");
        if constexpr (!Epi::AFTER_DRAIN) { E(acc, cur, wr, wc, fr, fq); S.done(cur); }
        if (!has_next) break;
#pragma unroll
        for (int a = 0; a < 2; ++a)
#pragma unroll
            for (int b = 0; b < 2; ++b)
#pragma unroll
                for (int m = 0; m < 4; ++m)
#pragma unroll
                    for (int n = 0; n < 2; ++n) acc[a][b][m][n] = (f32x4){0.f, 0.f, 0.f, 0.f};
        cur = nxt; cA = nA; cB = nB; ++ui;
        if constexpr (GATHER) { vA0[0] = nA0[0]; vA0[1] = nA0[1]; vA1[0] = nA1[0]; vA1[1] = nA1[1]; }
        if constexpr (ALIGN_EPI) { if (wr == 1) PG8_BAR; }
    }
    PG8_WAIT_V(0);
    if constexpr (!ALIGN_EPI) { if (wr == 0) PG8_BAR; }
    PG8_BAR;
    if constexpr (Epi::AFTER_DRAIN) { E.fused(acc, cur, wr, wc, fr, fq, lds, wid, lane); S.done(cur); }
#undef PG8_SA
#undef PG8_SB
#undef PG8_STAGE
#undef PG8_LDA
#undef PG8_LDB
#undef PG8_MMA
#undef PG8_CAT8
#undef PG8_WAIT_V
#undef PG8_WAIT_L
#undef PG8_BAR
#undef PG8_SCHED
#undef PG8_GOFF
}

template <class Epi, class Sched>
__device__ __forceinline__ void gemm_phase_dual(int tid_, PG8_LAS unsigned char* lds, const Gemm g0, const Gemm g1, const Sched& S, const Epi& E) {
    asm volatile("" : "+v"(tid_));
    const int tid = tid_, wid = __builtin_amdgcn_readfirstlane(tid >> 6), lane = tid & 63, wr = wid >> 2, wc = wid & 3, fr = lane & 15, fq = lane >> 4;
    unsigned vA_0[2], vB_0[2], vA_1[2], vB_1[2];
#pragma unroll
    for (int i = 0; i < 2; ++i) { int R, C; stage_rc(tid * 16 + i * 8192, R, C); const int Rb = Epi::WIDE ? ((R >> 5) * 64 + perm32(R & 31)) : (Epi::PERM ? ((R & ~31) + perm32(R & 31)) : R);
        vA_0[i] = (unsigned)(R * g0.K + C) * 2u; vB_0[i] = (unsigned)(Rb * g0.K + C) * 2u; vA_1[i] = (unsigned)(R * g1.K + C) * 2u; vB_1[i] = (unsigned)(Rb * g1.K + C) * 2u; }
    const size_t kstep = (size_t)(BK * 2);
    const size_t hs_0 = (size_t)HALF * g0.K * 2, hs_1 = (size_t)HALF * g1.K * 2;
#define PG8_BH(x) (Epi::WIDE ? (x) / 4 : (x))
    const int nt_0 = g0.K / BK, nt_1 = g1.K / BK;
    const unsigned ldsw = (unsigned)wid * 1024u;
    const int aoff = lds_byte(wr * 64 + fr, fq * 8), boff = lds_byte(wc * 32 + fr, fq * 8);
#define PG8_SA(b, h) (((b) * 2 + (h)) * HTB)
#define PG8_SB(b, h) ((4 + (b) * 2 + (h)) * HTB)
#define PG8_STAGE(bufoff, gbase, voff) do { _Pragma("unroll") for (int _i = 0; _i < 2; ++_i) \
        __builtin_amdgcn_global_load_lds((const unsigned*)((const char*)(gbase) + (voff)[_i]), (PG8_LAS unsigned*)(lds + (bufoff) + ldsw + _i * 8192), 16, 0, 0); } while (0)
#define PG8_LDA(dst, b, h) do { _Pragma("unroll") for (int m = 0; m < 4; ++m) _Pragma("unroll") for (int k = 0; k < 2; ++k) dst[m][k] = *(const PG8_LAS bf16x8*)(lds + PG8_SA(b, h) + aoff + m * 2048 + k * 1024); } while (0)
#define PG8_LDB(dst, b, h) do { _Pragma("unroll") for (int n = 0; n < 2; ++n) _Pragma("unroll") for (int k = 0; k < 2; ++k) dst[n][k] = *(const PG8_LAS bf16x8*)(lds + PG8_SB(b, h) + boff + n * 2048 + k * 1024); } while (0)
#define PG8_MMA(ai, bj, At, Bt) do { __builtin_amdgcn_s_setprio(1); _Pragma("unroll") for (int m = 0; m < 4; ++m) _Pragma("unroll") for (int n = 0; n < 2; ++n) _Pragma("unroll") for (int k = 0; k < 2; ++k) \
        acc[ai][bj][m][n] = __builtin_amdgcn_mfma_f32_16x16x32_bf16(Bt[n][k], At[m][k], acc[ai][bj][m][n], 0, 0, 0); __builtin_amdgcn_s_setprio(0); } while (0)
#define PG8_WAIT_V(n) asm volatile("s_waitcnt vmcnt(" #n ")" ::: "memory")
#define PG8_WAIT_L(n) asm volatile("s_waitcnt lgkmcnt(" #n ")" ::: "memory")
#define PG8_BAR __builtin_amdgcn_s_barrier()
#define PG8_SCHED __builtin_amdgcn_sched_barrier(0)
    Unit cur, nxt; int ui = 0, s = 0;
    if (!S.next(0, cur)) return;
    f32x4 acc[2][2][4][2];
#pragma unroll
    for (int a = 0; a < 2; ++a)
#pragma unroll
        for (int b = 0; b < 2; ++b)
#pragma unroll
            for (int m = 0; m < 4; ++m)
#pragma unroll
                for (int n = 0; n < 2; ++n) acc[a][b][m][n] = (f32x4){0.f, 0.f, 0.f, 0.f};
    bf16x8 At[4][2], B0[2][2], B1[2][2];
    const char* cA = (const char*)g0.A + (size_t)cur.pm * 2 * hs_0; const char* cB = (const char*)g0.Bt + (size_t)cur.pn * 2 * hs_0;
    size_t hsC = hs_0; unsigned vAc[2] = {vA_0[0], vA_0[1]}, vBc[2] = {vB_0[0], vB_0[1]};
    PG8_STAGE(PG8_SB(0, 0), cB, vBc); PG8_STAGE(PG8_SB(0, 1), cB + PG8_BH(hsC), vBc); PG8_STAGE(PG8_SA(0, 0), cA, vAc); PG8_STAGE(PG8_SA(0, 1), cA + hsC, vAc);
    if (wr == 1) PG8_BAR;
    PG8_WAIT_V(2); PG8_BAR;
    PG8_STAGE(PG8_SB(1, 0), cB + kstep, vBc); PG8_STAGE(PG8_SA(1, 0), cA + kstep, vAc); PG8_STAGE(PG8_SB(1, 1), cB + PG8_BH(hsC) + kstep, vBc);
    PG8_WAIT_V(6); PG8_BAR;
    for (;;) {
        bool has_next = true; if (s == 1) has_next = S.next(ui + 1, nxt);
        const int npm = (s == 0) ? cur.pm : nxt.pm, npn = (s == 0) ? cur.pn : nxt.pn;
        const size_t hsN = has_next ? (s == 0 ? hs_1 : hs_0) : hsC;
        const char* nA = has_next ? (s == 0 ? (const char*)g1.A : (const char*)g0.A) + (size_t)npm * 2 * hsN : cA;
        const char* nB = has_next ? (s == 0 ? (const char*)g1.Bt : (const char*)g0.Bt) + (size_t)npn * 2 * hsN : cB;
        unsigned vAn[2], vBn[2];
#pragma unroll
        for (int i = 0; i < 2; ++i) { vAn[i] = has_next ? (s == 0 ? vA_1[i] : vA_0[i]) : vAc[i]; vBn[i] = has_next ? (s == 0 ? vB_1[i] : vB_0[i]) : vBc[i]; }
        const int nt = (s == 0) ? nt_0 : nt_1;
#pragma unroll 1
        for (int t = 0; t < nt; t += 2) {
            const bool last = (t == nt - 2);
            const char* a1 = cA + (size_t)(t + 1) * kstep;
            const char* a2 = last ? nA : cA + (size_t)(t + 2) * kstep; const char* b2 = last ? nB : cB + (size_t)(t + 2) * kstep;
            const char* a3 = a2 + kstep; const char* b3 = b2 + kstep;
            const size_t hs2 = last ? hsN : hsC;
            unsigned vA2[2], vB2[2];
#pragma unroll
            for (int i = 0; i < 2; ++i) { vA2[i] = last ? vAn[i] : vAc[i]; vB2[i] = last ? vBn[i] : vBc[i]; }
            PG8_LDB(B0, 0, 0); PG8_LDB(B1, 0, 1); PG8_SCHED; PG8_LDA(At, 0, 0); PG8_STAGE(PG8_SA(1, 1), a1 + hsC, vAc);
            PG8_WAIT_V(8); PG8_WAIT_L(0); PG8_BAR; PG8_MMA(0, 0, At, B0); PG8_MMA(0, 1, At, B1); PG8_BAR; PG8_SCHED;
            PG8_LDA(At, 0, 1); PG8_STAGE(PG8_SB(0, 0), b2, vB2); PG8_STAGE(PG8_SB(0, 1), b2 + PG8_BH(hs2), vB2); PG8_STAGE(PG8_SA(0, 0), a2, vA2);
            PG8_WAIT_V(8); PG8_WAIT_L(0); PG8_BAR; PG8_MMA(1, 0, At, B0); PG8_MMA(1, 1, At, B1); PG8_BAR; PG8_SCHED;
            PG8_LDB(B0, 1, 0); PG8_LDB(B1, 1, 1); PG8_SCHED; PG8_LDA(At, 1, 0); PG8_STAGE(PG8_SA(0, 1), a2 + hs2, vA2);
            PG8_WAIT_V(8); PG8_WAIT_L(0); PG8_BAR; PG8_MMA(0, 0, At, B0); PG8_MMA(0, 1, At, B1); PG8_BAR; PG8_SCHED;
            PG8_LDA(At, 1, 1); PG8_STAGE(PG8_SB(1, 0), b3, vB2); PG8_STAGE(PG8_SB(1, 1), b3 + PG8_BH(hs2), vB2); PG8_STAGE(PG8_SA(1, 0), a3, vA2);
            PG8_WAIT_V(8); PG8_WAIT_L(0); PG8_BAR; PG8_MMA(1, 0, At, B0); PG8_MMA(1, 1, At, B1); PG8_BAR; PG8_SCHED;
        }
        if (wr == 0) PG8_BAR;
        if (s == 0) E.mid(acc, cur, wr, wc, fr, fq); else E(acc, cur, wr, wc, fr, fq);
        if (!has_next) break;
        if (s == 1) {
#pragma unroll
            for (int a = 0; a < 2; ++a)
#pragma unroll
                for (int b = 0; b < 2; ++b)
#pragma unroll
                    for (int m = 0; m < 4; ++m)
#pragma unroll
                        for (int n = 0; n < 2; ++n) acc[a][b][m][n] = (f32x4){0.f, 0.f, 0.f, 0.f};
            cur = nxt; ++ui; }
        s ^= 1; cA = nA; cB = nB; hsC = hsN;
#pragma unroll
        for (int i = 0; i < 2; ++i) { vAc[i] = vAn[i]; vBc[i] = vBn[i]; }
        if (wr == 1) PG8_BAR;
    }
    PG8_WAIT_V(0);
    PG8_BAR;
#undef PG8_SA
#undef PG8_SB
#undef PG8_STAGE
#undef PG8_LDA
#undef PG8_LDB
#undef PG8_MMA
#undef PG8_WAIT_V
#undef PG8_WAIT_L
#undef PG8_BAR
#undef PG8_SCHED
#undef PG8_BH
}
}

constexpr int NWAVES = 8;
constexpr int NB = 32, SEQ = 2048, DM = 1024, MTOK = NB * SEQ, DEPTH = 4;
constexpr int INC = 5888, NE = 16, CAP = 256, DEX = 1024, MEXP = NE * NB * CAP;
constexpr float RMS_EPS = 1e-6f, LOG2E = 1.4426950408889634f;
constexpr float QSCALE = 0.125f * LOG2E;

constexpr size_t MiB = 1u << 20;
constexpr size_t WS_CTL = 0, CTL_ZERO_BYTES = 32768;
constexpr size_t WS_WIN = 1 * MiB;
constexpr size_t WS_WA = WS_WIN + (size_t)INC * DM * 2;
constexpr size_t WS_WB = WS_WA + (size_t)DM * 256 * 2;
constexpr size_t WS_WO = WS_WB + (size_t)DM * DM * 2;
constexpr size_t WS_WGU = WS_WO + (size_t)DM * DM * 2;
constexpr size_t WS_WD = WS_WGU + (size_t)NE * 2048 * DM * 2;
constexpr size_t WS_HN = WS_WD + (size_t)NE * DM * DEX * 2;
constexpr size_t WS_BIG = WS_HN + (size_t)MTOK * DM * 2;
constexpr size_t B_QA = 0, B_KA = 96 * MiB, B_VA = 192 * MiB, B_QW = 288 * MiB, B_KW = 416 * MiB, B_VW = 448 * MiB, B_G = 480 * MiB, B_OA = 736 * MiB, B_END = 768 * MiB;
constexpr size_t B_MERGED = 0;
constexpr size_t B_XE = 0, B_ACT = 256 * MiB, B_Y = 512 * MiB;
constexpr size_t WS_AFF = WS_BIG + B_END;
constexpr size_t WS_SEL = WS_AFF + (size_t)MTOK * NE * 4;
constexpr size_t WS_GATE = WS_SEL + (size_t)MTOK * NE * 4;
constexpr size_t WS_LSE = WS_GATE + (size_t)MEXP * 4;
constexpr size_t WS_IDX = WS_LSE + (size_t)3 * MTOK * 4 * 4;
constexpr size_t WS_HB = WS_IDX + (size_t)MEXP * 4;
constexpr size_t WS_END = WS_HB + (size_t)MTOK * DM * 2;
static_assert(WS_WIN % 256 == 0 && WS_WA % 256 == 0 && WS_WGU % 256 == 0 && WS_HN % 256 == 0 && WS_BIG % 256 == 0 && WS_AFF % 256 == 0, "alignment");
constexpr int CW_BAR = 4096;
constexpr int AROW_OFF = 131072;
constexpr int MISC_OFF = 147456, LDS_BYTES = 151552;

#define GAS __attribute__((address_space(1)))
#define LAS __attribute__((address_space(3)))
typedef unsigned short bf16;
typedef unsigned v4u __attribute__((ext_vector_type(4)));
typedef unsigned v2u __attribute__((ext_vector_type(2)));
typedef float f32x4 __attribute__((ext_vector_type(4)));
typedef float f32x16 __attribute__((ext_vector_type(16)));
typedef short bf16x8 __attribute__((ext_vector_type(8)));
#define LDS_WAIT() asm volatile("s_waitcnt lgkmcnt(0)" ::: "memory")
#define VM_WAIT() asm volatile("s_waitcnt vmcnt(0)" ::: "memory")

#define XB_TMO      128
#define XB_XCNT(j)  (256  + 64 * (j))
#define XB_XSUB(j)  (1280 + 64 * (j))
#define XB_XGEN(j)  (2304 + 64 * (j))
#define XB_TOP      3328
#define XB_TOPGEN   3392
#define XCD_BAR_WORDS 3456
#define XB_SPIN_CAP (1u << 18)

__device__ __forceinline__ unsigned xb_ld(unsigned* p)              { return __hip_atomic_load(p, __ATOMIC_RELAXED, __HIP_MEMORY_SCOPE_AGENT); }
__device__ __forceinline__ unsigned xb_add(unsigned* p, unsigned v) { return __hip_atomic_fetch_add(p, v, __ATOMIC_RELAXED, __HIP_MEMORY_SCOPE_AGENT); }
__device__ __forceinline__ unsigned xb_xcc_id() { return (unsigned)__builtin_amdgcn_s_getreg((3 << 11) | 20) & 0xFu; }
#define XB_SPIN(cond, bar) do { unsigned _sp = 0; while (cond) { __builtin_amdgcn_s_sleep(1); \
    if ((++_sp & 255u) == 0u) { if (xb_ld(&(bar)[XB_TMO])) break; if (_sp > XB_SPIN_CAP) { atomicAdd(&(bar)[XB_TMO], 1u); break; } } } } while (0)

__device__ __forceinline__ int xb_lane() { unsigned z = 0u; asm volatile("" : "+v"(z)); return (int)__builtin_amdgcn_mbcnt_hi(~0u, __builtin_amdgcn_mbcnt_lo(~0u, z)); }
struct XcdBarrier {
    int w;
    unsigned* bar; unsigned x;
    volatile LAS unsigned* st;
};

__device__ __forceinline__ XcdBarrier xcd_barrier_post(unsigned* bar, volatile LAS unsigned* st, int wave) {
    XcdBarrier b; b.w = wave; b.bar = bar; b.x = xb_xcc_id(); b.st = st;
    if (wave == 0 && xb_lane() == 0) (void)xb_add(&bar[XB_XCNT(b.x)], 1u);
    return b;
}
__device__ __forceinline__ void xcd_barrier_complete(unsigned* bar, unsigned x, unsigned& nloc, unsigned& nx) {
    const unsigned G = gridDim.x * gridDim.y * gridDim.z;
    unsigned sum, cnt, mine, sp = 0u;
    for (;;) {
        sum = 0u; cnt = 0u; mine = 0u;
#pragma unroll
        for (unsigned j = 0; j < 16; ++j) { const unsigned c = xb_ld(&bar[XB_XCNT(j)]); sum += c; cnt += (c > 0u) ? 1u : 0u; mine = (j == x) ? c : mine; }
        if (sum == G) break;
        __builtin_amdgcn_s_sleep(1);
        if ((++sp & 255u) == 0u) { if (xb_ld(&bar[XB_TMO])) break; if (sp > XB_SPIN_CAP) { atomicAdd(&bar[XB_TMO], 1u); break; } }
    }
    nloc = mine > 0u ? mine : 1u; nx = cnt > 0u ? cnt : 1u;
}

__device__ __forceinline__ void xcd_barrier(const XcdBarrier& b) {
    asm volatile("s_waitcnt vmcnt(0)" ::: "memory");
    __syncthreads();
    if (b.w == 0 && xb_lane() == 0) {
        unsigned* bar = b.bar;
        __builtin_amdgcn_s_waitcnt(0);
        unsigned nloc = b.st[0], nx = b.st[1];
        if (nloc == 0u) { xcd_barrier_complete(bar, b.x, nloc, nx); b.st[0] = nloc; b.st[1] = nx; }
        const unsigned old = xb_add(&bar[XB_XSUB(b.x)], 1u);
        const unsigned gen = old / nloc;
        if (old + 1u == (gen + 1u) * nloc) {
            __builtin_amdgcn_fence(__ATOMIC_RELEASE, "agent");
            asm volatile("s_waitcnt vmcnt(0)" ::: "memory");
            const unsigned og = xb_add(&bar[XB_TOP], 1u);
            const unsigned tg = og / nx;
            if (og + 1u == (tg + 1u) * nx) xb_add(&bar[XB_TOPGEN], 1u);
            else XB_SPIN(xb_ld(&bar[XB_TOPGEN]) == tg, bar);
            __builtin_amdgcn_fence(__ATOMIC_ACQUIRE, "agent");
            xb_add(&bar[XB_XGEN(b.x)], 1u);
            asm volatile("s_waitcnt vmcnt(0)" ::: "memory");
        } else {
            XB_SPIN(xb_ld(&bar[XB_XGEN(b.x)]) == gen, bar);
            __builtin_amdgcn_fence(__ATOMIC_ACQUIRE, "agent");
            asm volatile("s_waitcnt vmcnt(0)" ::: "memory");
        }
    }
    __syncthreads();
}

struct Frame {
    LAS unsigned char* lds;
    int tid, lane, wave, gw;
};
constexpr int PTAB_OFF = MISC_OFF + 256;
__device__ __forceinline__ unsigned long long ptab_get(LAS unsigned char* lds, int i) {
    LAS unsigned char* base = lds + PTAB_OFF; asm volatile("" : "+v"(base));
    const unsigned long long v = ((const volatile LAS unsigned long long*)base)[i];
    const unsigned lo = __builtin_amdgcn_readfirstlane((unsigned)v), hi = __builtin_amdgcn_readfirstlane((unsigned)(v >> 32));
    return ((unsigned long long)hi << 32) | lo;
}
#define P_IN(i) ((const float*)(const GAS float*)ptab_get(F.lds, (i)))
#define P_OUT ((float*)(GAS float*)ptab_get(F.lds, 14))
#define P_WS ((unsigned char*)(GAS unsigned char*)ptab_get(F.lds, 15))
__device__ __forceinline__ Frame make_frame(LAS unsigned char* lds, int wave_s) { Frame F; F.lds = lds; int bx = blockIdx.x; asm volatile("" : "+s"(bx));
    int ln = xb_lane(); asm volatile("" : "+v"(ln));
    F.lane = ln; F.wave = wave_s; F.tid = wave_s * 64 + ln; F.gw = bx * NWAVES + F.wave; return F; }
__device__ __forceinline__ float shx(float v, int o, int lane) { return __builtin_bit_cast(float, __builtin_amdgcn_ds_bpermute((lane ^ o) << 2, __builtin_bit_cast(int, v))); }
__device__ __forceinline__ unsigned shrel(unsigned v, int d, int lane) { return (unsigned)__builtin_amdgcn_ds_bpermute(((lane + d) & 63) << 2, (int)v); }
__device__ __forceinline__ float wave_sum(float v, int lane) {
#pragma unroll
    for (int o = 1; o < 64; o <<= 1) v += shx(v, o, lane);
    return v;
}
template <bool SCALE = false>
__device__ __forceinline__ void transpose_item(const float* W, int K, int N, bf16* dst, LAS float* scr, int k0, int n0, int lane, const float* gk = nullptr) {
    float tv[32];
#pragma unroll
    for (int i = 0; i < 32; ++i) { const int kk = 2 * i + (lane >> 5); tv[i] = W[(size_t)(k0 + kk) * N + n0 + (lane & 31)]; }
#pragma unroll
    for (int i = 0; i < 32; ++i) { const int kk = 2 * i + (lane >> 5); scr[kk * 33 + (lane & 31)] = tv[i]; }
    LDS_WAIT(); asm volatile("" ::: "memory");
    const int c = lane & 7;
    f32x4 ga = {1.f, 1.f, 1.f, 1.f}, gb = {1.f, 1.f, 1.f, 1.f};
    if (SCALE) { ga = *(const f32x4*)(gk + k0 + 8 * c); gb = *(const f32x4*)(gk + k0 + 8 * c + 4); }
#pragma unroll
    for (int j = 0; j < 4; ++j) { const int n = (lane >> 3) + 8 * j; const LAS float* s = scr + (8 * c) * 33 + n;
        v4u o; o.x = pk2bf(s[0 * 33] * ga.x, s[1 * 33] * ga.y); o.y = pk2bf(s[2 * 33] * ga.z, s[3 * 33] * ga.w); o.z = pk2bf(s[4 * 33] * gb.x, s[5 * 33] * gb.y); o.w = pk2bf(s[6 * 33] * gb.z, s[7 * 33] * gb.w);
        *(GAS v4u*)(dst + (size_t)n * K + k0 + 8 * c) = o; }
    LDS_WAIT(); asm volatile("" ::: "memory");
}
__device__ __forceinline__ float f8clamp(float x) { return fminf(fmaxf(x, -440.f), 440.f); }
__device__ __forceinline__ unsigned pk4f8(float a, float b, float c, float d) {
    int w = __builtin_amdgcn_cvt_pk_fp8_f32(f8clamp(a), f8clamp(b), 0, false); w = __builtin_amdgcn_cvt_pk_fp8_f32(f8clamp(c), f8clamp(d), w, true); return (unsigned)w; }
template <bool SCALE = false>
__device__ __forceinline__ void transpose_item8(const float* W, int K, int N, unsigned char* dst8, LAS float* scr, int k0, int n0, int lane, float mul, const float* gk = nullptr) {
    float tv[32];
#pragma unroll
    for (int i = 0; i < 32; ++i) { const int kk = 2 * i + (lane >> 5); tv[i] = W[(size_t)(k0 + kk) * N + n0 + (lane & 31)]; }
#pragma unroll
    for (int i = 0; i < 32; ++i) { const int kk = 2 * i + (lane >> 5); scr[kk * 33 + (lane & 31)] = tv[i]; }
    LDS_WAIT(); asm volatile("" ::: "memory");
    const int c = lane & 7;
    f32x4 ga = {mul, mul, mul, mul}, gb = {mul, mul, mul, mul};
    if (SCALE) { ga = *(const f32x4*)(gk + k0 + 8 * c) * mul; gb = *(const f32x4*)(gk + k0 + 8 * c + 4) * mul; }
#pragma unroll
    for (int j = 0; j < 4; ++j) { const int n = (lane >> 3) + 8 * j; const LAS float* s = scr + (8 * c) * 33 + n;
        v2u o; o.x = pk4f8(s[0 * 33] * ga.x, s[1 * 33] * ga.y, s[2 * 33] * ga.z, s[3 * 33] * ga.w); o.y = pk4f8(s[4 * 33] * gb.x, s[5 * 33] * gb.y, s[6 * 33] * gb.z, s[7 * 33] * gb.w);
        *(GAS v2u*)(dst8 + (size_t)n * K + k0 + 8 * c) = o; }
    LDS_WAIT(); asm volatile("" ::: "memory");
}
__device__ __forceinline__ void convert_weights(Frame& F, int l) {
    LAS float* scr = (LAS float*)(F.lds + F.wave * 8448);
    const int NGW = 256 * NWAVES;
    unsigned char* ws = P_WS;
    bf16* WinT = (bf16*)(ws + WS_WIN); bf16* WaT = (bf16*)(ws + WS_WA); bf16* WbT = (bf16*)(ws + WS_WB); bf16* WoT = (bf16*)(ws + WS_WO);
    bf16* WguT = (bf16*)(ws + WS_WGU); bf16* WdT = (bf16*)(ws + WS_WD);
    const float* w_in = P_IN(2) + (size_t)l * DM * INC; const float* w_a = P_IN(3) + (size_t)l * 256 * DM; const float* w_b = P_IN(4) + (size_t)l * DM * DM;
    const float* w_o = P_IN(7) + (size_t)l * DM * DM; const float* g2 = P_IN(8) + (size_t)l * DM; const float* g1n = P_IN(1) + (size_t)l * DM;
    const float* w_g = P_IN(10) + (size_t)l * NE * DM * DEX; const float* w_u = P_IN(11) + (size_t)l * NE * DM * DEX; const float* w_d = P_IN(12) + (size_t)l * NE * DEX * DM;
    constexpr int I_IN = 16 * (INC / 32), I_A = 4 * 32, I_B = 16 * 32, I_O = 16 * 32, I_E = NE * 16 * 32;
    constexpr int NITEMS = I_IN + I_A + I_B + I_O + 3 * I_E;
    for (int it = F.gw; it < NITEMS; it += NGW) {
        int r = it;
        if (r < I_IN) { const int nb = r % (INC / 32), kb = r / (INC / 32), n0 = 32 * nb; int drow = n0;
            if (n0 >= 3840) { const int gc = n0 - 3840, br = gc >> 10, cc = gc & 1023; drow = 3840 + (cc >> 7) * 256 + ((cc & 127) >> 5) * 64 + br * 32; }
            if (n0 >= 3840) transpose_item8<true>(w_in, DM, INC, (unsigned char*)(WinT + (size_t)3840 * DM) + (size_t)(drow - 3840) * DM, scr, 64 * kb, n0, F.lane, 64.0f, g1n);
            else transpose_item<true>(w_in, DM, INC, WinT + (size_t)drow * DM, scr, 64 * kb, n0, F.lane, g1n);
            continue; } r -= I_IN;
        if (r < I_A) { const int nb = r % 32, kb = r / 32; transpose_item(w_a, 256, DM, WaT + (size_t)(32 * nb) * 256, scr, 64 * kb, 32 * nb, F.lane); continue; } r -= I_A;
        if (r < I_B) { const int nb = r % 32, kb = r / 32; transpose_item(w_b, DM, DM, WbT + (size_t)(32 * nb) * DM, scr, 64 * kb, 32 * nb, F.lane); continue; } r -= I_B;
        if (r < I_O) { const int nb = r % 32, kb = r / 32; transpose_item8(w_o, DM, DM, (unsigned char*)WoT + (size_t)(32 * nb) * DM, scr, 64 * kb, 32 * nb, F.lane, 64.0f); continue; } r -= I_O;
        if (r < 2 * I_E) { const int up = r >= I_E; if (up) r -= I_E; const int e = r / 512, loc = r % 512, nb = loc % 32, kb = loc / 32, f0 = 32 * nb;
            const float* W = (up ? w_u : w_g) + (size_t)e * DM * DEX;
            transpose_item8<true>(W, DM, DEX, (unsigned char*)WguT + ((size_t)e * 2048 + (f0 >> 7) * 256 + (up ? 128 : 0) + (f0 & 127)) * DM, scr, 64 * kb, f0, F.lane, 64.0f, g2); continue; } r -= 2 * I_E;
        { const int e = r / 512, loc = r % 512, nb = loc % 32, kb = loc / 32;
            transpose_item8(w_d + (size_t)e * DEX * DM, DEX, DM, (unsigned char*)WdT + ((size_t)e * 1024 + 32 * nb) * DEX, scr, 64 * kb, 32 * nb, F.lane, 64.0f); }
    }
}
__device__ __forceinline__ void unpk8(const v4u w, float (&v)[8]) { v[0] = bflo(w.x); v[1] = bfhi(w.x); v[2] = bflo(w.y); v[3] = bfhi(w.y); v[4] = bflo(w.z); v[5] = bfhi(w.z); v[6] = bflo(w.w); v[7] = bfhi(w.w); }
__device__ __forceinline__ v4u pk8(const float (&v)[8]) { v4u w; w.x = pk2bf(v[0], v[1]); w.y = pk2bf(v[2], v[3]); w.z = pk2bf(v[4], v[5]); w.w = pk2bf(v[6], v[7]); return w; }
template <bool XIN, bool COMBINE, bool FINAL>
__device__ __forceinline__ void norm_rows(Frame& F, const float* xin, bf16* hb, const float* gain, float* rsv, float* out, unsigned char* hn8 = nullptr) {
    const int NGW = 256 * NWAVES;
    unsigned char* ws = P_WS;
    const int* sel = (const int*)(ws + WS_SEL); const bf16* Y = (const bf16*)(ws + WS_BIG + B_Y);
    float gv[2][8];
#pragma unroll
    for (int j = 0; j < 2; ++j) { const f32x4 a = *(const f32x4*)(gain + (64 * j + F.lane) * 8), b = *(const f32x4*)(gain + (64 * j + F.lane) * 8 + 4);
        gv[j][0] = a.x; gv[j][1] = a.y; gv[j][2] = a.z; gv[j][3] = a.w; gv[j][4] = b.x; gv[j][5] = b.y; gv[j][6] = b.z; gv[j][7] = b.w; }
    constexpr int NR = 4;
    for (int m0 = F.gw; m0 < MTOK; m0 += NR * NGW) {
        float v[NR][2][8]; int sv[NR];
#pragma unroll
        for (int rr = 0; rr < NR; ++rr) { const int m = m0 + rr * NGW;
            if (COMBINE) sv[rr] = sel[(size_t)m * NE + (F.lane & 15)];
            if (XIN) {
#pragma unroll
                for (int j = 0; j < 2; ++j) { const f32x4 a = *(const f32x4*)(xin + (size_t)m * DM + (64 * j + F.lane) * 8), b = *(const f32x4*)(xin + (size_t)m * DM + (64 * j + F.lane) * 8 + 4);
                    v[rr][j][0] = a.x; v[rr][j][1] = a.y; v[rr][j][2] = a.z; v[rr][j][3] = a.w; v[rr][j][4] = b.x; v[rr][j][5] = b.y; v[rr][j][6] = b.z; v[rr][j][7] = b.w; }
            } else {
#pragma unroll
                for (int j = 0; j < 2; ++j) unpk8(*(const v4u*)(hb + (size_t)m * DM + (64 * j + F.lane) * 8), v[rr][j]);
            } }
        if (COMBINE) {
            unsigned msk[NR];
#pragma unroll
            for (int rr = 0; rr < NR; ++rr) msk[rr] = (unsigned)(__builtin_amdgcn_ballot_w64(sv[rr] >= 0) & 0xffffull);
            unsigned any = 0u;
#pragma unroll
            for (int rr = 0; rr < NR; ++rr) any |= msk[rr];
            while (any != 0u) {
                v4u yv[NR][2]; float wgt[NR];
#pragma unroll
                for (int rr = 0; rr < NR; ++rr) { const int m = m0 + rr * NGW, b = m >> 11; const bool has = msk[rr] != 0u;
                    const int e = has ? __builtin_ctz(msk[rr]) : 0; const int r = has ? __builtin_amdgcn_readlane(sv[rr], e) : 0;
                    const bf16* yr = Y + ((size_t)(e * NB + b) * CAP + r) * DM; wgt[rr] = has ? 1.0f : 0.0f; msk[rr] &= msk[rr] - 1u;
#pragma unroll
                    for (int j = 0; j < 2; ++j) yv[rr][j] = *(const v4u*)(yr + (64 * j + F.lane) * 8); }
                any = 0u;
#pragma unroll
                for (int rr = 0; rr < NR; ++rr) { any |= msk[rr];
#pragma unroll
                    for (int j = 0; j < 2; ++j) { float y[8]; unpk8(yv[rr][j], y);
#pragma unroll
                        for (int i = 0; i < 8; ++i) v[rr][j][i] += wgt[rr] * y[i]; } }
            }
        }
#pragma unroll
        for (int rr = 0; rr < NR; ++rr) { const int m = m0 + rr * NGW;
            if ((XIN || COMBINE) && !FINAL) {
#pragma unroll
                for (int j = 0; j < 2; ++j) *(v4u*)(hb + (size_t)m * DM + (64 * j + F.lane) * 8) = pk8(v[rr][j]);
            }
            float ss = 0.f;
#pragma unroll
            for (int j = 0; j < 2; ++j)
#pragma unroll
                for (int i = 0; i < 8; ++i) ss += v[rr][j][i] * v[rr][j][i];
            const float rs = 1.0f / sqrtf(wave_sum(ss, F.lane) * (1.0f / DM) + RMS_EPS);
            if (FINAL) {
#pragma unroll
                for (int j = 0; j < 2; ++j) { float o[8];
#pragma unroll
                    for (int i = 0; i < 8; ++i) o[i] = v[rr][j][i] * rs * gv[j][i];
                    float* op = out + (size_t)m * DM + (64 * j + F.lane) * 8; *(f32x4*)op = (f32x4){o[0], o[1], o[2], o[3]}; *(f32x4*)(op + 4) = (f32x4){o[4], o[5], o[6], o[7]}; }
            } else { if (F.lane == 0) rsv[m] = rs;
                const float rs16 = rs * 16.0f;
#pragma unroll
                for (int j = 0; j < 2; ++j) { v2u o; o.x = pk4f8(v[rr][j][0] * rs16, v[rr][j][1] * rs16, v[rr][j][2] * rs16, v[rr][j][3] * rs16); o.y = pk4f8(v[rr][j][4] * rs16, v[rr][j][5] * rs16, v[rr][j][6] * rs16, v[rr][j][7] * rs16);
                    *(v2u*)(hn8 + (size_t)m * DM + (64 * j + F.lane) * 8) = o; } } }
    }
}
constexpr int RT_PITCH = 2048 + 16;
__device__ __forceinline__ void norm_router(Frame& F, const bf16* hb, const float* gain, const float* wr, float* rsv, float* aff, unsigned char* hn8) {
    LAS unsigned char* whi = F.lds; LAS unsigned char* wlo = F.lds + 16 * RT_PITCH; LAS float* gl = (LAS float*)(F.lds + 32 * RT_PITCH);
    { const float g0 = gain[F.tid], g1 = gain[F.tid + NWAVES * 64]; gl[F.tid] = g0; gl[F.tid + NWAVES * 64] = g1; }
    __syncthreads();
    { f32x4 wv[8];
#pragma unroll
      for (int j = 0; j < 8; ++j) wv[j] = *(const f32x4*)(wr + 4 * (F.tid + j * NWAVES * 64));
      asm volatile("" ::: "memory");
#pragma unroll
      for (int j = 0; j < 8; ++j) { const int i0 = 4 * (F.tid + j * NWAVES * 64), k = i0 >> 4, e0 = i0 & 15; const float g = gl[k];
#pragma unroll
          for (int t = 0; t < 4; ++t) { const float w = wv[j][t] * g; const unsigned hi = pk2bf(w, 0.f) & 0xffffu; const float rem = w - bflo(hi);
              *(LAS unsigned short*)(whi + (e0 + t) * RT_PITCH + k * 2) = (unsigned short)hi; *(LAS unsigned short*)(wlo + (e0 + t) * RT_PITCH + k * 2) = (unsigned short)(pk2bf(rem, 0.f) & 0xffffu); } } }
    __syncthreads();
    const int NGW = 256 * NWAVES, r16 = F.lane & 15, q = F.lane >> 4;
    for (int grp = F.gw; grp < MTOK / 16; grp += NGW) {
        const size_t row = (size_t)grp * 16 + r16;
        v4u xs[32];
#pragma unroll
        for (int s = 0; s < 16; ++s) { const v4u* p = (const v4u*)(hb + row * DM + 64 * s + 16 * q); xs[2 * s] = p[0]; xs[2 * s + 1] = p[1]; }
        f32x4 acc = {0.f, 0.f, 0.f, 0.f}; float ss = 0.f;
#pragma unroll
        for (int s = 0; s < 16; ++s) {
#pragma unroll
            for (int h2 = 0; h2 < 2; ++h2) { const bf16x8 a = __builtin_bit_cast(bf16x8, xs[2 * s + h2]);
                const bf16x8 bh = *(const LAS bf16x8*)(whi + r16 * RT_PITCH + (64 * s + 16 * q + 8 * h2) * 2), bl = *(const LAS bf16x8*)(wlo + r16 * RT_PITCH + (64 * s + 16 * q + 8 * h2) * 2);
                acc = __builtin_amdgcn_mfma_f32_16x16x32_bf16(a, bh, acc, 0, 0, 0); acc = __builtin_amdgcn_mfma_f32_16x16x32_bf16(a, bl, acc, 0, 0, 0);
                float x[8]; unpk8(xs[2 * s + h2], x);
#pragma unroll
                for (int i = 0; i < 8; ++i) ss += x[i] * x[i]; }
            asm volatile("" ::: "memory"); }
        ss += shx(ss, 16, F.lane); ss += shx(ss, 32, F.lane);
        const float rs = 1.0f / sqrtf(ss * (1.0f / DM) + RMS_EPS);
        float lg[4];
#pragma unroll
        for (int r = 0; r < 4; ++r) { const float rr = __builtin_bit_cast(float, __builtin_amdgcn_ds_bpermute((4 * q + r) << 2, __builtin_bit_cast(int, rs))); lg[r] = acc[r] * rr; }
#pragma unroll
        for (int r = 0; r < 4; ++r) { float mx = lg[r];
#pragma unroll
            for (int o = 1; o < 16; o <<= 1) mx = fmaxf(mx, shx(mx, o, F.lane));
            const float ex = __expf(lg[r] - mx); float sm = ex;
#pragma unroll
            for (int o = 1; o < 16; o <<= 1) sm += shx(sm, o, F.lane);
            aff[((size_t)grp * 16 + 4 * q + r) * NE + r16] = ex / sm; }
        if (q == 0) rsv[row] = rs;
        { const float rs16 = rs * 16.0f;
#pragma unroll
          for (int s = 0; s < 16; ++s) { v4u o;
#pragma unroll
              for (int h2 = 0; h2 < 2; ++h2) { v4u t = xs[2 * s + h2]; asm volatile("" : "+v"(t));
                  float x[8]; unpk8(t, x);
                  o[2 * h2] = pk4f8(x[0] * rs16, x[1] * rs16, x[2] * rs16, x[3] * rs16); o[2 * h2 + 1] = pk4f8(x[4] * rs16, x[5] * rs16, x[6] * rs16, x[7] * rs16); }
              *(v4u*)(hn8 + row * DM + 64 * s + 16 * q) = o;
              asm volatile("" ::: "memory"); } }
    }
}
__device__ __forceinline__ void topk_gather(Frame& F, const float* aff, const float* rsv, int* sel, float* gatev, int* idxg) {
    LAS unsigned* hist = (LAS unsigned*)F.lds;
    volatile LAS unsigned* st = (volatile LAS unsigned*)(F.lds + 1024);
    for (int u = blockIdx.x; u < NB * NE; u += 256) {
        const int b = u >> 4, e = u & 15;
        unsigned bits[4];
#pragma unroll
        for (int q = 0; q < 4; ++q) bits[q] = __float_as_uint(aff[((size_t)b * SEQ + 4 * F.tid + q) * NE + e]);
        const f32x4 rs4 = *(const f32x4*)(rsv + (size_t)b * SEQ + 4 * F.tid);
        unsigned prefix = 0u, kk = CAP;
#pragma unroll 1
        for (int pass = 0; pass < 4; ++pass) {
            const int shift = 24 - 8 * pass;
            if (F.tid < 256) hist[F.tid] = 0u;
            __syncthreads();
#pragma unroll
            for (int q = 0; q < 4; ++q) { const bool in = (pass == 0) || ((bits[q] >> (shift + 8)) == prefix); if (in) atomicAdd((unsigned*)&hist[(bits[q] >> shift) & 255u], 1u); }
            __syncthreads();
            if (F.wave == 0) {
                const unsigned c0 = hist[4 * F.lane], c1 = hist[4 * F.lane + 1], c2 = hist[4 * F.lane + 2], c3 = hist[4 * F.lane + 3];
                unsigned incl = c0 + c1 + c2 + c3;
#pragma unroll
                for (int o = 1; o < 64; o <<= 1) { const unsigned v = shrel(incl, o, F.lane); if (F.lane + o < 64) incl += v; }
                unsigned cum = incl - (c0 + c1 + c2 + c3);
                int found = -1; unsigned above = 0u;
                if (cum < kk && cum + c3 >= kk) { found = 3; above = cum; } cum += c3;
                if (cum < kk && cum + c2 >= kk) { found = 2; above = cum; } cum += c2;
                if (cum < kk && cum + c1 >= kk) { found = 1; above = cum; } cum += c1;
                if (cum < kk && cum + c0 >= kk) { found = 0; above = cum; }
                if (found >= 0) { st[0] = (prefix << 8) | (unsigned)(4 * F.lane + found); st[1] = kk - above; }
            }
            __syncthreads();
            prefix = st[0]; kk = st[1];
        }
        const unsigned T = prefix;
        unsigned ngt = 0u, neq = 0u;
#pragma unroll
        for (int q = 0; q < 4; ++q) { ngt += bits[q] > T ? 1u : 0u; neq += bits[q] == T ? 1u : 0u; }
        unsigned pk = ngt | (neq << 16), inc = pk;
#pragma unroll
        for (int o = 1; o < 64; o <<= 1) { const unsigned v = shrel(inc, -o, F.lane); if (F.lane >= o) inc += v; }
        if (F.lane == 63) st[8 + F.wave] = inc;
        __syncthreads();
        unsigned base = 0u;
#pragma unroll
        for (int w = 0; w < NWAVES; ++w) base += (w < F.wave) ? st[8 + w] : 0u;
        const unsigned excl = base + inc - pk;
        unsigned pgt = excl & 0xffffu, peq = excl >> 16;
#pragma unroll
        for (int q = 0; q < 4; ++q) { const int i = 4 * F.tid + q; const bool g = bits[q] > T, eq = bits[q] == T; const bool keep = g || (eq && peq < kk);
            const unsigned slot = pgt + (peq < kk ? peq : kk);
            if (keep) { idxg[(size_t)(e * NB + b) * CAP + slot] = (int)((unsigned)(b * SEQ + i) | ((unsigned)__builtin_bit_cast(unsigned short, (_Float16)rs4[q]) << 16)); gatev[(size_t)(e * NB + b) * CAP + slot] = __uint_as_float(bits[q]); }
            sel[((size_t)b * SEQ + i) * NE + e] = keep ? (int)slot : -1;
            pgt += g ? 1u : 0u; peq += eq ? 1u : 0u; }
        __syncthreads();
    }
}


constexpr int ATT_KPITCH = 144, ATT_VT_OFF = 512 * ATT_KPITCH, ATT_VPITCH = 1040, ATT_SINK_OFF = MISC_OFF + 1024;
static_assert(ATT_VT_OFF + 64 * ATT_VPITCH <= MISC_OFF, "attention LDS");
#ifndef ATT_JT_UNROLL
#define ATT_JT_UNROLL 1
#endif
struct ChunkP { const bf16* K; const bf16* V; int ldkv, tok0, cstep, r, L, nseg, qs, i0; };
template <int W>
__device__ __forceinline__ void attn_issue(const ChunkP& p, int tid, v4u (&kreg)[8], v4u (&vreg)[2][4]) {
    asm volatile("" : "+v"(tid));
    const int KS = p.qs + 2 * W, nrows = p.nseg * KS, Lm1 = p.L - 1;
    constexpr int NKP = 8;
#pragma unroll
    for (int it = 0; it < NKP; ++it) { const int pc = tid + it * NWAVES * 64, row0 = pc >> 3, ch = pc & 7, row = row0 < nrows ? row0 : nrows - 1, s = row >= KS ? 1 : 0, rho = row - s * KS;
        int j = p.i0 - W + rho; j = j < 0 ? 0 : j; j = j > Lm1 ? Lm1 : j;
        kreg[it] = *(const v4u*)(p.K + (size_t)(p.tok0 + s * p.cstep + p.r * j) * p.ldkv + ch * 8); }
#pragma unroll
    for (int it = 0; it < 2; ++it) { const int t = tid + it * NWAVES * 64, r4 = t >> 3, ch = t & 7, rowa = 4 * r4, row0 = rowa < nrows ? rowa : nrows - 4, s = row0 >= KS ? 1 : 0, rho = row0 - s * KS, j0 = p.i0 - W + rho;
#pragma unroll
        for (int q = 0; q < 4; ++q) { int j = j0 + q; j = j < 0 ? 0 : j; j = j > Lm1 ? Lm1 : j;
            vreg[it][q] = *(const v4u*)(p.V + (size_t)(p.tok0 + s * p.cstep + p.r * j) * p.ldkv + ch * 8); } }
}
__device__ __forceinline__ void attn_loadq(const Frame& F, const ChunkP& p, const bf16* Q, int ldq, bf16x8 (&qf)[4]) {
    int lane_ = F.lane; asm volatile("" : "+v"(lane_));
    const int wq = F.wave * 32, sidx = (wq >= p.qs) ? 1 : 0, qo = wq - sidx * p.qs, ql = lane_ & 31, hh = lane_ >> 5, qi = p.i0 + qo + ql;
    const bf16* q0 = Q + (size_t)(p.tok0 + sidx * p.cstep + p.r * qi) * ldq;
#pragma unroll
    for (int ks = 0; ks < 4; ++ks) qf[ks] = *(const bf16x8*)(q0 + 16 * ks + 8 * hh);
}
template <int W>
__device__ __forceinline__ void attn_commit(Frame& F, const ChunkP& p, const v4u (&kreg)[8], const v4u (&vreg)[2][4]) {
    int tid = F.tid; asm volatile("" : "+v"(tid));
    const int KS = p.qs + 2 * W, nrows = p.nseg * KS;
    LAS unsigned char* ldsK = F.lds; LAS unsigned char* ldsV = F.lds + ATT_VT_OFF;
    constexpr int NKP = 8;
#pragma unroll
    for (int it = 0; it < NKP; ++it) { const int pc = tid + it * NWAVES * 64, row = pc >> 3, ch = pc & 7;
        if (pc < nrows * 8) *(LAS v4u*)(ldsK + row * ATT_KPITCH + ch * 16) = kreg[it]; }
#pragma unroll
    for (int it = 0; it < 2; ++it) { const int t = tid + it * NWAVES * 64, r4 = t >> 3, ch = t & 7, row0 = 4 * r4;
        if (t < nrows * 2) {
            const int kap = row0 & 31, slot = (kap >> 4) * 16 + ((kap >> 2) & 1) * 8 + ((kap >> 3) & 1) * 4, pos = (row0 & ~31) + slot;
#pragma unroll
            for (int w = 0; w < 4; ++w) {
                v2u lo, hi;
                lo.x = (vreg[it][0][w] & 0xffffu) | (vreg[it][1][w] << 16); lo.y = (vreg[it][2][w] & 0xffffu) | (vreg[it][3][w] << 16);
                hi.x = (vreg[it][0][w] >> 16) | (vreg[it][1][w] & 0xffff0000u); hi.y = (vreg[it][2][w] >> 16) | (vreg[it][3][w] & 0xffff0000u);
                *(LAS v2u*)(ldsV + (ch * 8 + 2 * w) * ATT_VPITCH + pos * 2) = lo;
                *(LAS v2u*)(ldsV + (ch * 8 + 2 * w + 1) * ATT_VPITCH + pos * 2) = hi;
            } } }
}
#ifndef ATT_THR
#define ATT_THR 8.0f
#endif
template <int W, int NH, bool SINK, bool WRITE_LSE>
__device__ __forceinline__ void attn_compute(Frame& F, const ChunkP& p, bf16* Q, int ldq, long odelta, float* lse, float slope1, const float* sinkp, int hbase, bf16x8 (&qf)[4]) {
    constexpr int NJT = 2 * W / 32 + 1, JC = W / 32;
    const int KS = p.qs + 2 * W, L = p.L, i0 = p.i0;
    LAS unsigned char* ldsK = F.lds; LAS unsigned char* ldsV = F.lds + ATT_VT_OFF;
    const int wq = F.wave * 32, sidx = (wq >= p.qs) ? 1 : 0, qo = wq - sidx * p.qs, segbase = sidx * KS;
    int lane_ = F.lane; asm volatile("" : "+v"(lane_));
    const int ql = lane_ & 31, hh = lane_ >> 5;
    const int qi = i0 + qo + ql;
    const size_t qtok = (size_t)(p.tok0 + sidx * p.cstep + p.r * qi);
    const float flo = (float)((-qi > -W) ? -qi : -W), fhi = (float)((L - 1 - qi < W) ? (L - 1 - qi) : W);
#pragma unroll 1
    for (int g = 0; g < NH; ++g) {
        bf16* qptr = Q + qtok * ldq + g * 64;
        f32x16 O0, O1;
        float m, l;
#ifdef PRB_REP
        constexpr int nrep = (NH == PRB_NH) ? PRB_REP : 1;
#pragma unroll 1
        for (int rep = 0; rep < nrep; ++rep) {
        asm volatile("" ::: "memory");
#endif
#pragma unroll
        for (int i = 0; i < 16; ++i) { O0[i] = 0.f; O1[i] = 0.f; }
        const float sl = (NH == 1) ? slope1 : __builtin_amdgcn_exp2f(-0.5f * (float)(hbase + g + 1)) * LOG2E;
        const float sk2 = SINK ? *(const LAS float*)(F.lds + ATT_SINK_OFF + 4 * (hbase + g)) : 0.f;
        {
            const int jbase = i0 + qo - W + 32 * JC, krow = segbase + qo + 32 * JC;
            const bool need_mask = (jbase < 0) || (jbase + 31 >= L);
            f32x16 S;
#pragma unroll
            for (int i = 0; i < 16; ++i) S[i] = 0.f;
#pragma unroll
            for (int ks = 0; ks < 4; ++ks) { const bf16x8 kf = *(const LAS bf16x8*)(ldsK + (krow + ql) * ATT_KPITCH + (16 * ks + 8 * hh) * 2); S = __builtin_amdgcn_mfma_f32_32x32x16_bf16(kf, qf[ks], S, 0, 0, 0); }
            const float fd0 = (float)(jbase + 4 * hh - qi);
#pragma unroll
            for (int i = 0; i < 16; ++i) { const float fd = fd0 + (float)((i & 3) + 8 * (i >> 2)); S[i] = S[i] - sl * fabsf(fd); }
            if (need_mask) {
#pragma unroll
                for (int i = 0; i < 16; ++i) { const float fd = fd0 + (float)((i & 3) + 8 * (i >> 2)); S[i] = (fd >= flo && fd <= fhi) ? S[i] : -INFINITY; } }
            float mloc = S[0];
#pragma unroll
            for (int i = 1; i < 16; ++i) mloc = fmaxf(mloc, S[i]);
            m = fmaxf(mloc, shx(mloc, 32, lane_));
            float ps = 0.f;
#pragma unroll
            for (int i = 0; i < 16; ++i) { const float pv = __builtin_amdgcn_exp2f(S[i] - m); S[i] = pv; ps += pv; }
            l = ps;
#pragma unroll
            for (int s2 = 0; s2 < 2; ++s2) {
                f32x8_t pp;
#pragma unroll
                for (int i = 0; i < 8; ++i) pp[i] = S[8 * s2 + i];
                const bf16x8 pf = __builtin_bit_cast(bf16x8, __builtin_convertvector(pp, nbf16x8));
                const bf16x8 v0 = *(const LAS bf16x8*)(ldsV + ql * ATT_VPITCH + (krow + 16 * s2 + 8 * hh) * 2);
                const bf16x8 v1 = *(const LAS bf16x8*)(ldsV + (ql + 32) * ATT_VPITCH + (krow + 16 * s2 + 8 * hh) * 2);
                O0 = __builtin_amdgcn_mfma_f32_32x32x16_bf16(v0, pf, O0, 0, 0, 0);
                O1 = __builtin_amdgcn_mfma_f32_32x32x16_bf16(v1, pf, O1, 0, 0, 0);
            }
        }
#pragma unroll 1
        for (int jt = 0; jt < NJT; ++jt) {
            if (jt == JC) continue;
            const int jbase = i0 + qo - W + 32 * jt;
            if (jbase + 31 < 0 || jbase >= L) continue;
            const bool need_mask = (jt == 0) || (jt == NJT - 1) || (jbase < 0) || (jbase + 31 >= L);
            const int krow = segbase + qo + 32 * jt;
            const float fd0 = (float)(jbase + 4 * hh - qi);
            bf16x8 kf[4];
#pragma unroll
            for (int ks = 0; ks < 4; ++ks) kf[ks] = *(const LAS bf16x8*)(ldsK + (krow + ql) * ATT_KPITCH + (16 * ks + 8 * hh) * 2);
            const bf16x8 vf00 = *(const LAS bf16x8*)(ldsV + ql * ATT_VPITCH + (krow + 8 * hh) * 2), vf10 = *(const LAS bf16x8*)(ldsV + (ql + 32) * ATT_VPITCH + (krow + 8 * hh) * 2);
            f32x16 S;
            if (jt < JC) { const float k1 = sl * fd0 - m;
#pragma unroll
                for (int i = 0; i < 16; ++i) S[i] = fmaf(sl, (float)((i & 3) + 8 * (i >> 2)), k1); }
            else { const float k1 = -sl * fd0 - m;
#pragma unroll
                for (int i = 0; i < 16; ++i) S[i] = fmaf(-sl, (float)((i & 3) + 8 * (i >> 2)), k1); }
            if (need_mask) {
#pragma unroll
                for (int i = 0; i < 16; ++i) { const float fd = fd0 + (float)((i & 3) + 8 * (i >> 2)); S[i] = (fd >= flo && fd <= fhi) ? S[i] : -INFINITY; } }
#pragma unroll
            for (int ks = 0; ks < 4; ++ks) S = __builtin_amdgcn_mfma_f32_32x32x16_bf16(kf[ks], qf[ks], S, 0, 0, 0);
            const bf16x8 vf01 = *(const LAS bf16x8*)(ldsV + ql * ATT_VPITCH + (krow + 16 + 8 * hh) * 2), vf11 = *(const LAS bf16x8*)(ldsV + (ql + 32) * ATT_VPITCH + (krow + 16 + 8 * hh) * 2);
            float tmax = S[0];
#pragma unroll
            for (int i = 1; i < 16; ++i) tmax = fmaxf(tmax, S[i]);
            if (__builtin_amdgcn_ballot_w64(tmax > ATT_THR) != 0ull) {
                float d = fmaxf(tmax, 0.f); d = fmaxf(d, shx(d, 32, lane_));
                const float sc = __builtin_amdgcn_exp2f(-d);
#pragma unroll
                for (int i = 0; i < 16; ++i) { S[i] -= d; O0[i] *= sc; O1[i] *= sc; }
                l *= sc; m += d;
            }
            float ps = 0.f;
#pragma unroll
            for (int i = 0; i < 16; ++i) { const float pv = __builtin_amdgcn_exp2f(S[i]); S[i] = pv; ps += pv; }
            l += ps;
            { f32x8_t pp;
#pragma unroll
              for (int i = 0; i < 8; ++i) pp[i] = S[i];
              const bf16x8 pf = __builtin_bit_cast(bf16x8, __builtin_convertvector(pp, nbf16x8));
              O0 = __builtin_amdgcn_mfma_f32_32x32x16_bf16(vf00, pf, O0, 0, 0, 0); O1 = __builtin_amdgcn_mfma_f32_32x32x16_bf16(vf10, pf, O1, 0, 0, 0); }
            { f32x8_t pp;
#pragma unroll
              for (int i = 0; i < 8; ++i) pp[i] = S[8 + i];
              const bf16x8 pf = __builtin_bit_cast(bf16x8, __builtin_convertvector(pp, nbf16x8));
              O0 = __builtin_amdgcn_mfma_f32_32x32x16_bf16(vf01, pf, O0, 0, 0, 0); O1 = __builtin_amdgcn_mfma_f32_32x32x16_bf16(vf11, pf, O1, 0, 0, 0); }
        }
#ifdef PRB_REP
        }
        const float sk2 = SINK ? *(const LAS float*)(F.lds + ATT_SINK_OFF + 4 * (hbase + g)) : 0.f;
#endif
        float lt = l + shx(l, 32, lane_);
        float osc = 1.0f;
        if (SINK) { const float mf = fmaxf(m, sk2); osc = __builtin_amdgcn_exp2f(m - mf); lt = lt * osc + __builtin_amdgcn_exp2f(sk2 - mf); }
        if (WRITE_LSE) { if (hh == 0) lse[qtok * 4] = m + __builtin_amdgcn_logf(lt); }
        const float inv = osc / lt;
        if (NH > 1 && g + 1 < NH) {
#pragma unroll
            for (int ks = 0; ks < 4; ++ks) qf[ks] = *(const bf16x8*)(qptr + 64 + 16 * ks + 8 * hh); }
        v2u WW[8];
#pragma unroll
        for (int g4 = 0; g4 < 4; ++g4) {
            WW[g4].x = pk2bf(O0[4 * g4] * inv, O0[4 * g4 + 1] * inv); WW[g4].y = pk2bf(O0[4 * g4 + 2] * inv, O0[4 * g4 + 3] * inv);
            WW[4 + g4].x = pk2bf(O1[4 * g4] * inv, O1[4 * g4 + 1] * inv); WW[4 + g4].y = pk2bf(O1[4 * g4 + 2] * inv, O1[4 * g4 + 3] * inv); }
#pragma unroll
        for (int s4 = 0; s4 < 4; ++s4) {
            v2u a = WW[2 * s4], b = WW[2 * s4 + 1];
            { const auto r = __builtin_amdgcn_permlane32_swap(a.x, b.x, false, false); a.x = r[0]; b.x = r[1]; }
            { const auto r = __builtin_amdgcn_permlane32_swap(a.y, b.y, false, false); a.y = r[0]; b.y = r[1]; }
            *(v4u*)(qptr + odelta + 16 * s4 + 8 * hh) = (v4u){a.x, a.y, b.x, b.y};
#ifdef PRB_ST2
            asm volatile("" ::: "memory");
            *(v4u*)(qptr + odelta + 16 * s4 + 8 * hh) = (v4u){a.x, a.y, b.x, b.y};
            asm volatile("" ::: "memory");
#endif
        }
    }
}
__device__ __forceinline__ ChunkP dil_chunk(const bf16* KA, const bf16* VA, int b, int hs, int sc) {
    const int grp = sc >> 3, ix = sc & 7, col = grp * 256 + hs * 64; ChunkP p; p.K = KA + col; p.V = VA + col; p.ldkv = 768;
    if (grp == 0) { p.tok0 = b * SEQ; p.cstep = 0; p.r = 1; p.L = 2048; p.nseg = 1; p.qs = 256; p.i0 = 256 * ix; }
    else if (grp == 1) { p.tok0 = b * SEQ + (ix >> 1); p.cstep = 0; p.r = 4; p.L = 512; p.nseg = 1; p.qs = 256; p.i0 = 256 * (ix & 1); }
    else { p.tok0 = b * SEQ + 2 * ix; p.cstep = 1; p.r = 16; p.L = 128; p.nseg = 2; p.qs = 128; p.i0 = 0; }
    return p;
}
__device__ __forceinline__ ChunkP win_chunk(const bf16* KW, const bf16* VW, int wc) {
    const int b = wc >> 5, kvh = (wc >> 3) & 3, ch = wc & 7; ChunkP p; p.K = KW + kvh * 64; p.V = VW + kvh * 64; p.ldkv = 256;
    p.tok0 = b * SEQ; p.cstep = 0; p.r = 1; p.L = SEQ; p.nseg = 1; p.qs = 256; p.i0 = 256 * ch; return p;
}
__device__ __forceinline__ void attention_phase(Frame& F, int l, long odA, long odW, int which = 3) {
    unsigned char* ws = P_WS;
    bf16* big = (bf16*)(ws + WS_BIG);
    bf16* QA = big + B_QA / 2; bf16* KA = big + B_KA / 2; bf16* VA = big + B_VA / 2; bf16* QW = big + B_QW / 2; bf16* KW = big + B_KW / 2; bf16* VW = big + B_VW / 2; bf16* OA = big + B_OA / 2;
    float* LSE = (float*)(ws + WS_LSE);
    const int c = blockIdx.x;
    int w_lo, w_hi;
    v4u kreg[8], vreg[2][4];
    bf16x8 qf[4];
#ifndef ATT_N1
#define ATT_N1 0
#endif
    static_assert(ATT_N1 == 0, "the dilated workgroups take no window chunks");
    if (c < 128) { w_lo = ATT_N1 * c; w_hi = w_lo + ATT_N1; } else { w_lo = 128 * ATT_N1 + (c - 128) * (8 - ATT_N1); w_hi = w_lo + (8 - ATT_N1); }
    if (c < 128) { if (which & 1) {
        const int b = c >> 2, hs = c & 3;
        { const ChunkP p0 = dil_chunk(KA, VA, b, hs, 0); attn_issue<64>(p0, F.tid, kreg, vreg); attn_loadq(F, p0, QA + hs * 64, 768, qf); attn_commit<64>(F, p0, kreg, vreg); }
        __syncthreads();
#pragma unroll 1
        for (int sc = 0; sc < 24; ++sc) {
            const ChunkP p = dil_chunk(KA, VA, b, hs, sc); const int grp = sc >> 3;
            const int scn = sc + 1 < 24 ? sc + 1 : sc;
            const ChunkP pn = dil_chunk(KA, VA, b, hs, scn);
            bf16x8 qn[4];
            attn_issue<64>(pn, F.tid, kreg, vreg); attn_loadq(F, pn, QA + (scn >> 3) * 256 + hs * 64, 768, qn);
            const float slope1 = __builtin_amdgcn_exp2f(-8.0f * (float)(grp * 4 + hs + 1) / 12.0f) * (float)p.r * LOG2E;
            attn_compute<64, 1, false, true>(F, p, QA + grp * 256 + hs * 64, 768, odA, LSE + (size_t)grp * MTOK * 4 + hs, slope1, nullptr, 0, qf);
            __syncthreads();
            if (sc + 1 < 24) attn_commit<64>(F, pn, kreg, vreg);
            __syncthreads();
#pragma unroll
            for (int ks = 0; ks < 4; ++ks) qf[ks] = qn[ks];
        }
        VM_WAIT(); __syncthreads(); __builtin_amdgcn_fence(__ATOMIC_ACQUIRE, "agent"); VM_WAIT();
        constexpr int CB = 8;
#pragma unroll 1
        for (int t0 = F.tid; t0 < SEQ * 8; t0 += NWAVES * 64 * CB) {
            float lv[CB][3]; v4u av[CB][3];
#pragma unroll
            for (int k = 0; k < CB; ++k) { const int t = t0 + k * NWAVES * 64, tok = t >> 3, ch = t & 7; const size_t row = (size_t)b * SEQ + tok;
                lv[k][0] = LSE[row * 4 + hs]; lv[k][1] = LSE[(size_t)MTOK * 4 + row * 4 + hs]; lv[k][2] = LSE[(size_t)2 * MTOK * 4 + row * 4 + hs];
                const bf16* og = QA + odA + row * 768 + hs * 64 + ch * 8; av[k][0] = *(const v4u*)(og); av[k][1] = *(const v4u*)(og + 256); av[k][2] = *(const v4u*)(og + 512); }
            asm volatile("" ::: "memory");
#pragma unroll
            for (int k = 0; k < CB; ++k) { const int t = t0 + k * NWAVES * 64, tok = t >> 3, ch = t & 7; const size_t row = (size_t)b * SEQ + tok;
                const float mx = fmaxf(lv[k][0], fmaxf(lv[k][1], lv[k][2]));
                float w0 = __builtin_amdgcn_exp2f(lv[k][0] - mx), w1 = __builtin_amdgcn_exp2f(lv[k][1] - mx), w2 = __builtin_amdgcn_exp2f(lv[k][2] - mx);
                const float inv = 1.0f / (w0 + w1 + w2); w0 *= inv; w1 *= inv; w2 *= inv;
                v4u o;
#pragma unroll
                for (int w = 0; w < 4; ++w) o[w] = pk2bf(w0 * bflo(av[k][0][w]) + w1 * bflo(av[k][1][w]) + w2 * bflo(av[k][2][w]), w0 * bfhi(av[k][0][w]) + w1 * bfhi(av[k][1][w]) + w2 * bfhi(av[k][2][w]));
                *(v4u*)(OA + row * 256 + hs * 64 + ch * 8) = o; }
        }
    } } else if (which & 2) {
        if (F.tid < 16) *(LAS float*)(F.lds + ATT_SINK_OFF + 4 * F.tid) = P_IN(6)[l * 16 + F.tid] * LOG2E;
        const ChunkP p0 = win_chunk(KW, VW, w_lo); attn_issue<128>(p0, F.tid, kreg, vreg); attn_loadq(F, p0, QW + ((w_lo >> 3) & 3) * 256, 1024, qf); attn_commit<128>(F, p0, kreg, vreg);
        __syncthreads();
    }
#pragma unroll 1
    for (int wc = w_lo; wc < ((which & 2) ? w_hi : w_lo); ++wc) {
        const ChunkP p = win_chunk(KW, VW, wc); const int kvh = (wc >> 3) & 3;
        const int wn = wc + 1 < w_hi ? wc + 1 : wc;
        const ChunkP pn = win_chunk(KW, VW, wn);
        bf16x8 qn[4];
        attn_issue<128>(pn, F.tid, kreg, vreg); attn_loadq(F, pn, QW + ((wn >> 3) & 3) * 256, 1024, qn);
        attn_compute<128, 4, true, false>(F, p, QW + kvh * 256, 1024, odW, nullptr, 0.f, nullptr, kvh * 4, qf);
        __syncthreads();
        if (wc + 1 < w_hi) attn_commit<128>(F, pn, kreg, vreg);
        __syncthreads();
#pragma unroll
        for (int ks = 0; ks < 4; ++ks) qf[ks] = qn[ks];
    }
}
#ifndef PH_A
#define PH_A 1
#endif
#ifndef PH_B
#define PH_B 1
#endif
#ifndef PH_C
#define PH_C 1
#endif
#ifndef PH_D
#define PH_D 1
#endif
#ifndef PH_E
#define PH_E 1
#endif
#ifndef PH_F
#define PH_F 1
#endif
#ifndef PH_G
#define PH_G 1
#endif
#ifndef PH_H
#define PH_H 1
#endif
#ifndef PH_I
#define PH_I 1
#endif
#ifndef PH_J
#define PH_J 1
#endif
#ifndef PH_Z
#define PH_Z 1
#endif

struct Args { const float* in[14]; float* out; unsigned char* ws; };
__global__ void __launch_bounds__(NWAVES * 64, 2) mk_fwd(Args args) {
    extern __shared__ __attribute__((aligned(16))) unsigned char lds_raw[];
    LAS unsigned char* const lds = (LAS unsigned char*)lds_raw;
    int wave_s = __builtin_amdgcn_readfirstlane((int)(threadIdx.x >> 6)); asm volatile("" : "+s"(wave_s));
    {
        const int t0 = wave_s * 64 + xb_lane();
        volatile LAS unsigned* MISC = (volatile LAS unsigned*)(lds + MISC_OFF);
        if (t0 < 32) MISC[t0] = 0u;
        if (t0 == 0) { volatile LAS unsigned long long* pt = (volatile LAS unsigned long long*)(lds + PTAB_OFF);
            pt[0] = (unsigned long long)args.in[0]; pt[1] = (unsigned long long)args.in[1]; pt[2] = (unsigned long long)args.in[2]; pt[3] = (unsigned long long)args.in[3];
            pt[4] = (unsigned long long)args.in[4]; pt[5] = (unsigned long long)args.in[5]; pt[6] = (unsigned long long)args.in[6]; pt[7] = (unsigned long long)args.in[7];
            pt[8] = (unsigned long long)args.in[8]; pt[9] = (unsigned long long)args.in[9]; pt[10] = (unsigned long long)args.in[10]; pt[11] = (unsigned long long)args.in[11];
            pt[12] = (unsigned long long)args.in[12]; pt[13] = (unsigned long long)args.in[13]; pt[14] = (unsigned long long)args.out; pt[15] = (unsigned long long)args.ws; }
        __syncthreads();
    }
    XcdBarrier bar = xcd_barrier_post((unsigned*)(args.ws + WS_CTL) + CW_BAR, (volatile LAS unsigned*)(lds + MISC_OFF) + 8, wave_s);
    const int G = 256;

#pragma unroll 1
    for (int l = 0; l < DEPTH; ++l) {
        int c = blockIdx.x; asm volatile("" : "+s"(c));
#if PH_A
        { Frame F = make_frame(lds, wave_s); convert_weights(F, l);
          unsigned char* ws = P_WS;
          if (l == 0) norm_rows<true, false, false>(F, P_IN(0), (bf16*)(ws + WS_HB), P_IN(1) + l * DM, (float*)(ws + WS_LSE), nullptr, ws + WS_HN);
          else norm_rows<false, true, false>(F, nullptr, (bf16*)(ws + WS_HB), P_IN(1) + l * DM, (float*)(ws + WS_LSE), nullptr, ws + WS_HN);
          }
#endif
        xcd_barrier(bar);
#if PH_B
        { Frame F = make_frame(lds, wave_s); unsigned char* ws = P_WS; bf16* big = (bf16*)(ws + WS_BIG);
          pg8::Gemm g{(const bf16*)(ws + WS_HB), (const bf16*)(ws + WS_WIN), MTOK, INC, DM}; pg8::StaticOrder S; S.init(MTOK, 3840, G, c);
          pg8::EpiInProj E{big + B_QA / 2, big + B_KA / 2, big + B_VA / 2, big + B_QW / 2, big + B_KW / 2, big + B_VW / 2, big + B_G / 2, big + B_G / 2 + (size_t)MTOK * DM, P_IN(5) + l * 2048, QSCALE, (const float*)(ws + WS_LSE), 0.f, 0.f};
          pg8::gemm_phase<pg8::EpiInProj, pg8::StaticOrder, true, true>(F.tid, lds, g, S, E);
          pg8::Gemm g8{(const bf16*)(ws + WS_HN), (const bf16*)(ws + WS_WIN) + (size_t)3840 * DM, MTOK, 2048, DM / 2}; pg8::StaticOrder S8; S8.init(MTOK, 2048, G, c);
          pg8::EpiGate8 E8{big + B_G / 2, big + B_G / 2 + (size_t)MTOK * DM, P_IN(5) + l * 2048};
          pg8::gemm_phase<pg8::EpiGate8, pg8::StaticOrder, true, true, false, true>(F.tid, lds, g8, S8, E8); }
#endif
        xcd_barrier(bar);
#ifdef DUP_C
        { Frame F = make_frame(lds, wave_s); attention_phase(F, l, ((long)WS_HN - (long)(WS_BIG + B_QA)) / 2, ((long)WS_HN - (long)(WS_BIG + B_QW)) / 2, DUP_C); }
        xcd_barrier(bar);
#endif
#if PH_C
        { Frame F = make_frame(lds, wave_s); attention_phase(F, l, 0, 0); }
#endif
        xcd_barrier(bar);
#if PH_E
        { Frame F = make_frame(lds, wave_s); unsigned char* ws = P_WS; bf16* big = (bf16*)(ws + WS_BIG);
          pg8::Gemm g0{big + B_OA / 2, (const bf16*)(ws + WS_WA), MTOK, DM, 256}; pg8::Gemm g1{big + B_QW / 2, (const bf16*)(ws + WS_WB), MTOK, DM, DM}; pg8::StaticOrder S; S.init(MTOK, DM, G, c);
          pg8::EpiMergeDual E{(unsigned char*)(big + B_MERGED / 2), big + B_G / 2, big + B_G / 2 + (size_t)MTOK * DM};
          pg8::gemm_phase_dual<pg8::EpiMergeDual, pg8::StaticOrder>(F.tid, lds, g0, g1, S, E); }
#endif
        xcd_barrier(bar);
#if PH_F
        { Frame F = make_frame(lds, wave_s); unsigned char* ws = P_WS; bf16* big = (bf16*)(ws + WS_BIG); bf16* hb = (bf16*)(ws + WS_HB);
          pg8::Gemm g{big + B_MERGED / 2, (const bf16*)(ws + WS_WO), MTOK, DM, DM / 2}; pg8::StaticOrder S; S.init(MTOK, DM, G, c);
          pg8::EpiResid E{hb, hb};
          pg8::gemm_phase<pg8::EpiResid, pg8::StaticOrder, true, true, false, true>(F.tid, lds, g, S, E); }
#endif
        xcd_barrier(bar);
#if PH_G
        { Frame F = make_frame(lds, wave_s); unsigned char* ws = P_WS;
          norm_router(F, (const bf16*)(ws + WS_HB), P_IN(8) + l * DM, P_IN(9) + (size_t)l * DM * NE, (float*)(ws + WS_LSE), (float*)(ws + WS_AFF), ws + WS_HN); }
#endif
        xcd_barrier(bar);
#if PH_H
        { Frame F = make_frame(lds, wave_s); unsigned char* ws = P_WS;
          topk_gather(F, (const float*)(ws + WS_AFF), (const float*)(ws + WS_LSE), (int*)(ws + WS_SEL), (float*)(ws + WS_GATE), (int*)(ws + WS_IDX)); }
#endif
        xcd_barrier(bar);
#if PH_I
        { Frame F = make_frame(lds, wave_s); unsigned char* ws = P_WS; bf16* big = (bf16*)(ws + WS_BIG);
          pg8::Gemm g{(const bf16*)(ws + WS_HN), (const bf16*)(ws + WS_WGU), MEXP, NE * 2048, DM / 2}; pg8::GroupedOrder S; S.init(NE, NB, 8, G, c);
          pg8::EpiSwiGLU E{(unsigned char*)(big + B_ACT / 2), (const LAS int*)(lds + AROW_OFF), 0};
          { const int* idxg = (const int*)(ws + WS_IDX); LAS int* arow = (LAS int*)(lds + AROW_OFF);
            int rv[NE]; const int r = F.tid & 255;
#pragma unroll
            for (int i = 0; i < NE; ++i) { pg8::Unit u; u.pm = 0; u.pn = 0; S.next(i, u); rv[i] = u.pm; }
            asm volatile("" ::: "memory");
#pragma unroll
            for (int i = 0; i < NE; ++i) rv[i] = idxg[(size_t)rv[i] * 256 + r];
#pragma unroll
            for (int i = 0; i < NE; ++i) if (F.tid < 256) arow[i * 256 + r] = rv[i];
            __syncthreads(); }
          pg8::gemm_phase<pg8::EpiSwiGLU, pg8::GroupedOrder, true, true, true, true>(F.tid, lds, g, S, E, (const LAS int*)(lds + AROW_OFF)); }
#endif
        xcd_barrier(bar);
#if PH_J
        { Frame F = make_frame(lds, wave_s); unsigned char* ws = P_WS; bf16* big = (bf16*)(ws + WS_BIG);
          pg8::Gemm g{big + B_ACT / 2, (const bf16*)(ws + WS_WD), MEXP, NE * 1024, DEX / 2}; pg8::GroupedOrder S; S.init(NE, NB, 4, G, c);
          pg8::EpiDown E{big + B_Y / 2, (const LAS float*)(lds + AROW_OFF), 0};
          { const float* gatev = (const float*)(ws + WS_GATE); LAS float* gl = (LAS float*)(lds + AROW_OFF);
            float gv[8]; int pmv[8]; const int r = F.tid & 255;
#pragma unroll
            for (int i = 0; i < 8; ++i) { pg8::Unit u; u.pm = 0; u.pn = 0; S.next(i, u); pmv[i] = u.pm; }
            asm volatile("" ::: "memory");
#pragma unroll
            for (int i = 0; i < 8; ++i) gv[i] = gatev[(size_t)pmv[i] * 256 + r];
#pragma unroll
            for (int i = 0; i < 8; ++i) if (F.tid < 256) gl[i * 256 + r] = gv[i];
            __syncthreads(); }
          pg8::gemm_phase<pg8::EpiDown, pg8::GroupedOrder, true, true, false, true>(F.tid, lds, g, S, E); }
#endif
        xcd_barrier(bar);
    }
#if PH_Z
    { Frame F = make_frame(lds, wave_s); unsigned char* ws = P_WS; norm_rows<false, true, true>(F, nullptr, (bf16*)(ws + WS_HB), P_IN(13), nullptr, P_OUT); }
#endif
}

extern "C" void kernel_launch(void* const* d_in, const int* in_sizes, int n_in, void* d_out, int out_size, void* d_ws, size_t ws_size, hipStream_t stream) {
    static int grid = 0;
    if (grid == 0) {
        if (n_in != 14 || out_size != MTOK * DM || ws_size < WS_END) { fprintf(stderr, "kernel_launch: unexpected shapes (n_in %d, out %d, ws %zu < %zu); nothing launched\n", n_in, out_size, ws_size, (size_t)WS_END); grid = -1; return; }
        int dev = 0, cus = 0, per_cu = 0;
        if (hipGetDevice(&dev) != hipSuccess || hipDeviceGetAttribute(&cus, hipDeviceAttributeMultiprocessorCount, dev) != hipSuccess) { grid = -1; return; }
        if (hipFuncSetAttribute((const void*)mk_fwd, hipFuncAttributeMaxDynamicSharedMemorySize, LDS_BYTES) != hipSuccess) { fprintf(stderr, "kernel_launch: hipFuncSetAttribute failed\n"); grid = -1; return; }
        if (hipOccupancyMaxActiveBlocksPerMultiprocessor(&per_cu, (const void*)mk_fwd, NWAVES * 64, LDS_BYTES) != hipSuccess || per_cu < 1) fprintf(stderr, "kernel_launch: occupancy query reports %d\n", per_cu);
        (void)hipGetLastError();
        grid = 256;
        if (cus != 256) fprintf(stderr, "kernel_launch: device has %d CUs, built for 256\n", cus);
    }
    if (grid < 0) return;
    (void)in_sizes;
    hipMemsetAsync((char*)d_ws + WS_CTL, 0, CTL_ZERO_BYTES, stream);
    Args a{};
    for (int i = 0; i < 14; ++i) a.in[i] = (const float*)d_in[i];
    a.out = (float*)d_out; a.ws = (unsigned char*)d_ws;
    hipLaunchKernelGGL(mk_fwd, dim3(grid), dim3(NWAVES * 64), LDS_BYTES, stream, a);
}
```

```cpp
#include <hip/hip_runtime.h>
#include <cstdio>
#include <cstdint>
typedef __bf16 nbf16x2 __attribute__((ext_vector_type(2)));
typedef __bf16 nbf16x4 __attribute__((ext_vector_type(4)));
typedef __bf16 nbf16x8 __attribute__((ext_vector_type(8)));
typedef float f32x2_t __attribute__((ext_vector_type(2)));
typedef float f32x8_t __attribute__((ext_vector_type(8)));
__device__ __forceinline__ unsigned pk2bf(float lo, float hi) { f32x2_t v = {lo, hi}; return __builtin_bit_cast(unsigned, __builtin_convertvector(v, nbf16x2)); }
__device__ __forceinline__ float bflo(unsigned w) { return __builtin_bit_cast(float, w << 16); }
__device__ __forceinline__ float bfhi(unsigned w) { return __builtin_bit_cast(float, w & 0xffff0000u); }
namespace pg8 {
#define PG8_LAS __attribute__((address_space(3)))
typedef unsigned short bf16_t;
typedef short bf16x8 __attribute__((ext_vector_type(8)));
typedef float f32x4 __attribute__((ext_vector_type(4)));
typedef unsigned u32x4 __attribute__((ext_vector_type(4)));
typedef int i32x4_t __attribute__((ext_vector_type(4)));
constexpr int BM = 256, BK = 64, HALF = 128, HTB = HALF * BK * 2  , STAGE_BYTES = 8 * HTB, NXCD = 8;
#ifndef PG8_WGM
#define PG8_WGM 8
#endif
#ifndef PG8_WGM_G
#define PG8_WGM_G 8
#endif
constexpr int WGM = PG8_WGM, WGM_G = PG8_WGM_G;

__host__ __device__ __forceinline__ int lds_byte(int r, int c) { const int st = (r >> 4) * 2 + (c >> 5), rr = r & 15, cc = c & 31, ob = rr * 64 + cc * 2; return st * 1024 + (ob ^ (((ob >> 9) & 1) << 5)); }
__host__ __device__ __forceinline__ void stage_rc(int b, int& R, int& C) { const int st = b / 1024, sb = b % 1024, swz = sb ^ (((sb >> 9) & 1) << 5); R = (st >> 1) * 16 + swz / 64; C = (st & 1) * 32 + (swz % 64) / 2; }
__host__ __device__ __forceinline__ int perm32(int rho) { const int n = rho >> 4, i = rho & 15; return 8 * (i >> 2) + 4 * n + (i & 3); }

struct Unit { int pm, pn; };
struct Gemm { const bf16_t* A; const bf16_t* Bt; int M, N, K; };

struct StaticOrder {
    int nM, nN, nwg, G, c;
    __host__ __device__ void init(int M, int N, int G_, int c_) { nM = M / BM; nN = N / BM; nwg = nM * nN; G = G_; c = c_; }
    __host__ __device__ bool next(int i, Unit& u) const {
        const long L = (long)i * G + c; if (L >= nwg) return false;
        int wgid = (int)L; { const int q = nwg / NXCD, r = nwg % NXCD, xcd = wgid % NXCD, off = wgid / NXCD; wgid = (xcd < r ? xcd * (q + 1) : r * (q + 1) + (xcd - r) * q) + off; }
        const int nig = WGM * nN, gid = wgid / nig, fm = gid * WGM, gsz = (nM - fm) < WGM ? (nM - fm) : WGM;
        u.pm = fm + ((wgid % nig) % gsz); u.pn = (wgid % nig) / gsz; return true;
    }
    __device__ __forceinline__ void a_ready(const Unit&) const {}
    __device__ __forceinline__ void done(const Unit&) const {}
};

struct GroupedOrder {
    int nMg, nNg, upg, ntot, G, c;
    __host__ __device__ void init(int ngrp, int nMg_, int nNg_, int G_, int c_) { nMg = nMg_; nNg = nNg_; upg = nMg * nNg; ntot = ngrp * upg; G = G_; c = c_; }
    __host__ __device__ bool next(int i, Unit& u) const {
        const long L = (long)i * G + c; if (L >= ntot) return false;
        const int e = (int)(L / upg); int wgid = (int)(L % upg);
        { const int q = upg / NXCD, r = upg % NXCD, xcd = wgid % NXCD, off = wgid / NXCD; wgid = (xcd < r ? xcd * (q + 1) : r * (q + 1) + (xcd - r) * q) + off; }
        const int nig = WGM_G * nNg, gid = wgid / nig, fm = gid * WGM_G, gsz = (nMg - fm) < WGM_G ? (nMg - fm) : WGM_G;
        u.pm = e * nMg + fm + ((wgid % nig) % gsz); u.pn = e * nNg + (wgid % nig) / gsz; return true;
    }
    __device__ __forceinline__ void a_ready(const Unit&) const {}
    __device__ __forceinline__ void done(const Unit&) const {}
};

#ifndef EPI_NT
#define EPI_NT 0
#endif
#if EPI_NT
#define EPI_ST(ptr, val) __builtin_nontemporal_store((val), (ptr))
#else
#define EPI_ST(ptr, val) (*(ptr) = (val))
#endif
#ifndef EPI_NT_B
#define EPI_NT_B 0
#endif
#if EPI_NT_B
#define EPI_ST_B(ptr, val) __builtin_nontemporal_store((val), (ptr))
#else
#define EPI_ST_B(ptr, val) (*(ptr) = (val))
#endif
__device__ __forceinline__ u32x4 pack8(const f32x4 a, const f32x4 b) { u32x4 w; w.x = pk2bf(a[0], a[1]); w.y = pk2bf(a[2], a[3]); w.z = pk2bf(b[0], b[1]); w.w = pk2bf(b[2], b[3]); return w; }
__device__ __forceinline__ void unpack8(const u32x4 w, f32x4& a, f32x4& b) { a = (f32x4){bflo(w.x), bfhi(w.x), bflo(w.y), bfhi(w.y)}; b = (f32x4){bflo(w.z), bfhi(w.z), bflo(w.w), bfhi(w.w)}; }
typedef unsigned u32x2 __attribute__((ext_vector_type(2)));
__device__ __forceinline__ unsigned pk4f8u(const f32x4 v) { int w = __builtin_amdgcn_cvt_pk_fp8_f32(v[0], v[1], 0, false); w = __builtin_amdgcn_cvt_pk_fp8_f32(v[2], v[3], w, true); return (unsigned)w; }
__device__ __forceinline__ unsigned pk4f8c(const f32x4 v) { f32x4 c; for (int i = 0; i < 4; ++i) c[i] = fminf(fmaxf(v[i], -440.f), 440.f); return pk4f8u(c); }
__device__ __forceinline__ float sigmoidf_fast(float x) { return __builtin_amdgcn_rcpf(1.0f + __builtin_amdgcn_exp2f(-1.4426950408889634f * x)); }

__device__ __forceinline__ size_t gate_blk(int pm, int pn, int wave, int ai, int m, int bj, int lane) { return ((size_t)(((pm * 4 + pn) * 8 + wave) * 16 + (ai * 8 + m * 2 + bj)) * 64 + lane) * 8; }
__device__ __forceinline__ u32x4 xchg_pair(const u32x4 v) { u32x4 r;
#pragma unroll
    for (int w = 0; w < 4; ++w) r[w] = (unsigned)__builtin_amdgcn_mov_dpp((int)v[w], 0xB1, 0xF, 0xF, true);
    return r; }
__device__ __forceinline__ void wide_pair(const u32x4 p0, const u32x4 p1, bool odd, u32x4& a, u32x4& b) {
    const u32x4 recv = xchg_pair(odd ? p0 : p1); a = odd ? recv : p0; b = odd ? p1 : recv; }
struct EpiInProj {
    static constexpr bool PERM = true, AFTER_DRAIN = false, WIDE = true, ROWSCALE = true; static constexpr int F8_SW = 0, F8_SA = 0;
    bf16_t *qa, *ka, *va, *qw, *kw, *vw, *gr, *g1; const float* bgate; float qscale;
    const float* rsv; mutable float rs0, rs1;
    __device__ __forceinline__ float row_rs(int ai, int m, int fr) const { return __builtin_bit_cast(float, __builtin_amdgcn_ds_bpermute((fr + 16 * m) << 2, __builtin_bit_cast(int, ai ? rs1 : rs0))); }
    __device__ __forceinline__ void operator()(const f32x4 (&acc)[2][2][4][2], const Unit& u, int wr, int wc, int fr, int fq) const {
        const int pn = u.pn; const int row0 = u.pm * BM + wr * 64 + fr;
        if (pn >= 15) {
            const int cc0 = (pn - 15) * HALF + wc * 32 + 8 * fq;
            f32x4 b0[2], b1[2];
#pragma unroll
            for (int n = 0; n < 2; ++n) { b0[n] = *(const f32x4*)(bgate + cc0 + 4 * n); b1[n] = *(const f32x4*)(bgate + 1024 + cc0 + 4 * n); }
#pragma unroll
            for (int ai = 0; ai < 2; ++ai)
#pragma unroll
                for (int m = 0; m < 4; ++m) { const size_t off = gate_blk(u.pm, (pn - 15) >> 1, wr * 4 + wc, ai, m, (pn - 15) & 1, fq * 16 + fr); f32x4 rr[2], gg[2]; const float rs = row_rs(ai, m, fr);
#pragma unroll
                    for (int n = 0; n < 2; ++n)
#pragma unroll
                        for (int j = 0; j < 4; ++j) { float a0 = acc[ai][0][m][n][j] * rs + b0[n][j], a1 = acc[ai][1][m][n][j] * rs + b1[n][j];
                            a0 = fminf(fmaxf(a0, -30.f), 30.f); a1 = fminf(fmaxf(a1, -30.f), 30.f);
                            const float e0 = __builtin_amdgcn_exp2f(-1.4426950408889634f * a0), e1 = __builtin_amdgcn_exp2f(-1.4426950408889634f * a1);
                            gg[n][j] = __builtin_amdgcn_rcpf(1.0f + e1); rr[n][j] = (1.0f + e1) * __builtin_amdgcn_rcpf(1.0f + e0); }
                    EPI_ST_B((u32x4*)(gr + off), pack8(rr[0], rr[1])); EPI_ST_B((u32x4*)(g1 + off), pack8(gg[0], gg[1])); }
            return;
        }
        bf16_t* base; int ldc, ct; float sc = 1.0f;
        if (pn < 3) { base = qa; ldc = 768; ct = pn; sc = qscale; }
        else if (pn < 6) { base = ka; ldc = 768; ct = pn - 3; }
        else if (pn < 9) { base = va; ldc = 768; ct = pn - 6; }
        else if (pn < 13) { base = qw; ldc = 1024; ct = pn - 9; sc = qscale; }
        else if (pn == 13) { base = kw; ldc = 256; ct = 0; }
        else { base = vw; ldc = 256; ct = 0; }
        const bool odd = (fr & 1) != 0;
        const int col0 = ct * BM + wc * 64 + 8 * fq + (odd ? 32 : 0);
#pragma unroll
        for (int ai = 0; ai < 2; ++ai)
#pragma unroll
            for (int m = 0; m < 4; ++m) { bf16_t* rowp = base + (size_t)(row0 - (odd ? 1 : 0) + ai * HALF + m * 16) * ldc + col0;
                const float s2 = sc * row_rs(ai, m, fr);
                u32x4 a, b; wide_pair(pack8(acc[ai][0][m][0] * s2, acc[ai][0][m][1] * s2), pack8(acc[ai][1][m][0] * s2, acc[ai][1][m][1] * s2), odd, a, b);
                EPI_ST_B((u32x4*)rowp, a); EPI_ST_B((u32x4*)(rowp + ldc), b); }
    }
};
struct EpiGate8 {
    static constexpr bool PERM = true, AFTER_DRAIN = false, WIDE = true, ROWSCALE = false; static constexpr int F8_SW = 0, F8_SA = 0; static constexpr int NVM = 32;
    bf16_t *gr, *g1; const float* bgate;
    __device__ __forceinline__ void operator()(const f32x4 (&acc)[2][2][4][2], const Unit& u, int wr, int wc, int fr, int fq) const {
        const int pn = u.pn;
        const int cc0 = pn * HALF + wc * 32 + 8 * fq;
        f32x4 b0[2], b1[2];
#pragma unroll
        for (int n = 0; n < 2; ++n) { b0[n] = *(const f32x4*)(bgate + cc0 + 4 * n); b1[n] = *(const f32x4*)(bgate + 1024 + cc0 + 4 * n); }
        constexpr float SC = 1.0f / 1024.0f;
#pragma unroll
        for (int ai = 0; ai < 2; ++ai)
#pragma unroll
            for (int m = 0; m < 4; ++m) { const size_t off = gate_blk(u.pm, pn >> 1, wr * 4 + wc, ai, m, pn & 1, fq * 16 + fr); f32x4 rr[2], gg[2];
#pragma unroll
                for (int n = 0; n < 2; ++n)
#pragma unroll
                    for (int j = 0; j < 4; ++j) { float a0 = acc[ai][0][m][n][j] * SC + b0[n][j], a1 = acc[ai][1][m][n][j] * SC + b1[n][j];
                        a0 = fminf(fmaxf(a0, -30.f), 30.f); a1 = fminf(fmaxf(a1, -30.f), 30.f);
                        const float e0 = __builtin_amdgcn_exp2f(-1.4426950408889634f * a0), e1 = __builtin_amdgcn_exp2f(-1.4426950408889634f * a1);
                        gg[n][j] = __builtin_amdgcn_rcpf(1.0f + e1); rr[n][j] = (1.0f + e1) * __builtin_amdgcn_rcpf(1.0f + e0); }
                EPI_ST_B((u32x4*)(gr + off), pack8(rr[0], rr[1])); EPI_ST_B((u32x4*)(g1 + off), pack8(gg[0], gg[1])); }
    }
};
struct EpiMergeDual {
    static constexpr bool PERM = true, AFTER_DRAIN = false, WIDE = true, ROWSCALE = false; static constexpr int F8_SW = 0, F8_SA = 0;
    unsigned char* merged; const bf16_t* gr; const bf16_t* g1;
    __device__ __forceinline__ size_t gblk(const Unit& u, int wr, int wc, int ai, int m, int bj, int fr, int fq) const { return gate_blk(u.pm, u.pn, wr * 4 + 2 * (wc & 1) + bj, ai, m, wc >> 1, fq * 16 + fr); }
    __device__ __forceinline__ void mid(f32x4 (&acc)[2][2][4][2], const Unit& u, int wr, int wc, int fr, int fq) const {
        u32x4 w[2][4][2];
#pragma unroll
        for (int ai = 0; ai < 2; ++ai)
#pragma unroll
            for (int m = 0; m < 4; ++m) {
#pragma unroll
                for (int bj = 0; bj < 2; ++bj) w[ai][m][bj] = *(const u32x4*)(gr + gblk(u, wr, wc, ai, m, bj, fr, fq)); }
        asm volatile("" ::: "memory");
#pragma unroll
        for (int ai = 0; ai < 2; ++ai)
#pragma unroll
            for (int m = 0; m < 4; ++m) {
#pragma unroll
                for (int bj = 0; bj < 2; ++bj) { f32x4 r0, r1; unpack8(w[ai][m][bj], r0, r1); acc[ai][bj][m][0] *= r0; acc[ai][bj][m][1] *= r1; } }
    }
    __device__ __forceinline__ void operator()(const f32x4 (&acc)[2][2][4][2], const Unit& u, int wr, int wc, int fr, int fq) const {
        u32x4 w[2][4][2];
#pragma unroll
        for (int ai = 0; ai < 2; ++ai)
#pragma unroll
            for (int m = 0; m < 4; ++m) {
#pragma unroll
                for (int bj = 0; bj < 2; ++bj) w[ai][m][bj] = *(const u32x4*)(g1 + gblk(u, wr, wc, ai, m, bj, fr, fq)); }
        asm volatile("" ::: "memory");
#pragma unroll
        for (int ai = 0; ai < 2; ++ai)
#pragma unroll
            for (int m = 0; m < 4; ++m) { f32x4 a0, a1, c0, c1; unpack8(w[ai][m][0], a0, a1); unpack8(w[ai][m][1], c0, c1);
                unsigned char* p = merged + (size_t)(u.pm * BM + wr * 64 + fr + ai * HALF + m * 16) * 1024 + u.pn * BM + wc * 64 + 8 * fq;
                u32x2 p0, p1; p0.x = pk4f8c(acc[ai][0][m][0] * a0 * 16.0f); p0.y = pk4f8c(acc[ai][0][m][1] * a1 * 16.0f); p1.x = pk4f8c(acc[ai][1][m][0] * c0 * 16.0f); p1.y = pk4f8c(acc[ai][1][m][1] * c1 * 16.0f);
                *(u32x2*)p = p0; *(u32x2*)(p + 32) = p1; }
    }
};
struct EpiResid {
    static constexpr bool PERM = true, AFTER_DRAIN = false, WIDE = true, ROWSCALE = false; static constexpr int F8_SW = 0, F8_SA = 0;
    const bf16_t* base; bf16_t* out;
    __device__ __forceinline__ void operator()(const f32x4 (&acc)[2][2][4][2], const Unit& u, int wr, int wc, int fr, int fq) const {
        const bool odd = (fr & 1) != 0;
        const int rowe = u.pm * BM + wr * 64 + (fr & ~1), col = u.pn * BM + wc * 64 + 8 * fq + (odd ? 32 : 0);
        u32x4 la[2][4], lb[2][4];
#pragma unroll
        for (int ai = 0; ai < 2; ++ai)
#pragma unroll
            for (int m = 0; m < 4; ++m) { const bf16_t* p = base + (size_t)(rowe + ai * HALF + m * 16) * 1024 + col; la[ai][m] = *(const u32x4*)p; lb[ai][m] = *(const u32x4*)(p + 1024); }
        asm volatile("" ::: "memory");
#pragma unroll
        for (int ai = 0; ai < 2; ++ai)
#pragma unroll
            for (int m = 0; m < 4; ++m) {
                const u32x4 recv = xchg_pair(odd ? la[ai][m] : lb[ai][m]); const u32x4 r0 = odd ? recv : la[ai][m], r1 = odd ? lb[ai][m] : recv;
                f32x4 b0, b1, c0, c1; unpack8(r0, b0, b1); unpack8(r1, c0, c1);
                constexpr float SC = 1.0f / 1024.0f;
                u32x4 a, b; wide_pair(pack8(b0 + acc[ai][0][m][0] * SC, b1 + acc[ai][0][m][1] * SC), pack8(c0 + acc[ai][1][m][0] * SC, c1 + acc[ai][1][m][1] * SC), odd, a, b);
                bf16_t* p = out + (size_t)(rowe + ai * HALF + m * 16) * 1024 + col;
                EPI_ST((u32x4*)p, a); EPI_ST((u32x4*)(p + 1024), b); }
    }
};
struct EpiSwiGLU {
    static constexpr bool PERM = true, AFTER_DRAIN = false, WIDE = false, ROWSCALE = false; static constexpr int F8_SW = 0, F8_SA = 0;
    unsigned char* act; const PG8_LAS int* arow; mutable int ui;
    __device__ __forceinline__ void operator()(const f32x4 (&acc)[2][2][4][2], const Unit& u, int wr, int wc, int fr, int fq) const {
        const int row0 = u.pm * BM + wr * 64 + fr, col0 = (u.pn & 7) * HALF + wc * 32 + 8 * fq;
#pragma unroll
        for (int ai = 0; ai < 2; ++ai)
#pragma unroll
            for (int m = 0; m < 4; ++m) { f32x4 o[2];
                const float rs = 1.0f / 1024.0f;
#pragma unroll
                for (int n = 0; n < 2; ++n)
#pragma unroll
                    for (int j = 0; j < 4; ++j) { const float a = acc[ai][0][m][n][j] * rs, up = acc[ai][1][m][n][j] * rs; o[n][j] = fminf(fmaxf(8.0f * a * sigmoidf_fast(a) * up, -440.f), 440.f); }
                u32x2 w8; w8.x = pk4f8u(o[0]); w8.y = pk4f8u(o[1]);
                *(u32x2*)(act + (size_t)(row0 + ai * HALF + m * 16) * 1024 + col0) = w8; }
        ++ui;
    }
};
struct EpiDown {
    static constexpr bool PERM = true, AFTER_DRAIN = false, WIDE = true, ROWSCALE = false; static constexpr int F8_SW = 0, F8_SA = 0;
    bf16_t* y; const PG8_LAS float* glds; mutable int ui;
    __device__ __forceinline__ void operator()(const f32x4 (&acc)[2][2][4][2], const Unit& u, int wr, int wc, int fr, int fq) const {
        const bool odd = (fr & 1) != 0;
        const int rowe = u.pm * BM + wr * 64 + (fr & ~1), col = (u.pn & 3) * BM + wc * 64 + 8 * fq + (odd ? 32 : 0);
#pragma unroll
        for (int ai = 0; ai < 2; ++ai)
#pragma unroll
            for (int m = 0; m < 4; ++m) { const float gv = glds[ui * 256 + wr * 64 + fr + ai * HALF + m * 16] * (1.0f / 512.0f);
                u32x4 a, b; wide_pair(pack8(acc[ai][0][m][0] * gv, acc[ai][0][m][1] * gv), pack8(acc[ai][1][m][0] * gv, acc[ai][1][m][1] * gv), odd, a, b);
                bf16_t* p = y + (size_t)(rowe + ai * HALF + m * 16) * 1024 + col;
                EPI_ST((u32x4*)p, a); EPI_ST((u32x4*)(p + 1024), b); }
        ++ui;
    }
};

template <class Epi, class Sched, bool ALIGN_EPI = false, bool SP2 = false, bool GATHER = false, bool FP8 = false>
__device__ __forceinline__ void gemm_phase(int tid_, PG8_LAS unsigned char* lds, const Gemm g, const Sched& S, const Epi& E, const PG8_LAS int* arow = nullptr) {
    static_assert(!GATHER || SP2, "GATHER is written for the SP2 loop");
    asm volatile("" : "+v"(tid_));
    const int tid = tid_, wid = __builtin_amdgcn_readfirstlane(tid >> 6), lane = tid & 63, wr = wid >> 2, wc = wid & 3, fr = lane & 15, fq = lane >> 4;
    const int K = g.K, nt = K / BK;
    unsigned voffA[2], voffB[2];
#pragma unroll
    for (int i = 0; i < 2; ++i) { int R, C; stage_rc(tid * 16 + i * 8192, R, C); const int Rb = Epi::WIDE ? ((R >> 5) * 64 + perm32(R & 31)) : (Epi::PERM ? ((R & ~31) + perm32(R & 31)) : R);
        voffA[i] = (unsigned)(R * K + C) * 2u; voffB[i] = (unsigned)(Rb * K + C) * 2u; }
    unsigned vA0[2] = {voffA[0], voffA[1]}, vA1[2] = {voffA[0], voffA[1]}, nA0[2] = {voffA[0], voffA[1]}, nA1[2] = {voffA[0], voffA[1]};
    int gR[2], gC[2];
#pragma unroll
    for (int i = 0; i < 2; ++i) { stage_rc(tid * 16 + i * 8192, gR[i], gC[i]); }
#define PG8_GOFF(dst0, dst1, u_) do { _Pragma("unroll") for (int _i = 0; _i < 2; ++_i) { \
        dst0[_i] = (((unsigned)arow[(u_) * 256 + gR[_i]] & 0xffffu) * (unsigned)K + (unsigned)gC[_i]) * 2u; dst1[_i] = (((unsigned)arow[(u_) * 256 + HALF + gR[_i]] & 0xffffu) * (unsigned)K + (unsigned)gC[_i]) * 2u; } } while (0)
    const size_t kstep = (size_t)(BK * 2);
    const size_t hstep = (size_t)HALF * K * 2;
    const size_t tstep = 2 * hstep;
    const size_t bhs = Epi::WIDE ? (size_t)32 * K * 2 : hstep;
    const size_t ahs = GATHER ? (size_t)0 : hstep, atstep = GATHER ? (size_t)0 : tstep;
    const unsigned ldsw = (unsigned)wid * 1024u;
    const int aoff = lds_byte(wr * 64 + fr, fq * 8), boff = lds_byte(wc * 32 + fr, fq * 8);
#define PG8_SA(b, h) (((b) * 2 + (h)) * HTB)
#define PG8_SB(b, h) ((4 + (b) * 2 + (h)) * HTB)
#define PG8_STAGE(bufoff, gbase, voff) do { _Pragma("unroll") for (int _i = 0; _i < 2; ++_i) \
        __builtin_amdgcn_global_load_lds((const unsigned*)((const char*)(gbase) + (voff)[_i]), (PG8_LAS unsigned*)(lds + (bufoff) + ldsw + _i * 8192), 16, 0, 0); } while (0)
#define PG8_LDA(dst, b, h) do { _Pragma("unroll") for (int m = 0; m < 4; ++m) _Pragma("unroll") for (int k = 0; k < 2; ++k) dst[m][k] = *(const PG8_LAS bf16x8*)(lds + PG8_SA(b, h) + aoff + m * 2048 + k * 1024); } while (0)
#define PG8_LDB(dst, b, h) do { _Pragma("unroll") for (int n = 0; n < 2; ++n) _Pragma("unroll") for (int k = 0; k < 2; ++k) dst[n][k] = *(const PG8_LAS bf16x8*)(lds + PG8_SB(b, h) + boff + n * 2048 + k * 1024); } while (0)
#define PG8_CAT8(x0, x1) __builtin_shufflevector(__builtin_bit_cast(i32x4_t, (x0)), __builtin_bit_cast(i32x4_t, (x1)), 0, 1, 2, 3, 4, 5, 6, 7)
#define PG8_MMA(ai, bj, At, Bt) do { __builtin_amdgcn_s_setprio(1); \
        if constexpr (FP8) { _Pragma("unroll") for (int m = 0; m < 4; ++m) _Pragma("unroll") for (int n = 0; n < 2; ++n) \
            asm volatile("v_mfma_f32_16x16x128_f8f6f4 %0, %1, %2, %0" : "+v"(acc[ai][bj][m][n]) : "v"(PG8_CAT8(Bt[n][0], Bt[n][1])), "v"(PG8_CAT8(At[m][0], At[m][1]))); } \
        else { _Pragma("unroll") for (int m = 0; m < 4; ++m) _Pragma("unroll") for (int n = 0; n < 2; ++n) _Pragma("unroll") for (int k = 0; k < 2; ++k) \
            acc[ai][bj][m][n] = __builtin_amdgcn_mfma_f32_16x16x32_bf16(Bt[n][k], At[m][k], acc[ai][bj][m][n], 0, 0, 0); } \
        __builtin_amdgcn_s_setprio(0); } while (0)
#define PG8_WAIT_V(n) asm volatile("s_waitcnt vmcnt(" #n ")" ::: "memory")
#define PG8_WAIT_L(n) asm volatile("s_waitcnt lgkmcnt(" #n ")" ::: "memory")
#define PG8_BAR __builtin_amdgcn_s_barrier()
#define PG8_SCHED __builtin_amdgcn_sched_barrier(0)
    Unit cur, nxt; int ui = 0;
    if (!S.next(0, cur)) return;
    f32x4 acc[2][2][4][2];
#pragma unroll
    for (int a = 0; a < 2; ++a)
#pragma unroll
        for (int b = 0; b < 2; ++b)
#pragma unroll
            for (int m = 0; m < 4; ++m)
#pragma unroll
                for (int n = 0; n < 2; ++n) acc[a][b][m][n] = (f32x4){0.f, 0.f, 0.f, 0.f};
    bf16x8 At[4][2], B0[2][2], B1[2][2];
    const char* cA = (const char*)g.A + (size_t)cur.pm * atstep; const char* cB = (const char*)g.Bt + (size_t)cur.pn * tstep;
    if constexpr (GATHER) { PG8_GOFF(vA0, vA1, 0); }
    S.a_ready(cur);
    if constexpr (SP2) {
        PG8_STAGE(PG8_SB(0, 0), cB, voffB); PG8_STAGE(PG8_SB(0, 1), cB + bhs, voffB); PG8_STAGE(PG8_SA(0, 0), cA, vA0); PG8_STAGE(PG8_SA(0, 1), cA + ahs, vA1);
        if (wr == 1) PG8_BAR;
        PG8_WAIT_V(2); PG8_BAR;
        PG8_STAGE(PG8_SB(1, 0), cB + kstep, voffB); PG8_STAGE(PG8_SA(1, 0), cA + kstep, vA0); PG8_STAGE(PG8_SB(1, 1), cB + bhs + kstep, voffB);
        PG8_WAIT_V(6); PG8_BAR;
    } else {
        PG8_STAGE(PG8_SB(0, 0), cB, voffB); PG8_STAGE(PG8_SA(0, 0), cA, voffA); PG8_STAGE(PG8_SB(0, 1), cB + bhs, voffB); PG8_STAGE(PG8_SA(0, 1), cA + hstep, voffA);
        if (wr == 1) PG8_BAR;
        PG8_WAIT_V(4); PG8_BAR;
        PG8_STAGE(PG8_SB(1, 0), cB + kstep, voffB); PG8_STAGE(PG8_SA(1, 0), cA + kstep, voffA); PG8_STAGE(PG8_SB(1, 1), cB + bhs + kstep, voffB);
        PG8_WAIT_V(6); PG8_BAR;
    }
    for (;;) {
        const bool has_next = S.next(ui + 1, nxt);
        const char* nA = has_next ? (const char*)g.A + (size_t)nxt.pm * atstep : cA; const char* nB = has_next ? (const char*)g.Bt + (size_t)nxt.pn * tstep : cB;
#pragma unroll 1
        for (int t = 0; t < nt; t += 2) {
            const bool last = (t == nt - 2);
            const char* a1 = cA + (size_t)(t + 1) * kstep;
            const char* a2 = last ? nA : cA + (size_t)(t + 2) * kstep; const char* b2 = last ? nB : cB + (size_t)(t + 2) * kstep;
            const char* a3 = a2 + kstep; const char* b3 = b2 + kstep;
            if (last && has_next) S.a_ready(nxt);
            if constexpr (Epi::ROWSCALE) { if (last) { E.rs0 = E.rsv[cur.pm * BM + wr * 64 + lane]; E.rs1 = E.rsv[cur.pm * BM + HALF + wr * 64 + lane]; } }
            unsigned s0[2] = {vA0[0], vA0[1]}, s1[2] = {vA1[0], vA1[1]};
            if constexpr (GATHER) { if (last && has_next) { PG8_GOFF(nA0, nA1, ui + 1); s0[0] = nA0[0]; s0[1] = nA0[1]; s1[0] = nA1[0]; s1[1] = nA1[1]; } }
            if constexpr (SP2) {
            PG8_LDB(B0, 0, 0); PG8_LDB(B1, 0, 1); PG8_SCHED; PG8_LDA(At, 0, 0); PG8_STAGE(PG8_SA(1, 1), a1 + ahs, vA1);
            PG8_WAIT_V(8); PG8_WAIT_L(0); PG8_BAR; PG8_MMA(0, 0, At, B0); PG8_MMA(0, 1, At, B1); PG8_BAR; PG8_SCHED;
            PG8_LDA(At, 0, 1); PG8_STAGE(PG8_SB(0, 0), b2, voffB); PG8_STAGE(PG8_SB(0, 1), b2 + bhs, voffB); PG8_STAGE(PG8_SA(0, 0), a2, s0);
            PG8_WAIT_V(8); PG8_WAIT_L(0); PG8_BAR; PG8_MMA(1, 0, At, B0); PG8_MMA(1, 1, At, B1); PG8_BAR; PG8_SCHED;
            PG8_LDB(B0, 1, 0); PG8_LDB(B1, 1, 1); PG8_SCHED; PG8_LDA(At, 1, 0); PG8_STAGE(PG8_SA(0, 1), a2 + ahs, s1);
            PG8_WAIT_V(8); PG8_WAIT_L(0); PG8_BAR; PG8_MMA(0, 0, At, B0); PG8_MMA(0, 1, At, B1); PG8_BAR; PG8_SCHED;
            PG8_LDA(At, 1, 1); PG8_STAGE(PG8_SB(1, 0), b3, voffB); PG8_STAGE(PG8_SB(1, 1), b3 + bhs, voffB); PG8_STAGE(PG8_SA(1, 0), a3, s0);
            PG8_WAIT_V(8); PG8_WAIT_L(0); PG8_BAR; PG8_MMA(1, 0, At, B0); PG8_MMA(1, 1, At, B1); PG8_BAR; PG8_SCHED;
            } else {
            PG8_LDB(B0, 0, 0); PG8_SCHED; PG8_LDA(At, 0, 0); PG8_STAGE(PG8_SA(1, 1), a1 + hstep, voffA);
            PG8_WAIT_L(8); PG8_BAR; PG8_WAIT_L(0); PG8_MMA(0, 0, At, B0); PG8_BAR; PG8_SCHED;
            PG8_LDB(B1, 0, 1); PG8_STAGE(PG8_SB(0, 0), b2, voffB);
            PG8_BAR; PG8_WAIT_L(0); PG8_MMA(0, 1, At, B1); PG8_BAR;
            PG8_LDA(At, 0, 1); PG8_STAGE(PG8_SA(0, 0), a2, voffA);
            PG8_BAR; PG8_WAIT_L(0); PG8_MMA(1, 0, At, B0); PG8_BAR; PG8_SCHED;
            PG8_STAGE(PG8_SB(0, 1), b2 + bhs, voffB);
            PG8_WAIT_V(6); PG8_BAR; PG8_MMA(1, 1, At, B1); PG8_BAR;
            PG8_LDB(B0, 1, 0); PG8_SCHED; PG8_LDA(At, 1, 0); PG8_STAGE(PG8_SA(0, 1), a2 + hstep, voffA);
            PG8_WAIT_L(8); PG8_BAR; PG8_WAIT_L(0); PG8_MMA(0, 0, At, B0); PG8_BAR; PG8_SCHED;
            PG8_LDB(B1, 1, 1); PG8_STAGE(PG8_SB(1, 0), b3, voffB);
            PG8_BAR; PG8_WAIT_L(0); PG8_MMA(0, 1, At, B1); PG8_BAR;
            PG8_LDA(At, 1, 1); PG8_STAGE(PG8_SA(1, 0), a3, voffA);
            PG8_BAR; PG8_WAIT_L(0); PG8_MMA(1, 0, At, B0); PG8_BAR; PG8_SCHED;
            PG8_STAGE(PG8_SB(1, 1), b3 + bhs, voffB);
            PG8_WAIT_V(6); PG8_BAR; PG8_MMA(1, 1, At, B1); PG8_BAR;
            }
        }
        if constexpr (ALIGN_EPI) { if (wr == 0) PG8_BAR; }
        if constexpr (FP8) asm volatile("s_nop 15\n\ts_nop 15" ::: "memory");
        if constexpr (!Epi::AFTER_DRAIN) { E(acc, cur, wr, wc, fr, fq); S.done(cur); }
        if (!has_next) break;
#pragma unroll
        for (int a = 0; a < 2; ++a)
#pragma unroll
            for (int b = 0; b < 2; ++b)
#pragma unroll
                for (int m = 0; m < 4; ++m)
#pragma unroll
                    for (int n = 0; n < 2; ++n) acc[a][b][m][n] = (f32x4){0.f, 0.f, 0.f, 0.f};
        cur = nxt; cA = nA; cB = nB; ++ui;
        if constexpr (GATHER) { vA0[0] = nA0[0]; vA0[1] = nA0[1]; vA1[0] = nA1[0]; vA1[1] = nA1[1]; }
        if constexpr (ALIGN_EPI) { if (wr == 1) PG8_BAR; }
    }
    PG8_WAIT_V(0);
    if constexpr (!ALIGN_EPI) { if (wr == 0) PG8_BAR; }
    PG8_BAR;
    if constexpr (Epi::AFTER_DRAIN) { E.fused(acc, cur, wr, wc, fr, fq, lds, wid, lane); S.done(cur); }
#undef PG8_SA
#undef PG8_SB
#undef PG8_STAGE
#undef PG8_LDA
#undef PG8_LDB
#undef PG8_MMA
#undef PG8_CAT8
#undef PG8_WAIT_V
#undef PG8_WAIT_L
#undef PG8_BAR
#undef PG8_SCHED
#undef PG8_GOFF
}

template <class Epi, class Sched>
__device__ __forceinline__ void gemm_phase_dual(int tid_, PG8_LAS unsigned char* lds, const Gemm g0, const Gemm g1, const Sched& S, const Epi& E) {
    asm volatile("" : "+v"(tid_));
    const int tid = tid_, wid = __builtin_amdgcn_readfirstlane(tid >> 6), lane = tid & 63, wr = wid >> 2, wc = wid & 3, fr = lane & 15, fq = lane >> 4;
    unsigned vA_0[2], vB_0[2], vA_1[2], vB_1[2];
#pragma unroll
    for (int i = 0; i < 2; ++i) { int R, C; stage_rc(tid * 16 + i * 8192, R, C); const int Rb = Epi::WIDE ? ((R >> 5) * 64 + perm32(R & 31)) : (Epi::PERM ? ((R & ~31) + perm32(R & 31)) : R);
        vA_0[i] = (unsigned)(R * g0.K + C) * 2u; vB_0[i] = (unsigned)(Rb * g0.K + C) * 2u; vA_1[i] = (unsigned)(R * g1.K + C) * 2u; vB_1[i] = (unsigned)(Rb * g1.K + C) * 2u; }
    const size_t kstep = (size_t)(BK * 2);
    const size_t hs_0 = (size_t)HALF * g0.K * 2, hs_1 = (size_t)HALF * g1.K * 2;
#define PG8_BH(x) (Epi::WIDE ? (x) / 4 : (x))
    const int nt_0 = g0.K / BK, nt_1 = g1.K / BK;
    const unsigned ldsw = (unsigned)wid * 1024u;
    const int aoff = lds_byte(wr * 64 + fr, fq * 8), boff = lds_byte(wc * 32 + fr, fq * 8);
#define PG8_SA(b, h) (((b) * 2 + (h)) * HTB)
#define PG8_SB(b, h) ((4 + (b) * 2 + (h)) * HTB)
#define PG8_STAGE(bufoff, gbase, voff) do { _Pragma("unroll") for (int _i = 0; _i < 2; ++_i) \
        __builtin_amdgcn_global_load_lds((const unsigned*)((const char*)(gbase) + (voff)[_i]), (PG8_LAS unsigned*)(lds + (bufoff) + ldsw + _i * 8192), 16, 0, 0); } while (0)
#define PG8_LDA(dst, b, h) do { _Pragma("unroll") for (int m = 0; m < 4; ++m) _Pragma("unroll") for (int k = 0; k < 2; ++k) dst[m][k] = *(const PG8_LAS bf16x8*)(lds + PG8_SA(b, h) + aoff + m * 2048 + k * 1024); } while (0)
#define PG8_LDB(dst, b, h) do { _Pragma("unroll") for (int n = 0; n < 2; ++n) _Pragma("unroll") for (int k = 0; k < 2; ++k) dst[n][k] = *(const PG8_LAS bf16x8*)(lds + PG8_SB(b, h) + boff + n * 2048 + k * 1024); } while (0)
#define PG8_MMA(ai, bj, At, Bt) do { __builtin_amdgcn_s_setprio(1); _Pragma("unroll") for (int m = 0; m < 4; ++m) _Pragma("unroll") for (int n = 0; n < 2; ++n) _Pragma("unroll") for (int k = 0; k < 2; ++k) \
        acc[ai][bj][m][n] = __builtin_amdgcn_mfma_f32_16x16x32_bf16(Bt[n][k], At[m][k], acc[ai][bj][m][n], 0, 0, 0); __builtin_amdgcn_s_setprio(0); } while (0)
#define PG8_WAIT_V(n) asm volatile("s_waitcnt vmcnt(" #n ")" ::: "memory")
#define PG8_WAIT_L(n) asm volatile("s_waitcnt lgkmcnt(" #n ")" ::: "memory")
#define PG8_BAR __builtin_amdgcn_s_barrier()
#define PG8_SCHED __builtin_amdgcn_sched_barrier(0)
    Unit cur, nxt; int ui = 0, s = 0;
    if (!S.next(0, cur)) return;
    f32x4 acc[2][2][4][2];
#pragma unroll
    for (int a = 0; a < 2; ++a)
#pragma unroll
        for (int b = 0; b < 2; ++b)
#pragma unroll
            for (int m = 0; m < 4; ++m)
#pragma unroll
                for (int n = 0; n < 2; ++n) acc[a][b][m][n] = (f32x4){0.f, 0.f, 0.f, 0.f};
    bf16x8 At[4][2], B0[2][2], B1[2][2];
    const char* cA = (const char*)g0.A + (size_t)cur.pm * 2 * hs_0; const char* cB = (const char*)g0.Bt + (size_t)cur.pn * 2 * hs_0;
    size_t hsC = hs_0; unsigned vAc[2] = {vA_0[0], vA_0[1]}, vBc[2] = {vB_0[0], vB_0[1]};
    PG8_STAGE(PG8_SB(0, 0), cB, vBc); PG8_STAGE(PG8_SB(0, 1), cB + PG8_BH(hsC), vBc); PG8_STAGE(PG8_SA(0, 0), cA, vAc); PG8_STAGE(PG8_SA(0, 1), cA + hsC, vAc);
    if (wr == 1) PG8_BAR;
    PG8_WAIT_V(2); PG8_BAR;
    PG8_STAGE(PG8_SB(1, 0), cB + kstep, vBc); PG8_STAGE(PG8_SA(1, 0), cA + kstep, vAc); PG8_STAGE(PG8_SB(1, 1), cB + PG8_BH(hsC) + kstep, vBc);
    PG8_WAIT_V(6); PG8_BAR;
    for (;;) {
        bool has_next = true; if (s == 1) has_next = S.next(ui + 1, nxt);
        const int npm = (s == 0) ? cur.pm : nxt.pm, npn = (s == 0) ? cur.pn : nxt.pn;
        const size_t hsN = has_next ? (s == 0 ? hs_1 : hs_0) : hsC;
        const char* nA = has_next ? (s == 0 ? (const char*)g1.A : (const char*)g0.A) + (size_t)npm * 2 * hsN : cA;
        const char* nB = has_next ? (s == 0 ? (const char*)g1.Bt : (const char*)g0.Bt) + (size_t)npn * 2 * hsN : cB;
        unsigned vAn[2], vBn[2];
#pragma unroll
        for (int i = 0; i < 2; ++i) { vAn[i] = has_next ? (s == 0 ? vA_1[i] : vA_0[i]) : vAc[i]; vBn[i] = has_next ? (s == 0 ? vB_1[i] : vB_0[i]) : vBc[i]; }
        const int nt = (s == 0) ? nt_0 : nt_1;
#pragma unroll 1
        for (int t = 0; t < nt; t += 2) {
            const bool last = (t == nt - 2);
            const char* a1 = cA + (size_t)(t + 1) * kstep;
            const char* a2 = last ? nA : cA + (size_t)(t + 2) * kstep; const char* b2 = last ? nB : cB + (size_t)(t + 2) * kstep;
            const char* a3 = a2 + kstep; const char* b3 = b2 + kstep;
            const size_t hs2 = last ? hsN : hsC;
            unsigned vA2[2], vB2[2];
#pragma unroll
            for (int i = 0; i < 2; ++i) { vA2[i] = last ? vAn[i] : vAc[i]; vB2[i] = last ? vBn[i] : vBc[i]; }
            PG8_LDB(B0, 0, 0); PG8_LDB(B1, 0, 1); PG8_SCHED; PG8_LDA(At, 0, 0); PG8_STAGE(PG8_SA(1, 1), a1 + hsC, vAc);
            PG8_WAIT_V(8); PG8_WAIT_L(0); PG8_BAR; PG8_MMA(0, 0, At, B0); PG8_MMA(0, 1, At, B1); PG8_BAR; PG8_SCHED;
            PG8_LDA(At, 0, 1); PG8_STAGE(PG8_SB(0, 0), b2, vB2); PG8_STAGE(PG8_SB(0, 1), b2 + PG8_BH(hs2), vB2); PG8_STAGE(PG8_SA(0, 0), a2, vA2);
            PG8_WAIT_V(8); PG8_WAIT_L(0); PG8_BAR; PG8_MMA(1, 0, At, B0); PG8_MMA(1, 1, At, B1); PG8_BAR; PG8_SCHED;
            PG8_LDB(B0, 1, 0); PG8_LDB(B1, 1, 1); PG8_SCHED; PG8_LDA(At, 1, 0); PG8_STAGE(PG8_SA(0, 1), a2 + hs2, vA2);
            PG8_WAIT_V(8); PG8_WAIT_L(0); PG8_BAR; PG8_MMA(0, 0, At, B0); PG8_MMA(0, 1, At, B1); PG8_BAR; PG8_SCHED;
            PG8_LDA(At, 1, 1); PG8_STAGE(PG8_SB(1, 0), b3, vB2); PG8_STAGE(PG8_SB(1, 1), b3 + PG8_BH(hs2), vB2); PG8_STAGE(PG8_SA(1, 0), a3, vA2);
            PG8_WAIT_V(8); PG8_WAIT_L(0); PG8_BAR; PG8_MMA(1, 0, At, B0); PG8_MMA(1, 1, At, B1); PG8_BAR; PG8_SCHED;
        }
        if (wr == 0) PG8_BAR;
        if (s == 0) E.mid(acc, cur, wr, wc, fr, fq); else E(acc, cur, wr, wc, fr, fq);
        if (!has_next) break;
        if (s == 1) {
#pragma unroll
            for (int a = 0; a < 2; ++a)
#pragma unroll
                for (int b = 0; b < 2; ++b)
#pragma unroll
                    for (int m = 0; m < 4; ++m)
#pragma unroll
                        for (int n = 0; n < 2; ++n) acc[a][b][m][n] = (f32x4){0.f, 0.f, 0.f, 0.f};
            cur = nxt; ++ui; }
        s ^= 1; cA = nA; cB = nB; hsC = hsN;
#pragma unroll
        for (int i = 0; i < 2; ++i) { vAc[i] = vAn[i]; vBc[i] = vBn[i]; }
        if (wr == 1) PG8_BAR;
    }
    PG8_WAIT_V(0);
    PG8_BAR;
#undef PG8_SA
#undef PG8_SB
#undef PG8_STAGE
#undef PG8_LDA
#undef PG8_LDB
#undef PG8_MMA
#undef PG8_WAIT_V
#undef PG8_WAIT_L
#undef PG8_BAR
#undef PG8_SCHED
#undef PG8_BH
}
}

constexpr int NWAVES = 8;
constexpr int NB = 32, SEQ = 2048, DM = 1024, MTOK = NB * SEQ, DEPTH = 4;
constexpr int INC = 5888, NE = 16, CAP = 256, DEX = 1024, MEXP = NE * NB * CAP;
constexpr float RMS_EPS = 1e-6f, LOG2E = 1.4426950408889634f;
constexpr float QSCALE = 0.125f * LOG2E;

constexpr size_t MiB = 1u << 20;
constexpr size_t WS_CTL = 0, CTL_ZERO_BYTES = 32768;
constexpr size_t WS_WIN = 1 * MiB;
constexpr size_t WS_WA = WS_WIN + (size_t)INC * DM * 2;
constexpr size_t WS_WB = WS_WA + (size_t)DM * 256 * 2;
constexpr size_t WS_WO = WS_WB + (size_t)DM * DM * 2;
constexpr size_t WS_WGU = WS_WO + (size_t)DM * DM * 2;
constexpr size_t WS_WD = WS_WGU + (size_t)NE * 2048 * DM * 2;
constexpr size_t WS_HN = WS_WD + (size_t)NE * DM * DEX * 2;
constexpr size_t WS_BIG = WS_HN + (size_t)MTOK * DM * 2;
constexpr size_t B_QA = 0, B_KA = 96 * MiB, B_VA = 192 * MiB, B_QW = 288 * MiB, B_KW = 416 * MiB, B_VW = 448 * MiB, B_G = 480 * MiB, B_OA = 736 * MiB, B_END = 768 * MiB;
constexpr size_t B_MERGED = 0;
constexpr size_t B_XE = 0, B_ACT = 256 * MiB, B_Y = 512 * MiB;
constexpr size_t WS_AFF = WS_BIG + B_END;
constexpr size_t WS_SEL = WS_AFF + (size_t)MTOK * NE * 4;
constexpr size_t WS_GATE = WS_SEL + (size_t)MTOK * NE * 4;
constexpr size_t WS_LSE = WS_GATE + (size_t)MEXP * 4;
constexpr size_t WS_IDX = WS_LSE + (size_t)3 * MTOK * 4 * 4;
constexpr size_t WS_HB = WS_IDX + (size_t)MEXP * 4;
constexpr size_t WS_END = WS_HB + (size_t)MTOK * DM * 2;
static_assert(WS_WIN % 256 == 0 && WS_WA % 256 == 0 && WS_WGU % 256 == 0 && WS_HN % 256 == 0 && WS_BIG % 256 == 0 && WS_AFF % 256 == 0, "alignment");
constexpr int CW_BAR = 4096;
constexpr int AROW_OFF = 131072;
constexpr int MISC_OFF = 147456, LDS_BYTES = 151552;

#define GAS __attribute__((address_space(1)))
#define LAS __attribute__((address_space(3)))
typedef unsigned short bf16;
typedef unsigned v4u __attribute__((ext_vector_type(4)));
typedef unsigned v2u __attribute__((ext_vector_type(2)));
typedef float f32x4 __attribute__((ext_vector_type(4)));
typedef float f32x16 __attribute__((ext_vector_type(16)));
typedef short bf16x8 __attribute__((ext_vector_type(8)));
#define LDS_WAIT() asm volatile("s_waitcnt lgkmcnt(0)" ::: "memory")
#define VM_WAIT() asm volatile("s_waitcnt vmcnt(0)" ::: "memory")

#define XB_TMO      128
#define XB_XCNT(j)  (256  + 64 * (j))
#define XB_XSUB(j)  (1280 + 64 * (j))
#define XB_XGEN(j)  (2304 + 64 * (j))
#define XB_TOP      3328
#define XB_TOPGEN   3392
#define XCD_BAR_WORDS 3456
#define XB_SPIN_CAP (1u << 18)

__device__ __forceinline__ unsigned xb_ld(unsigned* p)              { return __hip_atomic_load(p, __ATOMIC_RELAXED, __HIP_MEMORY_SCOPE_AGENT); }
__device__ __forceinline__ unsigned xb_add(unsigned* p, unsigned v) { return __hip_atomic_fetch_add(p, v, __ATOMIC_RELAXED, __HIP_MEMORY_SCOPE_AGENT); }
__device__ __forceinline__ unsigned xb_xcc_id() { return (unsigned)__builtin_amdgcn_s_getreg((3 << 11) | 20) & 0xFu; }
#define XB_SPIN(cond, bar) do { unsigned _sp = 0; while (cond) { __builtin_amdgcn_s_sleep(1); \
    if ((++_sp & 255u) == 0u) { if (xb_ld(&(bar)[XB_TMO])) break; if (_sp > XB_SPIN_CAP) { atomicAdd(&(bar)[XB_TMO], 1u); break; } } } } while (0)

__device__ __forceinline__ int xb_lane() { unsigned z = 0u; asm volatile("" : "+v"(z)); return (int)__builtin_amdgcn_mbcnt_hi(~0u, __builtin_amdgcn_mbcnt_lo(~0u, z)); }
struct XcdBarrier {
    int w;
    unsigned* bar; unsigned x;
    volatile LAS unsigned* st;
};

__device__ __forceinline__ XcdBarrier xcd_barrier_post(unsigned* bar, volatile LAS unsigned* st, int wave) {
    XcdBarrier b; b.w = wave; b.bar = bar; b.x = xb_xcc_id(); b.st = st;
    if (wave == 0 && xb_lane() == 0) (void)xb_add(&bar[XB_XCNT(b.x)], 1u);
    return b;
}
__device__ __forceinline__ void xcd_barrier_complete(unsigned* bar, unsigned x, unsigned& nloc, unsigned& nx) {
    const unsigned G = gridDim.x * gridDim.y * gridDim.z;
    unsigned sum, cnt, mine, sp = 0u;
    for (;;) {
        sum = 0u; cnt = 0u; mine = 0u;
#pragma unroll
        for (unsigned j = 0; j < 16; ++j) { const unsigned c = xb_ld(&bar[XB_XCNT(j)]); sum += c; cnt += (c > 0u) ? 1u : 0u; mine = (j == x) ? c : mine; }
        if (sum == G) break;
        __builtin_amdgcn_s_sleep(1);
        if ((++sp & 255u) == 0u) { if (xb_ld(&bar[XB_TMO])) break; if (sp > XB_SPIN_CAP) { atomicAdd(&bar[XB_TMO], 1u); break; } }
    }
    nloc = mine > 0u ? mine : 1u; nx = cnt > 0u ? cnt : 1u;
}

__device__ __forceinline__ void xcd_barrier(const XcdBarrier& b) {
    asm volatile("s_waitcnt vmcnt(0)" ::: "memory");
    __syncthreads();
    if (b.w == 0 && xb_lane() == 0) {
        unsigned* bar = b.bar;
        __builtin_amdgcn_s_waitcnt(0);
        unsigned nloc = b.st[0], nx = b.st[1];
        if (nloc == 0u) { xcd_barrier_complete(bar, b.x, nloc, nx); b.st[0] = nloc; b.st[1] = nx; }
        const unsigned old = xb_add(&bar[XB_XSUB(b.x)], 1u);
        const unsigned gen = old / nloc;
        if (old + 1u == (gen + 1u) * nloc) {
            __builtin_amdgcn_fence(__ATOMIC_RELEASE, "agent");
            asm volatile("s_waitcnt vmcnt(0)" ::: "memory");
            const unsigned og = xb_add(&bar[XB_TOP], 1u);
            const unsigned tg = og / nx;
            if (og + 1u == (tg + 1u) * nx) xb_add(&bar[XB_TOPGEN], 1u);
            else XB_SPIN(xb_ld(&bar[XB_TOPGEN]) == tg, bar);
            __builtin_amdgcn_fence(__ATOMIC_ACQUIRE, "agent");
            xb_add(&bar[XB_XGEN(b.x)], 1u);
            asm volatile("s_waitcnt vmcnt(0)" ::: "memory");
        } else {
            XB_SPIN(xb_ld(&bar[XB_XGEN(b.x)]) == gen, bar);
            __builtin_amdgcn_fence(__ATOMIC_ACQUIRE, "agent");
            asm volatile("s_waitcnt vmcnt(0)" ::: "memory");
        }
    }
    __syncthreads();
}

struct Frame {
    LAS unsigned char* lds;
    int tid, lane, wave, gw;
};
constexpr int PTAB_OFF = MISC_OFF + 256;
__device__ __forceinline__ unsigned long long ptab_get(LAS unsigned char* lds, int i) {
    LAS unsigned char* base = lds + PTAB_OFF; asm volatile("" : "+v"(base));
    const unsigned long long v = ((const volatile LAS unsigned long long*)base)[i];
    const unsigned lo = __builtin_amdgcn_readfirstlane((unsigned)v), hi = __builtin_amdgcn_readfirstlane((unsigned)(v >> 32));
    return ((unsigned long long)hi << 32) | lo;
}
#define P_IN(i) ((const float*)(const GAS float*)ptab_get(F.lds, (i)))
#define P_OUT ((float*)(GAS float*)ptab_get(F.lds, 14))
#define P_WS ((unsigned char*)(GAS unsigned char*)ptab_get(F.lds, 15))
__device__ __forceinline__ Frame make_frame(LAS unsigned char* lds, int wave_s) { Frame F; F.lds = lds; int bx = blockIdx.x; asm volatile("" : "+s"(bx));
    int ln = xb_lane(); asm volatile("" : "+v"(ln));
    F.lane = ln; F.wave = wave_s; F.tid = wave_s * 64 + ln; F.gw = bx * NWAVES + F.wave; return F; }
__device__ __forceinline__ float shx(float v, int o, int lane) { return __builtin_bit_cast(float, __builtin_amdgcn_ds_bpermute((lane ^ o) << 2, __builtin_bit_cast(int, v))); }
__device__ __forceinline__ unsigned shrel(unsigned v, int d, int lane) { return (unsigned)__builtin_amdgcn_ds_bpermute(((lane + d) & 63) << 2, (int)v); }
__device__ __forceinline__ float wave_sum(float v, int lane) {
#pragma unroll
    for (int o = 1; o < 64; o <<= 1) v += shx(v, o, lane);
    return v;
}
template <bool SCALE = false>
__device__ __forceinline__ void transpose_item(const float* W, int K, int N, bf16* dst, LAS float* scr, int k0, int n0, int lane, const float* gk = nullptr) {
    float tv[32];
#pragma unroll
    for (int i = 0; i < 32; ++i) { const int kk = 2 * i + (lane >> 5); tv[i] = W[(size_t)(k0 + kk) * N + n0 + (lane & 31)]; }
#pragma unroll
    for (int i = 0; i < 32; ++i) { const int kk = 2 * i + (lane >> 5); scr[kk * 33 + (lane & 31)] = tv[i]; }
    LDS_WAIT(); asm volatile("" ::: "memory");
    const int c = lane & 7;
    f32x4 ga = {1.f, 1.f, 1.f, 1.f}, gb = {1.f, 1.f, 1.f, 1.f};
    if (SCALE) { ga = *(const f32x4*)(gk + k0 + 8 * c); gb = *(const f32x4*)(gk + k0 + 8 * c + 4); }
#pragma unroll
    for (int j = 0; j < 4; ++j) { const int n = (lane >> 3) + 8 * j; const LAS float* s = scr + (8 * c) * 33 + n;
        v4u o; o.x = pk2bf(s[0 * 33] * ga.x, s[1 * 33] * ga.y); o.y = pk2bf(s[2 * 33] * ga.z, s[3 * 33] * ga.w); o.z = pk2bf(s[4 * 33] * gb.x, s[5 * 33] * gb.y); o.w = pk2bf(s[6 * 33] * gb.z, s[7 * 33] * gb.w);
        *(GAS v4u*)(dst + (size_t)n * K + k0 + 8 * c) = o; }
    LDS_WAIT(); asm volatile("" ::: "memory");
}
__device__ __forceinline__ float f8clamp(float x) { return fminf(fmaxf(x, -440.f), 440.f); }
__device__ __forceinline__ unsigned pk4f8(float a, float b, float c, float d) {
    int w = __builtin_amdgcn_cvt_pk_fp8_f32(f8clamp(a), f8clamp(b), 0, false); w = __builtin_amdgcn_cvt_pk_fp8_f32(f8clamp(c), f8clamp(d), w, true); return (unsigned)w; }
template <bool SCALE = false>
__device__ __forceinline__ void transpose_item8(const float* W, int K, int N, unsigned char* dst8, LAS float* scr, int k0, int n0, int lane, float mul, const float* gk = nullptr) {
    float tv[32];
#pragma unroll
    for (int i = 0; i < 32; ++i) { const int kk = 2 * i + (lane >> 5); tv[i] = W[(size_t)(k0 + kk) * N + n0 + (lane & 31)]; }
#pragma unroll
    for (int i = 0; i < 32; ++i) { const int kk = 2 * i + (lane >> 5); scr[kk * 33 + (lane & 31)] = tv[i]; }
    LDS_WAIT(); asm volatile("" ::: "memory");
    const int c = lane & 7;
    f32x4 ga = {mul, mul, mul, mul}, gb = {mul, mul, mul, mul};
    if (SCALE) { ga = *(const f32x4*)(gk + k0 + 8 * c) * mul; gb = *(const f32x4*)(gk + k0 + 8 * c + 4) * mul; }
#pragma unroll
    for (int j = 0; j < 4; ++j) { const int n = (lane >> 3) + 8 * j; const LAS float* s = scr + (8 * c) * 33 + n;
        v2u o; o.x = pk4f8(s[0 * 33] * ga.x, s[1 * 33] * ga.y, s[2 * 33] * ga.z, s[3 * 33] * ga.w); o.y = pk4f8(s[4 * 33] * gb.x, s[5 * 33] * gb.y, s[6 * 33] * gb.z, s[7 * 33] * gb.w);
        *(GAS v2u*)(dst8 + (size_t)n * K + k0 + 8 * c) = o; }
    LDS_WAIT(); asm volatile("" ::: "memory");
}
__device__ __forceinline__ void convert_weights(Frame& F, int l) {
    LAS float* scr = (LAS float*)(F.lds + F.wave * 8448);
    const int NGW = 256 * NWAVES;
    unsigned char* ws = P_WS;
    bf16* WinT = (bf16*)(ws + WS_WIN); bf16* WaT = (bf16*)(ws + WS_WA); bf16* WbT = (bf16*)(ws + WS_WB); bf16* WoT = (bf16*)(ws + WS_WO);
    bf16* WguT = (bf16*)(ws + WS_WGU); bf16* WdT = (bf16*)(ws + WS_WD);
    const float* w_in = P_IN(2) + (size_t)l * DM * INC; const float* w_a = P_IN(3) + (size_t)l * 256 * DM; const float* w_b = P_IN(4) + (size_t)l * DM * DM;
    const float* w_o = P_IN(7) + (size_t)l * DM * DM; const float* g2 = P_IN(8) + (size_t)l * DM; const float* g1n = P_IN(1) + (size_t)l * DM;
    const float* w_g = P_IN(10) + (size_t)l * NE * DM * DEX; const float* w_u = P_IN(11) + (size_t)l * NE * DM * DEX; const float* w_d = P_IN(12) + (size_t)l * NE * DEX * DM;
    constexpr int I_IN = 16 * (INC / 32), I_A = 4 * 32, I_B = 16 * 32, I_O = 16 * 32, I_E = NE * 16 * 32;
    constexpr int NITEMS = I_IN + I_A + I_B + I_O + 3 * I_E;
    for (int it = F.gw; it < NITEMS; it += NGW) {
        int r = it;
        if (r < I_IN) { const int nb = r % (INC / 32), kb = r / (INC / 32), n0 = 32 * nb; int drow = n0;
            if (n0 >= 3840) { const int gc = n0 - 3840, br = gc >> 10, cc = gc & 1023; drow = 3840 + (cc >> 7) * 256 + ((cc & 127) >> 5) * 64 + br * 32; }
            if (n0 >= 3840) transpose_item8<true>(w_in, DM, INC, (unsigned char*)(WinT + (size_t)3840 * DM) + (size_t)(drow - 3840) * DM, scr, 64 * kb, n0, F.lane, 64.0f, g1n);
            else transpose_item<true>(w_in, DM, INC, WinT + (size_t)drow * DM, scr, 64 * kb, n0, F.lane, g1n);
            continue; } r -= I_IN;
        if (r < I_A) { const int nb = r % 32, kb = r / 32; transpose_item(w_a, 256, DM, WaT + (size_t)(32 * nb) * 256, scr, 64 * kb, 32 * nb, F.lane); continue; } r -= I_A;
        if (r < I_B) { const int nb = r % 32, kb = r / 32; transpose_item(w_b, DM, DM, WbT + (size_t)(32 * nb) * DM, scr, 64 * kb, 32 * nb, F.lane); continue; } r -= I_B;
        if (r < I_O) { const int nb = r % 32, kb = r / 32; transpose_item8(w_o, DM, DM, (unsigned char*)WoT + (size_t)(32 * nb) * DM, scr, 64 * kb, 32 * nb, F.lane, 64.0f); continue; } r -= I_O;
        if (r < 2 * I_E) { const int up = r >= I_E; if (up) r -= I_E; const int e = r / 512, loc = r % 512, nb = loc % 32, kb = loc / 32, f0 = 32 * nb;
            const float* W = (up ? w_u : w_g) + (size_t)e * DM * DEX;
            transpose_item8<true>(W, DM, DEX, (unsigned char*)WguT + ((size_t)e * 2048 + (f0 >> 7) * 256 + (up ? 128 : 0) + (f0 & 127)) * DM, scr, 64 * kb, f0, F.lane, 64.0f, g2); continue; } r -= 2 * I_E;
        { const int e = r / 512, loc = r % 512, nb = loc % 32, kb = loc / 32;
            transpose_item8(w_d + (size_t)e * DEX * DM, DEX, DM, (unsigned char*)WdT + ((size_t)e * 1024 + 32 * nb) * DEX, scr, 64 * kb, 32 * nb, F.lane, 64.0f); }
    }
}
__device__ __forceinline__ void unpk8(const v4u w, float (&v)[8]) { v[0] = bflo(w.x); v[1] = bfhi(w.x); v[2] = bflo(w.y); v[3] = bfhi(w.y); v[4] = bflo(w.z); v[5] = bfhi(w.z); v[6] = bflo(w.w); v[7] = bfhi(w.w); }
__device__ __forceinline__ v4u pk8(const float (&v)[8]) { v4u w; w.x = pk2bf(v[0], v[1]); w.y = pk2bf(v[2], v[3]); w.z = pk2bf(v[4], v[5]); w.w = pk2bf(v[6], v[7]); return w; }
template <bool XIN, bool COMBINE, bool FINAL>
__device__ __forceinline__ void norm_rows(Frame& F, const float* xin, bf16* hb, const float* gain, float* rsv, float* out, unsigned char* hn8 = nullptr) {
    const int NGW = 256 * NWAVES;
    unsigned char* ws = P_WS;
    const int* sel = (const int*)(ws + WS_SEL); const bf16* Y = (const bf16*)(ws + WS_BIG + B_Y);
    float gv[2][8];
#pragma unroll
    for (int j = 0; j < 2; ++j) { const f32x4 a = *(const f32x4*)(gain + (64 * j + F.lane) * 8), b = *(const f32x4*)(gain + (64 * j + F.lane) * 8 + 4);
        gv[j][0] = a.x; gv[j][1] = a.y; gv[j][2] = a.z; gv[j][3] = a.w; gv[j][4] = b.x; gv[j][5] = b.y; gv[j][6] = b.z; gv[j][7] = b.w; }
    constexpr int NR = 4;
    for (int m0 = F.gw; m0 < MTOK; m0 += NR * NGW) {
        float v[NR][2][8]; int sv[NR];
#pragma unroll
        for (int rr = 0; rr < NR; ++rr) { const int m = m0 + rr * NGW;
            if (COMBINE) sv[rr] = sel[(size_t)m * NE + (F.lane & 15)];
            if (XIN) {
#pragma unroll
                for (int j = 0; j < 2; ++j) { const f32x4 a = *(const f32x4*)(xin + (size_t)m * DM + (64 * j + F.lane) * 8), b = *(const f32x4*)(xin + (size_t)m * DM + (64 * j + F.lane) * 8 + 4);
                    v[rr][j][0] = a.x; v[rr][j][1] = a.y; v[rr][j][2] = a.z; v[rr][j][3] = a.w; v[rr][j][4] = b.x; v[rr][j][5] = b.y; v[rr][j][6] = b.z; v[rr][j][7] = b.w; }
            } else {
#pragma unroll
                for (int j = 0; j < 2; ++j) unpk8(*(const v4u*)(hb + (size_t)m * DM + (64 * j + F.lane) * 8), v[rr][j]);
            } }
        if (COMBINE) {
            unsigned msk[NR];
#pragma unroll
            for (int rr = 0; rr < NR; ++rr) msk[rr] = (unsigned)(__builtin_amdgcn_ballot_w64(sv[rr] >= 0) & 0xffffull);
            unsigned any = 0u;
#pragma unroll
            for (int rr = 0; rr < NR; ++rr) any |= msk[rr];
            while (any != 0u) {
                v4u yv[NR][2]; float wgt[NR];
#pragma unroll
                for (int rr = 0; rr < NR; ++rr) { const int m = m0 + rr * NGW, b = m >> 11; const bool has = msk[rr] != 0u;
                    const int e = has ? __builtin_ctz(msk[rr]) : 0; const int r = has ? __builtin_amdgcn_readlane(sv[rr], e) : 0;
                    const bf16* yr = Y + ((size_t)(e * NB + b) * CAP + r) * DM; wgt[rr] = has ? 1.0f : 0.0f; msk[rr] &= msk[rr] - 1u;
#pragma unroll
                    for (int j = 0; j < 2; ++j) yv[rr][j] = *(const v4u*)(yr + (64 * j + F.lane) * 8); }
                any = 0u;
#pragma unroll
                for (int rr = 0; rr < NR; ++rr) { any |= msk[rr];
#pragma unroll
                    for (int j = 0; j < 2; ++j) { float y[8]; unpk8(yv[rr][j], y);
#pragma unroll
                        for (int i = 0; i < 8; ++i) v[rr][j][i] += wgt[rr] * y[i]; } }
            }
        }
#pragma unroll
        for (int rr = 0; rr < NR; ++rr) { const int m = m0 + rr * NGW;
            if ((XIN || COMBINE) && !FINAL) {
#pragma unroll
                for (int j = 0; j < 2; ++j) *(v4u*)(hb + (size_t)m * DM + (64 * j + F.lane) * 8) = pk8(v[rr][j]);
            }
            float ss = 0.f;
#pragma unroll
            for (int j = 0; j < 2; ++j)
#pragma unroll
                for (int i = 0; i < 8; ++i) ss += v[rr][j][i] * v[rr][j][i];
            const float rs = 1.0f / sqrtf(wave_sum(ss, F.lane) * (1.0f / DM) + RMS_EPS);
            if (FINAL) {
#pragma unroll
                for (int j = 0; j < 2; ++j) { float o[8];
#pragma unroll
                    for (int i = 0; i < 8; ++i) o[i] = v[rr][j][i] * rs * gv[j][i];
                    float* op = out + (size_t)m * DM + (64 * j + F.lane) * 8; *(f32x4*)op = (f32x4){o[0], o[1], o[2], o[3]}; *(f32x4*)(op + 4) = (f32x4){o[4], o[5], o[6], o[7]}; }
            } else { if (F.lane == 0) rsv[m] = rs;
                const float rs16 = rs * 16.0f;
#pragma unroll
                for (int j = 0; j < 2; ++j) { v2u o; o.x = pk4f8(v[rr][j][0] * rs16, v[rr][j][1] * rs16, v[rr][j][2] * rs16, v[rr][j][3] * rs16); o.y = pk4f8(v[rr][j][4] * rs16, v[rr][j][5] * rs16, v[rr][j][6] * rs16, v[rr][j][7] * rs16);
                    *(v2u*)(hn8 + (size_t)m * DM + (64 * j + F.lane) * 8) = o; } } }
    }
}
constexpr int RT_PITCH = 2048 + 16;
__device__ __forceinline__ void norm_router(Frame& F, const bf16* hb, const float* gain, const float* wr, float* rsv, float* aff, unsigned char* hn8) {
    LAS unsigned char* whi = F.lds; LAS unsigned char* wlo = F.lds + 16 * RT_PITCH; LAS float* gl = (LAS float*)(F.lds + 32 * RT_PITCH);
    { const float g0 = gain[F.tid], g1 = gain[F.tid + NWAVES * 64]; gl[F.tid] = g0; gl[F.tid + NWAVES * 64] = g1; }
    __syncthreads();
    { f32x4 wv[8];
#pragma unroll
      for (int j = 0; j < 8; ++j) wv[j] = *(const f32x4*)(wr + 4 * (F.tid + j * NWAVES * 64));
      asm volatile("" ::: "memory");
#pragma unroll
      for (int j = 0; j < 8; ++j) { const int i0 = 4 * (F.tid + j * NWAVES * 64), k = i0 >> 4, e0 = i0 & 15; const float g = gl[k];
#pragma unroll
          for (int t = 0; t < 4; ++t) { const float w = wv[j][t] * g; const unsigned hi = pk2bf(w, 0.f) & 0xffffu; const float rem = w - bflo(hi);
              *(LAS unsigned short*)(whi + (e0 + t) * RT_PITCH + k * 2) = (unsigned short)hi; *(LAS unsigned short*)(wlo + (e0 + t) * RT_PITCH + k * 2) = (unsigned short)(pk2bf(rem, 0.f) & 0xffffu); } } }
    __syncthreads();
    const int NGW = 256 * NWAVES, r16 = F.lane & 15, q = F.lane >> 4;
    for (int grp = F.gw; grp < MTOK / 16; grp += NGW) {
        const size_t row = (size_t)grp * 16 + r16;
        v4u xs[32];
#pragma unroll
        for (int s = 0; s < 16; ++s) { const v4u* p = (const v4u*)(hb + row * DM + 64 * s + 16 * q); xs[2 * s] = p[0]; xs[2 * s + 1] = p[1]; }
        f32x4 acc = {0.f, 0.f, 0.f, 0.f}; float ss = 0.f;
#pragma unroll
        for (int s = 0; s < 16; ++s) {
#pragma unroll
            for (int h2 = 0; h2 < 2; ++h2) { const bf16x8 a = __builtin_bit_cast(bf16x8, xs[2 * s + h2]);
                const bf16x8 bh = *(const LAS bf16x8*)(whi + r16 * RT_PITCH + (64 * s + 16 * q + 8 * h2) * 2), bl = *(const LAS bf16x8*)(wlo + r16 * RT_PITCH + (64 * s + 16 * q + 8 * h2) * 2);
                acc = __builtin_amdgcn_mfma_f32_16x16x32_bf16(a, bh, acc, 0, 0, 0); acc = __builtin_amdgcn_mfma_f32_16x16x32_bf16(a, bl, acc, 0, 0, 0);
                float x[8]; unpk8(xs[2 * s + h2], x);
#pragma unroll
                for (int i = 0; i < 8; ++i) ss += x[i] * x[i]; }
            asm volatile("" ::: "memory"); }
        ss += shx(ss, 16, F.lane); ss += shx(ss, 32, F.lane);
        const float rs = 1.0f / sqrtf(ss * (1.0f / DM) + RMS_EPS);
        float lg[4];
#pragma unroll
        for (int r = 0; r < 4; ++r) { const float rr = __builtin_bit_cast(float, __builtin_amdgcn_ds_bpermute((4 * q + r) << 2, __builtin_bit_cast(int, rs))); lg[r] = acc[r] * rr; }
#pragma unroll
        for (int r = 0; r < 4; ++r) { float mx = lg[r];
#pragma unroll
            for (int o = 1; o < 16; o <<= 1) mx = fmaxf(mx, shx(mx, o, F.lane));
            const float ex = __expf(lg[r] - mx); float sm = ex;
#pragma unroll
            for (int o = 1; o < 16; o <<= 1) sm += shx(sm, o, F.lane);
            aff[((size_t)grp * 16 + 4 * q + r) * NE + r16] = ex / sm; }
        if (q == 0) rsv[row] = rs;
        { const float rs16 = rs * 16.0f;
#pragma unroll
          for (int s = 0; s < 16; ++s) { v4u o;
#pragma unroll
              for (int h2 = 0; h2 < 2; ++h2) { v4u t = xs[2 * s + h2]; asm volatile("" : "+v"(t));
                  float x[8]; unpk8(t, x);
                  o[2 * h2] = pk4f8(x[0] * rs16, x[1] * rs16, x[2] * rs16, x[3] * rs16); o[2 * h2 + 1] = pk4f8(x[4] * rs16, x[5] * rs16, x[6] * rs16, x[7] * rs16); }
              *(v4u*)(hn8 + row * DM + 64 * s + 16 * q) = o;
              asm volatile("" ::: "memory"); } }
    }
}
__device__ __forceinline__ void topk_gather(Frame& F, const float* aff, const float* rsv, int* sel, float* gatev, int* idxg) {
    LAS unsigned* hist = (LAS unsigned*)F.lds;
    volatile LAS unsigned* st = (volatile LAS unsigned*)(F.lds + 1024);
    for (int u = blockIdx.x; u < NB * NE; u += 256) {
        const int b = u >> 4, e = u & 15;
        unsigned bits[4];
#pragma unroll
        for (int q = 0; q < 4; ++q) bits[q] = __float_as_uint(aff[((size_t)b * SEQ + 4 * F.tid + q) * NE + e]);
        const f32x4 rs4 = *(const f32x4*)(rsv + (size_t)b * SEQ + 4 * F.tid);
        unsigned prefix = 0u, kk = CAP;
#pragma unroll 1
        for (int pass = 0; pass < 4; ++pass) {
            const int shift = 24 - 8 * pass;
            if (F.tid < 256) hist[F.tid] = 0u;
            __syncthreads();
#pragma unroll
            for (int q = 0; q < 4; ++q) { const bool in = (pass == 0) || ((bits[q] >> (shift + 8)) == prefix); if (in) atomicAdd((unsigned*)&hist[(bits[q] >> shift) & 255u], 1u); }
            __syncthreads();
            if (F.wave == 0) {
                const unsigned c0 = hist[4 * F.lane], c1 = hist[4 * F.lane + 1], c2 = hist[4 * F.lane + 2], c3 = hist[4 * F.lane + 3];
                unsigned incl = c0 + c1 + c2 + c3;
#pragma unroll
                for (int o = 1; o < 64; o <<= 1) { const unsigned v = shrel(incl, o, F.lane); if (F.lane + o < 64) incl += v; }
                unsigned cum = incl - (c0 + c1 + c2 + c3);
                int found = -1; unsigned above = 0u;
                if (cum < kk && cum + c3 >= kk) { found = 3; above = cum; } cum += c3;
                if (cum < kk && cum + c2 >= kk) { found = 2; above = cum; } cum += c2;
                if (cum < kk && cum + c1 >= kk) { found = 1; above = cum; } cum += c1;
                if (cum < kk && cum + c0 >= kk) { found = 0; above = cum; }
                if (found >= 0) { st[0] = (prefix << 8) | (unsigned)(4 * F.lane + found); st[1] = kk - above; }
            }
            __syncthreads();
            prefix = st[0]; kk = st[1];
        }
        const unsigned T = prefix;
        unsigned ngt = 0u, neq = 0u;
#pragma unroll
        for (int q = 0; q < 4; ++q) { ngt += bits[q] > T ? 1u : 0u; neq += bits[q] == T ? 1u : 0u; }
        unsigned pk = ngt | (neq << 16), inc = pk;
#pragma unroll
        for (int o = 1; o < 64; o <<= 1) { const unsigned v = shrel(inc, -o, F.lane); if (F.lane >= o) inc += v; }
        if (F.lane == 63) st[8 + F.wave] = inc;
        __syncthreads();
        unsigned base = 0u;
#pragma unroll
        for (int w = 0; w < NWAVES; ++w) base += (w < F.wave) ? st[8 + w] : 0u;
        const unsigned excl = base + inc - pk;
        unsigned pgt = excl & 0xffffu, peq = excl >> 16;
#pragma unroll
        for (int q = 0; q < 4; ++q) { const int i = 4 * F.tid + q; const bool g = bits[q] > T, eq = bits[q] == T; const bool keep = g || (eq && peq < kk);
            const unsigned slot = pgt + (peq < kk ? peq : kk);
            if (keep) { idxg[(size_t)(e * NB + b) * CAP + slot] = (int)((unsigned)(b * SEQ + i) | ((unsigned)__builtin_bit_cast(unsigned short, (_Float16)rs4[q]) << 16)); gatev[(size_t)(e * NB + b) * CAP + slot] = __uint_as_float(bits[q]); }
            sel[((size_t)b * SEQ + i) * NE + e] = keep ? (int)slot : -1;
            pgt += g ? 1u : 0u; peq += eq ? 1u : 0u; }
        __syncthreads();
    }
}


constexpr int ATT_KPITCH = 144, ATT_VT_OFF = 512 * ATT_KPITCH, ATT_VPITCH = 1040, ATT_SINK_OFF = MISC_OFF + 1024;
static_assert(ATT_VT_OFF + 64 * ATT_VPITCH <= MISC_OFF, "attention LDS");
#ifndef ATT_JT_UNROLL
#define ATT_JT_UNROLL 1
#endif
struct ChunkP { const bf16* K; const bf16* V; int ldkv, tok0, cstep, r, L, nseg, qs, i0; };
template <int W>
__device__ __forceinline__ void attn_issue(const ChunkP& p, int tid, v4u (&kreg)[8], v4u (&vreg)[2][4]) {
    asm volatile("" : "+v"(tid));
    const int KS = p.qs + 2 * W, nrows = p.nseg * KS, Lm1 = p.L - 1;
    constexpr int NKP = 8;
#pragma unroll
    for (int it = 0; it < NKP; ++it) { const int pc = tid + it * NWAVES * 64, row0 = pc >> 3, ch = pc & 7, row = row0 < nrows ? row0 : nrows - 1, s = row >= KS ? 1 : 0, rho = row - s * KS;
        int j = p.i0 - W + rho; j = j < 0 ? 0 : j; j = j > Lm1 ? Lm1 : j;
        kreg[it] = *(const v4u*)(p.K + (size_t)(p.tok0 + s * p.cstep + p.r * j) * p.ldkv + ch * 8); }
#pragma unroll
    for (int it = 0; it < 2; ++it) { const int t = tid + it * NWAVES * 64, r4 = t >> 3, ch = t & 7, rowa = 4 * r4, row0 = rowa < nrows ? rowa : nrows - 4, s = row0 >= KS ? 1 : 0, rho = row0 - s * KS, j0 = p.i0 - W + rho;
#pragma unroll
        for (int q = 0; q < 4; ++q) { int j = j0 + q; j = j < 0 ? 0 : j; j = j > Lm1 ? Lm1 : j;
            vreg[it][q] = *(const v4u*)(p.V + (size_t)(p.tok0 + s * p.cstep + p.r * j) * p.ldkv + ch * 8); } }
}
__device__ __forceinline__ void attn_loadq(const Frame& F, const ChunkP& p, const bf16* Q, int ldq, bf16x8 (&qf)[4]) {
    int lane_ = F.lane; asm volatile("" : "+v"(lane_));
    const int wq = F.wave * 32, sidx = (wq >= p.qs) ? 1 : 0, qo = wq - sidx * p.qs, ql = lane_ & 31, hh = lane_ >> 5, qi = p.i0 + qo + ql;
    const bf16* q0 = Q + (size_t)(p.tok0 + sidx * p.cstep + p.r * qi) * ldq;
#pragma unroll
    for (int ks = 0; ks < 4; ++ks) qf[ks] = *(const bf16x8*)(q0 + 16 * ks + 8 * hh);
}
template <int W>
__device__ __forceinline__ void attn_commit(Frame& F, const ChunkP& p, const v4u (&kreg)[8], const v4u (&vreg)[2][4]) {
    int tid = F.tid; asm volatile("" : "+v"(tid));
    const int KS = p.qs + 2 * W, nrows = p.nseg * KS;
    LAS unsigned char* ldsK = F.lds; LAS unsigned char* ldsV = F.lds + ATT_VT_OFF;
    constexpr int NKP = 8;
#pragma unroll
    for (int it = 0; it < NKP; ++it) { const int pc = tid + it * NWAVES * 64, row = pc >> 3, ch = pc & 7;
        if (pc < nrows * 8) *(LAS v4u*)(ldsK + row * ATT_KPITCH + ch * 16) = kreg[it]; }
#pragma unroll
    for (int it = 0; it < 2; ++it) { const int t = tid + it * NWAVES * 64, r4 = t >> 3, ch = t & 7, row0 = 4 * r4;
        if (t < nrows * 2) {
            const int kap = row0 & 31, slot = (kap >> 4) * 16 + ((kap >> 2) & 1) * 8 + ((kap >> 3) & 1) * 4, pos = (row0 & ~31) + slot;
#pragma unroll
            for (int w = 0; w < 4; ++w) {
                v2u lo, hi;
                lo.x = (vreg[it][0][w] & 0xffffu) | (vreg[it][1][w] << 16); lo.y = (vreg[it][2][w] & 0xffffu) | (vreg[it][3][w] << 16);
                hi.x = (vreg[it][0][w] >> 16) | (vreg[it][1][w] & 0xffff0000u); hi.y = (vreg[it][2][w] >> 16) | (vreg[it][3][w] & 0xffff0000u);
                *(LAS v2u*)(ldsV + (ch * 8 + 2 * w) * ATT_VPITCH + pos * 2) = lo;
                *(LAS v2u*)(ldsV + (ch * 8 + 2 * w + 1) * ATT_VPITCH + pos * 2) = hi;
            } } }
}
#ifndef ATT_THR
#define ATT_THR 8.0f
#endif
template <int W, int NH, bool SINK, bool WRITE_LSE>
__device__ __forceinline__ void attn_compute(Frame& F, const ChunkP& p, bf16* Q, int ldq, long odelta, float* lse, float slope1, const float* sinkp, int hbase, bf16x8 (&qf)[4]) {
    constexpr int NJT = 2 * W / 32 + 1, JC = W / 32;
    const int KS = p.qs + 2 * W, L = p.L, i0 = p.i0;
    LAS unsigned char* ldsK = F.lds; LAS unsigned char* ldsV = F.lds + ATT_VT_OFF;
    const int wq = F.wave * 32, sidx = (wq >= p.qs) ? 1 : 0, qo = wq - sidx * p.qs, segbase = sidx * KS;
    int lane_ = F.lane; asm volatile("" : "+v"(lane_));
    const int ql = lane_ & 31, hh = lane_ >> 5;
    const int qi = i0 + qo + ql;
    const size_t qtok = (size_t)(p.tok0 + sidx * p.cstep + p.r * qi);
    const float flo = (float)((-qi > -W) ? -qi : -W), fhi = (float)((L - 1 - qi < W) ? (L - 1 - qi) : W);
#pragma unroll 1
    for (int g = 0; g < NH; ++g) {
        bf16* qptr = Q + qtok * ldq + g * 64;
        f32x16 O0, O1;
        float m, l;
#ifdef PRB_REP
        constexpr int nrep = (NH == PRB_NH) ? PRB_REP : 1;
#pragma unroll 1
        for (int rep = 0; rep < nrep; ++rep) {
        asm volatile("" ::: "memory");
#endif
#pragma unroll
        for (int i = 0; i < 16; ++i) { O0[i] = 0.f; O1[i] = 0.f; }
        const float sl = (NH == 1) ? slope1 : __builtin_amdgcn_exp2f(-0.5f * (float)(hbase + g + 1)) * LOG2E;
        const float sk2 = SINK ? *(const LAS float*)(F.lds + ATT_SINK_OFF + 4 * (hbase + g)) : 0.f;
        {
            const int jbase = i0 + qo - W + 32 * JC, krow = segbase + qo + 32 * JC;
            const bool need_mask = (jbase < 0) || (jbase + 31 >= L);
            f32x16 S;
#pragma unroll
            for (int i = 0; i < 16; ++i) S[i] = 0.f;
#pragma unroll
            for (int ks = 0; ks < 4; ++ks) { const bf16x8 kf = *(const LAS bf16x8*)(ldsK + (krow + ql) * ATT_KPITCH + (16 * ks + 8 * hh) * 2); S = __builtin_amdgcn_mfma_f32_32x32x16_bf16(kf, qf[ks], S, 0, 0, 0); }
            const float fd0 = (float)(jbase + 4 * hh - qi);
#pragma unroll
            for (int i = 0; i < 16; ++i) { const float fd = fd0 + (float)((i & 3) + 8 * (i >> 2)); S[i] = S[i] - sl * fabsf(fd); }
            if (need_mask) {
#pragma unroll
                for (int i = 0; i < 16; ++i) { const float fd = fd0 + (float)((i & 3) + 8 * (i >> 2)); S[i] = (fd >= flo && fd <= fhi) ? S[i] : -INFINITY; } }
            float mloc = S[0];
#pragma unroll
            for (int i = 1; i < 16; ++i) mloc = fmaxf(mloc, S[i]);
            m = fmaxf(mloc, shx(mloc, 32, lane_));
            float ps = 0.f;
#pragma unroll
            for (int i = 0; i < 16; ++i) { const float pv = __builtin_amdgcn_exp2f(S[i] - m); S[i] = pv; ps += pv; }
            l = ps;
#pragma unroll
            for (int s2 = 0; s2 < 2; ++s2) {
                f32x8_t pp;
#pragma unroll
                for (int i = 0; i < 8; ++i) pp[i] = S[8 * s2 + i];
                const bf16x8 pf = __builtin_bit_cast(bf16x8, __builtin_convertvector(pp, nbf16x8));
                const bf16x8 v0 = *(const LAS bf16x8*)(ldsV + ql * ATT_VPITCH + (krow + 16 * s2 + 8 * hh) * 2);
                const bf16x8 v1 = *(const LAS bf16x8*)(ldsV + (ql + 32) * ATT_VPITCH + (krow + 16 * s2 + 8 * hh) * 2);
                O0 = __builtin_amdgcn_mfma_f32_32x32x16_bf16(v0, pf, O0, 0, 0, 0);
                O1 = __builtin_amdgcn_mfma_f32_32x32x16_bf16(v1, pf, O1, 0, 0, 0);
            }
        }
#pragma unroll 1
        for (int jt = 0; jt < NJT; ++jt) {
            if (jt == JC) continue;
            const int jbase = i0 + qo - W + 32 * jt;
            if (jbase + 31 < 0 || jbase >= L) continue;
            const bool need_mask = (jt == 0) || (jt == NJT - 1) || (jbase < 0) || (jbase + 31 >= L);
            const int krow = segbase + qo + 32 * jt;
            const float fd0 = (float)(jbase + 4 * hh - qi);
            bf16x8 kf[4];
#pragma unroll
            for (int ks = 0; ks < 4; ++ks) kf[ks] = *(const LAS bf16x8*)(ldsK + (krow + ql) * ATT_KPITCH + (16 * ks + 8 * hh) * 2);
            const bf16x8 vf00 = *(const LAS bf16x8*)(ldsV + ql * ATT_VPITCH + (krow + 8 * hh) * 2), vf10 = *(const LAS bf16x8*)(ldsV + (ql + 32) * ATT_VPITCH + (krow + 8 * hh) * 2);
            f32x16 S;
            if (jt < JC) { const float k1 = sl * fd0 - m;
#pragma unroll
                for (int i = 0; i < 16; ++i) S[i] = fmaf(sl, (float)((i & 3) + 8 * (i >> 2)), k1); }
            else { const float k1 = -sl * fd0 - m;
#pragma unroll
                for (int i = 0; i < 16; ++i) S[i] = fmaf(-sl, (float)((i & 3) + 8 * (i >> 2)), k1); }
            if (need_mask) {
#pragma unroll
                for (int i = 0; i < 16; ++i) { const float fd = fd0 + (float)((i & 3) + 8 * (i >> 2)); S[i] = (fd >= flo && fd <= fhi) ? S[i] : -INFINITY; } }
#pragma unroll
            for (int ks = 0; ks < 4; ++ks) S = __builtin_amdgcn_mfma_f32_32x32x16_bf16(kf[ks], qf[ks], S, 0, 0, 0);
            const bf16x8 vf01 = *(const LAS bf16x8*)(ldsV + ql * ATT_VPITCH + (krow + 16 + 8 * hh) * 2), vf11 = *(const LAS bf16x8*)(ldsV + (ql + 32) * ATT_VPITCH + (krow + 16 + 8 * hh) * 2);
            float tmax = S[0];
#pragma unroll
            for (int i = 1; i < 16; ++i) tmax = fmaxf(tmax, S[i]);
            if (__builtin_amdgcn_ballot_w64(tmax > ATT_THR) != 0ull) {
                float d = fmaxf(tmax, 0.f); d = fmaxf(d, shx(d, 32, lane_));
                const float sc = __builtin_amdgcn_exp2f(-d);
#pragma unroll
                for (int i = 0; i < 16; ++i) { S[i] -= d; O0[i] *= sc; O1[i] *= sc; }
                l *= sc; m += d;
            }
            float ps = 0.f;
#pragma unroll
            for (int i = 0; i < 16; ++i) { const float pv = __builtin_amdgcn_exp2f(S[i]); S[i] = pv; ps += pv; }
            l += ps;
            { f32x8_t pp;
#pragma unroll
              for (int i = 0; i < 8; ++i) pp[i] = S[i];
              const bf16x8 pf = __builtin_bit_cast(bf16x8, __builtin_convertvector(pp, nbf16x8));
              O0 = __builtin_amdgcn_mfma_f32_32x32x16_bf16(vf00, pf, O0, 0, 0, 0); O1 = __builtin_amdgcn_mfma_f32_32x32x16_bf16(vf10, pf, O1, 0, 0, 0); }
            { f32x8_t pp;
#pragma unroll
              for (int i = 0; i < 8; ++i) pp[i] = S[8 + i];
              const bf16x8 pf = __builtin_bit_cast(bf16x8, __builtin_convertvector(pp, nbf16x8));
              O0 = __builtin_amdgcn_mfma_f32_32x32x16_bf16(vf01, pf, O0, 0, 0, 0); O1 = __builtin_amdgcn_mfma_f32_32x32x16_bf16(vf11, pf, O1, 0, 0, 0); }
        }
#ifdef PRB_REP
        }
        const float sk2 = SINK ? *(const LAS float*)(F.lds + ATT_SINK_OFF + 4 * (hbase + g)) : 0.f;
#endif
        float lt = l + shx(l, 32, lane_);
        float osc = 1.0f;
        if (SINK) { const float mf = fmaxf(m, sk2); osc = __builtin_amdgcn_exp2f(m - mf); lt = lt * osc + __builtin_amdgcn_exp2f(sk2 - mf); }
        if (WRITE_LSE) { if (hh == 0) lse[qtok * 4] = m + __builtin_amdgcn_logf(lt); }
        const float inv = osc / lt;
        if (NH > 1 && g + 1 < NH) {
#pragma unroll
            for (int ks = 0; ks < 4; ++ks) qf[ks] = *(const bf16x8*)(qptr + 64 + 16 * ks + 8 * hh); }
        v2u WW[8];
#pragma unroll
        for (int g4 = 0; g4 < 4; ++g4) {
            WW[g4].x = pk2bf(O0[4 * g4] * inv, O0[4 * g4 + 1] * inv); WW[g4].y = pk2bf(O0[4 * g4 + 2] * inv, O0[4 * g4 + 3] * inv);
            WW[4 + g4].x = pk2bf(O1[4 * g4] * inv, O1[4 * g4 + 1] * inv); WW[4 + g4].y = pk2bf(O1[4 * g4 + 2] * inv, O1[4 * g4 + 3] * inv); }
#pragma unroll
        for (int s4 = 0; s4 < 4; ++s4) {
            v2u a = WW[2 * s4], b = WW[2 * s4 + 1];
            { const auto r = __builtin_amdgcn_permlane32_swap(a.x, b.x, false, false); a.x = r[0]; b.x = r[1]; }
            { const auto r = __builtin_amdgcn_permlane32_swap(a.y, b.y, false, false); a.y = r[0]; b.y = r[1]; }
            *(v4u*)(qptr + odelta + 16 * s4 + 8 * hh) = (v4u){a.x, a.y, b.x, b.y};
#ifdef PRB_ST2
            asm volatile("" ::: "memory");
            *(v4u*)(qptr + odelta + 16 * s4 + 8 * hh) = (v4u){a.x, a.y, b.x, b.y};
            asm volatile("" ::: "memory");
#endif
        }
    }
}
__device__ __forceinline__ ChunkP dil_chunk(const bf16* KA, const bf16* VA, int b, int hs, int sc) {
    const int grp = sc >> 3, ix = sc & 7, col = grp * 256 + hs * 64; ChunkP p; p.K = KA + col; p.V = VA + col; p.ldkv = 768;
    if (grp == 0) { p.tok0 = b * SEQ; p.cstep = 0; p.r = 1; p.L = 2048; p.nseg = 1; p.qs = 256; p.i0 = 256 * ix; }
    else if (grp == 1) { p.tok0 = b * SEQ + (ix >> 1); p.cstep = 0; p.r = 4; p.L = 512; p.nseg = 1; p.qs = 256; p.i0 = 256 * (ix & 1); }
    else { p.tok0 = b * SEQ + 2 * ix; p.cstep = 1; p.r = 16; p.L = 128; p.nseg = 2; p.qs = 128; p.i0 = 0; }
    return p;
}
__device__ __forceinline__ ChunkP win_chunk(const bf16* KW, const bf16* VW, int wc) {
    const int b = wc >> 5, kvh = (wc >> 3) & 3, ch = wc & 7; ChunkP p; p.K = KW + kvh * 64; p.V = VW + kvh * 64; p.ldkv = 256;
    p.tok0 = b * SEQ; p.cstep = 0; p.r = 1; p.L = SEQ; p.nseg = 1; p.qs = 256; p.i0 = 256 * ch; return p;
}
__device__ __forceinline__ void attention_phase(Frame& F, int l, long odA, long odW, int which = 3) {
    unsigned char* ws = P_WS;
    bf16* big = (bf16*)(ws + WS_BIG);
    bf16* QA = big + B_QA / 2; bf16* KA = big + B_KA / 2; bf16* VA = big + B_VA / 2; bf16* QW = big + B_QW / 2; bf16* KW = big + B_KW / 2; bf16* VW = big + B_VW / 2; bf16* OA = big + B_OA / 2;
    float* LSE = (float*)(ws + WS_LSE);
    const int c = blockIdx.x;
    int w_lo, w_hi;
    v4u kreg[8], vreg[2][4];
    bf16x8 qf[4];
#ifndef ATT_N1
#define ATT_N1 0
#endif
    static_assert(ATT_N1 == 0, "the dilated workgroups take no window chunks");
    if (c < 128) { w_lo = ATT_N1 * c; w_hi = w_lo + ATT_N1; } else { w_lo = 128 * ATT_N1 + (c - 128) * (8 - ATT_N1); w_hi = w_lo + (8 - ATT_N1); }
    if (c < 128) { if (which & 1) {
        const int b = c >> 2, hs = c & 3;
        { const ChunkP p0 = dil_chunk(KA, VA, b, hs, 0); attn_issue<64>(p0, F.tid, kreg, vreg); attn_loadq(F, p0, QA + hs * 64, 768, qf); attn_commit<64>(F, p0, kreg, vreg); }
        __syncthreads();
#pragma unroll 1
        for (int sc = 0; sc < 24; ++sc) {
            const ChunkP p = dil_chunk(KA, VA, b, hs, sc); const int grp = sc >> 3;
            const int scn = sc + 1 < 24 ? sc + 1 : sc;
            const ChunkP pn = dil_chunk(KA, VA, b, hs, scn);
            bf16x8 qn[4];
            attn_issue<64>(pn, F.tid, kreg, vreg); attn_loadq(F, pn, QA + (scn >> 3) * 256 + hs * 64, 768, qn);
            const float slope1 = __builtin_amdgcn_exp2f(-8.0f * (float)(grp * 4 + hs + 1) / 12.0f) * (float)p.r * LOG2E;
            attn_compute<64, 1, false, true>(F, p, QA + grp * 256 + hs * 64, 768, odA, LSE + (size_t)grp * MTOK * 4 + hs, slope1, nullptr, 0, qf);
            __syncthreads();
            if (sc + 1 < 24) attn_commit<64>(F, pn, kreg, vreg);
            __syncthreads();
#pragma unroll
            for (int ks = 0; ks < 4; ++ks) qf[ks] = qn[ks];
        }
        VM_WAIT(); __syncthreads(); __builtin_amdgcn_fence(__ATOMIC_ACQUIRE, "agent"); VM_WAIT();
        constexpr int CB = 8;
#pragma unroll 1
        for (int t0 = F.tid; t0 < SEQ * 8; t0 += NWAVES * 64 * CB) {
            float lv[CB][3]; v4u av[CB][3];
#pragma unroll
            for (int k = 0; k < CB; ++k) { const int t = t0 + k * NWAVES * 64, tok = t >> 3, ch = t & 7; const size_t row = (size_t)b * SEQ + tok;
                lv[k][0] = LSE[row * 4 + hs]; lv[k][1] = LSE[(size_t)MTOK * 4 + row * 4 + hs]; lv[k][2] = LSE[(size_t)2 * MTOK * 4 + row * 4 + hs];
                const bf16* og = QA + odA + row * 768 + hs * 64 + ch * 8; av[k][0] = *(const v4u*)(og); av[k][1] = *(const v4u*)(og + 256); av[k][2] = *(const v4u*)(og + 512); }
            asm volatile("" ::: "memory");
#pragma unroll
            for (int k = 0; k < CB; ++k) { const int t = t0 + k * NWAVES * 64, tok = t >> 3, ch = t & 7; const size_t row = (size_t)b * SEQ + tok;
                const float mx = fmaxf(lv[k][0], fmaxf(lv[k][1], lv[k][2]));
                float w0 = __builtin_amdgcn_exp2f(lv[k][0] - mx), w1 = __builtin_amdgcn_exp2f(lv[k][1] - mx), w2 = __builtin_amdgcn_exp2f(lv[k][2] - mx);
                const float inv = 1.0f / (w0 + w1 + w2); w0 *= inv; w1 *= inv; w2 *= inv;
                v4u o;
#pragma unroll
                for (int w = 0; w < 4; ++w) o[w] = pk2bf(w0 * bflo(av[k][0][w]) + w1 * bflo(av[k][1][w]) + w2 * bflo(av[k][2][w]), w0 * bfhi(av[k][0][w]) + w1 * bfhi(av[k][1][w]) + w2 * bfhi(av[k][2][w]));
                *(v4u*)(OA + row * 256 + hs * 64 + ch * 8) = o; }
        }
    } } else if (which & 2) {
        if (F.tid < 16) *(LAS float*)(F.lds + ATT_SINK_OFF + 4 * F.tid) = P_IN(6)[l * 16 + F.tid] * LOG2E;
        const ChunkP p0 = win_chunk(KW, VW, w_lo); attn_issue<128>(p0, F.tid, kreg, vreg); attn_loadq(F, p0, QW + ((w_lo >> 3) & 3) * 256, 1024, qf); attn_commit<128>(F, p0, kreg, vreg);
        __syncthreads();
    }
#pragma unroll 1
    for (int wc = w_lo; wc < ((which & 2) ? w_hi : w_lo); ++wc) {
        const ChunkP p = win_chunk(KW, VW, wc); const int kvh = (wc >> 3) & 3;
        const int wn = wc + 1 < w_hi ? wc + 1 : wc;
        const ChunkP pn = win_chunk(KW, VW, wn);
        bf16x8 qn[4];
        attn_issue<128>(pn, F.tid, kreg, vreg); attn_loadq(F, pn, QW + ((wn >> 3) & 3) * 256, 1024, qn);
        attn_compute<128, 4, true, false>(F, p, QW + kvh * 256, 1024, odW, nullptr, 0.f, nullptr, kvh * 4, qf);
        __syncthreads();
        if (wc + 1 < w_hi) attn_commit<128>(F, pn, kreg, vreg);
        __syncthreads();
#pragma unroll
        for (int ks = 0; ks < 4; ++ks) qf[ks] = qn[ks];
    }
}
#ifndef PH_A
#define PH_A 1
#endif
#ifndef PH_B
#define PH_B 1
#endif
#ifndef PH_C
#define PH_C 1
#endif
#ifndef PH_D
#define PH_D 1
#endif
#ifndef PH_E
#define PH_E 1
#endif
#ifndef PH_F
#define PH_F 1
#endif
#ifndef PH_G
#define PH_G 1
#endif
#ifndef PH_H
#define PH_H 1
#endif
#ifndef PH_I
#define PH_I 1
#endif
#ifndef PH_J
#define PH_J 1
#endif
#ifndef PH_Z
#define PH_Z 1
#endif

struct Args { const float* in[14]; float* out; unsigned char* ws; };
__global__ void __launch_bounds__(NWAVES * 64, 2) mk_fwd(Args args) {
    extern __shared__ __attribute__((aligned(16))) unsigned char lds_raw[];
    LAS unsigned char* const lds = (LAS unsigned char*)lds_raw;
    int wave_s = __builtin_amdgcn_readfirstlane((int)(threadIdx.x >> 6)); asm volatile("" : "+s"(wave_s));
    {
        const int t0 = wave_s * 64 + xb_lane();
        volatile LAS unsigned* MISC = (volatile LAS unsigned*)(lds + MISC_OFF);
        if (t0 < 32) MISC[t0] = 0u;
        if (t0 == 0) { volatile LAS unsigned long long* pt = (volatile LAS unsigned long long*)(lds + PTAB_OFF);
            pt[0] = (unsigned long long)args.in[0]; pt[1] = (unsigned long long)args.in[1]; pt[2] = (unsigned long long)args.in[2]; pt[3] = (unsigned long long)args.in[3];
            pt[4] = (unsigned long long)args.in[4]; pt[5] = (unsigned long long)args.in[5]; pt[6] = (unsigned long long)args.in[6]; pt[7] = (unsigned long long)args.in[7];
            pt[8] = (unsigned long long)args.in[8]; pt[9] = (unsigned long long)args.in[9]; pt[10] = (unsigned long long)args.in[10]; pt[11] = (unsigned long long)args.in[11];
            pt[12] = (unsigned long long)args.in[12]; pt[13] = (unsigned long long)args.in[13]; pt[14] = (unsigned long long)args.out; pt[15] = (unsigned long long)args.ws; }
        __syncthreads();
    }
    XcdBarrier bar = xcd_barrier_post((unsigned*)(args.ws + WS_CTL) + CW_BAR, (volatile LAS unsigned*)(lds + MISC_OFF) + 8, wave_s);
    const int G = 256;

#pragma unroll 1
    for (int l = 0; l < DEPTH; ++l) {
        int c = blockIdx.x; asm volatile("" : "+s"(c));
#if PH_A
        { Frame F = make_frame(lds, wave_s); convert_weights(F, l);
          unsigned char* ws = P_WS;
          if (l == 0) norm_rows<true, false, false>(F, P_IN(0), (bf16*)(ws + WS_HB), P_IN(1) + l * DM, (float*)(ws + WS_LSE), nullptr, ws + WS_HN);
          else norm_rows<false, true, false>(F, nullptr, (bf16*)(ws + WS_HB), P_IN(1) + l * DM, (float*)(ws + WS_LSE), nullptr, ws + WS_HN);
          }
#endif
        xcd_barrier(bar);
#if PH_B
        { Frame F = make_frame(lds, wave_s); unsigned char* ws = P_WS; bf16* big = (bf16*)(ws + WS_BIG);
          pg8::Gemm g{(const bf16*)(ws + WS_HB), (const bf16*)(ws + WS_WIN), MTOK, INC, DM}; pg8::StaticOrder S; S.init(MTOK, 3840, G, c);
          pg8::EpiInProj E{big + B_QA / 2, big + B_KA / 2, big + B_VA / 2, big + B_QW / 2, big + B_KW / 2, big + B_VW / 2, big + B_G / 2, big + B_G / 2 + (size_t)MTOK * DM, P_IN(5) + l * 2048, QSCALE, (const float*)(ws + WS_LSE), 0.f, 0.f};
          pg8::gemm_phase<pg8::EpiInProj, pg8::StaticOrder, true, true>(F.tid, lds, g, S, E);
          pg8::Gemm g8{(const bf16*)(ws + WS_HN), (const bf16*)(ws + WS_WIN) + (size_t)3840 * DM, MTOK, 2048, DM / 2}; pg8::StaticOrder S8; S8.init(MTOK, 2048, G, c);
          pg8::EpiGate8 E8{big + B_G / 2, big + B_G / 2 + (size_t)MTOK * DM, P_IN(5) + l * 2048};
          pg8::gemm_phase<pg8::EpiGate8, pg8::StaticOrder, true, true, false, true>(F.tid, lds, g8, S8, E8); }
#endif
        xcd_barrier(bar);
#ifdef DUP_C
        { Frame F = make_frame(lds, wave_s); attention_phase(F, l, ((long)WS_HN - (long)(WS_BIG + B_QA)) / 2, ((long)WS_HN - (long)(WS_BIG + B_QW)) / 2, DUP_C); }
        xcd_barrier(bar);
#endif
#if PH_C
        { Frame F = make_frame(lds, wave_s); attention_phase(F, l, 0, 0); }
#endif
        xcd_barrier(bar);
#if PH_E
        { Frame F = make_frame(lds, wave_s); unsigned char* ws = P_WS; bf16* big = (bf16*)(ws + WS_BIG);
          pg8::Gemm g0{big + B_OA / 2, (const bf16*)(ws + WS_WA), MTOK, DM, 256}; pg8::Gemm g1{big + B_QW / 2, (const bf16*)(ws + WS_WB), MTOK, DM, DM}; pg8::StaticOrder S; S.init(MTOK, DM, G, c);
          pg8::EpiMergeDual E{(unsigned char*)(big + B_MERGED / 2), big + B_G / 2, big + B_G / 2 + (size_t)MTOK * DM};
          pg8::gemm_phase_dual<pg8::EpiMergeDual, pg8::StaticOrder>(F.tid, lds, g0, g1, S, E); }
#endif
        xcd_barrier(bar);
#if PH_F
        { Frame F = make_frame(lds, wave_s); unsigned char* ws = P_WS; bf16* big = (bf16*)(ws + WS_BIG); bf16* hb = (bf16*)(ws + WS_HB);
          pg8::Gemm g{big + B_MERGED / 2, (const bf16*)(ws + WS_WO), MTOK, DM, DM / 2}; pg8::StaticOrder S; S.init(MTOK, DM, G, c);
          pg8::EpiResid E{hb, hb};
          pg8::gemm_phase<pg8::EpiResid, pg8::StaticOrder, true, true, false, true>(F.tid, lds, g, S, E); }
#endif
        xcd_barrier(bar);
#if PH_G
        { Frame F = make_frame(lds, wave_s); unsigned char* ws = P_WS;
          norm_router(F, (const bf16*)(ws + WS_HB), P_IN(8) + l * DM, P_IN(9) + (size_t)l * DM * NE, (float*)(ws + WS_LSE), (float*)(ws + WS_AFF), ws + WS_HN); }
#endif
        xcd_barrier(bar);
#if PH_H
        { Frame F = make_frame(lds, wave_s); unsigned char* ws = P_WS;
          topk_gather(F, (const float*)(ws + WS_AFF), (const float*)(ws + WS_LSE), (int*)(ws + WS_SEL), (float*)(ws + WS_GATE), (int*)(ws + WS_IDX)); }
#endif
        xcd_barrier(bar);
#if PH_I
        { Frame F = make_frame(lds, wave_s); unsigned char* ws = P_WS; bf16* big = (bf16*)(ws + WS_BIG);
          pg8::Gemm g{(const bf16*)(ws + WS_HN), (const bf16*)(ws + WS_WGU), MEXP, NE * 2048, DM / 2}; pg8::GroupedOrder S; S.init(NE, NB, 8, G, c);
          pg8::EpiSwiGLU E{(unsigned char*)(big + B_ACT / 2), (const LAS int*)(lds + AROW_OFF), 0};
          { const int* idxg = (const int*)(ws + WS_IDX); LAS int* arow = (LAS int*)(lds + AROW_OFF);
            int rv[NE]; const int r = F.tid & 255;
#pragma unroll
            for (int i = 0; i < NE; ++i) { pg8::Unit u; u.pm = 0; u.pn = 0; S.next(i, u); rv[i] = u.pm; }
            asm volatile("" ::: "memory");
#pragma unroll
            for (int i = 0; i < NE; ++i) rv[i] = idxg[(size_t)rv[i] * 256 + r];
#pragma unroll
            for (int i = 0; i < NE; ++i) if (F.tid < 256) arow[i * 256 + r] = rv[i];
            __syncthreads(); }
          pg8::gemm_phase<pg8::EpiSwiGLU, pg8::GroupedOrder, true, true, true, true>(F.tid, lds, g, S, E, (const LAS int*)(lds + AROW_OFF)); }
#endif
        xcd_barrier(bar);
#if PH_J
        { Frame F = make_frame(lds, wave_s); unsigned char* ws = P_WS; bf16* big = (bf16*)(ws + WS_BIG);
          pg8::Gemm g{big + B_ACT / 2, (const bf16*)(ws + WS_WD), MEXP, NE * 1024, DEX / 2}; pg8::GroupedOrder S; S.init(NE, NB, 4, G, c);
          pg8::EpiDown E{big + B_Y / 2, (const LAS float*)(lds + AROW_OFF), 0};
          { const float* gatev = (const float*)(ws + WS_GATE); LAS float* gl = (LAS float*)(lds + AROW_OFF);
            float gv[8]; int pmv[8]; const int r = F.tid & 255;
#pragma unroll
            for (int i = 0; i < 8; ++i) { pg8::Unit u; u.pm = 0; u.pn = 0; S.next(i, u); pmv[i] = u.pm; }
            asm volatile("" ::: "memory");
#pragma unroll
            for (int i = 0; i < 8; ++i) gv[i] = gatev[(size_t)pmv[i] * 256 + r];
#pragma unroll
            for (int i = 0; i < 8; ++i) if (F.tid < 256) gl[i * 256 + r] = gv[i];
            __syncthreads(); }
          pg8::gemm_phase<pg8::EpiDown, pg8::GroupedOrder, true, true, false, true>(F.tid, lds, g, S, E); }
#endif
        xcd_barrier(bar);
    }
#if PH_Z
    { Frame F = make_frame(lds, wave_s); unsigned char* ws = P_WS; norm_rows<false, true, true>(F, nullptr, (bf16*)(ws + WS_HB), P_IN(13), nullptr, P_OUT); }
#endif
}

extern "C" void kernel_launch(void* const* d_in, const int* in_sizes, int n_in, void* d_out, int out_size, void* d_ws, size_t ws_size, hipStream_t stream) {
    static int grid = 0;
    if (grid == 0) {
        if (n_in != 14 || out_size != MTOK * DM || ws_size < WS_END) { fprintf(stderr, "kernel_launch: unexpected shapes (n_in %d, out %d, ws %zu < %zu); nothing launched\n", n_in, out_size, ws_size, (size_t)WS_END); grid = -1; return; }
        int dev = 0, cus = 0, per_cu = 0;
        if (hipGetDevice(&dev) != hipSuccess || hipDeviceGetAttribute(&cus, hipDeviceAttributeMultiprocessorCount, dev) != hipSuccess) { grid = -1; return; }
        if (hipFuncSetAttribute((const void*)mk_fwd, hipFuncAttributeMaxDynamicSharedMemorySize, LDS_BYTES) != hipSuccess) { fprintf(stderr, "kernel_launch: hipFuncSetAttribute failed\n"); grid = -1; return; }
        if (hipOccupancyMaxActiveBlocksPerMultiprocessor(&per_cu, (const void*)mk_fwd, NWAVES * 64, LDS_BYTES) != hipSuccess || per_cu < 1) fprintf(stderr, "kernel_launch: occupancy query reports %d\n", per_cu);
        (void)hipGetLastError();
        grid = 256;
        if (cus != 256) fprintf(stderr, "kernel_launch: device has %d CUs, built for 256\n", cus);
    }
    if (grid < 0) return;
    (void)in_sizes;
    hipMemsetAsync((char*)d_ws + WS_CTL, 0, CTL_ZERO_BYTES, stream);
    Args a{};
    for (int i = 0; i < 14; ++i) a.in[i] = (const float*)d_in[i];
    a.out = (float*)d_out; a.ws = (unsigned char*)d_ws;
    hipLaunchKernelGGL(mk_fwd, dim3(grid), dim3(NWAVES * 64), LDS_BYTES, stream, a);
}
```

```cpp
#include <hip/hip_runtime.h>
#include <cstdio>
#include <cstdint>
typedef __bf16 nbf16x2 __attribute__((ext_vector_type(2)));
typedef __bf16 nbf16x4 __attribute__((ext_vector_type(4)));
typedef __bf16 nbf16x8 __attribute__((ext_vector_type(8)));
typedef float f32x2_t __attribute__((ext_vector_type(2)));
typedef float f32x8_t __attribute__((ext_vector_type(8)));
__device__ __forceinline__ unsigned pk2bf(float lo, float hi) { f32x2_t v = {lo, hi}; return __builtin_bit_cast(unsigned, __builtin_convertvector(v, nbf16x2)); }
__device__ __forceinline__ float bflo(unsigned w) { return __builtin_bit_cast(float, w << 16); }
__device__ __forceinline__ float bfhi(unsigned w) { return __builtin_bit_cast(float, w & 0xffff0000u); }
namespace pg8 {
#define PG8_LAS __attribute__((address_space(3)))
typedef unsigned short bf16_t;
typedef short bf16x8 __attribute__((ext_vector_type(8)));
typedef float f32x4 __attribute__((ext_vector_type(4)));
typedef unsigned u32x4 __attribute__((ext_vector_type(4)));
typedef int i32x4_t __attribute__((ext_vector_type(4)));
constexpr int BM = 256, BK = 64, HALF = 128, HTB = HALF * BK * 2  , STAGE_BYTES = 8 * HTB, NXCD = 8;
#ifndef PG8_WGM
#define PG8_WGM 8
#endif
#ifndef PG8_WGM_G
#define PG8_WGM_G 8
#endif
constexpr int WGM = PG8_WGM, WGM_G = PG8_WGM_G;

__host__ __device__ __forceinline__ int lds_byte(int r, int c) { const int st = (r >> 4) * 2 + (c >> 5), rr = r & 15, cc = c & 31, ob = rr * 64 + cc * 2; return st * 1024 + (ob ^ (((ob >> 9) & 1) << 5)); }
__host__ __device__ __forceinline__ void stage_rc(int b, int& R, int& C) { const int st = b / 1024, sb = b % 1024, swz = sb ^ (((sb >> 9) & 1) << 5); R = (st >> 1) * 16 + swz / 64; C = (st & 1) * 32 + (swz % 64) / 2; }
__host__ __device__ __forceinline__ int perm32(int rho) { const int n = rho >> 4, i = rho & 15; return 8 * (i >> 2) + 4 * n + (i & 3); }

struct Unit { int pm, pn; };
struct Gemm { const bf16_t* A; const bf16_t* Bt; int M, N, K; };

struct StaticOrder {
    int nM, nN, nwg, G, c;
    __host__ __device__ void init(int M, int N, int G_, int c_) { nM = M / BM; nN = N / BM; nwg = nM * nN; G = G_; c = c_; }
    __host__ __device__ bool next(int i, Unit& u) const {
        const long L = (long)i * G + c; if (L >= nwg) return false;
        int wgid = (int)L; { const int q = nwg / NXCD, r = nwg % NXCD, xcd = wgid % NXCD, off = wgid / NXCD; wgid = (xcd < r ? xcd * (q + 1) : r * (q + 1) + (xcd - r) * q) + off; }
        const int nig = WGM * nN, gid = wgid / nig, fm = gid * WGM, gsz = (nM - fm) < WGM ? (nM - fm) : WGM;
        u.pm = fm + ((wgid % nig) % gsz); u.pn = (wgid % nig) / gsz; return true;
    }
    __device__ __forceinline__ void a_ready(const Unit&) const {}
    __device__ __forceinline__ void done(const Unit&) const {}
};

struct GroupedOrder {
    int nMg, nNg, upg, ntot, G, c;
    __host__ __device__ void init(int ngrp, int nMg_, int nNg_, int G_, int c_) { nMg = nMg_; nNg = nNg_; upg = nMg * nNg; ntot = ngrp * upg; G = G_; c = c_; }
    __host__ __device__ bool next(int i, Unit& u) const {
        const long L = (long)i * G + c; if (L >= ntot) return false;
        const int e = (int)(L / upg); int wgid = (int)(L % upg);
        { const int q = upg / NXCD, r = upg % NXCD, xcd = wgid % NXCD, off = wgid / NXCD; wgid = (xcd < r ? xcd * (q + 1) : r * (q + 1) + (xcd - r) * q) + off; }
        const int nig = WGM_G * nNg, gid = wgid / nig, fm = gid * WGM_G, gsz = (nMg - fm) < WGM_G ? (nMg - fm) : WGM_G;
        u.pm = e * nMg + fm + ((wgid % nig) % gsz); u.pn = e * nNg + (wgid % nig) / gsz; return true;
    }
    __device__ __forceinline__ void a_ready(const Unit&) const {}
    __device__ __forceinline__ void done(const Unit&) const {}
};

#ifndef EPI_NT
#define EPI_NT 0
#endif
#if EPI_NT
#define EPI_ST(ptr, val) __builtin_nontemporal_store((val), (ptr))
#else
#define EPI_ST(ptr, val) (*(ptr) = (val))
#endif
#ifndef EPI_NT_B
#define EPI_NT_B 0
#endif
#if EPI_NT_B
#define EPI_ST_B(ptr, val) __builtin_nontemporal_store((val), (ptr))
#else
#define EPI_ST_B(ptr, val) (*(ptr) = (val))
#endif
__device__ __forceinline__ u32x4 pack8(const f32x4 a, const f32x4 b) { u32x4 w; w.x = pk2bf(a[0], a[1]); w.y = pk2bf(a[2], a[3]); w.z = pk2bf(b[0], b[1]); w.w = pk2bf(b[2], b[3]); return w; }
__device__ __forceinline__ void unpack8(const u32x4 w, f32x4& a, f32x4& b) { a = (f32x4){bflo(w.x), bfhi(w.x), bflo(w.y), bfhi(w.y)}; b = (f32x4){bflo(w.z), bfhi(w.z), bflo(w.w), bfhi(w.w)}; }
typedef unsigned u32x2 __attribute__((ext_vector_type(2)));
__device__ __forceinline__ unsigned pk4f8u(const f32x4 v) { int w = __builtin_amdgcn_cvt_pk_fp8_f32(v[0], v[1], 0, false); w = __builtin_amdgcn_cvt_pk_fp8_f32(v[2], v[3], w, true); return (unsigned)w; }
__device__ __forceinline__ unsigned pk4f8c(const f32x4 v) { f32x4 c; for (int i = 0; i < 4; ++i) c[i] = fminf(fmaxf(v[i], -440.f), 440.f); return pk4f8u(c); }
__device__ __forceinline__ float sigmoidf_fast(float x) { return __builtin_amdgcn_rcpf(1.0f + __builtin_amdgcn_exp2f(-1.4426950408889634f * x)); }

__device__ __forceinline__ size_t gate_blk(int pm, int pn, int wave, int ai, int m, int bj, int lane) { return ((size_t)(((pm * 4 + pn) * 8 + wave) * 16 + (ai * 8 + m * 2 + bj)) * 64 + lane) * 8; }
__device__ __forceinline__ u32x4 xchg_pair(const u32x4 v) { u32x4 r;
#pragma unroll
    for (int w = 0; w < 4; ++w) r[w] = (unsigned)__builtin_amdgcn_mov_dpp((int)v[w], 0xB1, 0xF, 0xF, true);
    return r; }
__device__ __forceinline__ void wide_pair(const u32x4 p0, const u32x4 p1, bool odd, u32x4& a, u32x4& b) {
    const u32x4 recv = xchg_pair(odd ? p0 : p1); a = odd ? recv : p0; b = odd ? p1 : recv; }
__device__ __forceinline__ u32x4 fq_pair16(const u32x2 pm0, const u32x2 pm1) {
    const auto r0 = __builtin_amdgcn_permlane16_swap(pm0.x, pm1.x, false, false); const auto r1 = __builtin_amdgcn_permlane16_swap(pm0.y, pm1.y, false, false);
    return (u32x4){(unsigned)r0[0], (unsigned)r1[0], (unsigned)r0[1], (unsigned)r1[1]}; }
struct EpiInProj {
    static constexpr bool PERM = true, AFTER_DRAIN = false, WIDE = true, ROWSCALE = true; static constexpr int F8_SW = 0, F8_SA = 0;
    bf16_t *qa, *ka, *va, *qw, *kw, *vw, *gr, *g1; const float* bgate; float qscale;
    const float* rsv; mutable float rs0, rs1;
    __device__ __forceinline__ float row_rs(int ai, int m, int fr) const { return __builtin_bit_cast(float, __builtin_amdgcn_ds_bpermute((fr + 16 * m) << 2, __builtin_bit_cast(int, ai ? rs1 : rs0))); }
    __device__ __forceinline__ void operator()(const f32x4 (&acc)[2][2][4][2], const Unit& u, int wr, int wc, int fr, int fq) const {
        const int pn = u.pn; const int row0 = u.pm * BM + wr * 64 + fr;
        if (pn >= 15) {
            const int cc0 = (pn - 15) * HALF + wc * 32 + 8 * fq;
            f32x4 b0[2], b1[2];
#pragma unroll
            for (int n = 0; n < 2; ++n) { b0[n] = *(const f32x4*)(bgate + cc0 + 4 * n); b1[n] = *(const f32x4*)(bgate + 1024 + cc0 + 4 * n); }
#pragma unroll
            for (int ai = 0; ai < 2; ++ai)
#pragma unroll
                for (int m = 0; m < 4; ++m) { const size_t off = gate_blk(u.pm, (pn - 15) >> 1, wr * 4 + wc, ai, m, (pn - 15) & 1, fq * 16 + fr); f32x4 rr[2], gg[2]; const float rs = row_rs(ai, m, fr);
#pragma unroll
                    for (int n = 0; n < 2; ++n)
#pragma unroll
                        for (int j = 0; j < 4; ++j) { float a0 = acc[ai][0][m][n][j] * rs + b0[n][j], a1 = acc[ai][1][m][n][j] * rs + b1[n][j];
                            a0 = fminf(fmaxf(a0, -30.f), 30.f); a1 = fminf(fmaxf(a1, -30.f), 30.f);
                            const float e0 = __builtin_amdgcn_exp2f(-1.4426950408889634f * a0), e1 = __builtin_amdgcn_exp2f(-1.4426950408889634f * a1);
                            gg[n][j] = __builtin_amdgcn_rcpf(1.0f + e1); rr[n][j] = (1.0f + e1) * __builtin_amdgcn_rcpf(1.0f + e0); }
                    EPI_ST_B((u32x4*)(gr + off), pack8(rr[0], rr[1])); EPI_ST_B((u32x4*)(g1 + off), pack8(gg[0], gg[1])); }
            return;
        }
        bf16_t* base; int ldc, ct; float sc = 1.0f;
        if (pn < 3) { base = qa; ldc = 768; ct = pn; sc = qscale; }
        else if (pn < 6) { base = ka; ldc = 768; ct = pn - 3; }
        else if (pn < 9) { base = va; ldc = 768; ct = pn - 6; }
        else if (pn < 13) { base = qw; ldc = 1024; ct = pn - 9; sc = qscale; }
        else if (pn == 13) { base = kw; ldc = 256; ct = 0; }
        else { base = vw; ldc = 256; ct = 0; }
        const bool odd = (fr & 1) != 0;
        const int col0 = ct * BM + wc * 64 + 8 * fq + (odd ? 32 : 0);
#pragma unroll
        for (int ai = 0; ai < 2; ++ai)
#pragma unroll
            for (int m = 0; m < 4; ++m) { bf16_t* rowp = base + (size_t)(row0 - (odd ? 1 : 0) + ai * HALF + m * 16) * ldc + col0;
                const float s2 = sc * row_rs(ai, m, fr);
                u32x4 a, b; wide_pair(pack8(acc[ai][0][m][0] * s2, acc[ai][0][m][1] * s2), pack8(acc[ai][1][m][0] * s2, acc[ai][1][m][1] * s2), odd, a, b);
                EPI_ST_B((u32x4*)rowp, a); EPI_ST_B((u32x4*)(rowp + ldc), b); }
    }
};
struct SkipVOrder {
    StaticOrder S;
    __device__ __forceinline__ bool next(int i, Unit& u) const { if (!S.next(i, u)) return false; u.pn = u.pn < 6 ? u.pn : u.pn + 3; return true; }
    __device__ __forceinline__ void a_ready(const Unit&) const {}
    __device__ __forceinline__ void done(const Unit&) const {}
};
struct EpiGate8 {
    static constexpr bool PERM = true, AFTER_DRAIN = false, WIDE = true, ROWSCALE = false; static constexpr int F8_SW = 0, F8_SA = 0; static constexpr int NVM = 16;
    bf16_t *gr, *g1; const float* bgate; bf16_t *qa, *ka, *va, *qw, *kw, *vw; float qscale;
    __device__ __forceinline__ void operator()(const f32x4 (&acc)[2][2][4][2], const Unit& u, int wr, int wc, int fr, int fq) const {
        if (u.pn < 15) {
            bf16_t* base; int ldc, ct; float SV = 1.0f / 1024.0f;
            const int pn = u.pn;
            if (pn < 3) { base = qa; ldc = 768; ct = pn; SV *= qscale; }
            else if (pn < 6) { base = ka; ldc = 768; ct = pn - 3; }
            else if (pn < 9) { base = va; ldc = 768; ct = pn - 6; }
            else if (pn < 13) { base = qw; ldc = 1024; ct = pn - 9; SV *= qscale; }
            else if (pn == 13) { base = kw; ldc = 256; ct = 0; }
            else { base = vw; ldc = 256; ct = 0; }
            const bool odd = (fr & 1) != 0; const int row0 = u.pm * BM + wr * 64 + fr;
            const int col0 = ct * BM + wc * 64 + 8 * fq + (odd ? 32 : 0);
#pragma unroll
            for (int ai = 0; ai < 2; ++ai)
#pragma unroll
                for (int m = 0; m < 4; ++m) { bf16_t* rowp = base + (size_t)(row0 - (odd ? 1 : 0) + ai * HALF + m * 16) * ldc + col0;
                    u32x4 a, b; wide_pair(pack8(acc[ai][0][m][0] * SV, acc[ai][0][m][1] * SV), pack8(acc[ai][1][m][0] * SV, acc[ai][1][m][1] * SV), odd, a, b);
                    EPI_ST_B((u32x4*)rowp, a); EPI_ST_B((u32x4*)(rowp + ldc), b); }
            return;
        }
        const int pn = u.pn - 15;
        const int cc0 = pn * HALF + wc * 32 + 8 * fq;
        f32x4 b0[2], b1[2];
#pragma unroll
        for (int n = 0; n < 2; ++n) { b0[n] = *(const f32x4*)(bgate + cc0 + 4 * n); b1[n] = *(const f32x4*)(bgate + 1024 + cc0 + 4 * n); }
        constexpr float SC = 1.0f / 1024.0f;
#pragma unroll
        for (int ai = 0; ai < 2; ++ai)
#pragma unroll
            for (int m = 0; m < 4; ++m) { const size_t off = gate_blk(u.pm, pn >> 1, wr * 4 + wc, ai, m, pn & 1, fq * 16 + fr); f32x4 rr[2], gg[2];
#pragma unroll
                for (int n = 0; n < 2; ++n)
#pragma unroll
                    for (int j = 0; j < 4; ++j) { float a0 = acc[ai][0][m][n][j] * SC + b0[n][j], a1 = acc[ai][1][m][n][j] * SC + b1[n][j];
                        a0 = fminf(fmaxf(a0, -30.f), 30.f); a1 = fminf(fmaxf(a1, -30.f), 30.f);
                        const float e0 = __builtin_amdgcn_exp2f(-1.4426950408889634f * a0), e1 = __builtin_amdgcn_exp2f(-1.4426950408889634f * a1);
                        gg[n][j] = __builtin_amdgcn_rcpf(1.0f + e1); rr[n][j] = (1.0f + e1) * __builtin_amdgcn_rcpf(1.0f + e0); }
                EPI_ST_B((u32x4*)(gr + off), pack8(rr[0], rr[1])); EPI_ST_B((u32x4*)(g1 + off), pack8(gg[0], gg[1])); }
    }
};
struct EpiMergeDual {
    static constexpr bool PERM = true, AFTER_DRAIN = false, WIDE = true, ROWSCALE = false; static constexpr int F8_SW = 0, F8_SA = 0;
    unsigned char* merged; const bf16_t* gr; const bf16_t* g1;
    __device__ __forceinline__ size_t gblk(const Unit& u, int wr, int wc, int ai, int m, int bj, int fr, int fq) const { return gate_blk(u.pm, u.pn, wr * 4 + 2 * (wc & 1) + bj, ai, m, wc >> 1, fq * 16 + fr); }
    __device__ __forceinline__ void mid(f32x4 (&acc)[2][2][4][2], const Unit& u, int wr, int wc, int fr, int fq) const {
        u32x4 w[2][4][2];
#pragma unroll
        for (int ai = 0; ai < 2; ++ai)
#pragma unroll
            for (int m = 0; m < 4; ++m) {
#pragma unroll
                for (int bj = 0; bj < 2; ++bj) w[ai][m][bj] = *(const u32x4*)(gr + gblk(u, wr, wc, ai, m, bj, fr, fq)); }
        asm volatile("" ::: "memory");
#pragma unroll
        for (int ai = 0; ai < 2; ++ai)
#pragma unroll
            for (int m = 0; m < 4; ++m) {
#pragma unroll
                for (int bj = 0; bj < 2; ++bj) { f32x4 r0, r1; unpack8(w[ai][m][bj], r0, r1); acc[ai][bj][m][0] *= r0; acc[ai][bj][m][1] *= r1; } }
    }
    __device__ __forceinline__ void operator()(const f32x4 (&acc)[2][2][4][2], const Unit& u, int wr, int wc, int fr, int fq) const {
        u32x4 w[2][4][2];
#pragma unroll
        for (int ai = 0; ai < 2; ++ai)
#pragma unroll
            for (int m = 0; m < 4; ++m) {
#pragma unroll
                for (int bj = 0; bj < 2; ++bj) w[ai][m][bj] = *(const u32x4*)(g1 + gblk(u, wr, wc, ai, m, bj, fr, fq)); }
        asm volatile("" ::: "memory");
#pragma unroll
        for (int ai = 0; ai < 2; ++ai)
#pragma unroll
            for (int mp = 0; mp < 2; ++mp) { u32x2 p0[2], p1[2];
#pragma unroll
                for (int k = 0; k < 2; ++k) { const int m = 2 * mp + k; f32x4 a0, a1, c0, c1; unpack8(w[ai][m][0], a0, a1); unpack8(w[ai][m][1], c0, c1);
                    p0[k].x = pk4f8c(acc[ai][0][m][0] * a0 * 16.0f); p0[k].y = pk4f8c(acc[ai][0][m][1] * a1 * 16.0f); p1[k].x = pk4f8c(acc[ai][1][m][0] * c0 * 16.0f); p1[k].y = pk4f8c(acc[ai][1][m][1] * c1 * 16.0f); }
                unsigned char* p = merged + (size_t)(u.pm * BM + wr * 64 + fr + 16 * (fq & 1) + ai * HALF + mp * 32) * 1024 + u.pn * BM + wc * 64 + 8 * (fq & ~1);
                *(u32x4*)p = fq_pair16(p0[0], p0[1]); *(u32x4*)(p + 32) = fq_pair16(p1[0], p1[1]); }
    }
};
struct EpiResid {
    static constexpr bool PERM = true, AFTER_DRAIN = false, WIDE = true, ROWSCALE = false; static constexpr int F8_SW = 0, F8_SA = 0;
    const bf16_t* base; bf16_t* out;
    __device__ __forceinline__ void operator()(const f32x4 (&acc)[2][2][4][2], const Unit& u, int wr, int wc, int fr, int fq) const {
        const bool odd = (fr & 1) != 0;
        const int rowe = u.pm * BM + wr * 64 + (fr & ~1), col = u.pn * BM + wc * 64 + 8 * fq + (odd ? 32 : 0);
        u32x4 la[2][4], lb[2][4];
#pragma unroll
        for (int ai = 0; ai < 2; ++ai)
#pragma unroll
            for (int m = 0; m < 4; ++m) { const bf16_t* p = base + (size_t)(rowe + ai * HALF + m * 16) * 1024 + col; la[ai][m] = *(const u32x4*)p; lb[ai][m] = *(const u32x4*)(p + 1024); }
        asm volatile("" ::: "memory");
#pragma unroll
        for (int ai = 0; ai < 2; ++ai)
#pragma unroll
            for (int m = 0; m < 4; ++m) {
                const u32x4 recv = xchg_pair(odd ? la[ai][m] : lb[ai][m]); const u32x4 r0 = odd ? recv : la[ai][m], r1 = odd ? lb[ai][m] : recv;
                f32x4 b0, b1, c0, c1; unpack8(r0, b0, b1); unpack8(r1, c0, c1);
                constexpr float SC = 1.0f / 1024.0f;
                u32x4 a, b; wide_pair(pack8(b0 + acc[ai][0][m][0] * SC, b1 + acc[ai][0][m][1] * SC), pack8(c0 + acc[ai][1][m][0] * SC, c1 + acc[ai][1][m][1] * SC), odd, a, b);
                bf16_t* p = out + (size_t)(rowe + ai * HALF + m * 16) * 1024 + col;
                EPI_ST((u32x4*)p, a); EPI_ST((u32x4*)(p + 1024), b); }
    }
};
struct EpiSwiGLU {
    static constexpr bool PERM = true, AFTER_DRAIN = false, WIDE = false, ROWSCALE = false; static constexpr int F8_SW = 0, F8_SA = 0;
    unsigned char* act; const PG8_LAS int* arow; mutable int ui;
    __device__ __forceinline__ void operator()(const f32x4 (&acc)[2][2][4][2], const Unit& u, int wr, int wc, int fr, int fq) const {
        const int rowb = u.pm * BM + wr * 64 + fr + 16 * (fq & 1), col0 = (u.pn & 7) * HALF + wc * 32 + 8 * (fq & ~1);
        const float rs = 1.0f / 1024.0f;
#pragma unroll
        for (int ai = 0; ai < 2; ++ai)
#pragma unroll
            for (int mp = 0; mp < 2; ++mp) { u32x2 w8[2];
#pragma unroll
                for (int k = 0; k < 2; ++k) { const int m = 2 * mp + k; f32x4 o[2];
#pragma unroll
                    for (int n = 0; n < 2; ++n)
#pragma unroll
                        for (int j = 0; j < 4; ++j) { const float a = acc[ai][0][m][n][j] * rs, up = acc[ai][1][m][n][j] * rs; o[n][j] = fminf(fmaxf(8.0f * a * sigmoidf_fast(a) * up, -440.f), 440.f); }
                    w8[k].x = pk4f8u(o[0]); w8[k].y = pk4f8u(o[1]); }
                *(u32x4*)(act + (size_t)(rowb + ai * HALF + mp * 32) * 1024 + col0) = fq_pair16(w8[0], w8[1]); }
        ++ui;
    }
};
struct EpiDown {
    static constexpr bool PERM = true, AFTER_DRAIN = false, WIDE = true, ROWSCALE = false; static constexpr int F8_SW = 0, F8_SA = 0; static constexpr int NVM = 8;
    unsigned char* y; const PG8_LAS float* glds; mutable int ui;
    __device__ __forceinline__ void operator()(const f32x4 (&acc)[2][2][4][2], const Unit& u, int wr, int wc, int fr, int fq) const {
        const int rowb = u.pm * BM + wr * 64 + fr + 16 * (fq & 1), col = (u.pn & 3) * BM + wc * 64 + 8 * (fq & ~1);
#pragma unroll
        for (int ai = 0; ai < 2; ++ai)
#pragma unroll
            for (int mp = 0; mp < 2; ++mp) { u32x2 p0[2], p1[2];
#pragma unroll
                for (int k = 0; k < 2; ++k) { const int m = 2 * mp + k;
                    const float gv = glds[ui * 256 + wr * 64 + fr + ai * HALF + m * 16] * (128.0f / 512.0f);
                    p0[k].x = pk4f8c(acc[ai][0][m][0] * gv); p0[k].y = pk4f8c(acc[ai][0][m][1] * gv); p1[k].x = pk4f8c(acc[ai][1][m][0] * gv); p1[k].y = pk4f8c(acc[ai][1][m][1] * gv); }
                unsigned char* p = y + (size_t)(rowb + ai * HALF + mp * 32) * 1024 + col;
                *(u32x4*)p = fq_pair16(p0[0], p0[1]); *(u32x4*)(p + 32) = fq_pair16(p1[0], p1[1]); }
        ++ui;
    }
};

template <class Epi, class Sched, bool ALIGN_EPI = false, bool SP2 = false, bool GATHER = false, bool FP8 = false>
__device__ __forceinline__ void gemm_phase(int tid_, PG8_LAS unsigned char* lds, const Gemm g, const Sched& S, const Epi& E, const PG8_LAS int* arow = nullptr) {
    static_assert(!GATHER || SP2, "GATHER is written for the SP2 loop");
    asm volatile("" : "+v"(tid_));
    const int tid = tid_, wid = __builtin_amdgcn_readfirstlane(tid >> 6), lane = tid & 63, wr = wid >> 2, wc = wid & 3, fr = lane & 15, fq = lane >> 4;
    const int K = g.K, nt = K / BK;
    unsigned voffA[2], voffB[2];
#pragma unroll
    for (int i = 0; i < 2; ++i) { int R, C; stage_rc(tid * 16 + i * 8192, R, C); const int Rb = Epi::WIDE ? ((R >> 5) * 64 + perm32(R & 31)) : (Epi::PERM ? ((R & ~31) + perm32(R & 31)) : R);
        voffA[i] = (unsigned)(R * K + C) * 2u; voffB[i] = (unsigned)(Rb * K + C) * 2u; }
    unsigned vA0[2] = {voffA[0], voffA[1]}, vA1[2] = {voffA[0], voffA[1]}, nA0[2] = {voffA[0], voffA[1]}, nA1[2] = {voffA[0], voffA[1]};
    int gR[2], gC[2];
#pragma unroll
    for (int i = 0; i < 2; ++i) { stage_rc(tid * 16 + i * 8192, gR[i], gC[i]); }
#define PG8_GOFF(dst0, dst1, u_) do { _Pragma("unroll") for (int _i = 0; _i < 2; ++_i) { \
        dst0[_i] = (((unsigned)arow[(u_) * 256 + gR[_i]] & 0xffffu) * (unsigned)K + (unsigned)gC[_i]) * 2u; dst1[_i] = (((unsigned)arow[(u_) * 256 + HALF + gR[_i]] & 0xffffu) * (unsigned)K + (unsigned)gC[_i]) * 2u; } } while (0)
    const size_t kstep = (size_t)(BK * 2);
    const size_t hstep = (size_t)HALF * K * 2;
    const size_t tstep = 2 * hstep;
    const size_t bhs = Epi::WIDE ? (size_t)32 * K * 2 : hstep;
    const size_t ahs = GATHER ? (size_t)0 : hstep, atstep = GATHER ? (size_t)0 : tstep;
    const unsigned ldsw = (unsigned)wid * 1024u;
    const int aoff = lds_byte(wr * 64 + fr, fq * 8), boff = lds_byte(wc * 32 + fr, fq * 8);
#define PG8_SA(b, h) (((b) * 2 + (h)) * HTB)
#define PG8_SB(b, h) ((4 + (b) * 2 + (h)) * HTB)
#define PG8_STAGE(bufoff, gbase, voff) do { _Pragma("unroll") for (int _i = 0; _i < 2; ++_i) \
        __builtin_amdgcn_global_load_lds((const unsigned*)((const char*)(gbase) + (voff)[_i]), (PG8_LAS unsigned*)(lds + (bufoff) + ldsw + _i * 8192), 16, 0, 0); } while (0)
#define PG8_LDA(dst, b, h) do { _Pragma("unroll") for (int m = 0; m < 4; ++m) _Pragma("unroll") for (int k = 0; k < 2; ++k) dst[m][k] = *(const PG8_LAS bf16x8*)(lds + PG8_SA(b, h) + aoff + m * 2048 + k * 1024); } while (0)
#define PG8_LDB(dst, b, h) do { _Pragma("unroll") for (int n = 0; n < 2; ++n) _Pragma("unroll") for (int k = 0; k < 2; ++k) dst[n][k] = *(const PG8_LAS bf16x8*)(lds + PG8_SB(b, h) + boff + n * 2048 + k * 1024); } while (0)
#define PG8_CAT8(x0, x1) __builtin_shufflevector(__builtin_bit_cast(i32x4_t, (x0)), __builtin_bit_cast(i32x4_t, (x1)), 0, 1, 2, 3, 4, 5, 6, 7)
#define PG8_MMA(ai, bj, At, Bt) do { __builtin_amdgcn_s_setprio(1); \
        if constexpr (FP8) { _Pragma("unroll") for (int m = 0; m < 4; ++m) _Pragma("unroll") for (int n = 0; n < 2; ++n) \
            asm volatile("v_mfma_f32_16x16x128_f8f6f4 %0, %1, %2, %0" : "+v"(acc[ai][bj][m][n]) : "v"(PG8_CAT8(Bt[n][0], Bt[n][1])), "v"(PG8_CAT8(At[m][0], At[m][1]))); } \
        else { _Pragma("unroll") for (int m = 0; m < 4; ++m) _Pragma("unroll") for (int n = 0; n < 2; ++n) _Pragma("unroll") for (int k = 0; k < 2; ++k) \
            acc[ai][bj][m][n] = __builtin_amdgcn_mfma_f32_16x16x32_bf16(Bt[n][k], At[m][k], acc[ai][bj][m][n], 0, 0, 0); } \
        __builtin_amdgcn_s_setprio(0); } while (0)
#define PG8_WAIT_V(n) asm volatile("s_waitcnt vmcnt(" #n ")" ::: "memory")
#define PG8_WAIT_L(n) asm volatile("s_waitcnt lgkmcnt(" #n ")" ::: "memory")
#define PG8_BAR __builtin_amdgcn_s_barrier()
#define PG8_SCHED __builtin_amdgcn_sched_barrier(0)
    Unit cur, nxt; int ui = 0;
    if (!S.next(0, cur)) return;
    f32x4 acc[2][2][4][2];
#pragma unroll
    for (int a = 0; a < 2; ++a)
#pragma unroll
        for (int b = 0; b < 2; ++b)
#pragma unroll
            for (int m = 0; m < 4; ++m)
#pragma unroll
                for (int n = 0; n < 2; ++n) acc[a][b][m][n] = (f32x4){0.f, 0.f, 0.f, 0.f};
    bf16x8 At[4][2], B0[2][2], B1[2][2];
    const char* cA = (const char*)g.A + (size_t)cur.pm * atstep; const char* cB = (const char*)g.Bt + (size_t)cur.pn * tstep;
    if constexpr (GATHER) { PG8_GOFF(vA0, vA1, 0); }
    S.a_ready(cur);
    if constexpr (SP2) {
        PG8_STAGE(PG8_SB(0, 0), cB, voffB); PG8_STAGE(PG8_SB(0, 1), cB + bhs, voffB); PG8_STAGE(PG8_SA(0, 0), cA, vA0); PG8_STAGE(PG8_SA(0, 1), cA + ahs, vA1);
        if (wr == 1) PG8_BAR;
        PG8_WAIT_V(2); PG8_BAR;
        PG8_STAGE(PG8_SB(1, 0), cB + kstep, voffB); PG8_STAGE(PG8_SA(1, 0), cA + kstep, vA0); PG8_STAGE(PG8_SB(1, 1), cB + bhs + kstep, voffB);
        PG8_WAIT_V(6); PG8_BAR;
    } else {
        PG8_STAGE(PG8_SB(0, 0), cB, voffB); PG8_STAGE(PG8_SA(0, 0), cA, voffA); PG8_STAGE(PG8_SB(0, 1), cB + bhs, voffB); PG8_STAGE(PG8_SA(0, 1), cA + hstep, voffA);
        if (wr == 1) PG8_BAR;
        PG8_WAIT_V(4); PG8_BAR;
        PG8_STAGE(PG8_SB(1, 0), cB + kstep, voffB); PG8_STAGE(PG8_SA(1, 0), cA + kstep, voffA); PG8_STAGE(PG8_SB(1, 1), cB + bhs + kstep, voffB);
        PG8_WAIT_V(6); PG8_BAR;
    }
    for (;;) {
        const bool has_next = S.next(ui + 1, nxt);
        const char* nA = has_next ? (const char*)g.A + (size_t)nxt.pm * atstep : cA; const char* nB = has_next ? (const char*)g.Bt + (size_t)nxt.pn * tstep : cB;
#pragma unroll 1
        for (int t = 0; t < nt; t += 2) {
            const bool last = (t == nt - 2);
            const char* a1 = cA + (size_t)(t + 1) * kstep;
            const char* a2 = last ? nA : cA + (size_t)(t + 2) * kstep; const char* b2 = last ? nB : cB + (size_t)(t + 2) * kstep;
            const char* a3 = a2 + kstep; const char* b3 = b2 + kstep;
            if (last && has_next) S.a_ready(nxt);
            if constexpr (Epi::ROWSCALE) { if (last) { E.rs0 = E.rsv[cur.pm * BM + wr * 64 + lane]; E.rs1 = E.rsv[cur.pm * BM + HALF + wr * 64 + lane]; } }
            unsigned s0[2] = {vA0[0], vA0[1]}, s1[2] = {vA1[0], vA1[1]};
            if constexpr (GATHER) { if (last && has_next) { PG8_GOFF(nA0, nA1, ui + 1); s0[0] = nA0[0]; s0[1] = nA0[1]; s1[0] = nA1[0]; s1[1] = nA1[1]; } }
            if constexpr (SP2) {
            PG8_LDB(B0, 0, 0); PG8_LDB(B1, 0, 1); PG8_SCHED; PG8_LDA(At, 0, 0); PG8_STAGE(PG8_SA(1, 1), a1 + ahs, vA1);
            PG8_WAIT_V(8); PG8_WAIT_L(0); PG8_BAR; PG8_MMA(0, 0, At, B0); PG8_MMA(0, 1, At, B1); PG8_BAR; PG8_SCHED;
            PG8_LDA(At, 0, 1); PG8_STAGE(PG8_SB(0, 0), b2, voffB); PG8_STAGE(PG8_SB(0, 1), b2 + bhs, voffB); PG8_STAGE(PG8_SA(0, 0), a2, s0);
            PG8_WAIT_V(8); PG8_WAIT_L(0); PG8_BAR; PG8_MMA(1, 0, At, B0); PG8_MMA(1, 1, At, B1); PG8_BAR; PG8_SCHED;
            PG8_LDB(B0, 1, 0); PG8_LDB(B1, 1, 1); PG8_SCHED; PG8_LDA(At, 1, 0); PG8_STAGE(PG8_SA(0, 1), a2 + ahs, s1);
            PG8_WAIT_V(8); PG8_WAIT_L(0); PG8_BAR; PG8_MMA(0, 0, At, B0); PG8_MMA(0, 1, At, B1); PG8_BAR; PG8_SCHED;
            PG8_LDA(At, 1, 1); PG8_STAGE(PG8_SB(1, 0), b3, voffB); PG8_STAGE(PG8_SB(1, 1), b3 + bhs, voffB); PG8_STAGE(PG8_SA(1, 0), a3, s0);
            PG8_WAIT_V(8); PG8_WAIT_L(0); PG8_BAR; PG8_MMA(1, 0, At, B0); PG8_MMA(1, 1, At, B1); PG8_BAR; PG8_SCHED;
            } else {
            PG8_LDB(B0, 0, 0); PG8_SCHED; PG8_LDA(At, 0, 0); PG8_STAGE(PG8_SA(1, 1), a1 + hstep, voffA);
            PG8_WAIT_L(8); PG8_BAR; PG8_WAIT_L(0); PG8_MMA(0, 0, At, B0); PG8_BAR; PG8_SCHED;
            PG8_LDB(B1, 0, 1); PG8_STAGE(PG8_SB(0, 0), b2, voffB);
            PG8_BAR; PG8_WAIT_L(0); PG8_MMA(0, 1, At, B1); PG8_BAR;
            PG8_LDA(At, 0, 1); PG8_STAGE(PG8_SA(0, 0), a2, voffA);
            PG8_BAR; PG8_WAIT_L(0); PG8_MMA(1, 0, At, B0); PG8_BAR; PG8_SCHED;
            PG8_STAGE(PG8_SB(0, 1), b2 + bhs, voffB);
            PG8_WAIT_V(6); PG8_BAR; PG8_MMA(1, 1, At, B1); PG8_BAR;
            PG8_LDB(B0, 1, 0); PG8_SCHED; PG8_LDA(At, 1, 0); PG8_STAGE(PG8_SA(0, 1), a2 + hstep, voffA);
            PG8_WAIT_L(8); PG8_BAR; PG8_WAIT_L(0); PG8_MMA(0, 0, At, B0); PG8_BAR; PG8_SCHED;
            PG8_LDB(B1, 1, 1); PG8_STAGE(PG8_SB(1, 0), b3, voffB);
            PG8_BAR; PG8_WAIT_L(0); PG8_MMA(0, 1, At, B1); PG8_BAR;
            PG8_LDA(At, 1, 1); PG8_STAGE(PG8_SA(1, 0), a3, voffA);
            PG8_BAR; PG8_WAIT_L(0); PG8_MMA(1, 0, At, B0); PG8_BAR; PG8_SCHED;
            PG8_STAGE(PG8_SB(1, 1), b3 + bhs, voffB);
            PG8_WAIT_V(6); PG8_BAR; PG8_MMA(1, 1, At, B1); PG8_BAR;
            }
        }
        if constexpr (ALIGN_EPI) { if (wr == 0) PG8_BAR; }
        if constexpr (FP8) asm volatile("s_nop 15\n\ts_nop 15" ::: "memory");
        if constexpr (!Epi::AFTER_DRAIN) { E(acc, cur, wr, wc, fr, fq); S.done(cur); }
        if (!has_next) break;
#pragma unroll
        for (int a = 0; a < 2; ++a)
#pragma unroll
            for (int b = 0; b < 2; ++b)
#pragma unroll
                for (int m = 0; m < 4; ++m)
#pragma unroll
                    for (int n = 0; n < 2; ++n) acc[a][b][m][n] = (f32x4){0.f, 0.f, 0.f, 0.f};
        cur = nxt; cA = nA; cB = nB; ++ui;
        if constexpr (GATHER) { vA0[0] = nA0[0]; vA0[1] = nA0[1]; vA1[0] = nA1[0]; vA1[1] = nA1[1]; }
        if constexpr (ALIGN_EPI) { if (wr == 1) PG8_BAR; }
    }
    PG8_WAIT_V(0);
    if constexpr (!ALIGN_EPI) { if (wr == 0) PG8_BAR; }
    PG8_BAR;
    if constexpr (Epi::AFTER_DRAIN) { E.fused(acc, cur, wr, wc, fr, fq, lds, wid, lane); S.done(cur); }
#undef PG8_SA
#undef PG8_SB
#undef PG8_STAGE
#undef PG8_LDA
#undef PG8_LDB
#undef PG8_MMA
#undef PG8_CAT8
#undef PG8_WAIT_V
#undef PG8_WAIT_L
#undef PG8_BAR
#undef PG8_SCHED
#undef PG8_GOFF
}

template <class Epi, class Sched>
__device__ __forceinline__ void gemm_phase_dual(int tid_, PG8_LAS unsigned char* lds, const Gemm g0, const Gemm g1, const Sched& S, const Epi& E) {
    asm volatile("" : "+v"(tid_));
    const int tid = tid_, wid = __builtin_amdgcn_readfirstlane(tid >> 6), lane = tid & 63, wr = wid >> 2, wc = wid & 3, fr = lane & 15, fq = lane >> 4;
    unsigned vA_0[2], vB_0[2], vA_1[2], vB_1[2];
#pragma unroll
    for (int i = 0; i < 2; ++i) { int R, C; stage_rc(tid * 16 + i * 8192, R, C); const int Rb = Epi::WIDE ? ((R >> 5) * 64 + perm32(R & 31)) : (Epi::PERM ? ((R & ~31) + perm32(R & 31)) : R);
        vA_0[i] = (unsigned)(R * g0.K + C) * 2u; vB_0[i] = (unsigned)(Rb * g0.K + C) * 2u; vA_1[i] = (unsigned)(R * g1.K + C) * 2u; vB_1[i] = (unsigned)(Rb * g1.K + C) * 2u; }
    const size_t kstep = (size_t)(BK * 2);
    const size_t hs_0 = (size_t)HALF * g0.K * 2, hs_1 = (size_t)HALF * g1.K * 2;
#define PG8_BH(x) (Epi::WIDE ? (x) / 4 : (x))
    const int nt_0 = g0.K / BK, nt_1 = g1.K / BK;
    const unsigned ldsw = (unsigned)wid * 1024u;
    const int aoff = lds_byte(wr * 64 + fr, fq * 8), boff = lds_byte(wc * 32 + fr, fq * 8);
#define PG8_SA(b, h) (((b) * 2 + (h)) * HTB)
#define PG8_SB(b, h) ((4 + (b) * 2 + (h)) * HTB)
#define PG8_STAGE(bufoff, gbase, voff) do { _Pragma("unroll") for (int _i = 0; _i < 2; ++_i) \
        __builtin_amdgcn_global_load_lds((const unsigned*)((const char*)(gbase) + (voff)[_i]), (PG8_LAS unsigned*)(lds + (bufoff) + ldsw + _i * 8192), 16, 0, 0); } while (0)
#define PG8_LDA(dst, b, h) do { _Pragma("unroll") for (int m = 0; m < 4; ++m) _Pragma("unroll") for (int k = 0; k < 2; ++k) dst[m][k] = *(const PG8_LAS bf16x8*)(lds + PG8_SA(b, h) + aoff + m * 2048 + k * 1024); } while (0)
#define PG8_LDB(dst, b, h) do { _Pragma("unroll") for (int n = 0; n < 2; ++n) _Pragma("unroll") for (int k = 0; k < 2; ++k) dst[n][k] = *(const PG8_LAS bf16x8*)(lds + PG8_SB(b, h) + boff + n * 2048 + k * 1024); } while (0)
#define PG8_MMA(ai, bj, At, Bt) do { __builtin_amdgcn_s_setprio(1); _Pragma("unroll") for (int m = 0; m < 4; ++m) _Pragma("unroll") for (int n = 0; n < 2; ++n) _Pragma("unroll") for (int k = 0; k < 2; ++k) \
        acc[ai][bj][m][n] = __builtin_amdgcn_mfma_f32_16x16x32_bf16(Bt[n][k], At[m][k], acc[ai][bj][m][n], 0, 0, 0); __builtin_amdgcn_s_setprio(0); } while (0)
#define PG8_WAIT_V(n) asm volatile("s_waitcnt vmcnt(" #n ")" ::: "memory")
#define PG8_WAIT_L(n) asm volatile("s_waitcnt lgkmcnt(" #n ")" ::: "memory")
#define PG8_BAR __builtin_amdgcn_s_barrier()
#define PG8_SCHED __builtin_amdgcn_sched_barrier(0)
    Unit cur, nxt; int ui = 0, s = 0;
    if (!S.next(0, cur)) return;
    f32x4 acc[2][2][4][2];
#pragma unroll
    for (int a = 0; a < 2; ++a)
#pragma unroll
        for (int b = 0; b < 2; ++b)
#pragma unroll
            for (int m = 0; m < 4; ++m)
#pragma unroll
                for (int n = 0; n < 2; ++n) acc[a][b][m][n] = (f32x4){0.f, 0.f, 0.f, 0.f};
    bf16x8 At[4][2], B0[2][2], B1[2][2];
    const char* cA = (const char*)g0.A + (size_t)cur.pm * 2 * hs_0; const char* cB = (const char*)g0.Bt + (size_t)cur.pn * 2 * hs_0;
    size_t hsC = hs_0; unsigned vAc[2] = {vA_0[0], vA_0[1]}, vBc[2] = {vB_0[0], vB_0[1]};
    PG8_STAGE(PG8_SB(0, 0), cB, vBc); PG8_STAGE(PG8_SB(0, 1), cB + PG8_BH(hsC), vBc); PG8_STAGE(PG8_SA(0, 0), cA, vAc); PG8_STAGE(PG8_SA(0, 1), cA + hsC, vAc);
    if (wr == 1) PG8_BAR;
    PG8_WAIT_V(2); PG8_BAR;
    PG8_STAGE(PG8_SB(1, 0), cB + kstep, vBc); PG8_STAGE(PG8_SA(1, 0), cA + kstep, vAc); PG8_STAGE(PG8_SB(1, 1), cB + PG8_BH(hsC) + kstep, vBc);
    PG8_WAIT_V(6); PG8_BAR;
    for (;;) {
        bool has_next = true; if (s == 1) has_next = S.next(ui + 1, nxt);
        const int npm = (s == 0) ? cur.pm : nxt.pm, npn = (s == 0) ? cur.pn : nxt.pn;
        const size_t hsN = has_next ? (s == 0 ? hs_1 : hs_0) : hsC;
        const char* nA = has_next ? (s == 0 ? (const char*)g1.A : (const char*)g0.A) + (size_t)npm * 2 * hsN : cA;
        const char* nB = has_next ? (s == 0 ? (const char*)g1.Bt : (const char*)g0.Bt) + (size_t)npn * 2 * hsN : cB;
        unsigned vAn[2], vBn[2];
#pragma unroll
        for (int i = 0; i < 2; ++i) { vAn[i] = has_next ? (s == 0 ? vA_1[i] : vA_0[i]) : vAc[i]; vBn[i] = has_next ? (s == 0 ? vB_1[i] : vB_0[i]) : vBc[i]; }
        const int nt = (s == 0) ? nt_0 : nt_1;
#pragma unroll 1
        for (int t = 0; t < nt; t += 2) {
            const bool last = (t == nt - 2);
            const char* a1 = cA + (size_t)(t + 1) * kstep;
            const char* a2 = last ? nA : cA + (size_t)(t + 2) * kstep; const char* b2 = last ? nB : cB + (size_t)(t + 2) * kstep;
            const char* a3 = a2 + kstep; const char* b3 = b2 + kstep;
            const size_t hs2 = last ? hsN : hsC;
            unsigned vA2[2], vB2[2];
#pragma unroll
            for (int i = 0; i < 2; ++i) { vA2[i] = last ? vAn[i] : vAc[i]; vB2[i] = last ? vBn[i] : vBc[i]; }
            PG8_LDB(B0, 0, 0); PG8_LDB(B1, 0, 1); PG8_SCHED; PG8_LDA(At, 0, 0); PG8_STAGE(PG8_SA(1, 1), a1 + hsC, vAc);
            PG8_WAIT_V(8); PG8_WAIT_L(0); PG8_BAR; PG8_MMA(0, 0, At, B0); PG8_MMA(0, 1, At, B1); PG8_BAR; PG8_SCHED;
            PG8_LDA(At, 0, 1); PG8_STAGE(PG8_SB(0, 0), b2, vB2); PG8_STAGE(PG8_SB(0, 1), b2 + PG8_BH(hs2), vB2); PG8_STAGE(PG8_SA(0, 0), a2, vA2);
            PG8_WAIT_V(8); PG8_WAIT_L(0); PG8_BAR; PG8_MMA(1, 0, At, B0); PG8_MMA(1, 1, At, B1); PG8_BAR; PG8_SCHED;
            PG8_LDB(B0, 1, 0); PG8_LDB(B1, 1, 1); PG8_SCHED; PG8_LDA(At, 1, 0); PG8_STAGE(PG8_SA(0, 1), a2 + hs2, vA2);
            PG8_WAIT_V(8); PG8_WAIT_L(0); PG8_BAR; PG8_MMA(0, 0, At, B0); PG8_MMA(0, 1, At, B1); PG8_BAR; PG8_SCHED;
            PG8_LDA(At, 1, 1); PG8_STAGE(PG8_SB(1, 0), b3, vB2); PG8_STAGE(PG8_SB(1, 1), b3 + PG8_BH(hs2), vB2); PG8_STAGE(PG8_SA(1, 0), a3, vA2);
            PG8_WAIT_V(8); PG8_WAIT_L(0); PG8_BAR; PG8_MMA(1, 0, At, B0); PG8_MMA(1, 1, At, B1); PG8_BAR; PG8_SCHED;
        }
        if (wr == 0) PG8_BAR;
        if (s == 0) E.mid(acc, cur, wr, wc, fr, fq); else E(acc, cur, wr, wc, fr, fq);
        if (!has_next) break;
        if (s == 1) {
#pragma unroll
            for (int a = 0; a < 2; ++a)
#pragma unroll
                for (int b = 0; b < 2; ++b)
#pragma unroll
                    for (int m = 0; m < 4; ++m)
#pragma unroll
                        for (int n = 0; n < 2; ++n) acc[a][b][m][n] = (f32x4){0.f, 0.f, 0.f, 0.f};
            cur = nxt; ++ui; }
        s ^= 1; cA = nA; cB = nB; hsC = hsN;
#pragma unroll
        for (int i = 0; i < 2; ++i) { vAc[i] = vAn[i]; vBc[i] = vBn[i]; }
        if (wr == 1) PG8_BAR;
    }
    PG8_WAIT_V(0);
    PG8_BAR;
#undef PG8_SA
#undef PG8_SB
#undef PG8_STAGE
#undef PG8_LDA
#undef PG8_LDB
#undef PG8_MMA
#undef PG8_WAIT_V
#undef PG8_WAIT_L
#undef PG8_BAR
#undef PG8_SCHED
#undef PG8_BH
}
}

constexpr int NWAVES = 8;
constexpr int NB = 32, SEQ = 2048, DM = 1024, MTOK = NB * SEQ, DEPTH = 4;
constexpr int INC = 5888, NE = 16, CAP = 256, DEX = 1024, MEXP = NE * NB * CAP;
constexpr float RMS_EPS = 1e-6f, LOG2E = 1.4426950408889634f;
constexpr float QSCALE = 0.125f * LOG2E;

constexpr size_t MiB = 1u << 20;
constexpr size_t WS_CTL = 0, CTL_ZERO_BYTES = 32768;
constexpr size_t WS_WIN = 1 * MiB;
constexpr size_t WS_WA = WS_WIN + (size_t)INC * DM * 2;
constexpr size_t WS_WB = WS_WA + (size_t)DM * 256 * 2;
constexpr size_t WS_WO = WS_WB + (size_t)DM * DM * 2;
constexpr size_t WS_WGU = WS_WO + (size_t)DM * DM * 2;
constexpr size_t WS_WD = WS_WGU + (size_t)NE * 2048 * DM * 2;
constexpr size_t WS_HN = WS_WD + (size_t)NE * DM * DEX * 2;
constexpr size_t WS_BIG = WS_HN + (size_t)MTOK * DM * 2;
constexpr size_t B_QA = 0, B_KA = 96 * MiB, B_VA = 192 * MiB, B_QW = 288 * MiB, B_KW = 416 * MiB, B_VW = 448 * MiB, B_G = 480 * MiB, B_OA = 736 * MiB, B_END = 768 * MiB;
constexpr size_t B_MERGED = 0;
constexpr size_t B_XE = 0, B_ACT = 256 * MiB, B_Y = 512 * MiB;
constexpr size_t WS_AFF = WS_BIG + B_END;
constexpr size_t WS_SEL = WS_AFF + (size_t)MTOK * NE * 4;
constexpr size_t WS_GATE = WS_SEL + (size_t)MTOK * NE * 4;
constexpr size_t WS_LSE = WS_GATE + (size_t)MEXP * 4;
constexpr size_t WS_IDX = WS_LSE + (size_t)3 * MTOK * 4 * 4;
constexpr size_t WS_HB = WS_IDX + (size_t)MEXP * 4;
constexpr size_t WS_END = WS_HB + (size_t)MTOK * DM * 2;
static_assert(WS_WIN % 256 == 0 && WS_WA % 256 == 0 && WS_WGU % 256 == 0 && WS_HN % 256 == 0 && WS_BIG % 256 == 0 && WS_AFF % 256 == 0, "alignment");
constexpr int CW_BAR = 4096;
constexpr int AROW_OFF = 131072;
constexpr int MISC_OFF = 147456, LDS_BYTES = 151552;

#define GAS __attribute__((address_space(1)))
#define LAS __attribute__((address_space(3)))
typedef unsigned short bf16;
typedef unsigned v4u __attribute__((ext_vector_type(4)));
typedef unsigned v2u __attribute__((ext_vector_type(2)));
typedef float f32x4 __attribute__((ext_vector_type(4)));
typedef float f32x16 __attribute__((ext_vector_type(16)));
typedef short bf16x8 __attribute__((ext_vector_type(8)));
#define LDS_WAIT() asm volatile("s_waitcnt lgkmcnt(0)" ::: "memory")
#define VM_WAIT() asm volatile("s_waitcnt vmcnt(0)" ::: "memory")

#define XB_TMO      128
#define XB_XCNT(j)  (256  + 64 * (j))
#define XB_XSUB(j)  (1280 + 64 * (j))
#define XB_XGEN(j)  (2304 + 64 * (j))
#define XB_TOP      3328
#define XB_TOPGEN   3392
#define XCD_BAR_WORDS 3456
#define XB_SPIN_CAP (1u << 18)

__device__ __forceinline__ unsigned xb_ld(unsigned* p)              { return __hip_atomic_load(p, __ATOMIC_RELAXED, __HIP_MEMORY_SCOPE_AGENT); }
__device__ __forceinline__ unsigned xb_add(unsigned* p, unsigned v) { return __hip_atomic_fetch_add(p, v, __ATOMIC_RELAXED, __HIP_MEMORY_SCOPE_AGENT); }
__device__ __forceinline__ unsigned xb_xcc_id() { return (unsigned)__builtin_amdgcn_s_getreg((3 << 11) | 20) & 0xFu; }
#define XB_SPIN(cond, bar) do { unsigned _sp = 0; while (cond) { __builtin_amdgcn_s_sleep(1); \
    if ((++_sp & 255u) == 0u) { if (xb_ld(&(bar)[XB_TMO])) break; if (_sp > XB_SPIN_CAP) { atomicAdd(&(bar)[XB_TMO], 1u); break; } } } } while (0)

__device__ __forceinline__ int xb_lane() { unsigned z = 0u; asm volatile("" : "+v"(z)); return (int)__builtin_amdgcn_mbcnt_hi(~0u, __builtin_amdgcn_mbcnt_lo(~0u, z)); }
struct XcdBarrier {
    int w;
    unsigned* bar; unsigned x;
    volatile LAS unsigned* st;
};

__device__ __forceinline__ XcdBarrier xcd_barrier_post(unsigned* bar, volatile LAS unsigned* st, int wave) {
    XcdBarrier b; b.w = wave; b.bar = bar; b.x = xb_xcc_id(); b.st = st;
    if (wave == 0 && xb_lane() == 0) (void)xb_add(&bar[XB_XCNT(b.x)], 1u);
    return b;
}
__device__ __forceinline__ void xcd_barrier_complete(unsigned* bar, unsigned x, unsigned& nloc, unsigned& nx) {
    const unsigned G = gridDim.x * gridDim.y * gridDim.z;
    unsigned sum, cnt, mine, sp = 0u;
    for (;;) {
        sum = 0u; cnt = 0u; mine = 0u;
#pragma unroll
        for (unsigned j = 0; j < 16; ++j) { const unsigned c = xb_ld(&bar[XB_XCNT(j)]); sum += c; cnt += (c > 0u) ? 1u : 0u; mine = (j == x) ? c : mine; }
        if (sum == G) break;
        __builtin_amdgcn_s_sleep(1);
        if ((++sp & 255u) == 0u) { if (xb_ld(&bar[XB_TMO])) break; if (sp > XB_SPIN_CAP) { atomicAdd(&bar[XB_TMO], 1u); break; } }
    }
    nloc = mine > 0u ? mine : 1u; nx = cnt > 0u ? cnt : 1u;
}

__device__ __forceinline__ void xcd_barrier(const XcdBarrier& b) {
    asm volatile("s_waitcnt vmcnt(0)" ::: "memory");
    __syncthreads();
    if (b.w == 0 && xb_lane() == 0) {
        unsigned* bar = b.bar;
        __builtin_amdgcn_s_waitcnt(0);
        unsigned nloc = b.st[0], nx = b.st[1];
        if (nloc == 0u) { xcd_barrier_complete(bar, b.x, nloc, nx); b.st[0] = nloc; b.st[1] = nx; }
        const unsigned old = xb_add(&bar[XB_XSUB(b.x)], 1u);
        const unsigned gen = old / nloc;
        if (old + 1u == (gen + 1u) * nloc) {
            __builtin_amdgcn_fence(__ATOMIC_RELEASE, "agent");
            asm volatile("s_waitcnt vmcnt(0)" ::: "memory");
            const unsigned og = xb_add(&bar[XB_TOP], 1u);
            const unsigned tg = og / nx;
            if (og + 1u == (tg + 1u) * nx) xb_add(&bar[XB_TOPGEN], 1u);
            else XB_SPIN(xb_ld(&bar[XB_TOPGEN]) == tg, bar);
            __builtin_amdgcn_fence(__ATOMIC_ACQUIRE, "agent");
            xb_add(&bar[XB_XGEN(b.x)], 1u);
            asm volatile("s_waitcnt vmcnt(0)" ::: "memory");
        } else {
            XB_SPIN(xb_ld(&bar[XB_XGEN(b.x)]) == gen, bar);
            __builtin_amdgcn_fence(__ATOMIC_ACQUIRE, "agent");
            asm volatile("s_waitcnt vmcnt(0)" ::: "memory");
        }
    }
    __syncthreads();
}

struct Frame {
    LAS unsigned char* lds;
    int tid, lane, wave, gw;
};
constexpr int PTAB_OFF = MISC_OFF + 256;
__device__ __forceinline__ unsigned long long ptab_get(LAS unsigned char* lds, int i) {
    LAS unsigned char* base = lds + PTAB_OFF; asm volatile("" : "+v"(base));
    const unsigned long long v = ((const volatile LAS unsigned long long*)base)[i];
    const unsigned lo = __builtin_amdgcn_readfirstlane((unsigned)v), hi = __builtin_amdgcn_readfirstlane((unsigned)(v >> 32));
    return ((unsigned long long)hi << 32) | lo;
}
#define P_IN(i) ((const float*)(const GAS float*)ptab_get(F.lds, (i)))
#define P_OUT ((float*)(GAS float*)ptab_get(F.lds, 14))
#define P_WS ((unsigned char*)(GAS unsigned char*)ptab_get(F.lds, 15))
__device__ __forceinline__ Frame make_frame(LAS unsigned char* lds, int wave_s) { Frame F; F.lds = lds; int bx = blockIdx.x; asm volatile("" : "+s"(bx));
    int ln = xb_lane(); asm volatile("" : "+v"(ln));
    F.lane = ln; F.wave = wave_s; F.tid = wave_s * 64 + ln; F.gw = bx * NWAVES + F.wave; return F; }
__device__ __forceinline__ float shx(float v, int o, int lane) { return __builtin_bit_cast(float, __builtin_amdgcn_ds_bpermute((lane ^ o) << 2, __builtin_bit_cast(int, v))); }
__device__ __forceinline__ unsigned shrel(unsigned v, int d, int lane) { return (unsigned)__builtin_amdgcn_ds_bpermute(((lane + d) & 63) << 2, (int)v); }
__device__ __forceinline__ float wave_sum(float v, int lane) {
#pragma unroll
    for (int o = 1; o < 64; o <<= 1) v += shx(v, o, lane);
    return v;
}
template <bool SCALE = false>
__device__ __forceinline__ void transpose_item(const float* W, int K, int N, bf16* dst, LAS float* scr, int k0, int n0, int lane, const float* gk = nullptr) {
    float tv[32];
#pragma unroll
    for (int i = 0; i < 32; ++i) { const int kk = 2 * i + (lane >> 5); tv[i] = W[(size_t)(k0 + kk) * N + n0 + (lane & 31)]; }
#pragma unroll
    for (int i = 0; i < 32; ++i) { const int kk = 2 * i + (lane >> 5); scr[kk * 33 + (lane & 31)] = tv[i]; }
    LDS_WAIT(); asm volatile("" ::: "memory");
    const int c = lane & 7;
    f32x4 ga = {1.f, 1.f, 1.f, 1.f}, gb = {1.f, 1.f, 1.f, 1.f};
    if (SCALE) { ga = *(const f32x4*)(gk + k0 + 8 * c); gb = *(const f32x4*)(gk + k0 + 8 * c + 4); }
#pragma unroll
    for (int j = 0; j < 4; ++j) { const int n = (lane >> 3) + 8 * j; const LAS float* s = scr + (8 * c) * 33 + n;
        v4u o; o.x = pk2bf(s[0 * 33] * ga.x, s[1 * 33] * ga.y); o.y = pk2bf(s[2 * 33] * ga.z, s[3 * 33] * ga.w); o.z = pk2bf(s[4 * 33] * gb.x, s[5 * 33] * gb.y); o.w = pk2bf(s[6 * 33] * gb.z, s[7 * 33] * gb.w);
        *(GAS v4u*)(dst + (size_t)n * K + k0 + 8 * c) = o; }
    LDS_WAIT(); asm volatile("" ::: "memory");
}
__device__ __forceinline__ float f8clamp(float x) { return fminf(fmaxf(x, -440.f), 440.f); }
__device__ __forceinline__ unsigned pk4f8(float a, float b, float c, float d) {
    int w = __builtin_amdgcn_cvt_pk_fp8_f32(f8clamp(a), f8clamp(b), 0, false); w = __builtin_amdgcn_cvt_pk_fp8_f32(f8clamp(c), f8clamp(d), w, true); return (unsigned)w; }
template <bool SCALE = false>
__device__ __forceinline__ void transpose_item8(const float* W, int K, int N, unsigned char* dst8, LAS float* scr, int k0, int n0, int lane, float mul, const float* gk = nullptr) {
    float tv[32];
#pragma unroll
    for (int i = 0; i < 32; ++i) { const int kk = 2 * i + (lane >> 5); tv[i] = W[(size_t)(k0 + kk) * N + n0 + (lane & 31)]; }
#pragma unroll
    for (int i = 0; i < 32; ++i) { const int kk = 2 * i + (lane >> 5); scr[kk * 33 + (lane & 31)] = tv[i]; }
    LDS_WAIT(); asm volatile("" ::: "memory");
    const int c = lane & 7;
    f32x4 ga = {mul, mul, mul, mul}, gb = {mul, mul, mul, mul};
    if (SCALE) { ga = *(const f32x4*)(gk + k0 + 8 * c) * mul; gb = *(const f32x4*)(gk + k0 + 8 * c + 4) * mul; }
#pragma unroll
    for (int j = 0; j < 4; ++j) { const int n = (lane >> 3) + 8 * j; const LAS float* s = scr + (8 * c) * 33 + n;
        v2u o; o.x = pk4f8(s[0 * 33] * ga.x, s[1 * 33] * ga.y, s[2 * 33] * ga.z, s[3 * 33] * ga.w); o.y = pk4f8(s[4 * 33] * gb.x, s[5 * 33] * gb.y, s[6 * 33] * gb.z, s[7 * 33] * gb.w);
        *(GAS v2u*)(dst8 + (size_t)n * K + k0 + 8 * c) = o; }
    LDS_WAIT(); asm volatile("" ::: "memory");
}
__device__ __forceinline__ void convert_weights(Frame& F, int l) {
    LAS float* scr = (LAS float*)(F.lds + F.wave * 8448);
    const int NGW = 256 * NWAVES;
    unsigned char* ws = P_WS;
    bf16* WinT = (bf16*)(ws + WS_WIN); bf16* WaT = (bf16*)(ws + WS_WA); bf16* WbT = (bf16*)(ws + WS_WB); bf16* WoT = (bf16*)(ws + WS_WO);
    bf16* WguT = (bf16*)(ws + WS_WGU); bf16* WdT = (bf16*)(ws + WS_WD);
    const float* w_in = P_IN(2) + (size_t)l * DM * INC; const float* w_a = P_IN(3) + (size_t)l * 256 * DM; const float* w_b = P_IN(4) + (size_t)l * DM * DM;
    const float* w_o = P_IN(7) + (size_t)l * DM * DM; const float* g2 = P_IN(8) + (size_t)l * DM; const float* g1n = P_IN(1) + (size_t)l * DM;
    const float* w_g = P_IN(10) + (size_t)l * NE * DM * DEX; const float* w_u = P_IN(11) + (size_t)l * NE * DM * DEX; const float* w_d = P_IN(12) + (size_t)l * NE * DEX * DM;
    constexpr int I_IN = 16 * (INC / 32), I_A = 4 * 32, I_B = 16 * 32, I_O = 16 * 32, I_E = NE * 16 * 32;
    constexpr int NITEMS = I_IN + I_A + I_B + I_O + 3 * I_E;
    for (int it = F.gw; it < NITEMS; it += NGW) {
        int r = it;
        if (r < I_IN) { const int nb = r % (INC / 32), kb = r / (INC / 32), n0 = 32 * nb; int drow = n0;
            if (n0 >= 3840) { const int gc = n0 - 3840, br = gc >> 10, cc = gc & 1023; drow = 3840 + (cc >> 7) * 256 + ((cc & 127) >> 5) * 64 + br * 32; }
            transpose_item8<true>(w_in, DM, INC, (unsigned char*)WinT + (size_t)drow * DM, scr, 64 * kb, n0, F.lane, 64.0f, g1n);
            continue; } r -= I_IN;
        if (r < I_A) { const int nb = r % 32, kb = r / 32; transpose_item(w_a, 256, DM, WaT + (size_t)(32 * nb) * 256, scr, 64 * kb, 32 * nb, F.lane); continue; } r -= I_A;
        if (r < I_B) { const int nb = r % 32, kb = r / 32; transpose_item(w_b, DM, DM, WbT + (size_t)(32 * nb) * DM, scr, 64 * kb, 32 * nb, F.lane); continue; } r -= I_B;
        if (r < I_O) { const int nb = r % 32, kb = r / 32; transpose_item8(w_o, DM, DM, (unsigned char*)WoT + (size_t)(32 * nb) * DM, scr, 64 * kb, 32 * nb, F.lane, 64.0f); continue; } r -= I_O;
        if (r < 2 * I_E) { const int up = r >= I_E; if (up) r -= I_E; const int e = r / 512, loc = r % 512, nb = loc % 32, kb = loc / 32, f0 = 32 * nb;
            const float* W = (up ? w_u : w_g) + (size_t)e * DM * DEX;
            transpose_item8<true>(W, DM, DEX, (unsigned char*)WguT + ((size_t)e * 2048 + (f0 >> 7) * 256 + (up ? 128 : 0) + (f0 & 127)) * DM, scr, 64 * kb, f0, F.lane, 64.0f, g2); continue; } r -= 2 * I_E;
        { const int e = r / 512, loc = r % 512, nb = loc % 32, kb = loc / 32;
            transpose_item8(w_d + (size_t)e * DEX * DM, DEX, DM, (unsigned char*)WdT + ((size_t)e * 1024 + 32 * nb) * DEX, scr, 64 * kb, 32 * nb, F.lane, 64.0f); }
    }
}
__device__ __forceinline__ void unpk8(const v4u w, float (&v)[8]) { v[0] = bflo(w.x); v[1] = bfhi(w.x); v[2] = bflo(w.y); v[3] = bfhi(w.y); v[4] = bflo(w.z); v[5] = bfhi(w.z); v[6] = bflo(w.w); v[7] = bfhi(w.w); }
__device__ __forceinline__ v4u pk8(const float (&v)[8]) { v4u w; w.x = pk2bf(v[0], v[1]); w.y = pk2bf(v[2], v[3]); w.z = pk2bf(v[4], v[5]); w.w = pk2bf(v[6], v[7]); return w; }
__device__ __forceinline__ void unpk8f8(const v2u w, float (&v)[8]) {
    const f32x2_t a = __builtin_amdgcn_cvt_pk_f32_fp8((int)w.x, false), b = __builtin_amdgcn_cvt_pk_f32_fp8((int)w.x, true), c = __builtin_amdgcn_cvt_pk_f32_fp8((int)w.y, false), d = __builtin_amdgcn_cvt_pk_f32_fp8((int)w.y, true);
    v[0] = a.x; v[1] = a.y; v[2] = b.x; v[3] = b.y; v[4] = c.x; v[5] = c.y; v[6] = d.x; v[7] = d.y; }
template <bool XIN, bool COMBINE, bool FINAL>
__device__ __forceinline__ void norm_rows(Frame& F, const float* xin, bf16* hb, const float* gain, float* rsv, float* out, unsigned char* hn8 = nullptr) {
    const int NGW = 256 * NWAVES;
    unsigned char* ws = P_WS;
    const int* sel = (const int*)(ws + WS_SEL); const unsigned char* Y = ws + WS_BIG + B_Y;
    float gv[2][8];
#pragma unroll
    for (int j = 0; j < 2; ++j) { const f32x4 a = *(const f32x4*)(gain + (64 * j + F.lane) * 8), b = *(const f32x4*)(gain + (64 * j + F.lane) * 8 + 4);
        gv[j][0] = a.x; gv[j][1] = a.y; gv[j][2] = a.z; gv[j][3] = a.w; gv[j][4] = b.x; gv[j][5] = b.y; gv[j][6] = b.z; gv[j][7] = b.w; }
    constexpr int NR = 4;
    for (int m0 = F.gw; m0 < MTOK; m0 += NR * NGW) {
        float v[NR][2][8]; int sv[NR];
#pragma unroll
        for (int rr = 0; rr < NR; ++rr) { const int m = m0 + rr * NGW;
            if (COMBINE) sv[rr] = sel[(size_t)m * NE + (F.lane & 15)];
            if (XIN) {
#pragma unroll
                for (int j = 0; j < 2; ++j) { const f32x4 a = *(const f32x4*)(xin + (size_t)m * DM + (64 * j + F.lane) * 8), b = *(const f32x4*)(xin + (size_t)m * DM + (64 * j + F.lane) * 8 + 4);
                    v[rr][j][0] = a.x; v[rr][j][1] = a.y; v[rr][j][2] = a.z; v[rr][j][3] = a.w; v[rr][j][4] = b.x; v[rr][j][5] = b.y; v[rr][j][6] = b.z; v[rr][j][7] = b.w; }
            } else {
#pragma unroll
                for (int j = 0; j < 2; ++j) unpk8(*(const v4u*)(hb + (size_t)m * DM + (64 * j + F.lane) * 8), v[rr][j]);
            } }
        if (COMBINE) {
            unsigned msk[NR];
#pragma unroll
            for (int rr = 0; rr < NR; ++rr) msk[rr] = (unsigned)(__builtin_amdgcn_ballot_w64(sv[rr] >= 0) & 0xffffull);
            unsigned any = 0u;
#pragma unroll
            for (int rr = 0; rr < NR; ++rr) any |= msk[rr];
            while (any != 0u) {
                v2u yv[NR][2]; float wgt[NR];
#pragma unroll
                for (int rr = 0; rr < NR; ++rr) { const int m = m0 + rr * NGW, b = m >> 11; const bool has = msk[rr] != 0u;
                    const int e = has ? __builtin_ctz(msk[rr]) : 0; const int r = has ? __builtin_amdgcn_readlane(sv[rr], e) : 0;
                    const unsigned char* yr = Y + ((size_t)(e * NB + b) * CAP + r) * DM; wgt[rr] = has ? (1.0f / 128.0f) : 0.0f; msk[rr] &= msk[rr] - 1u;
#pragma unroll
                    for (int j = 0; j < 2; ++j) yv[rr][j] = *(const v2u*)(yr + (64 * j + F.lane) * 8); }
                any = 0u;
#pragma unroll
                for (int rr = 0; rr < NR; ++rr) { any |= msk[rr];
#pragma unroll
                    for (int j = 0; j < 2; ++j) { float y[8]; unpk8f8(yv[rr][j], y);
#pragma unroll
                        for (int i = 0; i < 8; ++i) v[rr][j][i] += wgt[rr] * y[i]; } }
            }
        }
#pragma unroll
        for (int rr = 0; rr < NR; ++rr) { const int m = m0 + rr * NGW;
            if ((XIN || COMBINE) && !FINAL) {
#pragma unroll
                for (int j = 0; j < 2; ++j) *(v4u*)(hb + (size_t)m * DM + (64 * j + F.lane) * 8) = pk8(v[rr][j]);
            }
            float ss = 0.f;
#pragma unroll
            for (int j = 0; j < 2; ++j)
#pragma unroll
                for (int i = 0; i < 8; ++i) ss += v[rr][j][i] * v[rr][j][i];
            const float rs = 1.0f / sqrtf(wave_sum(ss, F.lane) * (1.0f / DM) + RMS_EPS);
            if (FINAL) {
#pragma unroll
                for (int j = 0; j < 2; ++j) { float o[8];
#pragma unroll
                    for (int i = 0; i < 8; ++i) o[i] = v[rr][j][i] * rs * gv[j][i];
                    float* op = out + (size_t)m * DM + (64 * j + F.lane) * 8; *(f32x4*)op = (f32x4){o[0], o[1], o[2], o[3]}; *(f32x4*)(op + 4) = (f32x4){o[4], o[5], o[6], o[7]}; }
            } else { if (F.lane == 0) rsv[m] = rs;
                const float rs16 = rs * 16.0f;
#pragma unroll
                for (int j = 0; j < 2; ++j) { v2u o; o.x = pk4f8(v[rr][j][0] * rs16, v[rr][j][1] * rs16, v[rr][j][2] * rs16, v[rr][j][3] * rs16); o.y = pk4f8(v[rr][j][4] * rs16, v[rr][j][5] * rs16, v[rr][j][6] * rs16, v[rr][j][7] * rs16);
                    *(v2u*)(hn8 + (size_t)m * DM + (64 * j + F.lane) * 8) = o; } } }
    }
}
constexpr int RT_PITCH = 2048 + 16;
__device__ __forceinline__ void norm_router(Frame& F, const bf16* hb, const float* gain, const float* wr, float* rsv, float* aff, unsigned char* hn8) {
    LAS unsigned char* whi = F.lds; LAS unsigned char* wlo = F.lds + 16 * RT_PITCH; LAS float* gl = (LAS float*)(F.lds + 32 * RT_PITCH);
    { const float g0 = gain[F.tid], g1 = gain[F.tid + NWAVES * 64]; gl[F.tid] = g0; gl[F.tid + NWAVES * 64] = g1; }
    __syncthreads();
    { f32x4 wv[8];
#pragma unroll
      for (int j = 0; j < 8; ++j) wv[j] = *(const f32x4*)(wr + 4 * (F.tid + j * NWAVES * 64));
      asm volatile("" ::: "memory");
#pragma unroll
      for (int j = 0; j < 8; ++j) { const int i0 = 4 * (F.tid + j * NWAVES * 64), k = i0 >> 4, e0 = i0 & 15; const float g = gl[k];
#pragma unroll
          for (int t = 0; t < 4; ++t) { const float w = wv[j][t] * g; const unsigned hi = pk2bf(w, 0.f) & 0xffffu; const float rem = w - bflo(hi);
              *(LAS unsigned short*)(whi + (e0 + t) * RT_PITCH + k * 2) = (unsigned short)hi; *(LAS unsigned short*)(wlo + (e0 + t) * RT_PITCH + k * 2) = (unsigned short)(pk2bf(rem, 0.f) & 0xffffu); } } }
    __syncthreads();
    const int NGW = 256 * NWAVES, r16 = F.lane & 15, q = F.lane >> 4;
    for (int grp = F.gw; grp < MTOK / 16; grp += NGW) {
        const size_t row = (size_t)grp * 16 + r16;
        v4u xs[32];
#pragma unroll
        for (int s = 0; s < 16; ++s) { const v4u* p = (const v4u*)(hb + row * DM + 64 * s + 16 * q); xs[2 * s] = p[0]; xs[2 * s + 1] = p[1]; }
        f32x4 acc = {0.f, 0.f, 0.f, 0.f}; float ss = 0.f;
#pragma unroll
        for (int s = 0; s < 16; ++s) {
#pragma unroll
            for (int h2 = 0; h2 < 2; ++h2) { const bf16x8 a = __builtin_bit_cast(bf16x8, xs[2 * s + h2]);
                const bf16x8 bh = *(const LAS bf16x8*)(whi + r16 * RT_PITCH + (64 * s + 16 * q + 8 * h2) * 2), bl = *(const LAS bf16x8*)(wlo + r16 * RT_PITCH + (64 * s + 16 * q + 8 * h2) * 2);
                acc = __builtin_amdgcn_mfma_f32_16x16x32_bf16(a, bh, acc, 0, 0, 0); acc = __builtin_amdgcn_mfma_f32_16x16x32_bf16(a, bl, acc, 0, 0, 0);
                float x[8]; unpk8(xs[2 * s + h2], x);
#pragma unroll
                for (int i = 0; i < 8; ++i) ss += x[i] * x[i]; }
            asm volatile("" ::: "memory"); }
        ss += shx(ss, 16, F.lane); ss += shx(ss, 32, F.lane);
        const float rs = 1.0f / sqrtf(ss * (1.0f / DM) + RMS_EPS);
        float lg[4];
#pragma unroll
        for (int r = 0; r < 4; ++r) { const float rr = __builtin_bit_cast(float, __builtin_amdgcn_ds_bpermute((4 * q + r) << 2, __builtin_bit_cast(int, rs))); lg[r] = acc[r] * rr; }
#pragma unroll
        for (int r = 0; r < 4; ++r) { float mx = lg[r];
#pragma unroll
            for (int o = 1; o < 16; o <<= 1) mx = fmaxf(mx, shx(mx, o, F.lane));
            const float ex = __expf(lg[r] - mx); float sm = ex;
#pragma unroll
            for (int o = 1; o < 16; o <<= 1) sm += shx(sm, o, F.lane);
            aff[((size_t)grp * 16 + 4 * q + r) * NE + r16] = ex / sm; }
        if (q == 0) rsv[row] = rs;
        { const float rs16 = rs * 16.0f;
#pragma unroll
          for (int s = 0; s < 16; ++s) { v4u o;
#pragma unroll
              for (int h2 = 0; h2 < 2; ++h2) { v4u t = xs[2 * s + h2]; asm volatile("" : "+v"(t));
                  float x[8]; unpk8(t, x);
                  o[2 * h2] = pk4f8(x[0] * rs16, x[1] * rs16, x[2] * rs16, x[3] * rs16); o[2 * h2 + 1] = pk4f8(x[4] * rs16, x[5] * rs16, x[6] * rs16, x[7] * rs16); }
              *(v4u*)(hn8 + row * DM + 64 * s + 16 * q) = o;
              asm volatile("" ::: "memory"); } }
    }
}
__device__ __forceinline__ void topk_gather(Frame& F, const float* aff, const float* rsv, int* sel, float* gatev, int* idxg) {
    LAS unsigned* hist = (LAS unsigned*)F.lds;
    volatile LAS unsigned* st = (volatile LAS unsigned*)(F.lds + 1024);
    for (int u = blockIdx.x; u < NB * NE; u += 256) {
        const int b = u >> 4, e = u & 15;
        unsigned bits[4];
#pragma unroll
        for (int q = 0; q < 4; ++q) bits[q] = __float_as_uint(aff[((size_t)b * SEQ + 4 * F.tid + q) * NE + e]);
        const f32x4 rs4 = *(const f32x4*)(rsv + (size_t)b * SEQ + 4 * F.tid);
        unsigned prefix = 0u, kk = CAP;
#pragma unroll 1
        for (int pass = 0; pass < 4; ++pass) {
            const int shift = 24 - 8 * pass;
            if (F.tid < 256) hist[F.tid] = 0u;
            __syncthreads();
#pragma unroll
            for (int q = 0; q < 4; ++q) { const bool in = (pass == 0) || ((bits[q] >> (shift + 8)) == prefix); if (in) atomicAdd((unsigned*)&hist[(bits[q] >> shift) & 255u], 1u); }
            __syncthreads();
            if (F.wave == 0) {
                const unsigned c0 = hist[4 * F.lane], c1 = hist[4 * F.lane + 1], c2 = hist[4 * F.lane + 2], c3 = hist[4 * F.lane + 3];
                unsigned incl = c0 + c1 + c2 + c3;
#pragma unroll
                for (int o = 1; o < 64; o <<= 1) { const unsigned v = shrel(incl, o, F.lane); if (F.lane + o < 64) incl += v; }
                unsigned cum = incl - (c0 + c1 + c2 + c3);
                int found = -1; unsigned above = 0u;
                if (cum < kk && cum + c3 >= kk) { found = 3; above = cum; } cum += c3;
                if (cum < kk && cum + c2 >= kk) { found = 2; above = cum; } cum += c2;
                if (cum < kk && cum + c1 >= kk) { found = 1; above = cum; } cum += c1;
                if (cum < kk && cum + c0 >= kk) { found = 0; above = cum; }
                if (found >= 0) { st[0] = (prefix << 8) | (unsigned)(4 * F.lane + found); st[1] = kk - above; }
            }
            __syncthreads();
            prefix = st[0]; kk = st[1];
        }
        const unsigned T = prefix;
        unsigned ngt = 0u, neq = 0u;
#pragma unroll
        for (int q = 0; q < 4; ++q) { ngt += bits[q] > T ? 1u : 0u; neq += bits[q] == T ? 1u : 0u; }
        unsigned pk = ngt | (neq << 16), inc = pk;
#pragma unroll
        for (int o = 1; o < 64; o <<= 1) { const unsigned v = shrel(inc, -o, F.lane); if (F.lane >= o) inc += v; }
        if (F.lane == 63) st[8 + F.wave] = inc;
        __syncthreads();
        unsigned base = 0u;
#pragma unroll
        for (int w = 0; w < NWAVES; ++w) base += (w < F.wave) ? st[8 + w] : 0u;
        const unsigned excl = base + inc - pk;
        unsigned pgt = excl & 0xffffu, peq = excl >> 16;
#pragma unroll
        for (int q = 0; q < 4; ++q) { const int i = 4 * F.tid + q; const bool g = bits[q] > T, eq = bits[q] == T; const bool keep = g || (eq && peq < kk);
            const unsigned slot = pgt + (peq < kk ? peq : kk);
            if (keep) { idxg[(size_t)(e * NB + b) * CAP + slot] = (int)((unsigned)(b * SEQ + i) | ((unsigned)__builtin_bit_cast(unsigned short, (_Float16)rs4[q]) << 16)); gatev[(size_t)(e * NB + b) * CAP + slot] = __uint_as_float(bits[q]); }
            sel[((size_t)b * SEQ + i) * NE + e] = keep ? (int)slot : -1;
            pgt += g ? 1u : 0u; peq += eq ? 1u : 0u; }
        __syncthreads();
    }
}


constexpr int ATT_KPITCH = 144, ATT_VT_OFF = 512 * ATT_KPITCH, ATT_VPITCH = 1040, ATT_SINK_OFF = MISC_OFF + 1024;
static_assert(ATT_VT_OFF + 64 * ATT_VPITCH <= MISC_OFF, "attention LDS");
#ifndef ATT_JT_UNROLL
#define ATT_JT_UNROLL 1
#endif
struct ChunkP { const bf16* K; const bf16* V; int ldkv, tok0, cstep, r, L, nseg, qs, i0; };
template <int W>
__device__ __forceinline__ void attn_issue(const ChunkP& p, int tid, v4u (&kreg)[8], v4u (&vreg)[2][4]) {
    asm volatile("" : "+v"(tid));
    const int KS = p.qs + 2 * W, nrows = p.nseg * KS, Lm1 = p.L - 1;
    constexpr int NKP = 8;
#pragma unroll
    for (int it = 0; it < NKP; ++it) { const int pc = tid + it * NWAVES * 64, row0 = pc >> 3, ch = pc & 7, row = row0 < nrows ? row0 : nrows - 1, s = row >= KS ? 1 : 0, rho = row - s * KS;
        int j = p.i0 - W + rho; j = j < 0 ? 0 : j; j = j > Lm1 ? Lm1 : j;
        kreg[it] = *(const v4u*)(p.K + (size_t)(p.tok0 + s * p.cstep + p.r * j) * p.ldkv + ch * 8); }
#pragma unroll
    for (int it = 0; it < 2; ++it) { const int t = tid + it * NWAVES * 64, r4 = t >> 3, ch = t & 7, rowa = 4 * r4, row0 = rowa < nrows ? rowa : nrows - 4, s = row0 >= KS ? 1 : 0, rho = row0 - s * KS, j0 = p.i0 - W + rho;
#pragma unroll
        for (int q = 0; q < 4; ++q) { int j = j0 + q; j = j < 0 ? 0 : j; j = j > Lm1 ? Lm1 : j;
            vreg[it][q] = *(const v4u*)(p.V + (size_t)(p.tok0 + s * p.cstep + p.r * j) * p.ldkv + ch * 8); } }
}
__device__ __forceinline__ void attn_loadq(const Frame& F, const ChunkP& p, const bf16* Q, int ldq, bf16x8 (&qf)[4]) {
    int lane_ = F.lane; asm volatile("" : "+v"(lane_));
    const int wq = F.wave * 32, sidx = (wq >= p.qs) ? 1 : 0, qo = wq - sidx * p.qs, ql = lane_ & 31, hh = lane_ >> 5, qi = p.i0 + qo + ql;
    const bf16* q0 = Q + (size_t)(p.tok0 + sidx * p.cstep + p.r * qi) * ldq;
#pragma unroll
    for (int ks = 0; ks < 4; ++ks) qf[ks] = *(const bf16x8*)(q0 + 16 * ks + 8 * hh);
}
template <int W>
__device__ __forceinline__ void attn_commit(Frame& F, const ChunkP& p, const v4u (&kreg)[8], const v4u (&vreg)[2][4]) {
    int tid = F.tid; asm volatile("" : "+v"(tid));
    const int KS = p.qs + 2 * W, nrows = p.nseg * KS;
    LAS unsigned char* ldsK = F.lds; LAS unsigned char* ldsV = F.lds + ATT_VT_OFF;
    constexpr int NKP = 8;
#pragma unroll
    for (int it = 0; it < NKP; ++it) { const int pc = tid + it * NWAVES * 64, row = pc >> 3, ch = pc & 7;
        if (pc < nrows * 8) *(LAS v4u*)(ldsK + row * ATT_KPITCH + ch * 16) = kreg[it]; }
#pragma unroll
    for (int it = 0; it < 2; ++it) { const int t = tid + it * NWAVES * 64, r4 = t >> 3, ch = t & 7, row0 = 4 * r4;
        if (t < nrows * 2) {
            const int kap = row0 & 31, slot = (kap >> 4) * 16 + ((kap >> 2) & 1) * 8 + ((kap >> 3) & 1) * 4, pos = (row0 & ~31) + slot;
#pragma unroll
            for (int w = 0; w < 4; ++w) {
                v2u lo, hi;
                lo.x = (vreg[it][0][w] & 0xffffu) | (vreg[it][1][w] << 16); lo.y = (vreg[it][2][w] & 0xffffu) | (vreg[it][3][w] << 16);
                hi.x = (vreg[it][0][w] >> 16) | (vreg[it][1][w] & 0xffff0000u); hi.y = (vreg[it][2][w] >> 16) | (vreg[it][3][w] & 0xffff0000u);
                *(LAS v2u*)(ldsV + (ch * 8 + 2 * w) * ATT_VPITCH + pos * 2) = lo;
                *(LAS v2u*)(ldsV + (ch * 8 + 2 * w + 1) * ATT_VPITCH + pos * 2) = hi;
            } } }
}
#ifndef ATT_THR
#define ATT_THR 8.0f
#endif
template <int W, int NH, bool SINK, bool WRITE_LSE>
__device__ __forceinline__ void attn_compute(Frame& F, const ChunkP& p, bf16* Q, int ldq, long odelta, float* lse, float slope1, const float* sinkp, int hbase, bf16x8 (&qf)[4], int g_lo = 0, int g_hi = NH) {
    constexpr int NJT = 2 * W / 32 + 1, JC = W / 32;
    const int KS = p.qs + 2 * W, L = p.L, i0 = p.i0;
    LAS unsigned char* ldsK = F.lds; LAS unsigned char* ldsV = F.lds + ATT_VT_OFF;
    const int wq = F.wave * 32, sidx = (wq >= p.qs) ? 1 : 0, qo = wq - sidx * p.qs, segbase = sidx * KS;
    int lane_ = F.lane; asm volatile("" : "+v"(lane_));
    const int ql = lane_ & 31, hh = lane_ >> 5;
    const int qi = i0 + qo + ql;
    const size_t qtok = (size_t)(p.tok0 + sidx * p.cstep + p.r * qi);
    const float flo = (float)((-qi > -W) ? -qi : -W), fhi = (float)((L - 1 - qi < W) ? (L - 1 - qi) : W);
#pragma unroll 1
    for (int g = g_lo; g < g_hi; ++g) {
        bf16* qptr = Q + qtok * ldq + g * 64;
        f32x16 O0, O1;
        float m, l;
#ifdef PRB_REP
        constexpr int nrep = (NH == PRB_NH) ? PRB_REP : 1;
#pragma unroll 1
        for (int rep = 0; rep < nrep; ++rep) {
        asm volatile("" ::: "memory");
#endif
#pragma unroll
        for (int i = 0; i < 16; ++i) { O0[i] = 0.f; O1[i] = 0.f; }
        const float sl = (NH == 1) ? slope1 : __builtin_amdgcn_exp2f(-0.5f * (float)(hbase + g + 1)) * LOG2E;
        const float sk2 = SINK ? *(const LAS float*)(F.lds + ATT_SINK_OFF + 4 * (hbase + g)) : 0.f;
        {
            const int jbase = i0 + qo - W + 32 * JC, krow = segbase + qo + 32 * JC;
            const bool need_mask = (jbase < 0) || (jbase + 31 >= L);
            f32x16 S;
#pragma unroll
            for (int i = 0; i < 16; ++i) S[i] = 0.f;
#pragma unroll
            for (int ks = 0; ks < 4; ++ks) { const bf16x8 kf = *(const LAS bf16x8*)(ldsK + (krow + ql) * ATT_KPITCH + (16 * ks + 8 * hh) * 2); S = __builtin_amdgcn_mfma_f32_32x32x16_bf16(kf, qf[ks], S, 0, 0, 0); }
            const float fd0 = (float)(jbase + 4 * hh - qi);
#pragma unroll
            for (int i = 0; i < 16; ++i) { const float fd = fd0 + (float)((i & 3) + 8 * (i >> 2)); S[i] = S[i] - sl * fabsf(fd); }
            if (need_mask) {
#pragma unroll
                for (int i = 0; i < 16; ++i) { const float fd = fd0 + (float)((i & 3) + 8 * (i >> 2)); S[i] = (fd >= flo && fd <= fhi) ? S[i] : -INFINITY; } }
            float mloc = S[0];
#pragma unroll
            for (int i = 1; i < 16; ++i) mloc = fmaxf(mloc, S[i]);
            m = fmaxf(mloc, shx(mloc, 32, lane_));
            float ps = 0.f;
#pragma unroll
            for (int i = 0; i < 16; ++i) { const float pv = __builtin_amdgcn_exp2f(S[i] - m); S[i] = pv; ps += pv; }
            l = ps;
#pragma unroll
            for (int s2 = 0; s2 < 2; ++s2) {
                f32x8_t pp;
#pragma unroll
                for (int i = 0; i < 8; ++i) pp[i] = S[8 * s2 + i];
                const bf16x8 pf = __builtin_bit_cast(bf16x8, __builtin_convertvector(pp, nbf16x8));
                const bf16x8 v0 = *(const LAS bf16x8*)(ldsV + ql * ATT_VPITCH + (krow + 16 * s2 + 8 * hh) * 2);
                const bf16x8 v1 = *(const LAS bf16x8*)(ldsV + (ql + 32) * ATT_VPITCH + (krow + 16 * s2 + 8 * hh) * 2);
                O0 = __builtin_amdgcn_mfma_f32_32x32x16_bf16(v0, pf, O0, 0, 0, 0);
                O1 = __builtin_amdgcn_mfma_f32_32x32x16_bf16(v1, pf, O1, 0, 0, 0);
            }
        }
#pragma unroll 1
        for (int jt = 0; jt < NJT; ++jt) {
            if (jt == JC) continue;
            const int jbase = i0 + qo - W + 32 * jt;
            if (jbase + 31 < 0 || jbase >= L) continue;
            const bool need_mask = (jt == 0) || (jt == NJT - 1) || (jbase < 0) || (jbase + 31 >= L);
            const int krow = segbase + qo + 32 * jt;
            const float fd0 = (float)(jbase + 4 * hh - qi);
            bf16x8 kf[4];
#pragma unroll
            for (int ks = 0; ks < 4; ++ks) kf[ks] = *(const LAS bf16x8*)(ldsK + (krow + ql) * ATT_KPITCH + (16 * ks + 8 * hh) * 2);
            const bf16x8 vf00 = *(const LAS bf16x8*)(ldsV + ql * ATT_VPITCH + (krow + 8 * hh) * 2), vf10 = *(const LAS bf16x8*)(ldsV + (ql + 32) * ATT_VPITCH + (krow + 8 * hh) * 2);
            f32x16 S;
            if (jt < JC) { const float k1 = sl * fd0 - m;
#pragma unroll
                for (int i = 0; i < 16; ++i) S[i] = fmaf(sl, (float)((i & 3) + 8 * (i >> 2)), k1); }
            else { const float k1 = -sl * fd0 - m;
#pragma unroll
                for (int i = 0; i < 16; ++i) S[i] = fmaf(-sl, (float)((i & 3) + 8 * (i >> 2)), k1); }
            if (need_mask) {
#pragma unroll
                for (int i = 0; i < 16; ++i) { const float fd = fd0 + (float)((i & 3) + 8 * (i >> 2)); S[i] = (fd >= flo && fd <= fhi) ? S[i] : -INFINITY; } }
#pragma unroll
            for (int ks = 0; ks < 4; ++ks) S = __builtin_amdgcn_mfma_f32_32x32x16_bf16(kf[ks], qf[ks], S, 0, 0, 0);
            const bf16x8 vf01 = *(const LAS bf16x8*)(ldsV + ql * ATT_VPITCH + (krow + 16 + 8 * hh) * 2), vf11 = *(const LAS bf16x8*)(ldsV + (ql + 32) * ATT_VPITCH + (krow + 16 + 8 * hh) * 2);
            float tmax = S[0];
#pragma unroll
            for (int i = 1; i < 16; ++i) tmax = fmaxf(tmax, S[i]);
            if (__builtin_amdgcn_ballot_w64(tmax > ATT_THR) != 0ull) {
                float d = fmaxf(tmax, 0.f); d = fmaxf(d, shx(d, 32, lane_));
                const float sc = __builtin_amdgcn_exp2f(-d);
#pragma unroll
                for (int i = 0; i < 16; ++i) { S[i] -= d; O0[i] *= sc; O1[i] *= sc; }
                l *= sc; m += d;
            }
            float ps = 0.f;
#pragma unroll
            for (int i = 0; i < 16; ++i) { const float pv = __builtin_amdgcn_exp2f(S[i]); S[i] = pv; ps += pv; }
            l += ps;
            { f32x8_t pp;
#pragma unroll
              for (int i = 0; i < 8; ++i) pp[i] = S[i];
              const bf16x8 pf = __builtin_bit_cast(bf16x8, __builtin_convertvector(pp, nbf16x8));
              O0 = __builtin_amdgcn_mfma_f32_32x32x16_bf16(vf00, pf, O0, 0, 0, 0); O1 = __builtin_amdgcn_mfma_f32_32x32x16_bf16(vf10, pf, O1, 0, 0, 0); }
            { f32x8_t pp;
#pragma unroll
              for (int i = 0; i < 8; ++i) pp[i] = S[8 + i];
              const bf16x8 pf = __builtin_bit_cast(bf16x8, __builtin_convertvector(pp, nbf16x8));
              O0 = __builtin_amdgcn_mfma_f32_32x32x16_bf16(vf01, pf, O0, 0, 0, 0); O1 = __builtin_amdgcn_mfma_f32_32x32x16_bf16(vf11, pf, O1, 0, 0, 0); }
        }
#ifdef PRB_REP
        }
        const float sk2 = SINK ? *(const LAS float*)(F.lds + ATT_SINK_OFF + 4 * (hbase + g)) : 0.f;
#endif
        float lt = l + shx(l, 32, lane_);
        float osc = 1.0f;
        if (SINK) { const float mf = fmaxf(m, sk2); osc = __builtin_amdgcn_exp2f(m - mf); lt = lt * osc + __builtin_amdgcn_exp2f(sk2 - mf); }
        if (WRITE_LSE) { if (hh == 0) lse[qtok * 4] = m + __builtin_amdgcn_logf(lt); }
        const float inv = osc / lt;
        if (NH > 1 && g + 1 < g_hi) {
#pragma unroll
            for (int ks = 0; ks < 4; ++ks) qf[ks] = *(const bf16x8*)(qptr + 64 + 16 * ks + 8 * hh); }
        v2u WW[8];
#pragma unroll
        for (int g4 = 0; g4 < 4; ++g4) {
            WW[g4].x = pk2bf(O0[4 * g4] * inv, O0[4 * g4 + 1] * inv); WW[g4].y = pk2bf(O0[4 * g4 + 2] * inv, O0[4 * g4 + 3] * inv);
            WW[4 + g4].x = pk2bf(O1[4 * g4] * inv, O1[4 * g4 + 1] * inv); WW[4 + g4].y = pk2bf(O1[4 * g4 + 2] * inv, O1[4 * g4 + 3] * inv); }
#pragma unroll
        for (int s4 = 0; s4 < 4; ++s4) {
            v2u a = WW[2 * s4], b = WW[2 * s4 + 1];
            { const auto r = __builtin_amdgcn_permlane32_swap(a.x, b.x, false, false); a.x = r[0]; b.x = r[1]; }
            { const auto r = __builtin_amdgcn_permlane32_swap(a.y, b.y, false, false); a.y = r[0]; b.y = r[1]; }
            *(v4u*)(qptr + odelta + 16 * s4 + 8 * hh) = (v4u){a.x, a.y, b.x, b.y};
#ifdef PRB_ST2
            asm volatile("" ::: "memory");
            *(v4u*)(qptr + odelta + 16 * s4 + 8 * hh) = (v4u){a.x, a.y, b.x, b.y};
            asm volatile("" ::: "memory");
#endif
        }
    }
}
__device__ __forceinline__ ChunkP dil_chunk(const bf16* KA, const bf16* VA, int b, int hs, int sc) {
    const int grp = sc >> 3, ix = sc & 7, col = grp * 256 + hs * 64; ChunkP p; p.K = KA + col; p.V = VA + col; p.ldkv = 768;
    if (grp == 0) { p.tok0 = b * SEQ; p.cstep = 0; p.r = 1; p.L = 2048; p.nseg = 1; p.qs = 256; p.i0 = 256 * ix; }
    else if (grp == 1) { p.tok0 = b * SEQ + (ix >> 1); p.cstep = 0; p.r = 4; p.L = 512; p.nseg = 1; p.qs = 256; p.i0 = 256 * (ix & 1); }
    else { p.tok0 = b * SEQ + 2 * ix; p.cstep = 1; p.r = 16; p.L = 128; p.nseg = 2; p.qs = 128; p.i0 = 0; }
    return p;
}
__device__ __forceinline__ ChunkP win_chunk(const bf16* KW, const bf16* VW, int wc) {
    const int b = wc >> 5, kvh = (wc >> 3) & 3, ch = wc & 7; ChunkP p; p.K = KW + kvh * 64; p.V = VW + kvh * 64; p.ldkv = 256;
    p.tok0 = b * SEQ; p.cstep = 0; p.r = 1; p.L = SEQ; p.nseg = 1; p.qs = 256; p.i0 = 256 * ch; return p;
}
__device__ __forceinline__ void attention_phase(Frame& F, int l, long odA, long odW, int which = 3) {
    unsigned char* ws = P_WS;
    bf16* big = (bf16*)(ws + WS_BIG);
    bf16* QA = big + B_QA / 2; bf16* KA = big + B_KA / 2; bf16* VA = big + B_VA / 2; bf16* QW = big + B_QW / 2; bf16* KW = big + B_KW / 2; bf16* VW = big + B_VW / 2; bf16* OA = big + B_OA / 2;
    float* LSE = (float*)(ws + WS_LSE);
    const int c = blockIdx.x;
    int w_lo, w_hi;
    v4u kreg[8], vreg[2][4];
    bf16x8 qf[4];
#ifndef ATT_N1
#define ATT_N1 0
#endif
    static_assert(ATT_N1 == 0, "the dilated workgroups take no whole window chunks");
    if (c < 128) { w_lo = 8 * c + 7; w_hi = w_lo + 1; } else { w_lo = (c - 128) * 8; w_hi = w_lo + 8; }
    const int hd0 = (c < 128) ? 2 : 0;
    if (c < 128) { if (which & 1) {
        const int b = c >> 2, hs = c & 3;
        { const ChunkP p0 = dil_chunk(KA, VA, b, hs, 0); attn_issue<64>(p0, F.tid, kreg, vreg); attn_loadq(F, p0, QA + hs * 64, 768, qf); attn_commit<64>(F, p0, kreg, vreg); }
        __syncthreads();
#pragma unroll 1
        for (int sc = 0; sc < 24; ++sc) {
            const ChunkP p = dil_chunk(KA, VA, b, hs, sc); const int grp = sc >> 3;
            const int scn = sc + 1 < 24 ? sc + 1 : sc;
            const ChunkP pn = dil_chunk(KA, VA, b, hs, scn);
            bf16x8 qn[4];
            attn_issue<64>(pn, F.tid, kreg, vreg); attn_loadq(F, pn, QA + (scn >> 3) * 256 + hs * 64, 768, qn);
            const float slope1 = __builtin_amdgcn_exp2f(-8.0f * (float)(grp * 4 + hs + 1) / 12.0f) * (float)p.r * LOG2E;
            attn_compute<64, 1, false, true>(F, p, QA + grp * 256 + hs * 64, 768, odA, LSE + (size_t)grp * MTOK * 4 + hs, slope1, nullptr, 0, qf);
            __syncthreads();
            if (sc + 1 < 24) attn_commit<64>(F, pn, kreg, vreg);
            __syncthreads();
#pragma unroll
            for (int ks = 0; ks < 4; ++ks) qf[ks] = qn[ks];
        }
        VM_WAIT(); __syncthreads(); __builtin_amdgcn_fence(__ATOMIC_ACQUIRE, "agent"); VM_WAIT();
        constexpr int CB = 8;
#pragma unroll 1
        for (int t0 = F.tid; t0 < SEQ * 8; t0 += NWAVES * 64 * CB) {
            float lv[CB][3]; v4u av[CB][3];
#pragma unroll
            for (int k = 0; k < CB; ++k) { const int t = t0 + k * NWAVES * 64, tok = t >> 3, ch = t & 7; const size_t row = (size_t)b * SEQ + tok;
                lv[k][0] = LSE[row * 4 + hs]; lv[k][1] = LSE[(size_t)MTOK * 4 + row * 4 + hs]; lv[k][2] = LSE[(size_t)2 * MTOK * 4 + row * 4 + hs];
                const bf16* og = QA + odA + row * 768 + hs * 64 + ch * 8; av[k][0] = *(const v4u*)(og); av[k][1] = *(const v4u*)(og + 256); av[k][2] = *(const v4u*)(og + 512); }
            asm volatile("" ::: "memory");
#pragma unroll
            for (int k = 0; k < CB; ++k) { const int t = t0 + k * NWAVES * 64, tok = t >> 3, ch = t & 7; const size_t row = (size_t)b * SEQ + tok;
                const float mx = fmaxf(lv[k][0], fmaxf(lv[k][1], lv[k][2]));
                float w0 = __builtin_amdgcn_exp2f(lv[k][0] - mx), w1 = __builtin_amdgcn_exp2f(lv[k][1] - mx), w2 = __builtin_amdgcn_exp2f(lv[k][2] - mx);
                const float inv = 1.0f / (w0 + w1 + w2); w0 *= inv; w1 *= inv; w2 *= inv;
                v4u o;
#pragma unroll
                for (int w = 0; w < 4; ++w) o[w] = pk2bf(w0 * bflo(av[k][0][w]) + w1 * bflo(av[k][1][w]) + w2 * bflo(av[k][2][w]), w0 * bfhi(av[k][0][w]) + w1 * bfhi(av[k][1][w]) + w2 * bfhi(av[k][2][w]));
                *(v4u*)(OA + row * 256 + hs * 64 + ch * 8) = o; }
        }
    } }
    if (which & 2) {
        __syncthreads();
        if (F.tid < 16) *(LAS float*)(F.lds + ATT_SINK_OFF + 4 * F.tid) = P_IN(6)[l * 16 + F.tid] * LOG2E;
        const ChunkP p0 = win_chunk(KW, VW, w_lo); attn_issue<128>(p0, F.tid, kreg, vreg); attn_loadq(F, p0, QW + ((w_lo >> 3) & 3) * 256 + hd0 * 64, 1024, qf); attn_commit<128>(F, p0, kreg, vreg);
        __syncthreads();
    }
#pragma unroll 1
    for (int wc = w_lo; wc < ((which & 2) ? w_hi : w_lo); ++wc) {
        const ChunkP p = win_chunk(KW, VW, wc); const int kvh = (wc >> 3) & 3;
        const int wn = wc + 1 < w_hi ? wc + 1 : wc;
        const ChunkP pn = win_chunk(KW, VW, wn);
        bf16x8 qn[4];
        attn_issue<128>(pn, F.tid, kreg, vreg); attn_loadq(F, pn, QW + ((wn >> 3) & 3) * 256, 1024, qn);
        attn_compute<128, 4, true, false>(F, p, QW + kvh * 256, 1024, odW, nullptr, 0.f, nullptr, kvh * 4, qf, (c < 128) ? 2 : 0, (c >= 128 && wc + 1 == w_hi) ? 2 : 4);
        __syncthreads();
        if (wc + 1 < w_hi) attn_commit<128>(F, pn, kreg, vreg);
        __syncthreads();
#pragma unroll
        for (int ks = 0; ks < 4; ++ks) qf[ks] = qn[ks];
    }
}
#ifndef PH_A
#define PH_A 1
#endif
#ifndef PH_B
#define PH_B 1
#endif
#ifndef PH_C
#define PH_C 1
#endif
#ifndef PH_D
#define PH_D 1
#endif
#ifndef PH_E
#define PH_E 1
#endif
#ifndef PH_F
#define PH_F 1
#endif
#ifndef PH_G
#define PH_G 1
#endif
#ifndef PH_H
#define PH_H 1
#endif
#ifndef PH_I
#define PH_I 1
#endif
#ifndef PH_J
#define PH_J 1
#endif
#ifndef PH_Z
#define PH_Z 1
#endif

struct Args { const float* in[14]; float* out; unsigned char* ws; };
__global__ void __launch_bounds__(NWAVES * 64, 2) mk_fwd(Args args) {
    extern __shared__ __attribute__((aligned(16))) unsigned char lds_raw[];
    LAS unsigned char* const lds = (LAS unsigned char*)lds_raw;
    int wave_s = __builtin_amdgcn_readfirstlane((int)(threadIdx.x >> 6)); asm volatile("" : "+s"(wave_s));
    {
        const int t0 = wave_s * 64 + xb_lane();
        volatile LAS unsigned* MISC = (volatile LAS unsigned*)(lds + MISC_OFF);
        if (t0 < 32) MISC[t0] = 0u;
        if (t0 == 0) { volatile LAS unsigned long long* pt = (volatile LAS unsigned long long*)(lds + PTAB_OFF);
            pt[0] = (unsigned long long)args.in[0]; pt[1] = (unsigned long long)args.in[1]; pt[2] = (unsigned long long)args.in[2]; pt[3] = (unsigned long long)args.in[3];
            pt[4] = (unsigned long long)args.in[4]; pt[5] = (unsigned long long)args.in[5]; pt[6] = (unsigned long long)args.in[6]; pt[7] = (unsigned long long)args.in[7];
            pt[8] = (unsigned long long)args.in[8]; pt[9] = (unsigned long long)args.in[9]; pt[10] = (unsigned long long)args.in[10]; pt[11] = (unsigned long long)args.in[11];
            pt[12] = (unsigned long long)args.in[12]; pt[13] = (unsigned long long)args.in[13]; pt[14] = (unsigned long long)args.out; pt[15] = (unsigned long long)args.ws; }
        __syncthreads();
    }
    XcdBarrier bar = xcd_barrier_post((unsigned*)(args.ws + WS_CTL) + CW_BAR, (volatile LAS unsigned*)(lds + MISC_OFF) + 8, wave_s);
    const int G = 256;

#pragma unroll 1
    for (int l = 0; l < DEPTH; ++l) {
        int c = blockIdx.x; asm volatile("" : "+s"(c));
#if PH_A
        { Frame F = make_frame(lds, wave_s); convert_weights(F, l);
          unsigned char* ws = P_WS;
          if (l == 0) norm_rows<true, false, false>(F, P_IN(0), (bf16*)(ws + WS_HB), P_IN(1) + l * DM, (float*)(ws + WS_LSE), nullptr, ws + WS_HN);
          else norm_rows<false, true, false>(F, nullptr, (bf16*)(ws + WS_HB), P_IN(1) + l * DM, (float*)(ws + WS_LSE), nullptr, ws + WS_HN);
          }
#endif
        xcd_barrier(bar);
#if PH_B
        { Frame F = make_frame(lds, wave_s); unsigned char* ws = P_WS; bf16* big = (bf16*)(ws + WS_BIG);
          pg8::Gemm g8{(const bf16*)(ws + WS_HN), (const bf16*)(ws + WS_WIN), MTOK, INC, DM / 2}; pg8::StaticOrder S8; S8.init(MTOK, INC, G, c);
          pg8::EpiGate8 E8{big + B_G / 2, big + B_G / 2 + (size_t)MTOK * DM, P_IN(5) + l * 2048, big + B_QA / 2, big + B_KA / 2, big + B_VA / 2, big + B_QW / 2, big + B_KW / 2, big + B_VW / 2, QSCALE};
          pg8::gemm_phase<pg8::EpiGate8, pg8::StaticOrder, true, true, false, true>(F.tid, lds, g8, S8, E8); }
#endif
        xcd_barrier(bar);
#ifdef DUP_C
        { Frame F = make_frame(lds, wave_s); attention_phase(F, l, ((long)WS_HN - (long)(WS_BIG + B_QA)) / 2, ((long)WS_HN - (long)(WS_BIG + B_QW)) / 2, DUP_C); }
        xcd_barrier(bar);
#endif
#if PH_C
        { Frame F = make_frame(lds, wave_s); attention_phase(F, l, 0, 0); }
#endif
        xcd_barrier(bar);
#if PH_E
        { Frame F = make_frame(lds, wave_s); unsigned char* ws = P_WS; bf16* big = (bf16*)(ws + WS_BIG);
          pg8::Gemm g0{big + B_OA / 2, (const bf16*)(ws + WS_WA), MTOK, DM, 256}; pg8::Gemm g1{big + B_QW / 2, (const bf16*)(ws + WS_WB), MTOK, DM, DM}; pg8::StaticOrder S; S.init(MTOK, DM, G, c);
          pg8::EpiMergeDual E{(unsigned char*)(big + B_MERGED / 2), big + B_G / 2, big + B_G / 2 + (size_t)MTOK * DM};
          pg8::gemm_phase_dual<pg8::EpiMergeDual, pg8::StaticOrder>(F.tid, lds, g0, g1, S, E); }
#endif
        xcd_barrier(bar);
#if PH_F
        { Frame F = make_frame(lds, wave_s); unsigned char* ws = P_WS; bf16* big = (bf16*)(ws + WS_BIG); bf16* hb = (bf16*)(ws + WS_HB);
          pg8::Gemm g{big + B_MERGED / 2, (const bf16*)(ws + WS_WO), MTOK, DM, DM / 2}; pg8::StaticOrder S; S.init(MTOK, DM, G, c);
          pg8::EpiResid E{hb, hb};
          pg8::gemm_phase<pg8::EpiResid, pg8::StaticOrder, true, true, false, true>(F.tid, lds, g, S, E); }
#endif
        xcd_barrier(bar);
#if PH_G
        { Frame F = make_frame(lds, wave_s); unsigned char* ws = P_WS;
          norm_router(F, (const bf16*)(ws + WS_HB), P_IN(8) + l * DM, P_IN(9) + (size_t)l * DM * NE, (float*)(ws + WS_LSE), (float*)(ws + WS_AFF), ws + WS_HN); }
#endif
        xcd_barrier(bar);
#if PH_H
        { Frame F = make_frame(lds, wave_s); unsigned char* ws = P_WS;
          topk_gather(F, (const float*)(ws + WS_AFF), (const float*)(ws + WS_LSE), (int*)(ws + WS_SEL), (float*)(ws + WS_GATE), (int*)(ws + WS_IDX)); }
#endif
        xcd_barrier(bar);
#if PH_I
        { Frame F = make_frame(lds, wave_s); unsigned char* ws = P_WS; bf16* big = (bf16*)(ws + WS_BIG);
          pg8::Gemm g{(const bf16*)(ws + WS_HN), (const bf16*)(ws + WS_WGU), MEXP, NE * 2048, DM / 2}; pg8::GroupedOrder S; S.init(NE, NB, 8, G, c);
          pg8::EpiSwiGLU E{(unsigned char*)(big + B_ACT / 2), (const LAS int*)(lds + AROW_OFF), 0};
          { const int* idxg = (const int*)(ws + WS_IDX); LAS int* arow = (LAS int*)(lds + AROW_OFF);
            int rv[NE]; const int r = F.tid & 255;
#pragma unroll
            for (int i = 0; i < NE; ++i) { pg8::Unit u; u.pm = 0; u.pn = 0; S.next(i, u); rv[i] = u.pm; }
            asm volatile("" ::: "memory");
#pragma unroll
            for (int i = 0; i < NE; ++i) rv[i] = idxg[(size_t)rv[i] * 256 + r];
#pragma unroll
            for (int i = 0; i < NE; ++i) if (F.tid < 256) arow[i * 256 + r] = rv[i];
            __syncthreads(); }
          pg8::gemm_phase<pg8::EpiSwiGLU, pg8::GroupedOrder, true, true, true, true>(F.tid, lds, g, S, E, (const LAS int*)(lds + AROW_OFF)); }
#endif
        xcd_barrier(bar);
#if PH_J
        { Frame F = make_frame(lds, wave_s); unsigned char* ws = P_WS; bf16* big = (bf16*)(ws + WS_BIG);
          pg8::Gemm g{big + B_ACT / 2, (const bf16*)(ws + WS_WD), MEXP, NE * 1024, DEX / 2}; pg8::GroupedOrder S; S.init(NE, NB, 4, G, c);
          pg8::EpiDown E{(unsigned char*)(big + B_Y / 2), (const LAS float*)(lds + AROW_OFF), 0};
          { const float* gatev = (const float*)(ws + WS_GATE); LAS float* gl = (LAS float*)(lds + AROW_OFF);
            float gv[8]; int pmv[8]; const int r = F.tid & 255;
#pragma unroll
            for (int i = 0; i < 8; ++i) { pg8::Unit u; u.pm = 0; u.pn = 0; S.next(i, u); pmv[i] = u.pm; }
            asm volatile("" ::: "memory");
#pragma unroll
            for (int i = 0; i < 8; ++i) gv[i] = gatev[(size_t)pmv[i] * 256 + r];
#pragma unroll
            for (int i = 0; i < 8; ++i) if (F.tid < 256) gl[i * 256 + r] = gv[i];
            __syncthreads(); }
          pg8::gemm_phase<pg8::EpiDown, pg8::GroupedOrder, true, true, false, true>(F.tid, lds, g, S, E); }
#endif
        xcd_barrier(bar);
    }
#if PH_Z
    { Frame F = make_frame(lds, wave_s); unsigned char* ws = P_WS; norm_rows<false, true, true>(F, nullptr, (bf16*)(ws + WS_HB), P_IN(13), nullptr, P_OUT); }
#endif
}

extern "C" void kernel_launch(void* const* d_in, const int* in_sizes, int n_in, void* d_out, int out_size, void* d_ws, size_t ws_size, hipStream_t stream) {
    static int grid = 0;
    if (grid == 0) {
        if (n_in != 14 || out_size != MTOK * DM || ws_size < WS_END) { fprintf(stderr, "kernel_launch: unexpected shapes (n_in %d, out %d, ws %zu < %zu); nothing launched\n", n_in, out_size, ws_size, (size_t)WS_END); grid = -1; return; }
        int dev = 0, cus = 0, per_cu = 0;
        if (hipGetDevice(&dev) != hipSuccess || hipDeviceGetAttribute(&cus, hipDeviceAttributeMultiprocessorCount, dev) != hipSuccess) { grid = -1; return; }
        if (hipFuncSetAttribute((const void*)mk_fwd, hipFuncAttributeMaxDynamicSharedMemorySize, LDS_BYTES) != hipSuccess) { fprintf(stderr, "kernel_launch: hipFuncSetAttribute failed\n"); grid = -1; return; }
        if (hipOccupancyMaxActiveBlocksPerMultiprocessor(&per_cu, (const void*)mk_fwd, NWAVES * 64, LDS_BYTES) != hipSuccess || per_cu < 1) fprintf(stderr, "kernel_launch: occupancy query reports %d\n", per_cu);
        (void)hipGetLastError();
        grid = 256;
        if (cus != 256) fprintf(stderr, "kernel_launch: device has %d CUs, built for 256\n", cus);
    }
    if (grid < 0) return;
    (void)in_sizes;
    hipMemsetAsync((char*)d_ws + WS_CTL, 0, CTL_ZERO_BYTES, stream);
    Args a{};
    for (int i = 0; i < 14; ++i) a.in[i] = (const float*)d_in[i];
    a.out = (float*)d_out; a.ws = (unsigned char*)d_ws;
    hipLaunchKernelGGL(mk_fwd, dim3(grid), dim3(NWAVES * 64), LDS_BYTES, stream, a);
}
```
